# Optimizing an MI355X kernel written in HIP

```python
import jax
import jax.numpy as jnp
from jax import lax

D_MODEL = 1024
BATCH = 8
SEQ = 4096
DEPTH = 2

D_RNN = D_MODEL
D_POOL = D_MODEL
D_MIX = D_RNN + D_POOL
N_RNN_HEADS = 8
RNN_HEAD_DIM = D_RNN // N_RNN_HEADS
CONV_WIDTH = 4
LRU_C = 8.0
POOL_WINDOWS = (2, 4, 8, 16)
N_POOL_GROUPS = len(POOL_WINDOWS)
POOL_GROUP_DIM = D_POOL // N_POOL_GROUPS
NORM_EPS = 1e-6

kernel_name = "hybrid_rglru_multiscale_pool_parallel_heads"


def rmsnorm(x, g):
    xf = x.astype(jnp.float32)
    y = xf * lax.rsqrt(jnp.mean(xf * xf, axis=-1, keepdims=True) + NORM_EPS)
    return (y * g.astype(jnp.float32)).astype(x.dtype)


def causal_depthwise_conv(x, w, b):
    y = lax.conv_general_dilated(
        x, w[:, None, :].astype(x.dtype), window_strides=(1,),
        padding=[(CONV_WIDTH - 1, 0)],
        dimension_numbers=("NWC", "WIO", "NWC"),
        feature_group_count=x.shape[-1])
    return y + b


def rg_lru(x, w_a, b_a, w_x, b_x, lam):
    B, S, _ = x.shape
    xh = x.reshape(B, S, N_RNN_HEADS, RNN_HEAD_DIM)
    r = jax.nn.sigmoid(jnp.einsum("bshi,hij->bshj", xh, w_a) + b_a).reshape(B, S, D_RNN)
    i = jax.nn.sigmoid(jnp.einsum("bshi,hij->bshj", xh, w_x) + b_x).reshape(B, S, D_RNN)
    log_a = -LRU_C * r.astype(jnp.float32) * jax.nn.softplus(-lam.astype(jnp.float32))
    a = jnp.exp(log_a)
    mult = jnp.sqrt(-jnp.expm1(2.0 * log_a))
    u = mult * (i * x).astype(jnp.float32)

    def step(h, inp):
        a_t, u_t = inp
        h = a_t * h + u_t
        return h, h

    h0 = jnp.zeros((B, D_RNN), jnp.float32)
    _, hs = lax.scan(step, h0, (jnp.swapaxes(a, 0, 1), jnp.swapaxes(u, 0, 1)))
    return jnp.swapaxes(hs, 0, 1).astype(x.dtype)


def multi_scale_pool(x, w, b, scale):
    B, S, _ = x.shape
    xg = x.reshape(B, S, N_POOL_GROUPS, POOL_GROUP_DIM).astype(jnp.float32)
    cs = jnp.cumsum(xg, axis=1)
    t = jnp.arange(S)
    means = []
    for g, win in enumerate(POOL_WINDOWS):
        csg = cs[:, :, g]
        lagged = jnp.pad(csg, ((0, 0), (win, 0), (0, 0)))[:, :S]
        count = jnp.minimum(t + 1, win).astype(jnp.float32)[None, :, None]
        means.append((csg - lagged) / count)
    pooled = (jnp.stack(means, axis=2) - xg).astype(x.dtype)
    y = jnp.einsum("bsgi,gij->bsgj", pooled, w) + b
    return y.reshape(B, S, D_POOL) * scale


def setup_inputs(seed: int = 0) -> dict:
    key = jax.random.key(seed)
    ks = jax.random.split(key, 24)
    f32 = jnp.float32
    nrm = lambda k, shape, s: jax.random.normal(k, shape, f32) * s
    L = DEPTH
    x = jax.random.normal(ks[0], (BATCH, SEQ, D_MODEL), f32)
    c = jax.random.normal(ks[1], (BATCH, D_MODEL), f32)
    ada_w = nrm(ks[2], (L, D_MODEL, 3 * D_MODEL), 0.5 * D_MODEL ** -0.5)
    ada_b = nrm(ks[3], (L, 3 * D_MODEL), 0.01)
    pre_norm_g = 1.0 + nrm(ks[4], (L, D_MODEL), 0.05)
    w_in = nrm(ks[5], (L, D_MODEL, 2 * D_MIX), D_MODEL ** -0.5)
    conv_w = nrm(ks[6], (L, CONV_WIDTH, D_RNN), CONV_WIDTH ** -0.5)
    conv_b = nrm(ks[7], (L, D_RNN), 0.01)
    gate_a_w = nrm(ks[8], (L, N_RNN_HEADS, RNN_HEAD_DIM, RNN_HEAD_DIM), RNN_HEAD_DIM ** -0.5)
    gate_a_b = nrm(ks[9], (L, N_RNN_HEADS, RNN_HEAD_DIM), 0.01)
    gate_x_w = nrm(ks[10], (L, N_RNN_HEADS, RNN_HEAD_DIM, RNN_HEAD_DIM), RNN_HEAD_DIM ** -0.5)
    gate_x_b = nrm(ks[11], (L, N_RNN_HEADS, RNN_HEAD_DIM), 0.01)
    a_c = jax.random.uniform(ks[12], (L, D_RNN), f32, 0.9, 0.999)
    a0 = a_c ** (1.0 / LRU_C)
    lru_lambda = jnp.log(a0) - jnp.log1p(-a0)
    pool_w = nrm(ks[13], (L, N_POOL_GROUPS, POOL_GROUP_DIM, POOL_GROUP_DIM), POOL_GROUP_DIM ** -0.5)
    pool_b = nrm(ks[14], (L, N_POOL_GROUPS, POOL_GROUP_DIM), 0.01)
    pool_scale = jax.random.uniform(ks[15], (L, D_POOL), f32, 0.5, 1.5)
    w_out = nrm(ks[16], (L, D_MIX, D_MODEL), D_MIX ** -0.5)
    post_norm_g = 1.0 + nrm(ks[17], (L, D_MODEL), 0.05)
    return {"x": x, "c": c, "ada_w": ada_w, "ada_b": ada_b, "pre_norm_g": pre_norm_g,
            "w_in": w_in, "conv_w": conv_w, "conv_b": conv_b,
            "gate_a_w": gate_a_w, "gate_a_b": gate_a_b, "gate_x_w": gate_x_w, "gate_x_b": gate_x_b,
            "lru_lambda": lru_lambda, "pool_w": pool_w, "pool_b": pool_b, "pool_scale": pool_scale,
            "w_out": w_out, "post_norm_g": post_norm_g}


def reference(x, c, ada_w, ada_b, pre_norm_g, w_in, conv_w, conv_b,
              gate_a_w, gate_a_b, gate_x_w, gate_x_b, lru_lambda,
              pool_w, pool_b, pool_scale, w_out, post_norm_g):
    c_act = jax.nn.silu(c)
    for l in range(DEPTH):
        mod = c_act @ ada_w[l] + ada_b[l]
        shift, scale, gate = jnp.split(mod, 3, axis=-1)
        h = rmsnorm(x, pre_norm_g[l]) * (1.0 + scale[:, None, :]) + shift[:, None, :]
        proj = h @ w_in[l]
        x_rnn, g_rnn, x_pool, g_pool = jnp.split(
            proj, [D_RNN, 2 * D_RNN, 2 * D_RNN + D_POOL], axis=-1)
        u = causal_depthwise_conv(x_rnn, conv_w[l], conv_b[l])
        y_rnn = rg_lru(u, gate_a_w[l], gate_a_b[l], gate_x_w[l], gate_x_b[l],
                       lru_lambda[l]) * jax.nn.silu(g_rnn)
        y_pool = multi_scale_pool(x_pool, pool_w[l], pool_b[l], pool_scale[l]) * jax.nn.silu(g_pool)
        y = jnp.concatenate([y_rnn, y_pool], axis=-1) @ w_out[l]
        x = x + gate[:, None, :] * rmsnorm(y, post_norm_g[l])
    return x
```

```cpp
#include <hip/hip_runtime.h>
#include <hip/hip_cooperative_groups.h>
#include <cstdio>
#include <cstdint>
namespace cg = cooperative_groups;
__device__ __forceinline__ int opaque_tid() { int t = threadIdx.x; asm volatile("" : "+v"(t)); return t; }
namespace pg8 {
#define PG8_LAS __attribute__((address_space(3)))
typedef unsigned short bf16_t;
typedef short bf16x8 __attribute__((ext_vector_type(8)));
typedef float f32x4 __attribute__((ext_vector_type(4)));
typedef unsigned u32x4 __attribute__((ext_vector_type(4)));
constexpr int BM = 256, BK = 64, HALF = 128, HTB = HALF * BK * 2  , STAGE_BYTES = 8 * HTB, NXCD = 8, WGM = 8;

__host__ __device__ __forceinline__ int lds_byte(int r, int c) { const int st = (r >> 4) * 2 + (c >> 5), rr = r & 15, cc = c & 31, ob = rr * 64 + cc * 2; return st * 1024 + (ob ^ (((ob >> 9) & 1) << 5)); }
__host__ __device__ __forceinline__ void stage_rc(int b, int& R, int& C) { const int st = b / 1024, sb = b % 1024, swz = sb ^ (((sb >> 9) & 1) << 5); R = (st >> 1) * 16 + swz / 64; C = (st & 1) * 32 + (swz % 64) / 2; }
__host__ __device__ __forceinline__ int perm32(int rho) { const int n = rho >> 4, i = rho & 15; return 8 * (i >> 2) + 4 * n + (i & 3); }

struct Unit { int pm, pn; };
struct Gemm { const bf16_t* A; const bf16_t* Bt; int M, N, K; };

struct StaticOrder {
    int nM, nN, nwg, G, c;
    __host__ __device__ void init(int M, int N, int G_, int c_) { nM = M / BM; nN = N / BM; nwg = nM * nN; G = G_; c = c_; }
    __host__ __device__ bool next(int i, Unit& u) const {
        const long L = (long)i * G + c; if (L >= nwg) return false;
        int wgid = (int)L; { const int q = nwg / NXCD, r = nwg % NXCD, xcd = wgid % NXCD, off = wgid / NXCD; wgid = (xcd < r ? xcd * (q + 1) : r * (q + 1) + (xcd - r) * q) + off; }
        const int nig = WGM * nN, gid = wgid / nig, fm = gid * WGM, gsz = (nM - fm) < WGM ? (nM - fm) : WGM;
        u.pm = fm + ((wgid % nig) % gsz); u.pn = (wgid % nig) / gsz; return true;
    }
    __device__ __forceinline__ void a_ready(const Unit&) const {}
    __device__ __forceinline__ void done(const Unit&) const {}
};

__device__ __forceinline__ unsigned cvt_pk_bf16(float lo, float hi) { unsigned r; asm volatile("v_cvt_pk_bf16_f32 %0, %1, %2" : "=v"(r) : "v"(lo), "v"(hi)); return r; }
typedef float f32x2 __attribute__((ext_vector_type(2)));
__device__ __forceinline__ f32x2 gelu_pk(f32x2 v) {
    const f32x2 av = __builtin_elementwise_abs(v), d = av * 0.2316418882f + 1.0f;
    f32x2 t; t.x = __builtin_amdgcn_rcpf(d.x); t.y = __builtin_amdgcn_rcpf(d.y);
    f32x2 q = t * 0.5307027145f + (-0.7265760135f); q = q * t + 0.7107068705f; q = q * t + (-0.142248368f); q = q * t + 0.127414796f; q = q * t;
    const f32x2 s = (v * v) * (-0.72134752044f);
    f32x2 e; e.x = __builtin_amdgcn_exp2f(s.x); e.y = __builtin_amdgcn_exp2f(s.y);
    const f32x2 m = v * (q * e), r = v - m;
    f32x2 o; o.x = v.x < 0.f ? m.x : r.x; o.y = v.y < 0.f ? m.y : r.y; return o;
}

template <int ACT  > struct EpiBf16 {
    static constexpr bool PERM = true, AFTER_DRAIN = false; static_assert(ACT == 0 || ACT == 1, "EpiBf16: ACT is 0 (none) or 1 (gelu_pk)");
    bf16_t* O; int ldc; const float* bias; int split_cols; size_t split_stride; float scale0;
    __device__ __forceinline__ void operator()(const f32x4 (&acc)[2][2][4][2], const Unit& u, int wr, int wc, int fr, int fq) const {
        const int row0 = u.pm * BM + wr * 64 + fr; int colt = u.pn * BM; bf16_t* base = O;
        float sc = 1.f; if (split_cols) { const int t = colt / split_cols; base += (size_t)t * split_stride; colt -= t * split_cols; if (t == 0) sc = scale0; }
        const int col0 = colt + wc * 32 + 8 * fq, bcol0 = u.pn * BM + wc * 32 + 8 * fq;
        f32x4 bv[2][2];
#pragma unroll
        for (int bj = 0; bj < 2; ++bj)
#pragma unroll
            for (int n = 0; n < 2; ++n) bv[bj][n] = bias ? *(const f32x4*)(bias + bcol0 + bj * HALF + 4 * n) : (f32x4){0.f, 0.f, 0.f, 0.f};
#pragma unroll
        for (int ai = 0; ai < 2; ++ai)
#pragma unroll
            for (int m = 0; m < 4; ++m) { bf16_t* rowp = base + (size_t)(row0 + ai * HALF + m * 16) * ldc + col0;
#pragma unroll
                for (int bj = 0; bj < 2; ++bj) { f32x4 v0 = acc[ai][bj][m][0] + bv[bj][0], v1 = acc[ai][bj][m][1] + bv[bj][1];
                    if (ACT == 1) { f32x2 a = gelu_pk((f32x2){v0[0], v0[1]}), b = gelu_pk((f32x2){v0[2], v0[3]}), c = gelu_pk((f32x2){v1[0], v1[1]}), d = gelu_pk((f32x2){v1[2], v1[3]});
                        v0 = (f32x4){a.x, a.y, b.x, b.y}; v1 = (f32x4){c.x, c.y, d.x, d.y}; }
                    v0 = v0 * sc; v1 = v1 * sc; u32x4 w; w.x = cvt_pk_bf16(v0[0], v0[1]); w.y = cvt_pk_bf16(v0[2], v0[3]); w.z = cvt_pk_bf16(v1[0], v1[1]); w.w = cvt_pk_bf16(v1[2], v1[3]);
                    *(u32x4*)(rowp + bj * HALF) = w; } }
    }
};
template <class Epi, class Sched, bool ALIGN_EPI = false, bool SP2 = false>
__device__ __forceinline__ void gemm_phase(PG8_LAS unsigned char* lds, const Gemm g, const Sched& S, const Epi& E) {
    const int tid = opaque_tid(), wid = __builtin_amdgcn_readfirstlane(tid >> 6), lane = tid & 63, wr = wid >> 2, wc = wid & 3, fr = lane & 15, fq = lane >> 4;
    const int K = g.K, nt = K / BK;
    unsigned voffA[2], voffB[2];
#pragma unroll
    for (int i = 0; i < 2; ++i) { int R, C; stage_rc(tid * 16 + i * 8192, R, C); const int Rb = Epi::PERM ? ((R & ~31) + perm32(R & 31)) : R;
        voffA[i] = (unsigned)(R * K + C) * 2u; voffB[i] = (unsigned)(Rb * K + C) * 2u; }
    const size_t kstep = (size_t)(BK * 2);
    const size_t hstep = (size_t)HALF * K * 2;
    const size_t tstep = 2 * hstep;
    const unsigned ldsw = (unsigned)wid * 1024u;
    const int aoff = lds_byte(wr * 64 + fr, fq * 8), boff = lds_byte(wc * 32 + fr, fq * 8);
#define PG8_SA(b, h) (((b) * 2 + (h)) * HTB)
#define PG8_SB(b, h) ((4 + (b) * 2 + (h)) * HTB)
#define PG8_STAGE(bufoff, gbase, voff) do { _Pragma("unroll") for (int _i = 0; _i < 2; ++_i) \
        __builtin_amdgcn_global_load_lds((const unsigned*)((const char*)(gbase) + (voff)[_i]), (PG8_LAS unsigned*)(lds + (bufoff) + ldsw + _i * 8192), 16, 0, 0); } while (0)
#define PG8_LDA(dst, b, h) do { _Pragma("unroll") for (int m = 0; m < 4; ++m) _Pragma("unroll") for (int k = 0; k < 2; ++k) dst[m][k] = *(const PG8_LAS bf16x8*)(lds + PG8_SA(b, h) + aoff + m * 2048 + k * 1024); } while (0)
#define PG8_LDB(dst, b, h) do { _Pragma("unroll") for (int n = 0; n < 2; ++n) _Pragma("unroll") for (int k = 0; k < 2; ++k) dst[n][k] = *(const PG8_LAS bf16x8*)(lds + PG8_SB(b, h) + boff + n * 2048 + k * 1024); } while (0)
#define PG8_MMA(ai, bj, At, Bt) do { __builtin_amdgcn_s_setprio(1); _Pragma("unroll") for (int m = 0; m < 4; ++m) _Pragma("unroll") for (int n = 0; n < 2; ++n) _Pragma("unroll") for (int k = 0; k < 2; ++k) \
        acc[ai][bj][m][n] = __builtin_amdgcn_mfma_f32_16x16x32_bf16(Bt[n][k], At[m][k], acc[ai][bj][m][n], 0, 0, 0); __builtin_amdgcn_s_setprio(0); } while (0)
#define PG8_WAIT_V(n) asm volatile("s_waitcnt vmcnt(" #n ")" ::: "memory")
#define PG8_WAIT_L(n) asm volatile("s_waitcnt lgkmcnt(" #n ")" ::: "memory")
#define PG8_BAR __builtin_amdgcn_s_barrier()
#define PG8_SCHED __builtin_amdgcn_sched_barrier(0)
    Unit cur, nxt; int ui = 0;
    if (!S.next(0, cur)) return;
    f32x4 acc[2][2][4][2];
#pragma unroll
    for (int a = 0; a < 2; ++a)
#pragma unroll
        for (int b = 0; b < 2; ++b)
#pragma unroll
            for (int m = 0; m < 4; ++m)
#pragma unroll
                for (int n = 0; n < 2; ++n) acc[a][b][m][n] = (f32x4){0.f, 0.f, 0.f, 0.f};
    bf16x8 At[4][2], B0[2][2], B1[2][2];
    const char* cA = (const char*)g.A + (size_t)cur.pm * tstep; const char* cB = (const char*)g.Bt + (size_t)cur.pn * tstep;
    S.a_ready(cur);
    if constexpr (SP2) {
        PG8_STAGE(PG8_SB(0, 0), cB, voffB); PG8_STAGE(PG8_SB(0, 1), cB + hstep, voffB); PG8_STAGE(PG8_SA(0, 0), cA, voffA); PG8_STAGE(PG8_SA(0, 1), cA + hstep, voffA);
        if (wr == 1) PG8_BAR;
        PG8_WAIT_V(2); PG8_BAR;
        PG8_STAGE(PG8_SB(1, 0), cB + kstep, voffB); PG8_STAGE(PG8_SA(1, 0), cA + kstep, voffA); PG8_STAGE(PG8_SB(1, 1), cB + hstep + kstep, voffB);
        PG8_WAIT_V(6); PG8_BAR;
    } else {
        PG8_STAGE(PG8_SB(0, 0), cB, voffB); PG8_STAGE(PG8_SA(0, 0), cA, voffA); PG8_STAGE(PG8_SB(0, 1), cB + hstep, voffB); PG8_STAGE(PG8_SA(0, 1), cA + hstep, voffA);
        if (wr == 1) PG8_BAR;
        PG8_WAIT_V(4); PG8_BAR;
        PG8_STAGE(PG8_SB(1, 0), cB + kstep, voffB); PG8_STAGE(PG8_SA(1, 0), cA + kstep, voffA); PG8_STAGE(PG8_SB(1, 1), cB + hstep + kstep, voffB);
        PG8_WAIT_V(6); PG8_BAR;
    }
    for (;;) {
        const bool has_next = S.next(ui + 1, nxt);
        const char* nA = has_next ? (const char*)g.A + (size_t)nxt.pm * tstep : cA; const char* nB = has_next ? (const char*)g.Bt + (size_t)nxt.pn * tstep : cB;
        for (int t = 0; t < nt; t += 2) {
            const bool last = (t == nt - 2);
            const char* a1 = cA + (size_t)(t + 1) * kstep;
            const char* a2 = last ? nA : cA + (size_t)(t + 2) * kstep; const char* b2 = last ? nB : cB + (size_t)(t + 2) * kstep;
            const char* a3 = a2 + kstep; const char* b3 = b2 + kstep;
            if (last && has_next) S.a_ready(nxt);
            if constexpr (SP2) {
            PG8_LDB(B0, 0, 0); PG8_LDB(B1, 0, 1); PG8_SCHED; PG8_LDA(At, 0, 0); PG8_STAGE(PG8_SA(1, 1), a1 + hstep, voffA);
            PG8_WAIT_V(8); PG8_WAIT_L(0); PG8_BAR; PG8_MMA(0, 0, At, B0); PG8_MMA(0, 1, At, B1); PG8_BAR; PG8_SCHED;
            PG8_LDA(At, 0, 1); PG8_STAGE(PG8_SB(0, 0), b2, voffB); PG8_STAGE(PG8_SB(0, 1), b2 + hstep, voffB); PG8_STAGE(PG8_SA(0, 0), a2, voffA);
            PG8_WAIT_V(8); PG8_WAIT_L(0); PG8_BAR; PG8_MMA(1, 0, At, B0); PG8_MMA(1, 1, At, B1); PG8_BAR; PG8_SCHED;
            PG8_LDB(B0, 1, 0); PG8_LDB(B1, 1, 1); PG8_SCHED; PG8_LDA(At, 1, 0); PG8_STAGE(PG8_SA(0, 1), a2 + hstep, voffA);
            PG8_WAIT_V(8); PG8_WAIT_L(0); PG8_BAR; PG8_MMA(0, 0, At, B0); PG8_MMA(0, 1, At, B1); PG8_BAR; PG8_SCHED;
            PG8_LDA(At, 1, 1); PG8_STAGE(PG8_SB(1, 0), b3, voffB); PG8_STAGE(PG8_SB(1, 1), b3 + hstep, voffB); PG8_STAGE(PG8_SA(1, 0), a3, voffA);
            PG8_WAIT_V(8); PG8_WAIT_L(0); PG8_BAR; PG8_MMA(1, 0, At, B0); PG8_MMA(1, 1, At, B1); PG8_BAR; PG8_SCHED;
            } else {
            PG8_LDB(B0, 0, 0); PG8_SCHED; PG8_LDA(At, 0, 0); PG8_STAGE(PG8_SA(1, 1), a1 + hstep, voffA);
            PG8_WAIT_L(8); PG8_BAR; PG8_WAIT_L(0); PG8_MMA(0, 0, At, B0); PG8_BAR; PG8_SCHED;
            PG8_LDB(B1, 0, 1); PG8_STAGE(PG8_SB(0, 0), b2, voffB);
            PG8_BAR; PG8_WAIT_L(0); PG8_MMA(0, 1, At, B1); PG8_BAR;
            PG8_LDA(At, 0, 1); PG8_STAGE(PG8_SA(0, 0), a2, voffA);
            PG8_BAR; PG8_WAIT_L(0); PG8_MMA(1, 0, At, B0); PG8_BAR; PG8_SCHED;
            PG8_STAGE(PG8_SB(0, 1), b2 + hstep, voffB);
            PG8_WAIT_V(6); PG8_BAR; PG8_MMA(1, 1, At, B1); PG8_BAR;
            PG8_LDB(B0, 1, 0); PG8_SCHED; PG8_LDA(At, 1, 0); PG8_STAGE(PG8_SA(0, 1), a2 + hstep, voffA);
            PG8_WAIT_L(8); PG8_BAR; PG8_WAIT_L(0); PG8_MMA(0, 0, At, B0); PG8_BAR; PG8_SCHED;
            PG8_LDB(B1, 1, 1); PG8_STAGE(PG8_SB(1, 0), b3, voffB);
            PG8_BAR; PG8_WAIT_L(0); PG8_MMA(0, 1, At, B1); PG8_BAR;
            PG8_LDA(At, 1, 1); PG8_STAGE(PG8_SA(1, 0), a3, voffA);
            PG8_BAR; PG8_WAIT_L(0); PG8_MMA(1, 0, At, B0); PG8_BAR; PG8_SCHED;
            PG8_STAGE(PG8_SB(1, 1), b3 + hstep, voffB);
            PG8_WAIT_V(6); PG8_BAR; PG8_MMA(1, 1, At, B1); PG8_BAR;
            }
        }
        if constexpr (ALIGN_EPI) { if (wr == 0) PG8_BAR; }
        if constexpr (!Epi::AFTER_DRAIN) { E(acc, cur, wr, wc, fr, fq); S.done(cur); }
        if (!has_next) break;
#pragma unroll
        for (int a = 0; a < 2; ++a)
#pragma unroll
            for (int b = 0; b < 2; ++b)
#pragma unroll
                for (int m = 0; m < 4; ++m)
#pragma unroll
                    for (int n = 0; n < 2; ++n) acc[a][b][m][n] = (f32x4){0.f, 0.f, 0.f, 0.f};
        cur = nxt; cA = nA; cB = nB; ++ui;
        if constexpr (ALIGN_EPI) { if (wr == 1) PG8_BAR; }
    }
    PG8_WAIT_V(0);
    if constexpr (!ALIGN_EPI) { if (wr == 0) PG8_BAR; }
    PG8_BAR;
    if constexpr (Epi::AFTER_DRAIN) { E.fused(acc, cur, wr, wc, fr, fq, lds, wid, lane); S.done(cur); }
#undef PG8_SA
#undef PG8_SB
#undef PG8_STAGE
#undef PG8_LDA
#undef PG8_LDB
#undef PG8_MMA
#undef PG8_WAIT_V
#undef PG8_WAIT_L
#undef PG8_BAR
#undef PG8_SCHED
}
}
#ifndef PG8_SP2
#define PG8_SP2 true
#endif
#ifndef PG8_ALIGN
#define PG8_ALIGN true
#endif
#ifndef MK_N_LAUNCHES
#define MK_N_LAUNCHES 1
#endif

constexpr int NB = 8, SEQ = 4096, D = 1024, T = NB * SEQ, NPROJ = 4096, DMIX = 2048;
constexpr int NPH = 10;
constexpr float EPS = 1e-6f;
constexpr size_t MiB = 1u << 20;
constexpr size_t WS_WIN = 0, WS_WOUT = 16 * MiB, WS_GW = 24 * MiB, WS_PW = 25 * MiB, WS_MOD = 26 * MiB;
constexpr size_t WS_H = 32 * MiB, WS_YCAT = 96 * MiB, WS_PROJ = 224 * MiB, WS_Y = WS_PROJ, WS_END = 480 * MiB;
constexpr int LDS_BYTES = 147456;

#define LAS __attribute__((address_space(3)))
typedef unsigned short bf16;
typedef float f32x4 __attribute__((ext_vector_type(4)));
typedef unsigned u32x4 __attribute__((ext_vector_type(4)));
typedef unsigned u32x2 __attribute__((ext_vector_type(2)));
typedef short bf16x8 __attribute__((ext_vector_type(8)));

struct Args { const float* in[18]; float* out; unsigned char* ws; int ph_lo, ph_hi; };

__device__ __forceinline__ unsigned pk2(float lo, float hi) { return pg8::cvt_pk_bf16(lo, hi); }
__device__ __forceinline__ float bflo(unsigned w) { return __uint_as_float(w << 16); }
__device__ __forceinline__ float bfhi(unsigned w) { return __uint_as_float(w & 0xffff0000u); }
__device__ __forceinline__ float wave_sum(float v) {
#pragma unroll
    for (int o = 1; o < 64; o <<= 1) v += __shfl_xor(v, o);
    return v;
}
__device__ __forceinline__ float sigmoidf_(float x) { return 1.0f / (1.0f + __expf(-x)); }
__device__ __forceinline__ float siluf_(float x) { return x / (1.0f + __expf(-x)); }

__device__ __forceinline__ void transpose_item(const float* W, int K, int N, bf16* WT, LAS float* scr, int item, int lane) {
    const int nblk = N / 32, kb = item / nblk, nb = item % nblk, k0 = 64 * kb, n0 = 32 * nb;
#pragma unroll 8
    for (int i = 0; i < 32; ++i) { const int kk = 2 * i + (lane >> 5); scr[kk * 33 + (lane & 31)] = W[(size_t)(k0 + kk) * N + n0 + (lane & 31)]; }
    asm volatile("s_waitcnt lgkmcnt(0)" ::: "memory");
    const int c = lane & 7;
#pragma unroll
    for (int j = 0; j < 4; ++j) { const int n = (lane >> 3) + 8 * j; const LAS float* s = scr + (8 * c) * 33 + n;
        u32x4 o; o.x = pk2(s[0 * 33], s[1 * 33]); o.y = pk2(s[2 * 33], s[3 * 33]); o.z = pk2(s[4 * 33], s[5 * 33]); o.w = pk2(s[6 * 33], s[7 * 33]);
        *(u32x4*)(WT + (size_t)(n0 + n) * K + k0 + 8 * c) = o; }
    asm volatile("s_waitcnt lgkmcnt(0)" ::: "memory");
}

__device__ __forceinline__ void phase_prep(const Args& a, LAS unsigned char* lds) {
    const int tid = opaque_tid(), lane = tid & 63, wv = tid >> 6;
    const int G = gridDim.x;
    unsigned char* ws = a.ws;
    {
        LAS float* sc = (LAS float*)lds;
        LAS float* red = (LAS float*)(lds + 32768);
        const float* c = a.in[1]; const float* ada_w = a.in[2]; const float* ada_b = a.in[3];
        float* MOD = (float*)(ws + WS_MOD);
        if ((int)blockIdx.x < 192) {
            for (int i = tid; i < 8192; i += 512) sc[i] = siluf_(c[i]);
            __syncthreads();
            for (int unit = blockIdx.x; unit < 192; unit += G) {
                const int l = unit / 96, cb = (unit % 96) * 32, cl = tid & 31, ks = tid >> 5;
                const float* wp = ada_w + (size_t)l * 1024 * 3072 + (size_t)(ks * 64) * 3072 + cb + cl;
                float acc[8];
#pragma unroll
                for (int b = 0; b < 8; ++b) acc[b] = 0.f;
#pragma unroll 4
                for (int k = 0; k < 64; ++k) { const float w = wp[(size_t)k * 3072];
#pragma unroll
                    for (int b = 0; b < 8; ++b) acc[b] += sc[b * 1024 + ks * 64 + k] * w; }
#pragma unroll
                for (int b = 0; b < 8; ++b) red[(ks * 8 + b) * 32 + cl] = acc[b];
                __syncthreads();
                if (tid < 256) { const int b = tid >> 5; float s = 0.f;
#pragma unroll
                    for (int k2 = 0; k2 < 16; ++k2) s += red[(k2 * 8 + b) * 32 + cl];
                    MOD[(l * 8 + b) * 3072 + cb + cl] = s + ada_b[l * 3072 + cb + cl]; }
                __syncthreads();
            }
        }
        __syncthreads();
    }
    {
        LAS float* scr = (LAS float*)(lds + wv * 16384);
        const int gw = blockIdx.x * 8 + wv, NGW = G * 8;
        constexpr int I_IN = (1024 / 64) * (4096 / 32), I_OUT = (2048 / 64) * (1024 / 32);
        for (int it = gw; it < 2 * (I_IN + I_OUT); it += NGW) {
            int r = it;
            if (r < 2 * I_IN) { const int l = r / I_IN; r -= l * I_IN;
                transpose_item(a.in[5] + (size_t)l * 1024 * 4096, 1024, 4096, (bf16*)(ws + WS_WIN) + (size_t)l * 4096 * 1024, scr, r, lane); }
            else { r -= 2 * I_IN; const int l = r / I_OUT; r -= l * I_OUT;
                transpose_item(a.in[16] + (size_t)l * 2048 * 1024, 2048, 1024, (bf16*)(ws + WS_WOUT) + (size_t)l * 1024 * 2048, scr, r, lane); }
        }
    }
    {
        const size_t gt = (size_t)blockIdx.x * 512 + tid, GT = (size_t)G * 512;
        bf16* GWp = (bf16*)(ws + WS_GW); bf16* PWp = (bf16*)(ws + WS_PW);
        const float* ga = a.in[8]; const float* gx = a.in[10]; const float* pw = a.in[13];
        for (size_t i = gt; i < (size_t)2 * 8 * 4 * 64 * 128; i += GT) {
            const int k = (int)(i & 127), n = (int)((i >> 7) & 63), q = (int)((i >> 13) & 3), lh = (int)(i >> 15);
            const float v = (n < 32) ? ga[((size_t)lh * 128 + k) * 128 + q * 32 + n] : gx[((size_t)lh * 128 + k) * 128 + q * 32 + n - 32];
            GWp[i] = (bf16)(pk2(v, 0.f) & 0xffffu);
        }
        for (size_t i = gt; i < (size_t)2 * 4 * 256 * 256; i += GT) {
            const int k = (int)(i & 255), n = (int)((i >> 8) & 255), lg = (int)(i >> 16);
            const float v = pw[((size_t)lg * 256 + k) * 256 + n];
            PWp[i] = (bf16)(pk2(v, 0.f) & 0xffffu);
        }
    }
}

__device__ __forceinline__ void phase_h0(const Args& a) {
    const int tid = opaque_tid(), lane = tid & 63, wv = tid >> 6;
    const int gw = blockIdx.x * 8 + wv, NGW = gridDim.x * 8;
    const float* x = a.in[0]; const float* g = a.in[4]; const float* MOD = (const float*)(a.ws + WS_MOD);
    bf16* H = (bf16*)(a.ws + WS_H);
    for (int m = gw; m < T; m += NGW) {
        const int b = m >> 12;
        const f32x4* xr = (const f32x4*)(x + (size_t)m * D) + lane;
        f32x4 v[4]; float ss = 0.f;
#pragma unroll
        for (int j = 0; j < 4; ++j) { v[j] = xr[64 * j]; ss += (v[j].x * v[j].x + v[j].y * v[j].y) + (v[j].z * v[j].z + v[j].w * v[j].w); }
        const float rstd = 1.0f / sqrtf(wave_sum(ss) * (1.0f / D) + EPS);
        const float* sh = MOD + (size_t)b * 3072; const float* scl = sh + 1024;
        u32x2* o = (u32x2*)(H + (size_t)m * D) + lane;
#pragma unroll
        for (int j = 0; j < 4; ++j) { const int col = 4 * lane + 256 * j;
            const f32x4 gg = *(const f32x4*)(g + col), s4 = *(const f32x4*)(scl + col), h4 = *(const f32x4*)(sh + col);
            const f32x4 r = v[j] * rstd * gg * (s4 + 1.0f) + h4;
            u32x2 w; w.x = pk2(r.x, r.y); w.y = pk2(r.z, r.w); o[64 * j] = w; }
    }
}

__device__ __forceinline__ void phase_post(const Args& a, int l) {
    const int tid = opaque_tid(), lane = tid & 63, wv = tid >> 6;
    const int gw = blockIdx.x * 8 + wv, NGW = gridDim.x * 8;
    const float* xin = (l == 0) ? a.in[0] : a.out; float* out = a.out;
    const bf16* Y = (const bf16*)(a.ws + WS_Y); bf16* H = (bf16*)(a.ws + WS_H);
    const float* MOD = (const float*)(a.ws + WS_MOD);
    const float* gpost = a.in[17] + l * D; const float* gpre = a.in[4] + (l + 1) * D;
    for (int m = gw; m < T; m += NGW) {
        const int b = m >> 12;
        const f32x4* xr = (const f32x4*)(xin + (size_t)m * D) + lane;
        const u32x2* yr = (const u32x2*)(Y + (size_t)m * D) + lane;
        f32x4 xv[4], yv[4]; float ss = 0.f;
#pragma unroll
        for (int j = 0; j < 4; ++j) { xv[j] = xr[64 * j]; const u32x2 w = yr[64 * j]; yv[j] = (f32x4){bflo(w.x), bfhi(w.x), bflo(w.y), bfhi(w.y)};
            ss += (yv[j].x * yv[j].x + yv[j].y * yv[j].y) + (yv[j].z * yv[j].z + yv[j].w * yv[j].w); }
        const float rstd = 1.0f / sqrtf(wave_sum(ss) * (1.0f / D) + EPS);
        const float* gate = MOD + (size_t)(l * 8 + b) * 3072 + 2048;
        float ss2 = 0.f;
#pragma unroll
        for (int j = 0; j < 4; ++j) { const int col = 4 * lane + 256 * j;
            const f32x4 gp = *(const f32x4*)(gpost + col), gt = *(const f32x4*)(gate + col);
            xv[j] = xv[j] + gt * (yv[j] * rstd * gp);
            *((f32x4*)(out + (size_t)m * D + col)) = xv[j];
            ss2 += (xv[j].x * xv[j].x + xv[j].y * xv[j].y) + (xv[j].z * xv[j].z + xv[j].w * xv[j].w); }
        if (l == 0) {
            const float rstd2 = 1.0f / sqrtf(wave_sum(ss2) * (1.0f / D) + EPS);
            const float* sh = MOD + (size_t)(8 + b) * 3072; const float* scl = sh + 1024;
            u32x2* o = (u32x2*)(H + (size_t)m * D) + lane;
#pragma unroll
            for (int j = 0; j < 4; ++j) { const int col = 4 * lane + 256 * j;
                const f32x4 gg = *(const f32x4*)(gpre + col), s4 = *(const f32x4*)(scl + col), h4 = *(const f32x4*)(sh + col);
                const f32x4 r = xv[j] * rstd2 * gg * (s4 + 1.0f) + h4;
                u32x2 w; w.x = pk2(r.x, r.y); w.y = pk2(r.z, r.w); o[64 * j] = w; }
        }
    }
}
constexpr int XROW = 272;
constexpr int R_XT = 0, R_UT = 35840, R_A = 70656, R_V = 87040, R_SEGP = 103424, R_SEGH = 105472, R_HC = 107520, R_EP = 107776, R_CWT = 108800, R_WG = 111360;
__device__ __forceinline__ void rnn_unit(const Args& a, int l, int u, LAS unsigned char* lds) {
    const int tid = opaque_tid(), lane = tid & 63, wv = tid >> 6, fr = lane & 15, fq = lane >> 4;
    const int xcd = u & 7, jj = u >> 3, q = jj & 3, bh = (jj >> 2) * 8 + xcd, b = bh >> 3, h = bh & 7;
    const bf16* PROJ = (const bf16*)(a.ws + WS_PROJ); bf16* YCAT = (bf16*)(a.ws + WS_YCAT);
    const bf16* xr_base = PROJ + (size_t)(b * SEQ) * NPROJ + h * 128;
    const bf16* gr_base = PROJ + (size_t)(b * SEQ) * NPROJ + 1024 + h * 128 + q * 32;
    bf16* y_base = YCAT + (size_t)(b * SEQ) * DMIX + h * 128 + q * 32;
    LAS unsigned char* XT = lds + R_XT; LAS unsigned char* UT = lds + R_UT;
    LAS float* As = (LAS float*)(lds + R_A); LAS float* Vs = (LAS float*)(lds + R_V);
    LAS float* SEGP = (LAS float*)(lds + R_SEGP); LAS float* SEGH = (LAS float*)(lds + R_SEGH);
    LAS float* HC = (LAS float*)(lds + R_HC); LAS float* EP = (LAS float*)(lds + R_EP);
    LAS unsigned char* WG = lds + R_WG;
    {
        const bf16* gw = (const bf16*)(a.ws + WS_GW) + (size_t)((l * 8 + h) * 4 + q) * 64 * 128;
#pragma unroll
        for (int i = 0; i < 2; ++i) { const int id = tid + 512 * i, row = id >> 4, cc = id & 15; *(LAS u32x4*)(WG + row * XROW + cc * 16) = *(const u32x4*)(gw + row * 128 + cc * 8); }
    }
    const int ck = tid & 15, tg = tid >> 4;
    LAS float* CWT = (LAS float*)(lds + R_CWT);
    for (int i = tid; i < 640; i += 512) { const int r = i >> 7, c = i & 127;
        CWT[i] = (r < 4) ? a.in[6][(size_t)l * 4 * 1024 + r * 1024 + h * 128 + c] : a.in[7][(size_t)l * 1024 + h * 128 + c]; }
    if (tid < 256) {
        const int r = tid >> 5, c = tid & 31, ch = h * 128 + q * 32 + c; float v;
        if (r < 4) v = a.in[6][(size_t)l * 4 * 1024 + r * 1024 + ch];
        else if (r == 4) v = a.in[7][l * 1024 + ch];
        else if (r == 5) v = a.in[9][l * 1024 + ch];
        else if (r == 6) v = a.in[11][l * 1024 + ch];
        else v = 8.0f * log1pf(expf(-a.in[12][l * 1024 + ch]));
        EP[r * 32 + c] = v;
    }
    if (tid < 64) HC[tid] = 0.f;
    u32x4 pf[4], pfh = (u32x4){0u, 0u, 0u, 0u};
#pragma unroll
    for (int i = 0; i < 4; ++i) { const int id = tid + 512 * i, row = id >> 4, cc = id & 15; pf[i] = *(const u32x4*)(xr_base + (size_t)row * NPROJ + cc * 8); }
    const int sc_c = tid & 31, sc_sg = tid >> 5;
    for (int tile = 0; tile < SEQ / 128; ++tile) {
        const int t0 = tile * 128;
#pragma unroll
        for (int i = 0; i < 4; ++i) { const int id = tid + 512 * i, row = id >> 4, cc = id & 15; *(LAS u32x4*)(XT + (3 + row) * XROW + cc * 16) = pf[i]; }
        if (tid < 48) *(LAS u32x4*)(XT + (tid >> 4) * XROW + (tid & 15) * 16) = pfh;
        __syncthreads();
        if (tile + 1 < SEQ / 128) {
#pragma unroll
            for (int i = 0; i < 4; ++i) { const int id = tid + 512 * i, row = id >> 4, cc = id & 15; pf[i] = *(const u32x4*)(xr_base + (size_t)(t0 + 128 + row) * NPROJ + cc * 8); }
            if (tid < 48) pfh = *(const u32x4*)(xr_base + (size_t)(t0 + 125 + (tid >> 4)) * NPROJ + (tid & 15) * 8);
        }
        unsigned short gpre[8];
#pragma unroll
        for (int j = 0; j < 8; ++j) gpre[j] = gr_base[(size_t)(t0 + sc_sg * 8 + j) * NPROJ + sc_c];
        {
            float o[4][8];
            {
                const f32x4 b0 = *(const LAS f32x4*)(CWT + 4 * 128 + ck * 8), b1 = *(const LAS f32x4*)(CWT + 4 * 128 + ck * 8 + 4);
#pragma unroll
                for (int i = 0; i < 4; ++i) { o[i][0] = b0.x; o[i][1] = b0.y; o[i][2] = b0.z; o[i][3] = b0.w; o[i][4] = b1.x; o[i][5] = b1.y; o[i][6] = b1.z; o[i][7] = b1.w; }
            }
            float cw[4][8];
#pragma unroll
            for (int k = 0; k < 4; ++k) { const f32x4 w0 = *(const LAS f32x4*)(CWT + k * 128 + ck * 8), w1 = *(const LAS f32x4*)(CWT + k * 128 + ck * 8 + 4);
                cw[k][0] = w0.x; cw[k][1] = w0.y; cw[k][2] = w0.z; cw[k][3] = w0.w; cw[k][4] = w1.x; cw[k][5] = w1.y; cw[k][6] = w1.z; cw[k][7] = w1.w; }
#pragma unroll
            for (int r = 0; r < 7; ++r) {
                const u32x4 w = *(const LAS u32x4*)(XT + (tg * 4 + r) * XROW + ck * 16);
                const float xv[8] = {bflo(w.x), bfhi(w.x), bflo(w.y), bfhi(w.y), bflo(w.z), bfhi(w.z), bflo(w.w), bfhi(w.w)};
#pragma unroll
                for (int i = 0; i < 4; ++i) { const int k = r - i; if (k >= 0 && k < 4) {
#pragma unroll
                    for (int e = 0; e < 8; ++e) o[i][e] += cw[k][e] * xv[e]; } }
            }
#pragma unroll
            for (int i = 0; i < 4; ++i) { u32x4 w; w.x = pk2(o[i][0], o[i][1]); w.y = pk2(o[i][2], o[i][3]); w.z = pk2(o[i][4], o[i][5]); w.w = pk2(o[i][6], o[i][7]);
                *(LAS u32x4*)(UT + (tg * 4 + i) * XROW + ck * 16) = w; }
        }
        __syncthreads();
        {
            f32x4 acc[4];
#pragma unroll
            for (int nb = 0; nb < 4; ++nb) acc[nb] = (f32x4){0.f, 0.f, 0.f, 0.f};
#pragma unroll
            for (int kb = 0; kb < 4; ++kb) { const bf16x8 uf = *(const LAS bf16x8*)(UT + (wv * 16 + fr) * XROW + kb * 64 + fq * 16);
#pragma unroll
                for (int nb = 0; nb < 4; ++nb) acc[nb] = __builtin_amdgcn_mfma_f32_16x16x32_bf16(*(const LAS bf16x8*)(WG + (nb * 16 + fr) * XROW + kb * 64 + fq * 16), uf, acc[nb], 0, 0, 0); }
            const int tk = wv * 16 + fr;
#pragma unroll
            for (int nb2 = 0; nb2 < 2; ++nb2) {
                const int c0 = nb2 * 16 + 4 * fq;
                f32x4 uu = *(const LAS f32x4*)(EP + 4 * 32 + c0);
#pragma unroll
                for (int k = 0; k < 4; ++k) { const u32x2 w = *(const LAS u32x2*)(XT + (tk + k) * XROW + (q * 32 + c0) * 2);
                    const f32x4 xx = (f32x4){bflo(w.x), bfhi(w.x), bflo(w.y), bfhi(w.y)}; uu += *(const LAS f32x4*)(EP + k * 32 + c0) * xx; }
                const f32x4 ra = acc[nb2] + *(const LAS f32x4*)(EP + 5 * 32 + c0), rx = acc[nb2 + 2] + *(const LAS f32x4*)(EP + 6 * 32 + c0), sp8 = *(const LAS f32x4*)(EP + 7 * 32 + c0);
                f32x4 av, vv;
#pragma unroll
                for (int e = 0; e < 4; ++e) { const float r = sigmoidf_(ra[e]), ig = sigmoidf_(rx[e]), la = -r * sp8[e];
                    av[e] = expf(la); vv[e] = sqrtf(-expm1f(2.0f * la)) * (ig * uu[e]); }
                *(LAS f32x4*)(As + tk * 32 + c0) = av; *(LAS f32x4*)(Vs + tk * 32 + c0) = vv;
            }
        }
        __syncthreads();
        float hl[8], pp[8];
        {
            float hcur = 0.f, pcur = 1.f;
#pragma unroll
            for (int j = 0; j < 8; ++j) { const float av = As[(sc_sg * 8 + j) * 32 + sc_c], vv = Vs[(sc_sg * 8 + j) * 32 + sc_c];
                hcur = av * hcur + vv; pcur *= av; hl[j] = hcur; pp[j] = pcur; }
            SEGP[sc_sg * 32 + sc_c] = pcur; SEGH[sc_sg * 32 + sc_c] = hcur;
        }
        __syncthreads();
        {
            float carry = HC[(tile & 1) * 32 + sc_c];
            for (int s = 0; s < sc_sg; ++s) carry = SEGP[s * 32 + sc_c] * carry + SEGH[s * 32 + sc_c];
#pragma unroll
            for (int j = 0; j < 8; ++j) { const float hv = hl[j] + pp[j] * carry; const float gv = __uint_as_float((unsigned)gpre[j] << 16);
                const float yv = hv * siluf_(gv);
                y_base[(size_t)(t0 + sc_sg * 8 + j) * DMIX + sc_c] = (bf16)(pk2(yv, 0.f) & 0xffffu); }
            if (sc_sg == 15) HC[((tile + 1) & 1) * 32 + sc_c] = hl[7] + pp[7] * carry;
        }
    }
    __syncthreads();
}

constexpr int PROW = 528;
constexpr int R_XP = 0, R_PT = 41984;
__device__ __forceinline__ void pool_units(const Args& a, int l, int u, LAS unsigned char* lds) {
    const int tid = opaque_tid(), lane = tid & 63, wv = tid >> 6, fr = lane & 15, fq = lane >> 4;
    const int g = u & 3, bi = u >> 2, win = 2 << g;
    const bf16* PROJ = (const bf16*)(a.ws + WS_PROJ); bf16* YCAT = (bf16*)(a.ws + WS_YCAT);
    LAS unsigned char* XP = lds + R_XP; LAS unsigned char* PT = lds + R_PT;
    const bf16* pw = (const bf16*)(a.ws + WS_PW) + (size_t)(l * 4 + g) * 256 * 256;
    bf16x8 Wf[2][8];
#pragma unroll
    for (int nb = 0; nb < 2; ++nb)
#pragma unroll
        for (int kb = 0; kb < 8; ++kb) Wf[nb][kb] = *(const bf16x8*)(pw + (size_t)(wv * 32 + nb * 16 + fr) * 256 + kb * 32 + fq * 8);
    f32x4 pb[2], ps[2];
#pragma unroll
    for (int nb = 0; nb < 2; ++nb) { const int n = wv * 32 + nb * 16 + 4 * fq;
        pb[nb] = *(const f32x4*)(a.in[14] + (size_t)l * 1024 + g * 256 + n); ps[nb] = *(const f32x4*)(a.in[15] + (size_t)l * 1024 + g * 256 + n); }
    const int ck = tid & 31, tg = tid >> 5;
    for (int it = 0; it < 8; ++it) {
        const int tile = bi * 8 + it, b = tile >> 6, t0 = (tile & 63) * 64;
        const bf16* xp_base = PROJ + (size_t)(b * SEQ) * NPROJ + 2048 + g * 256;
        const bf16* gp_base = PROJ + (size_t)(b * SEQ) * NPROJ + 3072 + g * 256;
        bf16* y_base = YCAT + (size_t)(b * SEQ) * DMIX + 1024 + g * 256;
        for (int id = tid; id < 79 * 32; id += 512) { const int row = id >> 5, cc = id & 31, t = t0 - 15 + row;
            u32x4 v = (u32x4){0u, 0u, 0u, 0u}; if (t >= 0) v = *(const u32x4*)(xp_base + (size_t)t * NPROJ + cc * 8);
            *(LAS u32x4*)(XP + row * PROW + cc * 16) = v; }
        __syncthreads();
        {
            float s[8];
#pragma unroll
            for (int e = 0; e < 8; ++e) s[e] = 0.f;
            const int r0 = tg * 4 + 15;
            for (int r = r0 - win + 1; r < r0; ++r) { const u32x4 w = *(const LAS u32x4*)(XP + r * PROW + ck * 16);
                s[0] += bflo(w.x); s[1] += bfhi(w.x); s[2] += bflo(w.y); s[3] += bfhi(w.y); s[4] += bflo(w.z); s[5] += bfhi(w.z); s[6] += bflo(w.w); s[7] += bfhi(w.w); }
#pragma unroll
            for (int i = 0; i < 4; ++i) {
                const u32x4 w = *(const LAS u32x4*)(XP + (r0 + i) * PROW + ck * 16);
                const float xv[8] = {bflo(w.x), bfhi(w.x), bflo(w.y), bfhi(w.y), bflo(w.z), bfhi(w.z), bflo(w.w), bfhi(w.w)};
                const int t = t0 + tg * 4 + i; const float inv = 1.0f / (float)((t + 1 < win) ? (t + 1) : win);
                float p[8];
#pragma unroll
                for (int e = 0; e < 8; ++e) { s[e] += xv[e]; p[e] = s[e] * inv - xv[e]; }
                u32x4 o; o.x = pk2(p[0], p[1]); o.y = pk2(p[2], p[3]); o.z = pk2(p[4], p[5]); o.w = pk2(p[6], p[7]);
                *(LAS u32x4*)(PT + (tg * 4 + i) * PROW + ck * 16) = o;
                const u32x4 wo = *(const LAS u32x4*)(XP + (r0 + i - win + 1) * PROW + ck * 16);
                s[0] -= bflo(wo.x); s[1] -= bfhi(wo.x); s[2] -= bflo(wo.y); s[3] -= bfhi(wo.y); s[4] -= bflo(wo.z); s[5] -= bfhi(wo.z); s[6] -= bflo(wo.w); s[7] -= bfhi(wo.w);
            }
        }
        __syncthreads();
#pragma unroll
        for (int tb = 0; tb < 4; ++tb) {
            f32x4 acc[2] = {(f32x4){0.f, 0.f, 0.f, 0.f}, (f32x4){0.f, 0.f, 0.f, 0.f}};
#pragma unroll
            for (int kb = 0; kb < 8; ++kb) { const bf16x8 pfm = *(const LAS bf16x8*)(PT + (tb * 16 + fr) * PROW + kb * 64 + fq * 16);
#pragma unroll
                for (int nb = 0; nb < 2; ++nb) acc[nb] = __builtin_amdgcn_mfma_f32_16x16x32_bf16(Wf[nb][kb], pfm, acc[nb], 0, 0, 0); }
            const int t = t0 + tb * 16 + fr;
#pragma unroll
            for (int nb = 0; nb < 2; ++nb) { const int n = wv * 32 + nb * 16 + 4 * fq;
                const u32x2 gw2 = *(const u32x2*)(gp_base + (size_t)t * NPROJ + n);
                const f32x4 gv = (f32x4){bflo(gw2.x), bfhi(gw2.x), bflo(gw2.y), bfhi(gw2.y)};
                f32x4 r = (acc[nb] + pb[nb]) * ps[nb];
#pragma unroll
                for (int e = 0; e < 4; ++e) r[e] *= siluf_(gv[e]);
                u32x2 o; o.x = pk2(r.x, r.y); o.y = pk2(r.z, r.w);
                *(u32x2*)(y_base + (size_t)t * DMIX + n) = o; }
        }
    }
    __syncthreads();
}

__device__ __forceinline__ void phase_mixer(const Args& a, int l, LAS unsigned char* lds) {
#ifndef MK_MIX
#define MK_MIX 3
#endif
    if (MK_MIX & 1) for (int u = blockIdx.x; u < 256; u += gridDim.x) rnn_unit(a, l, u, lds);
    if (MK_MIX & 2) for (int u = blockIdx.x; u < 256; u += gridDim.x) pool_units(a, l, u, lds);
}
#ifndef MK_MASK
#define MK_MASK 63
#endif
__global__ void __launch_bounds__(512, 2) mk_fwd(Args a) {
    extern __shared__ __attribute__((aligned(16))) unsigned char lds_raw[];
    LAS unsigned char* lds = (LAS unsigned char*)lds_raw;
    cg::grid_group grid = cg::this_grid();
    for (int ph = a.ph_lo; ph < a.ph_hi; ++ph) {
        if (ph == 0) { if (MK_MASK & 1) phase_prep(a, lds); }
        else if (ph == 1) { if (MK_MASK & 2) phase_h0(a); }
        else {
            const int l = (ph - 2) >> 2, sub = (ph - 2) & 3;
            if (sub == 0) { if (MK_MASK & 4) {
                pg8::Gemm g{(const pg8::bf16_t*)(a.ws + WS_H), (const pg8::bf16_t*)(a.ws + WS_WIN) + (size_t)l * NPROJ * D, T, NPROJ, D};
                pg8::StaticOrder S; S.init(T, NPROJ, gridDim.x, (int)blockIdx.x);
                pg8::EpiBf16<0> E{(pg8::bf16_t*)(a.ws + WS_PROJ), NPROJ, nullptr, 0, 0, 1.f};
                pg8::gemm_phase<pg8::EpiBf16<0>, pg8::StaticOrder, PG8_ALIGN, PG8_SP2>(lds, g, S, E); }
            } else if (sub == 1) {
                if (MK_MASK & 8) phase_mixer(a, l, lds);
            } else if (sub == 2) { if (MK_MASK & 16) {
                pg8::Gemm g{(const pg8::bf16_t*)(a.ws + WS_YCAT), (const pg8::bf16_t*)(a.ws + WS_WOUT) + (size_t)l * D * DMIX, T, D, DMIX};
                pg8::StaticOrder S; S.init(T, D, gridDim.x, (int)blockIdx.x);
                pg8::EpiBf16<0> E{(pg8::bf16_t*)(a.ws + WS_Y), D, nullptr, 0, 0, 1.f};
                pg8::gemm_phase<pg8::EpiBf16<0>, pg8::StaticOrder, PG8_ALIGN, PG8_SP2>(lds, g, S, E); }
            } else {
                if (MK_MASK & 32) phase_post(a, l);
            }
        }
        if (ph + 1 < a.ph_hi) grid.sync();
    }
}

extern "C" void kernel_launch(void* const* d_in, const int* in_sizes, int n_in, void* d_out, int out_size, void* d_ws, size_t ws_size, hipStream_t stream) {
    static int grid = 0;
    if (grid == 0) {
        if (n_in != 18 || in_sizes[0] != T * D || out_size != T * D || ws_size < WS_END) {
            fprintf(stderr, "kernel_launch: unexpected shapes (n_in %d, in0 %d, out %d, ws %zu); nothing launched\n", n_in, n_in > 0 ? in_sizes[0] : -1, out_size, ws_size); grid = -1; return; }
        int dev = 0, cus = 0, per_cu = 0;
        if (hipGetDevice(&dev) != hipSuccess || hipDeviceGetAttribute(&cus, hipDeviceAttributeMultiprocessorCount, dev) != hipSuccess) { grid = -1; return; }
        if (hipFuncSetAttribute((const void*)mk_fwd, hipFuncAttributeMaxDynamicSharedMemorySize, LDS_BYTES) != hipSuccess) { fprintf(stderr, "kernel_launch: hipFuncSetAttribute failed\n"); grid = -1; return; }
        if (hipOccupancyMaxActiveBlocksPerMultiprocessor(&per_cu, (const void*)mk_fwd, 512, LDS_BYTES) != hipSuccess || per_cu < 1) { fprintf(stderr, "kernel_launch: occupancy query says %d blocks per CU\n", per_cu); per_cu = 1; }
        (void)hipGetLastError();
        grid = cus;
    }
    if (grid < 0) return;
    Args a{};
    for (int i = 0; i < 18; ++i) a.in[i] = (const float*)d_in[i];
    a.out = (float*)d_out; a.ws = (unsigned char*)d_ws;
#if MK_N_LAUNCHES == 1
    a.ph_lo = 0; a.ph_hi = NPH;
    void* args[] = {&a};
    const hipError_t e = hipLaunchCooperativeKernel((const void*)mk_fwd, dim3(grid), dim3(512), args, LDS_BYTES, stream);
    if (e != hipSuccess) fprintf(stderr, "kernel_launch: cooperative launch failed: %s (grid %d)\n", hipGetErrorString(e), grid);
#else
    for (int ph = 0; ph < NPH; ++ph) {
        a.ph_lo = ph; a.ph_hi = ph + 1;
        hipLaunchKernelGGL(mk_fwd, dim3(grid), dim3(512), LDS_BYTES, stream, a);
    }
#endif
}
```

```cpp
#include <hip/hip_runtime.h>
#include <hip/hip_cooperative_groups.h>
#include <cstdio>
#include <cstdint>
namespace cg = cooperative_groups;
__device__ __forceinline__ int opaque_tid() { int t = threadIdx.x; asm volatile("" : "+v"(t)); return t; }
namespace pg8 {
#define PG8_LAS __attribute__((address_space(3)))
typedef unsigned short bf16_t;
typedef short bf16x8 __attribute__((ext_vector_type(8)));
typedef float f32x4 __attribute__((ext_vector_type(4)));
typedef unsigned u32x4 __attribute__((ext_vector_type(4)));
constexpr int BM = 256, BK = 64, HALF = 128, HTB = HALF * BK * 2  , STAGE_BYTES = 8 * HTB, NXCD = 8, WGM = 8;

__host__ __device__ __forceinline__ int lds_byte(int r, int c) { const int st = (r >> 4) * 2 + (c >> 5), rr = r & 15, cc = c & 31, ob = rr * 64 + cc * 2; return st * 1024 + (ob ^ (((ob >> 9) & 1) << 5)); }
__host__ __device__ __forceinline__ void stage_rc(int b, int& R, int& C) { const int st = b / 1024, sb = b % 1024, swz = sb ^ (((sb >> 9) & 1) << 5); R = (st >> 1) * 16 + swz / 64; C = (st & 1) * 32 + (swz % 64) / 2; }
__host__ __device__ __forceinline__ int perm32(int rho) { const int n = rho >> 4, i = rho & 15; return 8 * (i >> 2) + 4 * n + (i & 3); }

struct Unit { int pm, pn; };
struct Gemm { const bf16_t* A; const bf16_t* Bt; int M, N, K; };

struct StaticOrder {
    int nM, nN, nwg, G, c;
    __host__ __device__ void init(int M, int N, int G_, int c_) { nM = M / BM; nN = N / BM; nwg = nM * nN; G = G_; c = c_; }
    __host__ __device__ bool next(int i, Unit& u) const {
        const long L = (long)i * G + c; if (L >= nwg) return false;
        int wgid = (int)L; { const int q = nwg / NXCD, r = nwg % NXCD, xcd = wgid % NXCD, off = wgid / NXCD; wgid = (xcd < r ? xcd * (q + 1) : r * (q + 1) + (xcd - r) * q) + off; }
        const int nig = WGM * nN, gid = wgid / nig, fm = gid * WGM, gsz = (nM - fm) < WGM ? (nM - fm) : WGM;
        u.pm = fm + ((wgid % nig) % gsz); u.pn = (wgid % nig) / gsz; return true;
    }
    __device__ __forceinline__ void a_ready(const Unit&) const {}
    __device__ __forceinline__ void done(const Unit&) const {}
};

__device__ __forceinline__ unsigned cvt_pk_bf16(float lo, float hi) { unsigned r; asm volatile("v_cvt_pk_bf16_f32 %0, %1, %2" : "=v"(r) : "v"(lo), "v"(hi)); return r; }
typedef float f32x2 __attribute__((ext_vector_type(2)));
__device__ __forceinline__ f32x2 gelu_pk(f32x2 v) {
    const f32x2 av = __builtin_elementwise_abs(v), d = av * 0.2316418882f + 1.0f;
    f32x2 t; t.x = __builtin_amdgcn_rcpf(d.x); t.y = __builtin_amdgcn_rcpf(d.y);
    f32x2 q = t * 0.5307027145f + (-0.7265760135f); q = q * t + 0.7107068705f; q = q * t + (-0.142248368f); q = q * t + 0.127414796f; q = q * t;
    const f32x2 s = (v * v) * (-0.72134752044f);
    f32x2 e; e.x = __builtin_amdgcn_exp2f(s.x); e.y = __builtin_amdgcn_exp2f(s.y);
    const f32x2 m = v * (q * e), r = v - m;
    f32x2 o; o.x = v.x < 0.f ? m.x : r.x; o.y = v.y < 0.f ? m.y : r.y; return o;
}

template <int ACT  > struct EpiBf16 {
    static constexpr bool PERM = true, AFTER_DRAIN = false; static_assert(ACT == 0 || ACT == 1, "EpiBf16: ACT is 0 (none) or 1 (gelu_pk)");
    bf16_t* O; int ldc; const float* bias; int split_cols; size_t split_stride; float scale0;
    __device__ __forceinline__ void operator()(const f32x4 (&acc)[2][2][4][2], const Unit& u, int wr, int wc, int fr, int fq) const {
        const int row0 = u.pm * BM + wr * 64 + fr; int colt = u.pn * BM; bf16_t* base = O;
        float sc = 1.f; if (split_cols) { const int t = colt / split_cols; base += (size_t)t * split_stride; colt -= t * split_cols; if (t == 0) sc = scale0; }
        const int col0 = colt + wc * 32 + 8 * fq, bcol0 = u.pn * BM + wc * 32 + 8 * fq;
        f32x4 bv[2][2];
#pragma unroll
        for (int bj = 0; bj < 2; ++bj)
#pragma unroll
            for (int n = 0; n < 2; ++n) bv[bj][n] = bias ? *(const f32x4*)(bias + bcol0 + bj * HALF + 4 * n) : (f32x4){0.f, 0.f, 0.f, 0.f};
#pragma unroll
        for (int ai = 0; ai < 2; ++ai)
#pragma unroll
            for (int m = 0; m < 4; ++m) { bf16_t* rowp = base + (size_t)(row0 + ai * HALF + m * 16) * ldc + col0;
#pragma unroll
                for (int bj = 0; bj < 2; ++bj) { f32x4 v0 = acc[ai][bj][m][0] + bv[bj][0], v1 = acc[ai][bj][m][1] + bv[bj][1];
                    if (ACT == 1) { f32x2 a = gelu_pk((f32x2){v0[0], v0[1]}), b = gelu_pk((f32x2){v0[2], v0[3]}), c = gelu_pk((f32x2){v1[0], v1[1]}), d = gelu_pk((f32x2){v1[2], v1[3]});
                        v0 = (f32x4){a.x, a.y, b.x, b.y}; v1 = (f32x4){c.x, c.y, d.x, d.y}; }
                    v0 = v0 * sc; v1 = v1 * sc; u32x4 w; w.x = cvt_pk_bf16(v0[0], v0[1]); w.y = cvt_pk_bf16(v0[2], v0[3]); w.z = cvt_pk_bf16(v1[0], v1[1]); w.w = cvt_pk_bf16(v1[2], v1[3]);
                    *(u32x4*)(rowp + bj * HALF) = w; } }
    }
};
template <class Epi, class Sched, bool ALIGN_EPI = false, bool SP2 = false>
__device__ __forceinline__ void gemm_phase(PG8_LAS unsigned char* lds, const Gemm g, const Sched& S, const Epi& E) {
    const int tid = opaque_tid(), wid = __builtin_amdgcn_readfirstlane(tid >> 6), lane = tid & 63, wr = wid >> 2, wc = wid & 3, fr = lane & 15, fq = lane >> 4;
    const int K = g.K, nt = K / BK;
    unsigned voffA[2], voffB[2];
#pragma unroll
    for (int i = 0; i < 2; ++i) { int R, C; stage_rc(tid * 16 + i * 8192, R, C); const int Rb = Epi::PERM ? ((R & ~31) + perm32(R & 31)) : R;
        voffA[i] = (unsigned)(R * K + C) * 2u; voffB[i] = (unsigned)(Rb * K + C) * 2u; }
    const size_t kstep = (size_t)(BK * 2);
    const size_t hstep = (size_t)HALF * K * 2;
    const size_t tstep = 2 * hstep;
    const unsigned ldsw = (unsigned)wid * 1024u;
    const int aoff = lds_byte(wr * 64 + fr, fq * 8), boff = lds_byte(wc * 32 + fr, fq * 8);
#define PG8_SA(b, h) (((b) * 2 + (h)) * HTB)
#define PG8_SB(b, h) ((4 + (b) * 2 + (h)) * HTB)
#define PG8_STAGE(bufoff, gbase, voff) do { _Pragma("unroll") for (int _i = 0; _i < 2; ++_i) \
        __builtin_amdgcn_global_load_lds((const unsigned*)((const char*)(gbase) + (voff)[_i]), (PG8_LAS unsigned*)(lds + (bufoff) + ldsw + _i * 8192), 16, 0, 0); } while (0)
#define PG8_LDA(dst, b, h) do { _Pragma("unroll") for (int m = 0; m < 4; ++m) _Pragma("unroll") for (int k = 0; k < 2; ++k) dst[m][k] = *(const PG8_LAS bf16x8*)(lds + PG8_SA(b, h) + aoff + m * 2048 + k * 1024); } while (0)
#define PG8_LDB(dst, b, h) do { _Pragma("unroll") for (int n = 0; n < 2; ++n) _Pragma("unroll") for (int k = 0; k < 2; ++k) dst[n][k] = *(const PG8_LAS bf16x8*)(lds + PG8_SB(b, h) + boff + n * 2048 + k * 1024); } while (0)
#define PG8_MMA(ai, bj, At, Bt) do { __builtin_amdgcn_s_setprio(1); _Pragma("unroll") for (int m = 0; m < 4; ++m) _Pragma("unroll") for (int n = 0; n < 2; ++n) _Pragma("unroll") for (int k = 0; k < 2; ++k) \
        acc[ai][bj][m][n] = __builtin_amdgcn_mfma_f32_16x16x32_bf16(Bt[n][k], At[m][k], acc[ai][bj][m][n], 0, 0, 0); __builtin_amdgcn_s_setprio(0); } while (0)
#define PG8_WAIT_V(n) asm volatile("s_waitcnt vmcnt(" #n ")" ::: "memory")
#define PG8_WAIT_L(n) asm volatile("s_waitcnt lgkmcnt(" #n ")" ::: "memory")
#define PG8_BAR __builtin_amdgcn_s_barrier()
#define PG8_SCHED __builtin_amdgcn_sched_barrier(0)
    Unit cur, nxt; int ui = 0;
    if (!S.next(0, cur)) return;
    f32x4 acc[2][2][4][2];
#pragma unroll
    for (int a = 0; a < 2; ++a)
#pragma unroll
        for (int b = 0; b < 2; ++b)
#pragma unroll
            for (int m = 0; m < 4; ++m)
#pragma unroll
                for (int n = 0; n < 2; ++n) acc[a][b][m][n] = (f32x4){0.f, 0.f, 0.f, 0.f};
    bf16x8 At[4][2], B0[2][2], B1[2][2];
    const char* cA = (const char*)g.A + (size_t)cur.pm * tstep; const char* cB = (const char*)g.Bt + (size_t)cur.pn * tstep;
    S.a_ready(cur);
    if constexpr (SP2) {
        PG8_STAGE(PG8_SB(0, 0), cB, voffB); PG8_STAGE(PG8_SB(0, 1), cB + hstep, voffB); PG8_STAGE(PG8_SA(0, 0), cA, voffA); PG8_STAGE(PG8_SA(0, 1), cA + hstep, voffA);
        if (wr == 1) PG8_BAR;
        PG8_WAIT_V(2); PG8_BAR;
        PG8_STAGE(PG8_SB(1, 0), cB + kstep, voffB); PG8_STAGE(PG8_SA(1, 0), cA + kstep, voffA); PG8_STAGE(PG8_SB(1, 1), cB + hstep + kstep, voffB);
        PG8_WAIT_V(6); PG8_BAR;
    } else {
        PG8_STAGE(PG8_SB(0, 0), cB, voffB); PG8_STAGE(PG8_SA(0, 0), cA, voffA); PG8_STAGE(PG8_SB(0, 1), cB + hstep, voffB); PG8_STAGE(PG8_SA(0, 1), cA + hstep, voffA);
        if (wr == 1) PG8_BAR;
        PG8_WAIT_V(4); PG8_BAR;
        PG8_STAGE(PG8_SB(1, 0), cB + kstep, voffB); PG8_STAGE(PG8_SA(1, 0), cA + kstep, voffA); PG8_STAGE(PG8_SB(1, 1), cB + hstep + kstep, voffB);
        PG8_WAIT_V(6); PG8_BAR;
    }
    for (;;) {
        const bool has_next = S.next(ui + 1, nxt);
        const char* nA = has_next ? (const char*)g.A + (size_t)nxt.pm * tstep : cA; const char* nB = has_next ? (const char*)g.Bt + (size_t)nxt.pn * tstep : cB;
        for (int t = 0; t < nt; t += 2) {
            const bool last = (t == nt - 2);
            const char* a1 = cA + (size_t)(t + 1) * kstep;
            const char* a2 = last ? nA : cA + (size_t)(t + 2) * kstep; const char* b2 = last ? nB : cB + (size_t)(t + 2) * kstep;
            const char* a3 = a2 + kstep; const char* b3 = b2 + kstep;
            if (last && has_next) S.a_ready(nxt);
            if constexpr (SP2) {
            PG8_LDB(B0, 0, 0); PG8_LDB(B1, 0, 1); PG8_SCHED; PG8_LDA(At, 0, 0); PG8_STAGE(PG8_SA(1, 1), a1 + hstep, voffA);
            PG8_WAIT_V(8); PG8_WAIT_L(0); PG8_BAR; PG8_MMA(0, 0, At, B0); PG8_MMA(0, 1, At, B1); PG8_BAR; PG8_SCHED;
            PG8_LDA(At, 0, 1); PG8_STAGE(PG8_SB(0, 0), b2, voffB); PG8_STAGE(PG8_SB(0, 1), b2 + hstep, voffB); PG8_STAGE(PG8_SA(0, 0), a2, voffA);
            PG8_WAIT_V(8); PG8_WAIT_L(0); PG8_BAR; PG8_MMA(1, 0, At, B0); PG8_MMA(1, 1, At, B1); PG8_BAR; PG8_SCHED;
            PG8_LDB(B0, 1, 0); PG8_LDB(B1, 1, 1); PG8_SCHED; PG8_LDA(At, 1, 0); PG8_STAGE(PG8_SA(0, 1), a2 + hstep, voffA);
            PG8_WAIT_V(8); PG8_WAIT_L(0); PG8_BAR; PG8_MMA(0, 0, At, B0); PG8_MMA(0, 1, At, B1); PG8_BAR; PG8_SCHED;
            PG8_LDA(At, 1, 1); PG8_STAGE(PG8_SB(1, 0), b3, voffB); PG8_STAGE(PG8_SB(1, 1), b3 + hstep, voffB); PG8_STAGE(PG8_SA(1, 0), a3, voffA);
            PG8_WAIT_V(8); PG8_WAIT_L(0); PG8_BAR; PG8_MMA(1, 0, At, B0); PG8_MMA(1, 1, At, B1); PG8_BAR; PG8_SCHED;
            } else {
            PG8_LDB(B0, 0, 0); PG8_SCHED; PG8_LDA(At, 0, 0); PG8_STAGE(PG8_SA(1, 1), a1 + hstep, voffA);
            PG8_WAIT_L(8); PG8_BAR; PG8_WAIT_L(0); PG8_MMA(0, 0, At, B0); PG8_BAR; PG8_SCHED;
            PG8_LDB(B1, 0, 1); PG8_STAGE(PG8_SB(0, 0), b2, voffB);
            PG8_BAR; PG8_WAIT_L(0); PG8_MMA(0, 1, At, B1); PG8_BAR;
            PG8_LDA(At, 0, 1); PG8_STAGE(PG8_SA(0, 0), a2, voffA);
            PG8_BAR; PG8_WAIT_L(0); PG8_MMA(1, 0, At, B0); PG8_BAR; PG8_SCHED;
            PG8_STAGE(PG8_SB(0, 1), b2 + hstep, voffB);
            PG8_WAIT_V(6); PG8_BAR; PG8_MMA(1, 1, At, B1); PG8_BAR;
            PG8_LDB(B0, 1, 0); PG8_SCHED; PG8_LDA(At, 1, 0); PG8_STAGE(PG8_SA(0, 1), a2 + hstep, voffA);
            PG8_WAIT_L(8); PG8_BAR; PG8_WAIT_L(0); PG8_MMA(0, 0, At, B0); PG8_BAR; PG8_SCHED;
            PG8_LDB(B1, 1, 1); PG8_STAGE(PG8_SB(1, 0), b3, voffB);
            PG8_BAR; PG8_WAIT_L(0); PG8_MMA(0, 1, At, B1); PG8_BAR;
            PG8_LDA(At, 1, 1); PG8_STAGE(PG8_SA(1, 0), a3, voffA);
            PG8_BAR; PG8_WAIT_L(0); PG8_MMA(1, 0, At, B0); PG8_BAR; PG8_SCHED;
            PG8_STAGE(PG8_SB(1, 1), b3 + hstep, voffB);
            PG8_WAIT_V(6); PG8_BAR; PG8_MMA(1, 1, At, B1); PG8_BAR;
            }
        }
        if constexpr (ALIGN_EPI) { if (wr == 0) PG8_BAR; }
        if constexpr (!Epi::AFTER_DRAIN) { E(acc, cur, wr, wc, fr, fq); S.done(cur); }
        if (!has_next) break;
#pragma unroll
        for (int a = 0; a < 2; ++a)
#pragma unroll
            for (int b = 0; b < 2; ++b)
#pragma unroll
                for (int m = 0; m < 4; ++m)
#pragma unroll
                    for (int n = 0; n < 2; ++n) acc[a][b][m][n] = (f32x4){0.f, 0.f, 0.f, 0.f};
        cur = nxt; cA = nA; cB = nB; ++ui;
        if constexpr (ALIGN_EPI) { if (wr == 1) PG8_BAR; }
    }
    PG8_WAIT_V(0);
    if constexpr (!ALIGN_EPI) { if (wr == 0) PG8_BAR; }
    PG8_BAR;
    if constexpr (Epi::AFTER_DRAIN) { E.fused(acc, cur, wr, wc, fr, fq, lds, wid, lane); S.done(cur); }
#undef PG8_SA
#undef PG8_SB
#undef PG8_STAGE
#undef PG8_LDA
#undef PG8_LDB
#undef PG8_MMA
#undef PG8_WAIT_V
#undef PG8_WAIT_L
#undef PG8_BAR
#undef PG8_SCHED
}
}
#ifndef PG8_SP2
#define PG8_SP2 true
#endif
#ifndef PG8_ALIGN
#define PG8_ALIGN true
#endif
#ifndef MK_N_LAUNCHES
#define MK_N_LAUNCHES 1
#endif

constexpr int NB = 8, SEQ = 4096, D = 1024, T = NB * SEQ, NPROJ = 4096, DMIX = 2048;
constexpr int NPH = 10;
constexpr float EPS = 1e-6f;
constexpr size_t MiB = 1u << 20;
constexpr size_t WS_WIN = 0, WS_WOUT = 16 * MiB, WS_GW = 24 * MiB, WS_PW = 25 * MiB, WS_MOD = 26 * MiB;
constexpr size_t WS_H = 32 * MiB, WS_YCAT = 96 * MiB, WS_PROJ = 224 * MiB, WS_Y = WS_PROJ, WS_END = 480 * MiB;
constexpr int LDS_BYTES = 147456;

#define LAS __attribute__((address_space(3)))
typedef unsigned short bf16;
typedef float f32x4 __attribute__((ext_vector_type(4)));
typedef float f32x2 __attribute__((ext_vector_type(2)));
typedef unsigned u32x4 __attribute__((ext_vector_type(4)));
typedef unsigned u32x2 __attribute__((ext_vector_type(2)));
typedef short bf16x8 __attribute__((ext_vector_type(8)));

struct Args { const float* in[18]; float* out; unsigned char* ws; int ph_lo, ph_hi; };

__device__ __forceinline__ unsigned pk2(float lo, float hi) { return pg8::cvt_pk_bf16(lo, hi); }
__device__ __forceinline__ float bflo(unsigned w) { return __uint_as_float(w << 16); }
__device__ __forceinline__ float bfhi(unsigned w) { return __uint_as_float(w & 0xffff0000u); }
__device__ __forceinline__ float wave_sum(float v) {
#pragma unroll
    for (int o = 1; o < 64; o <<= 1) v += __shfl_xor(v, o);
    return v;
}
__device__ __forceinline__ float sigmoidf_(float x) { return 1.0f / (1.0f + __expf(-x)); }
__device__ __forceinline__ float siluf_(float x) { return x / (1.0f + __expf(-x)); }

__device__ __forceinline__ void transpose_item(const float* W, int K, int N, bf16* WT, LAS float* scr, int item, int lane) {
    const int nblk = N / 32, kb = item / nblk, nb = item % nblk, k0 = 64 * kb, n0 = 32 * nb;
#pragma unroll 8
    for (int i = 0; i < 32; ++i) { const int kk = 2 * i + (lane >> 5); scr[kk * 33 + (lane & 31)] = W[(size_t)(k0 + kk) * N + n0 + (lane & 31)]; }
    asm volatile("s_waitcnt lgkmcnt(0)" ::: "memory");
    const int c = lane & 7;
#pragma unroll
    for (int j = 0; j < 4; ++j) { const int n = (lane >> 3) + 8 * j; const LAS float* s = scr + (8 * c) * 33 + n;
        u32x4 o; o.x = pk2(s[0 * 33], s[1 * 33]); o.y = pk2(s[2 * 33], s[3 * 33]); o.z = pk2(s[4 * 33], s[5 * 33]); o.w = pk2(s[6 * 33], s[7 * 33]);
        *(u32x4*)(WT + (size_t)(n0 + n) * K + k0 + 8 * c) = o; }
    asm volatile("s_waitcnt lgkmcnt(0)" ::: "memory");
}

__device__ __forceinline__ void phase_prep(const Args& a, LAS unsigned char* lds) {
    const int tid = opaque_tid(), lane = tid & 63, wv = tid >> 6;
    const int G = gridDim.x;
    unsigned char* ws = a.ws;
    {
        LAS float* sc = (LAS float*)lds;
        LAS float* red = (LAS float*)(lds + 32768);
        const float* c = a.in[1]; const float* ada_w = a.in[2]; const float* ada_b = a.in[3];
        float* MOD = (float*)(ws + WS_MOD);
        if ((int)blockIdx.x < 192) {
            for (int i = tid; i < 8192; i += 512) sc[i] = siluf_(c[i]);
            __syncthreads();
            for (int unit = blockIdx.x; unit < 192; unit += G) {
                const int l = unit / 96, cb = (unit % 96) * 32, cl = tid & 31, ks = tid >> 5;
                const float* wp = ada_w + (size_t)l * 1024 * 3072 + (size_t)(ks * 64) * 3072 + cb + cl;
                float acc[8];
#pragma unroll
                for (int b = 0; b < 8; ++b) acc[b] = 0.f;
#pragma unroll 4
                for (int k = 0; k < 64; ++k) { const float w = wp[(size_t)k * 3072];
#pragma unroll
                    for (int b = 0; b < 8; ++b) acc[b] += sc[b * 1024 + ks * 64 + k] * w; }
#pragma unroll
                for (int b = 0; b < 8; ++b) red[(ks * 8 + b) * 32 + cl] = acc[b];
                __syncthreads();
                if (tid < 256) { const int b = tid >> 5; float s = 0.f;
#pragma unroll
                    for (int k2 = 0; k2 < 16; ++k2) s += red[(k2 * 8 + b) * 32 + cl];
                    MOD[(l * 8 + b) * 3072 + cb + cl] = s + ada_b[l * 3072 + cb + cl]; }
                __syncthreads();
            }
        }
        __syncthreads();
    }
    {
        LAS float* scr = (LAS float*)(lds + wv * 16384);
        const int gw = blockIdx.x * 8 + wv, NGW = G * 8;
        constexpr int I_IN = (1024 / 64) * (4096 / 32), I_OUT = (2048 / 64) * (1024 / 32);
        for (int it = gw; it < 2 * (I_IN + I_OUT); it += NGW) {
            int r = it;
            if (r < 2 * I_IN) { const int l = r / I_IN; r -= l * I_IN;
                transpose_item(a.in[5] + (size_t)l * 1024 * 4096, 1024, 4096, (bf16*)(ws + WS_WIN) + (size_t)l * 4096 * 1024, scr, r, lane); }
            else { r -= 2 * I_IN; const int l = r / I_OUT; r -= l * I_OUT;
                transpose_item(a.in[16] + (size_t)l * 2048 * 1024, 2048, 1024, (bf16*)(ws + WS_WOUT) + (size_t)l * 1024 * 2048, scr, r, lane); }
        }
    }
    {
        const size_t gt = (size_t)blockIdx.x * 512 + tid, GT = (size_t)G * 512;
        bf16* GWp = (bf16*)(ws + WS_GW); bf16* PWp = (bf16*)(ws + WS_PW);
        const float* ga = a.in[8]; const float* gx = a.in[10]; const float* pw = a.in[13];
        for (size_t i = gt; i < (size_t)2 * 8 * 4 * 64 * 128; i += GT) {
            const int k = (int)(i & 127), n = (int)((i >> 7) & 63), q = (int)((i >> 13) & 3), lh = (int)(i >> 15);
            const float v = (n < 32) ? ga[((size_t)lh * 128 + k) * 128 + q * 32 + n] : gx[((size_t)lh * 128 + k) * 128 + q * 32 + n - 32];
            GWp[i] = (bf16)(pk2(v, 0.f) & 0xffffu);
        }
        for (size_t i = gt; i < (size_t)2 * 4 * 256 * 256; i += GT) {
            const int k = (int)(i & 255), n = (int)((i >> 8) & 255), lg = (int)(i >> 16);
            const float v = pw[((size_t)lg * 256 + k) * 256 + n];
            PWp[i] = (bf16)(pk2(v, 0.f) & 0xffffu);
        }
    }
}

constexpr int RPW = 4;
__device__ __forceinline__ void phase_h0(const Args& a) {
    const int tid = opaque_tid(), lane = tid & 63, wv = tid >> 6;
    const int gw = blockIdx.x * 8 + wv, NGW = gridDim.x * 8;
    const float* x = a.in[0]; const float* g = a.in[4]; const float* MOD = (const float*)(a.ws + WS_MOD);
    bf16* H = (bf16*)(a.ws + WS_H);
    for (int m0 = gw * RPW; m0 < T; m0 += NGW * RPW) {
        f32x4 v[RPW][4];
#pragma unroll
        for (int r = 0; r < RPW; ++r) { const f32x4* xr = (const f32x4*)(x + (size_t)(m0 + r) * D) + lane;
#pragma unroll
            for (int j = 0; j < 4; ++j) v[r][j] = __builtin_nontemporal_load(xr + 64 * j); }
        const int b = m0 >> 12;
        const float* sh = MOD + (size_t)b * 3072; const float* scl = sh + 1024;
#pragma unroll
        for (int r = 0; r < RPW; ++r) {
            float ss = 0.f;
#pragma unroll
            for (int j = 0; j < 4; ++j) ss += (v[r][j].x * v[r][j].x + v[r][j].y * v[r][j].y) + (v[r][j].z * v[r][j].z + v[r][j].w * v[r][j].w);
            const float rstd = 1.0f / sqrtf(wave_sum(ss) * (1.0f / D) + EPS);
            u32x2* o = (u32x2*)(H + (size_t)(m0 + r) * D) + lane;
#pragma unroll
            for (int j = 0; j < 4; ++j) { const int col = 4 * lane + 256 * j;
                const f32x4 gg = *(const f32x4*)(g + col), s4 = *(const f32x4*)(scl + col), h4 = *(const f32x4*)(sh + col);
                const f32x4 rr = v[r][j] * rstd * gg * (s4 + 1.0f) + h4;
                u32x2 w; w.x = pk2(rr.x, rr.y); w.y = pk2(rr.z, rr.w); o[64 * j] = w; }
        }
    }
}

__device__ __forceinline__ void phase_post(const Args& a, int l) {
    const int tid = opaque_tid(), lane = tid & 63, wv = tid >> 6;
    const int gw = blockIdx.x * 8 + wv, NGW = gridDim.x * 8;
    const float* xin = (l == 0) ? a.in[0] : a.out; float* out = a.out;
    const bf16* Y = (const bf16*)(a.ws + WS_Y); bf16* H = (bf16*)(a.ws + WS_H);
    const float* MOD = (const float*)(a.ws + WS_MOD);
    const float* gpost = a.in[17] + l * D; const float* gpre = a.in[4] + (l + 1) * D;
    for (int m0 = gw * RPW; m0 < T; m0 += NGW * RPW) {
        f32x4 xv[RPW][4]; u32x2 yw[RPW][4];
#pragma unroll
        for (int r = 0; r < RPW; ++r) { const f32x4* xr = (const f32x4*)(xin + (size_t)(m0 + r) * D) + lane; const u32x2* yr = (const u32x2*)(Y + (size_t)(m0 + r) * D) + lane;
#pragma unroll
            for (int j = 0; j < 4; ++j) { xv[r][j] = xr[64 * j]; yw[r][j] = yr[64 * j]; } }
        const int b = m0 >> 12;
        const float* gate = MOD + (size_t)(l * 8 + b) * 3072 + 2048;
        const float* sh = MOD + (size_t)(8 + b) * 3072; const float* scl = sh + 1024;
#pragma unroll
        for (int r = 0; r < RPW; ++r) {
            f32x4 yv[4]; float ss = 0.f;
#pragma unroll
            for (int j = 0; j < 4; ++j) { const u32x2 w = yw[r][j]; yv[j] = (f32x4){bflo(w.x), bfhi(w.x), bflo(w.y), bfhi(w.y)};
                ss += (yv[j].x * yv[j].x + yv[j].y * yv[j].y) + (yv[j].z * yv[j].z + yv[j].w * yv[j].w); }
            const float rstd = 1.0f / sqrtf(wave_sum(ss) * (1.0f / D) + EPS);
            float ss2 = 0.f;
#pragma unroll
            for (int j = 0; j < 4; ++j) { const int col = 4 * lane + 256 * j;
                const f32x4 gp = *(const f32x4*)(gpost + col), gt = *(const f32x4*)(gate + col);
                const f32x4 xn = xv[r][j] + gt * (yv[j] * rstd * gp);
                xv[r][j] = xn;
                if (l == 0) *((f32x4*)(out + (size_t)(m0 + r) * D + col)) = xn;
                else __builtin_nontemporal_store(xn, (f32x4*)(out + (size_t)(m0 + r) * D + col));
                ss2 += (xn.x * xn.x + xn.y * xn.y) + (xn.z * xn.z + xn.w * xn.w); }
            if (l == 0) {
                const float rstd2 = 1.0f / sqrtf(wave_sum(ss2) * (1.0f / D) + EPS);
                u32x2* o = (u32x2*)(H + (size_t)(m0 + r) * D) + lane;
#pragma unroll
                for (int j = 0; j < 4; ++j) { const int col = 4 * lane + 256 * j;
                    const f32x4 gg = *(const f32x4*)(gpre + col), s4 = *(const f32x4*)(scl + col), h4 = *(const f32x4*)(sh + col);
                    const f32x4 rr = xv[r][j] * rstd2 * gg * (s4 + 1.0f) + h4;
                    u32x2 w; w.x = pk2(rr.x, rr.y); w.y = pk2(rr.z, rr.w); o[64 * j] = w; }
            }
        }
    }
}
#define LDS_BARRIER() do { asm volatile("s_waitcnt lgkmcnt(0)" ::: "memory"); __builtin_amdgcn_s_barrier(); asm volatile("" ::: "memory"); } while (0)
constexpr int XROW = 272;
constexpr int CROW = 132;
constexpr int R_XT = 0, R_UT = 35840, R_AT = 70656, R_VT = 87552, R_EP = 104448, R_CWT = 105472, R_WG = 108032;
__device__ __forceinline__ float fast_sigmoid(float x) { return __builtin_amdgcn_rcpf(1.0f + __builtin_amdgcn_exp2f(-1.4426950408889634f * x)); }
__device__ __forceinline__ void rnn_unit(const Args& a, int l, int u, LAS unsigned char* lds) {
    const int tid = opaque_tid(), lane = tid & 63, wv = tid >> 6, fr = lane & 15, fq = lane >> 4;
    const int xcd = u & 7, jj = u >> 3, q = jj & 3, bh = (jj >> 2) * 8 + xcd, b = bh >> 3, h = bh & 7;
    const bf16* PROJ = (const bf16*)(a.ws + WS_PROJ); bf16* YCAT = (bf16*)(a.ws + WS_YCAT);
    const bf16* xr_base = PROJ + (size_t)(b * SEQ) * NPROJ + h * 128;
    const bf16* gr_base = PROJ + (size_t)(b * SEQ) * NPROJ + 1024 + h * 128 + q * 32;
    bf16* y_base = YCAT + (size_t)(b * SEQ) * DMIX + h * 128 + q * 32;
    LAS unsigned char* XT = lds + R_XT; LAS unsigned char* UT = lds + R_UT;
    LAS float* AT = (LAS float*)(lds + R_AT); LAS float* VT = (LAS float*)(lds + R_VT);
    LAS float* EP = (LAS float*)(lds + R_EP);
    LAS unsigned char* WG = lds + R_WG;
    {
        const bf16* gw = (const bf16*)(a.ws + WS_GW) + (size_t)((l * 8 + h) * 4 + q) * 64 * 128;
#pragma unroll
        for (int i = 0; i < 2; ++i) { const int id = tid + 512 * i, row = id >> 4, cc = id & 15; *(LAS u32x4*)(WG + row * XROW + cc * 16) = *(const u32x4*)(gw + row * 128 + cc * 8); }
    }
    const int ck = tid & 15, tg = tid >> 4;
    LAS float* CWT = (LAS float*)(lds + R_CWT);
    for (int i = tid; i < 640; i += 512) { const int r = i >> 7, c = i & 127;
        CWT[i] = (r < 4) ? a.in[6][(size_t)l * 4 * 1024 + r * 1024 + h * 128 + c] : a.in[7][(size_t)l * 1024 + h * 128 + c]; }
    if (tid < 96) {
        const int r = tid >> 5, c = tid & 31, ch = h * 128 + q * 32 + c; float v;
        if (r == 0) v = a.in[9][l * 1024 + ch];
        else if (r == 1) v = a.in[11][l * 1024 + ch];
        else v = 8.0f * 1.4426950408889634f * log1pf(expf(-a.in[12][l * 1024 + ch]));
        EP[r * 32 + c] = v;
    }
    u32x4 pf[4], pfh = (u32x4){0u, 0u, 0u, 0u};
#pragma unroll
    for (int i = 0; i < 4; ++i) { const int id = tid + 512 * i, row = id >> 4, cc = id & 15; pf[i] = *(const u32x4*)(xr_base + (size_t)row * NPROJ + cc * 8); }
    const int sc_ci = lane >> 4, sc_sg = lane & 15, sc_c = wv * 4 + sc_ci;
    float hcar = 0.f;
#pragma unroll
    for (int i = 0; i < 4; ++i) { const int id = tid + 512 * i, row = id >> 4, cc = id & 15; *(LAS u32x4*)(XT + (3 + row) * XROW + cc * 16) = pf[i]; }
    if (tid < 48) *(LAS u32x4*)(XT + (tid >> 4) * XROW + (tid & 15) * 16) = pfh;
    for (int tile = 0; tile < SEQ / 128; ++tile) {
        const int t0 = tile * 128;
        LDS_BARRIER();
        {
            const int t0n = (tile + 1 < SEQ / 128) ? t0 + 128 : t0;
#pragma unroll
            for (int i = 0; i < 4; ++i) { const int id = tid + 512 * i, row = id >> 4, cc = id & 15; pf[i] = *(const u32x4*)(xr_base + (size_t)(t0n + row) * NPROJ + cc * 8); }
            if (tid < 48) pfh = *(const u32x4*)(xr_base + (size_t)(t0n - 3 + (tid >> 4)) * NPROJ + (tid & 15) * 8);
        }
        unsigned short gpre[8];
#pragma unroll
        for (int j = 0; j < 8; ++j) gpre[j] = gr_base[(size_t)(t0 + sc_sg * 8 + j) * NPROJ + sc_c];
        {
            f32x2 o[4][4], cw[4][4];
            {
                const f32x4 b0 = *(const LAS f32x4*)(CWT + 4 * 128 + ck * 8), b1 = *(const LAS f32x4*)(CWT + 4 * 128 + ck * 8 + 4);
#pragma unroll
                for (int i = 0; i < 4; ++i) { o[i][0] = (f32x2){b0.x, b0.y}; o[i][1] = (f32x2){b0.z, b0.w}; o[i][2] = (f32x2){b1.x, b1.y}; o[i][3] = (f32x2){b1.z, b1.w}; }
            }
#pragma unroll
            for (int k = 0; k < 4; ++k) { const f32x4 w0 = *(const LAS f32x4*)(CWT + k * 128 + ck * 8), w1 = *(const LAS f32x4*)(CWT + k * 128 + ck * 8 + 4);
                cw[k][0] = (f32x2){w0.x, w0.y}; cw[k][1] = (f32x2){w0.z, w0.w}; cw[k][2] = (f32x2){w1.x, w1.y}; cw[k][3] = (f32x2){w1.z, w1.w}; }
#pragma unroll
            for (int r = 0; r < 7; ++r) {
                const u32x4 w = *(const LAS u32x4*)(XT + (tg * 4 + r) * XROW + ck * 16);
                const f32x2 xv[4] = {(f32x2){bflo(w.x), bfhi(w.x)}, (f32x2){bflo(w.y), bfhi(w.y)}, (f32x2){bflo(w.z), bfhi(w.z)}, (f32x2){bflo(w.w), bfhi(w.w)}};
#pragma unroll
                for (int i = 0; i < 4; ++i) { const int k = r - i; if (k >= 0 && k < 4) {
#pragma unroll
                    for (int e = 0; e < 4; ++e) o[i][e] = __builtin_elementwise_fma(cw[k][e], xv[e], o[i][e]); } }
            }
#pragma unroll
            for (int i = 0; i < 4; ++i) { u32x4 w; w.x = pk2(o[i][0].x, o[i][0].y); w.y = pk2(o[i][1].x, o[i][1].y); w.z = pk2(o[i][2].x, o[i][2].y); w.w = pk2(o[i][3].x, o[i][3].y);
                *(LAS u32x4*)(UT + (tg * 4 + i) * XROW + ck * 16) = w; }
        }
        LDS_BARRIER();
        {
            f32x4 acc[4];
#pragma unroll
            for (int nb = 0; nb < 4; ++nb) acc[nb] = (f32x4){0.f, 0.f, 0.f, 0.f};
#pragma unroll
            for (int kb = 0; kb < 4; ++kb) { const bf16x8 uf = *(const LAS bf16x8*)(UT + (wv * 16 + fr) * XROW + kb * 64 + fq * 16);
#pragma unroll
                for (int nb = 0; nb < 4; ++nb) acc[nb] = __builtin_amdgcn_mfma_f32_16x16x32_bf16(*(const LAS bf16x8*)(WG + (nb * 16 + fr) * XROW + kb * 64 + fq * 16), uf, acc[nb], 0, 0, 0); }
            const int tk = wv * 16 + fr;
#pragma unroll
            for (int nb2 = 0; nb2 < 2; ++nb2) {
                const int c0 = nb2 * 16 + 4 * fq;
                const u32x2 uw = *(const LAS u32x2*)(UT + tk * XROW + (q * 32 + c0) * 2);
                const f32x4 uu = (f32x4){bflo(uw.x), bfhi(uw.x), bflo(uw.y), bfhi(uw.y)};
                const f32x4 ra = acc[nb2] + *(const LAS f32x4*)(EP + c0), rx = acc[nb2 + 2] + *(const LAS f32x4*)(EP + 32 + c0), sp8 = *(const LAS f32x4*)(EP + 64 + c0);
#pragma unroll
                for (int e = 0; e < 4; ++e) { const float r = fast_sigmoid(ra[e]), ig = fast_sigmoid(rx[e]);
                    const float av = __builtin_amdgcn_exp2f(-r * sp8[e]);
                    const float m2 = fmaxf(__builtin_fmaf(-av, av, 1.0f), 0.f);
                    AT[(c0 + e) * CROW + tk] = av; VT[(c0 + e) * CROW + tk] = __builtin_amdgcn_sqrtf(m2) * (ig * uu[e]); }
            }
        }
        LDS_BARRIER();
        {
            const f32x4 a0 = *(const LAS f32x4*)(AT + sc_c * CROW + sc_sg * 8), a1 = *(const LAS f32x4*)(AT + sc_c * CROW + sc_sg * 8 + 4);
            const f32x4 v0 = *(const LAS f32x4*)(VT + sc_c * CROW + sc_sg * 8), v1 = *(const LAS f32x4*)(VT + sc_c * CROW + sc_sg * 8 + 4);
            const float av[8] = {a0.x, a0.y, a0.z, a0.w, a1.x, a1.y, a1.z, a1.w}, vv[8] = {v0.x, v0.y, v0.z, v0.w, v1.x, v1.y, v1.z, v1.w};
            float hl[8], pp[8]; float hcur = 0.f, pcur = 1.f;
#pragma unroll
            for (int j = 0; j < 8; ++j) { hcur = __builtin_fmaf(av[j], hcur, vv[j]); pcur *= av[j]; hl[j] = hcur; pp[j] = pcur; }
            float P = pcur, H = hcur;
#pragma unroll
            for (int d = 1; d < 16; d <<= 1) { const float Pp = __shfl_up(P, d, 16), Hp = __shfl_up(H, d, 16); if (sc_sg >= d) { H = __builtin_fmaf(P, Hp, H); P *= Pp; } }
            float Pe = __shfl_up(P, 1, 16), He = __shfl_up(H, 1, 16); if (sc_sg == 0) { Pe = 1.f; He = 0.f; }
            const float carry = __builtin_fmaf(Pe, hcar, He);
            const float hend = __builtin_fmaf(P, hcar, H);
            hcar = __shfl(hend, 15, 16);
#pragma unroll
            for (int j = 0; j < 8; ++j) { const float hv = __builtin_fmaf(pp[j], carry, hl[j]); unsigned gw_ = gpre[j]; asm volatile("" : "+v"(gw_)); const float gv = __uint_as_float(gw_ << 16);
                const float yv = hv * gv * fast_sigmoid(gv);
                y_base[(size_t)(t0 + sc_sg * 8 + j) * DMIX + sc_c] = (bf16)(pk2(yv, 0.f) & 0xffffu); }
        }
#pragma unroll
        for (int i = 0; i < 4; ++i) { const int id = tid + 512 * i, row = id >> 4, cc = id & 15; *(LAS u32x4*)(XT + (3 + row) * XROW + cc * 16) = pf[i]; }
        if (tid < 48) *(LAS u32x4*)(XT + (tid >> 4) * XROW + (tid & 15) * 16) = pfh;
    }
    LDS_BARRIER();
}

constexpr int PROW = 528;
constexpr int R_XP = 0, R_PT = 42240;
__device__ __forceinline__ void pool_units(const Args& a, int l, int u, LAS unsigned char* lds) {
    const int tid = opaque_tid(), lane = tid & 63, wv = tid >> 6, fr = lane & 15, fq = lane >> 4;
    const int g = u & 3, bi = u >> 2, win = 2 << g;
    const bf16* PROJ = (const bf16*)(a.ws + WS_PROJ); bf16* YCAT = (bf16*)(a.ws + WS_YCAT);
    LAS unsigned char* XP = lds + R_XP; LAS unsigned char* PT = lds + R_PT;
    const bf16* pw = (const bf16*)(a.ws + WS_PW) + (size_t)(l * 4 + g) * 256 * 256;
    bf16x8 Wf[2][8];
#pragma unroll
    for (int nb = 0; nb < 2; ++nb)
#pragma unroll
        for (int kb = 0; kb < 8; ++kb) Wf[nb][kb] = *(const bf16x8*)(pw + (size_t)(wv * 32 + nb * 16 + fr) * 256 + kb * 32 + fq * 8);
    f32x4 pb[2], ps[2];
#pragma unroll
    for (int nb = 0; nb < 2; ++nb) { const int n = wv * 32 + nb * 16 + 4 * fq;
        pb[nb] = *(const f32x4*)(a.in[14] + (size_t)l * 1024 + g * 256 + n); ps[nb] = *(const f32x4*)(a.in[15] + (size_t)l * 1024 + g * 256 + n); }
    const int ck = tid & 31, tg = tid >> 5;
    u32x4 pf[5];
    {
        const int tile = bi * 8, b = tile >> 6, t0 = (tile & 63) * 64;
        const bf16* xp_base = PROJ + (size_t)(b * SEQ) * NPROJ + 2048 + g * 256;
#pragma unroll
        for (int i = 0; i < 5; ++i) { const int id = tid + 512 * i, row = id >> 5, cc = id & 31, t = t0 - 16 + row;
            const u32x4 v = *(const u32x4*)(xp_base + (size_t)(t < 0 ? 0 : t) * NPROJ + cc * 8); pf[i] = (t < 0) ? (u32x4){0u, 0u, 0u, 0u} : v; }
    }
#pragma unroll
    for (int i = 0; i < 5; ++i) { const int id = tid + 512 * i, row = id >> 5, cc = id & 31; *(LAS u32x4*)(XP + row * PROW + cc * 16) = pf[i]; }
    for (int it = 0; it < 8; ++it) {
        const int tile = bi * 8 + it, b = tile >> 6, t0 = (tile & 63) * 64;
        const bf16* gp_base = PROJ + (size_t)(b * SEQ) * NPROJ + 3072 + g * 256;
        bf16* y_base = YCAT + (size_t)(b * SEQ) * DMIX + 1024 + g * 256;
        LDS_BARRIER();
        {
            const int tile2 = bi * 8 + ((it + 1 < 8) ? it + 1 : it), b2 = tile2 >> 6, t02 = (tile2 & 63) * 64;
            const bf16* xp_base = PROJ + (size_t)(b2 * SEQ) * NPROJ + 2048 + g * 256;
#pragma unroll
            for (int i = 0; i < 5; ++i) { const int id = tid + 512 * i, row = id >> 5, cc = id & 31, t = t02 - 16 + row;
                const u32x4 v = *(const u32x4*)(xp_base + (size_t)(t < 0 ? 0 : t) * NPROJ + cc * 8); pf[i] = (t < 0) ? (u32x4){0u, 0u, 0u, 0u} : v; }
        }
        u32x2 gp[4][2];
#pragma unroll
        for (int tb = 0; tb < 4; ++tb)
#pragma unroll
            for (int nb = 0; nb < 2; ++nb) gp[tb][nb] = *(const u32x2*)(gp_base + (size_t)(t0 + tb * 16 + fr) * NPROJ + wv * 32 + nb * 16 + 4 * fq);
        {
            float s[8];
#pragma unroll
            for (int e = 0; e < 8; ++e) s[e] = 0.f;
            const int r0 = tg * 4 + 16;
            for (int r = r0 - win + 1; r < r0; ++r) { const u32x4 w = *(const LAS u32x4*)(XP + r * PROW + ck * 16);
                s[0] += bflo(w.x); s[1] += bfhi(w.x); s[2] += bflo(w.y); s[3] += bfhi(w.y); s[4] += bflo(w.z); s[5] += bfhi(w.z); s[6] += bflo(w.w); s[7] += bfhi(w.w); }
#pragma unroll
            for (int i = 0; i < 4; ++i) {
                const u32x4 w = *(const LAS u32x4*)(XP + (r0 + i) * PROW + ck * 16);
                const float xv[8] = {bflo(w.x), bfhi(w.x), bflo(w.y), bfhi(w.y), bflo(w.z), bfhi(w.z), bflo(w.w), bfhi(w.w)};
                const int t = t0 + tg * 4 + i; const float inv = __builtin_amdgcn_rcpf((float)((t + 1 < win) ? (t + 1) : win));
                float p[8];
#pragma unroll
                for (int e = 0; e < 8; ++e) { s[e] += xv[e]; p[e] = __builtin_fmaf(s[e], inv, -xv[e]); }
                u32x4 o; o.x = pk2(p[0], p[1]); o.y = pk2(p[2], p[3]); o.z = pk2(p[4], p[5]); o.w = pk2(p[6], p[7]);
                *(LAS u32x4*)(PT + (tg * 4 + i) * PROW + ck * 16) = o;
                const u32x4 wo = *(const LAS u32x4*)(XP + (r0 + i - win + 1) * PROW + ck * 16);
                s[0] -= bflo(wo.x); s[1] -= bfhi(wo.x); s[2] -= bflo(wo.y); s[3] -= bfhi(wo.y); s[4] -= bflo(wo.z); s[5] -= bfhi(wo.z); s[6] -= bflo(wo.w); s[7] -= bfhi(wo.w);
            }
        }
        LDS_BARRIER();
#pragma unroll
        for (int tb = 0; tb < 4; ++tb) {
            f32x4 acc[2] = {(f32x4){0.f, 0.f, 0.f, 0.f}, (f32x4){0.f, 0.f, 0.f, 0.f}};
#pragma unroll
            for (int kb = 0; kb < 8; ++kb) { const bf16x8 pfm = *(const LAS bf16x8*)(PT + (tb * 16 + fr) * PROW + kb * 64 + fq * 16);
#pragma unroll
                for (int nb = 0; nb < 2; ++nb) acc[nb] = __builtin_amdgcn_mfma_f32_16x16x32_bf16(Wf[nb][kb], pfm, acc[nb], 0, 0, 0); }
            const int t = t0 + tb * 16 + fr;
#pragma unroll
            for (int nb = 0; nb < 2; ++nb) { const int n = wv * 32 + nb * 16 + 4 * fq;
                const u32x2 gw2 = gp[tb][nb];
                const f32x4 gv = (f32x4){bflo(gw2.x), bfhi(gw2.x), bflo(gw2.y), bfhi(gw2.y)};
                f32x4 r = (acc[nb] + pb[nb]) * ps[nb];
#pragma unroll
                for (int e = 0; e < 4; ++e) r[e] *= gv[e] * fast_sigmoid(gv[e]);
                u32x2 o; o.x = pk2(r.x, r.y); o.y = pk2(r.z, r.w);
                *(u32x2*)(y_base + (size_t)t * DMIX + n) = o; }
        }
#pragma unroll
        for (int i = 0; i < 5; ++i) { const int id = tid + 512 * i, row = id >> 5, cc = id & 31; *(LAS u32x4*)(XP + row * PROW + cc * 16) = pf[i]; }
    }
    LDS_BARRIER();
}

__device__ __forceinline__ void phase_mixer(const Args& a, int l, LAS unsigned char* lds) {
#ifndef MK_MIX
#define MK_MIX 3
#endif
#ifndef MK_DBL_RNN
#define MK_DBL_RNN 0
#endif
#ifndef MK_DBL_POOL
#define MK_DBL_POOL 0
#endif
    for (int rep = 0; rep < 1 + ((l == 0) ? MK_DBL_RNN : 0); ++rep) for (int u = blockIdx.x; u < 256; u += gridDim.x) rnn_unit(a, l, u, lds);
    for (int rep = 0; rep < 1 + ((l == 0) ? MK_DBL_POOL : 0); ++rep) for (int u = blockIdx.x; u < 256; u += gridDim.x) pool_units(a, l, u, lds);
}
#ifndef MK_DBL_PH
#define MK_DBL_PH -1
#endif
#ifndef MK_MASK
#define MK_MASK 63
#endif
__global__ void __launch_bounds__(512, 2) mk_fwd(Args a) {
    extern __shared__ __attribute__((aligned(16))) unsigned char lds_raw[];
    LAS unsigned char* lds = (LAS unsigned char*)lds_raw;
    cg::grid_group grid = cg::this_grid();
    for (int ph = a.ph_lo; ph < a.ph_hi; ++ph) {
#if MK_DBL_PH >= 0
      for (int rep = 0; rep < ((ph == MK_DBL_PH) ? 2 : 1); ++rep) {
        if (rep) grid.sync();
#endif
        if (ph == 0) { if (MK_MASK & 1) phase_prep(a, lds); }
        else if (ph == 1) { if (MK_MASK & 2) phase_h0(a); }
        else {
            const int l = (ph - 2) >> 2, sub = (ph - 2) & 3;
            if (sub == 0) { if (MK_MASK & 4) {
                pg8::Gemm g{(const pg8::bf16_t*)(a.ws + WS_H), (const pg8::bf16_t*)(a.ws + WS_WIN) + (size_t)l * NPROJ * D, T, NPROJ, D};
                pg8::StaticOrder S; S.init(T, NPROJ, gridDim.x, (int)blockIdx.x);
                pg8::EpiBf16<0> E{(pg8::bf16_t*)(a.ws + WS_PROJ), NPROJ, nullptr, 0, 0, 1.f};
                pg8::gemm_phase<pg8::EpiBf16<0>, pg8::StaticOrder, PG8_ALIGN, PG8_SP2>(lds, g, S, E); }
            } else if (sub == 1) {
                if (MK_MASK & 8) phase_mixer(a, l, lds);
            } else if (sub == 2) { if (MK_MASK & 16) {
                pg8::Gemm g{(const pg8::bf16_t*)(a.ws + WS_YCAT), (const pg8::bf16_t*)(a.ws + WS_WOUT) + (size_t)l * D * DMIX, T, D, DMIX};
                pg8::StaticOrder S; S.init(T, D, gridDim.x, (int)blockIdx.x);
                pg8::EpiBf16<0> E{(pg8::bf16_t*)(a.ws + WS_Y), D, nullptr, 0, 0, 1.f};
                pg8::gemm_phase<pg8::EpiBf16<0>, pg8::StaticOrder, PG8_ALIGN, PG8_SP2>(lds, g, S, E); }
            } else {
                if (MK_MASK & 32) phase_post(a, l);
            }
        }
#if MK_DBL_PH >= 0
      }
#endif
        if (ph + 1 < a.ph_hi) grid.sync();
    }
}

extern "C" void kernel_launch(void* const* d_in, const int* in_sizes, int n_in, void* d_out, int out_size, void* d_ws, size_t ws_size, hipStream_t stream) {
    static int grid = 0;
    if (grid == 0) {
        if (n_in != 18 || in_sizes[0] != T * D || out_size != T * D || ws_size < WS_END) {
            fprintf(stderr, "kernel_launch: unexpected shapes (n_in %d, in0 %d, out %d, ws %zu); nothing launched\n", n_in, n_in > 0 ? in_sizes[0] : -1, out_size, ws_size); grid = -1; return; }
        int dev = 0, cus = 0, per_cu = 0;
        if (hipGetDevice(&dev) != hipSuccess || hipDeviceGetAttribute(&cus, hipDeviceAttributeMultiprocessorCount, dev) != hipSuccess) { grid = -1; return; }
        if (hipFuncSetAttribute((const void*)mk_fwd, hipFuncAttributeMaxDynamicSharedMemorySize, LDS_BYTES) != hipSuccess) { fprintf(stderr, "kernel_launch: hipFuncSetAttribute failed\n"); grid = -1; return; }
        if (hipOccupancyMaxActiveBlocksPerMultiprocessor(&per_cu, (const void*)mk_fwd, 512, LDS_BYTES) != hipSuccess || per_cu < 1) { fprintf(stderr, "kernel_launch: occupancy query says %d blocks per CU\n", per_cu); per_cu = 1; }
        (void)hipGetLastError();
        grid = cus;
    }
    if (grid < 0) return;
    Args a{};
    for (int i = 0; i < 18; ++i) a.in[i] = (const float*)d_in[i];
    a.out = (float*)d_out; a.ws = (unsigned char*)d_ws;
#if MK_N_LAUNCHES == 1
    a.ph_lo = 0; a.ph_hi = NPH;
    void* args[] = {&a};
    const hipError_t e = hipLaunchCooperativeKernel((const void*)mk_fwd, dim3(grid), dim3(512), args, LDS_BYTES, stream);
    if (e != hipSuccess) fprintf(stderr, "kernel_launch: cooperative launch failed: %s (grid %d)\n", hipGetErrorString(e), grid);
#else
    for (int ph = 0; ph < NPH; ++ph) {
        a.ph_lo = ph; a.ph_hi = ph + 1;
        hipLaunchKernelGGL(mk_fwd, dim3(grid), dim3(512), LDS_BYTES, stream, a);
    }
#endif
}
```

```cpp
#include <hip/hip_runtime.h>
#include <hip/hip_cooperative_groups.h>
#include <cstdio>
#include <cstdint>
namespace cg = cooperative_groups;
__device__ __forceinline__ int opaque_tid() { int t = threadIdx.x; asm volatile("" : "+v"(t)); return t; }
namespace pg8 {
#define PG8_LAS __attribute__((address_space(3)))
typedef unsigned short bf16_t;
typedef short bf16x8 __attribute__((ext_vector_type(8)));
typedef float f32x4 __attribute__((ext_vector_type(4)));
typedef unsigned u32x4 __attribute__((ext_vector_type(4)));
constexpr int BM = 256, BK = 64, HALF = 128, HTB = HALF * BK * 2  , STAGE_BYTES = 8 * HTB, NXCD = 8, WGM = 8;

__host__ __device__ __forceinline__ int lds_byte(int r, int c) { const int st = (r >> 4) * 2 + (c >> 5), rr = r & 15, cc = c & 31, ob = rr * 64 + cc * 2; return st * 1024 + (ob ^ (((ob >> 9) & 1) << 5)); }
__host__ __device__ __forceinline__ void stage_rc(int b, int& R, int& C) { const int st = b / 1024, sb = b % 1024, swz = sb ^ (((sb >> 9) & 1) << 5); R = (st >> 1) * 16 + swz / 64; C = (st & 1) * 32 + (swz % 64) / 2; }
__host__ __device__ __forceinline__ int perm32(int rho) { const int n = rho >> 4, i = rho & 15; return 8 * (i >> 2) + 4 * n + (i & 3); }

struct Unit { int pm, pn; };
struct Gemm { const bf16_t* A; const bf16_t* Bt; int M, N, K; };

struct StaticOrder {
    int nM, nN, nwg, G, c;
    __host__ __device__ void init(int M, int N, int G_, int c_) { nM = M / BM; nN = N / BM; nwg = nM * nN; G = G_; c = c_; }
    __host__ __device__ bool next(int i, Unit& u) const {
        const long L = (long)i * G + c; if (L >= nwg) return false;
        int wgid = (int)L; { const int q = nwg / NXCD, r = nwg % NXCD, xcd = wgid % NXCD, off = wgid / NXCD; wgid = (xcd < r ? xcd * (q + 1) : r * (q + 1) + (xcd - r) * q) + off; }
        const int nig = WGM * nN, gid = wgid / nig, fm = gid * WGM, gsz = (nM - fm) < WGM ? (nM - fm) : WGM;
        u.pm = fm + ((wgid % nig) % gsz); u.pn = (wgid % nig) / gsz; return true;
    }
    __device__ __forceinline__ void a_ready(const Unit&) const {}
    __device__ __forceinline__ void done(const Unit&) const {}
};

__device__ __forceinline__ unsigned cvt_pk_bf16(float lo, float hi) { unsigned r; asm volatile("v_cvt_pk_bf16_f32 %0, %1, %2" : "=v"(r) : "v"(lo), "v"(hi)); return r; }
typedef float f32x2 __attribute__((ext_vector_type(2)));
__device__ __forceinline__ f32x2 gelu_pk(f32x2 v) {
    const f32x2 av = __builtin_elementwise_abs(v), d = av * 0.2316418882f + 1.0f;
    f32x2 t; t.x = __builtin_amdgcn_rcpf(d.x); t.y = __builtin_amdgcn_rcpf(d.y);
    f32x2 q = t * 0.5307027145f + (-0.7265760135f); q = q * t + 0.7107068705f; q = q * t + (-0.142248368f); q = q * t + 0.127414796f; q = q * t;
    const f32x2 s = (v * v) * (-0.72134752044f);
    f32x2 e; e.x = __builtin_amdgcn_exp2f(s.x); e.y = __builtin_amdgcn_exp2f(s.y);
    const f32x2 m = v * (q * e), r = v - m;
    f32x2 o; o.x = v.x < 0.f ? m.x : r.x; o.y = v.y < 0.f ? m.y : r.y; return o;
}

template <int ACT  > struct EpiBf16 {
    static constexpr bool PERM = true, AFTER_DRAIN = false; static_assert(ACT == 0 || ACT == 1, "EpiBf16: ACT is 0 (none) or 1 (gelu_pk)");
    bf16_t* O; int ldc; const float* bias; int split_cols; size_t split_stride; float scale0;
    __device__ __forceinline__ void operator()(const f32x4 (&acc)[2][2][4][2], const Unit& u, int wr, int wc, int fr, int fq) const {
        const int row0 = u.pm * BM + wr * 64 + fr; int colt = u.pn * BM; bf16_t* base = O;
        float sc = 1.f; if (split_cols) { const int t = colt / split_cols; base += (size_t)t * split_stride; colt -= t * split_cols; if (t == 0) sc = scale0; }
        const int col0 = colt + wc * 32 + 8 * fq, bcol0 = u.pn * BM + wc * 32 + 8 * fq;
        f32x4 bv[2][2];
#pragma unroll
        for (int bj = 0; bj < 2; ++bj)
#pragma unroll
            for (int n = 0; n < 2; ++n) bv[bj][n] = bias ? *(const f32x4*)(bias + bcol0 + bj * HALF + 4 * n) : (f32x4){0.f, 0.f, 0.f, 0.f};
#pragma unroll
        for (int ai = 0; ai < 2; ++ai)
#pragma unroll
            for (int m = 0; m < 4; ++m) { bf16_t* rowp = base + (size_t)(row0 + ai * HALF + m * 16) * ldc + col0;
#pragma unroll
                for (int bj = 0; bj < 2; ++bj) { f32x4 v0 = acc[ai][bj][m][0] + bv[bj][0], v1 = acc[ai][bj][m][1] + bv[bj][1];
                    if (ACT == 1) { f32x2 a = gelu_pk((f32x2){v0[0], v0[1]}), b = gelu_pk((f32x2){v0[2], v0[3]}), c = gelu_pk((f32x2){v1[0], v1[1]}), d = gelu_pk((f32x2){v1[2], v1[3]});
                        v0 = (f32x4){a.x, a.y, b.x, b.y}; v1 = (f32x4){c.x, c.y, d.x, d.y}; }
                    v0 = v0 * sc; v1 = v1 * sc; u32x4 w; w.x = cvt_pk_bf16(v0[0], v0[1]); w.y = cvt_pk_bf16(v0[2], v0[3]); w.z = cvt_pk_bf16(v1[0], v1[1]); w.w = cvt_pk_bf16(v1[2], v1[3]);
                    *(u32x4*)(rowp + bj * HALF) = w; } }
    }
};
template <class Epi, class Sched, bool ALIGN_EPI = false, bool SP2 = false>
__device__ __forceinline__ void gemm_phase(PG8_LAS unsigned char* lds, const Gemm g, const Sched& S, const Epi& E) {
    const int tid = opaque_tid(), wid = __builtin_amdgcn_readfirstlane(tid >> 6), lane = tid & 63, wr = wid >> 2, wc = wid & 3, fr = lane & 15, fq = lane >> 4;
    const int K = g.K, nt = K / BK;
    unsigned voffA[2], voffB[2];
#pragma unroll
    for (int i = 0; i < 2; ++i) { int R, C; stage_rc(tid * 16 + i * 8192, R, C); const int Rb = Epi::PERM ? ((R & ~31) + perm32(R & 31)) : R;
        voffA[i] = (unsigned)(R * K + C) * 2u; voffB[i] = (unsigned)(Rb * K + C) * 2u; }
    const size_t kstep = (size_t)(BK * 2);
    const size_t hstep = (size_t)HALF * K * 2;
    const size_t tstep = 2 * hstep;
    const unsigned ldsw = (unsigned)wid * 1024u;
    const int aoff = lds_byte(wr * 64 + fr, fq * 8), boff = lds_byte(wc * 32 + fr, fq * 8);
#define PG8_SA(b, h) (((b) * 2 + (h)) * HTB)
#define PG8_SB(b, h) ((4 + (b) * 2 + (h)) * HTB)
#define PG8_STAGE(bufoff, gbase, voff) do { _Pragma("unroll") for (int _i = 0; _i < 2; ++_i) \
        __builtin_amdgcn_global_load_lds((const unsigned*)((const char*)(gbase) + (voff)[_i]), (PG8_LAS unsigned*)(lds + (bufoff) + ldsw + _i * 8192), 16, 0, 0); } while (0)
#define PG8_LDA(dst, b, h) do { _Pragma("unroll") for (int m = 0; m < 4; ++m) _Pragma("unroll") for (int k = 0; k < 2; ++k) dst[m][k] = *(const PG8_LAS bf16x8*)(lds + PG8_SA(b, h) + aoff + m * 2048 + k * 1024); } while (0)
#define PG8_LDB(dst, b, h) do { _Pragma("unroll") for (int n = 0; n < 2; ++n) _Pragma("unroll") for (int k = 0; k < 2; ++k) dst[n][k] = *(const PG8_LAS bf16x8*)(lds + PG8_SB(b, h) + boff + n * 2048 + k * 1024); } while (0)
#define PG8_MMA(ai, bj, At, Bt) do { __builtin_amdgcn_s_setprio(1); _Pragma("unroll") for (int m = 0; m < 4; ++m) _Pragma("unroll") for (int n = 0; n < 2; ++n) _Pragma("unroll") for (int k = 0; k < 2; ++k) \
        acc[ai][bj][m][n] = __builtin_amdgcn_mfma_f32_16x16x32_bf16(Bt[n][k], At[m][k], acc[ai][bj][m][n], 0, 0, 0); __builtin_amdgcn_s_setprio(0); } while (0)
#define PG8_WAIT_V(n) asm volatile("s_waitcnt vmcnt(" #n ")" ::: "memory")
#define PG8_WAIT_L(n) asm volatile("s_waitcnt lgkmcnt(" #n ")" ::: "memory")
#define PG8_BAR __builtin_amdgcn_s_barrier()
#define PG8_SCHED __builtin_amdgcn_sched_barrier(0)
    Unit cur, nxt; int ui = 0;
    if (!S.next(0, cur)) return;
    f32x4 acc[2][2][4][2];
#pragma unroll
    for (int a = 0; a < 2; ++a)
#pragma unroll
        for (int b = 0; b < 2; ++b)
#pragma unroll
            for (int m = 0; m < 4; ++m)
#pragma unroll
                for (int n = 0; n < 2; ++n) acc[a][b][m][n] = (f32x4){0.f, 0.f, 0.f, 0.f};
    bf16x8 At[4][2], B0[2][2], B1[2][2];
    const char* cA = (const char*)g.A + (size_t)cur.pm * tstep; const char* cB = (const char*)g.Bt + (size_t)cur.pn * tstep;
    S.a_ready(cur);
    if constexpr (SP2) {
        PG8_STAGE(PG8_SB(0, 0), cB, voffB); PG8_STAGE(PG8_SB(0, 1), cB + hstep, voffB); PG8_STAGE(PG8_SA(0, 0), cA, voffA); PG8_STAGE(PG8_SA(0, 1), cA + hstep, voffA);
        if (wr == 1) PG8_BAR;
        PG8_WAIT_V(2); PG8_BAR;
        PG8_STAGE(PG8_SB(1, 0), cB + kstep, voffB); PG8_STAGE(PG8_SA(1, 0), cA + kstep, voffA); PG8_STAGE(PG8_SB(1, 1), cB + hstep + kstep, voffB);
        PG8_WAIT_V(6); PG8_BAR;
    } else {
        PG8_STAGE(PG8_SB(0, 0), cB, voffB); PG8_STAGE(PG8_SA(0, 0), cA, voffA); PG8_STAGE(PG8_SB(0, 1), cB + hstep, voffB); PG8_STAGE(PG8_SA(0, 1), cA + hstep, voffA);
        if (wr == 1) PG8_BAR;
        PG8_WAIT_V(4); PG8_BAR;
        PG8_STAGE(PG8_SB(1, 0), cB + kstep, voffB); PG8_STAGE(PG8_SA(1, 0), cA + kstep, voffA); PG8_STAGE(PG8_SB(1, 1), cB + hstep + kstep, voffB);
        PG8_WAIT_V(6); PG8_BAR;
    }
    for (;;) {
        const bool has_next = S.next(ui + 1, nxt);
        const char* nA = has_next ? (const char*)g.A + (size_t)nxt.pm * tstep : cA; const char* nB = has_next ? (const char*)g.Bt + (size_t)nxt.pn * tstep : cB;
        for (int t = 0; t < nt; t += 2) {
            const bool last = (t == nt - 2);
            const char* a1 = cA + (size_t)(t + 1) * kstep;
            const char* a2 = last ? nA : cA + (size_t)(t + 2) * kstep; const char* b2 = last ? nB : cB + (size_t)(t + 2) * kstep;
            const char* a3 = a2 + kstep; const char* b3 = b2 + kstep;
            if (last && has_next) S.a_ready(nxt);
            if constexpr (SP2) {
            PG8_LDB(B0, 0, 0); PG8_LDB(B1, 0, 1); PG8_SCHED; PG8_LDA(At, 0, 0); PG8_STAGE(PG8_SA(1, 1), a1 + hstep, voffA);
            PG8_WAIT_V(8); PG8_WAIT_L(0); PG8_BAR; PG8_MMA(0, 0, At, B0); PG8_MMA(0, 1, At, B1); PG8_BAR; PG8_SCHED;
            PG8_LDA(At, 0, 1); PG8_STAGE(PG8_SB(0, 0), b2, voffB); PG8_STAGE(PG8_SB(0, 1), b2 + hstep, voffB); PG8_STAGE(PG8_SA(0, 0), a2, voffA);
            PG8_WAIT_V(8); PG8_WAIT_L(0); PG8_BAR; PG8_MMA(1, 0, At, B0); PG8_MMA(1, 1, At, B1); PG8_BAR; PG8_SCHED;
            PG8_LDB(B0, 1, 0); PG8_LDB(B1, 1, 1); PG8_SCHED; PG8_LDA(At, 1, 0); PG8_STAGE(PG8_SA(0, 1), a2 + hstep, voffA);
            PG8_WAIT_V(8); PG8_WAIT_L(0); PG8_BAR; PG8_MMA(0, 0, At, B0); PG8_MMA(0, 1, At, B1); PG8_BAR; PG8_SCHED;
            PG8_LDA(At, 1, 1); PG8_STAGE(PG8_SB(1, 0), b3, voffB); PG8_STAGE(PG8_SB(1, 1), b3 + hstep, voffB); PG8_STAGE(PG8_SA(1, 0), a3, voffA);
            PG8_WAIT_V(8); PG8_WAIT_L(0); PG8_BAR; PG8_MMA(1, 0, At, B0); PG8_MMA(1, 1, At, B1); PG8_BAR; PG8_SCHED;
            } else {
            PG8_LDB(B0, 0, 0); PG8_SCHED; PG8_LDA(At, 0, 0); PG8_STAGE(PG8_SA(1, 1), a1 + hstep, voffA);
            PG8_WAIT_L(8); PG8_BAR; PG8_WAIT_L(0); PG8_MMA(0, 0, At, B0); PG8_BAR; PG8_SCHED;
            PG8_LDB(B1, 0, 1); PG8_STAGE(PG8_SB(0, 0), b2, voffB);
            PG8_BAR; PG8_WAIT_L(0); PG8_MMA(0, 1, At, B1); PG8_BAR;
            PG8_LDA(At, 0, 1); PG8_STAGE(PG8_SA(0, 0), a2, voffA);
            PG8_BAR; PG8_WAIT_L(0); PG8_MMA(1, 0, At, B0); PG8_BAR; PG8_SCHED;
            PG8_STAGE(PG8_SB(0, 1), b2 + hstep, voffB);
            PG8_WAIT_V(6); PG8_BAR; PG8_MMA(1, 1, At, B1); PG8_BAR;
            PG8_LDB(B0, 1, 0); PG8_SCHED; PG8_LDA(At, 1, 0); PG8_STAGE(PG8_SA(0, 1), a2 + hstep, voffA);
            PG8_WAIT_L(8); PG8_BAR; PG8_WAIT_L(0); PG8_MMA(0, 0, At, B0); PG8_BAR; PG8_SCHED;
            PG8_LDB(B1, 1, 1); PG8_STAGE(PG8_SB(1, 0), b3, voffB);
            PG8_BAR; PG8_WAIT_L(0); PG8_MMA(0, 1, At, B1); PG8_BAR;
            PG8_LDA(At, 1, 1); PG8_STAGE(PG8_SA(1, 0), a3, voffA);
            PG8_BAR; PG8_WAIT_L(0); PG8_MMA(1, 0, At, B0); PG8_BAR; PG8_SCHED;
            PG8_STAGE(PG8_SB(1, 1), b3 + hstep, voffB);
            PG8_WAIT_V(6); PG8_BAR; PG8_MMA(1, 1, At, B1); PG8_BAR;
            }
        }
        if constexpr (ALIGN_EPI) { if (wr == 0) PG8_BAR; }
        if constexpr (!Epi::AFTER_DRAIN) { E(acc, cur, wr, wc, fr, fq); S.done(cur); }
        if (!has_next) break;
#pragma unroll
        for (int a = 0; a < 2; ++a)
#pragma unroll
            for (int b = 0; b < 2; ++b)
#pragma unroll
                for (int m = 0; m < 4; ++m)
#pragma unroll
                    for (int n = 0; n < 2; ++n) acc[a][b][m][n] = (f32x4){0.f, 0.f, 0.f, 0.f};
        cur = nxt; cA = nA; cB = nB; ++ui;
        if constexpr (ALIGN_EPI) { if (wr == 1) PG8_BAR; }
    }
    PG8_WAIT_V(0);
    if constexpr (!ALIGN_EPI) { if (wr == 0) PG8_BAR; }
    PG8_BAR;
    if constexpr (Epi::AFTER_DRAIN) { E.fused(acc, cur, wr, wc, fr, fq, lds, wid, lane); S.done(cur); }
#undef PG8_SA
#undef PG8_SB
#undef PG8_STAGE
#undef PG8_LDA
#undef PG8_LDB
#undef PG8_MMA
#undef PG8_WAIT_V
#undef PG8_WAIT_L
#undef PG8_BAR
#undef PG8_SCHED
}
}
#ifndef PG8_SP2
#define PG8_SP2 true
#endif
#ifndef PG8_ALIGN
#define PG8_ALIGN true
#endif
#ifndef MK_N_LAUNCHES
#define MK_N_LAUNCHES 1
#endif

constexpr int NB = 8, SEQ = 4096, D = 1024, T = NB * SEQ, NPROJ = 4096, DMIX = 2048;
constexpr int NPH = 10;
constexpr float EPS = 1e-6f;
constexpr size_t MiB = 1u << 20;
constexpr size_t WS_WIN = 0, WS_WOUT = 16 * MiB, WS_GW = 24 * MiB, WS_PW = 25 * MiB, WS_MOD = 26 * MiB;
constexpr size_t WS_H = 32 * MiB, WS_YCAT = 96 * MiB, WS_PROJ = 224 * MiB, WS_Y = WS_PROJ, WS_END = 480 * MiB;
constexpr size_t WS_CTL = 28 * MiB, CTL_BYTES = 16384;
constexpr int LDS_BYTES = 147456, LDS_BST_OFF = 131072 + 64;

#define LAS __attribute__((address_space(3)))
typedef unsigned short bf16;
typedef float f32x4 __attribute__((ext_vector_type(4)));
typedef float f32x2 __attribute__((ext_vector_type(2)));
typedef unsigned u32x4 __attribute__((ext_vector_type(4)));
typedef unsigned u32x2 __attribute__((ext_vector_type(2)));
typedef short bf16x8 __attribute__((ext_vector_type(8)));

struct Args { const float* in[18]; float* out; unsigned char* ws; int ph_lo, ph_hi; };

__device__ __forceinline__ unsigned pk2(float lo, float hi) { return pg8::cvt_pk_bf16(lo, hi); }
__device__ __forceinline__ float bflo(unsigned w) { return __uint_as_float(w << 16); }
__device__ __forceinline__ float bfhi(unsigned w) { return __uint_as_float(w & 0xffff0000u); }
__device__ __forceinline__ float wave_sum(float v) {
#pragma unroll
    for (int o = 1; o < 64; o <<= 1) v += __shfl_xor(v, o);
    return v;
}
__device__ __forceinline__ float sigmoidf_(float x) { return 1.0f / (1.0f + __expf(-x)); }
__device__ __forceinline__ float siluf_(float x) { return x / (1.0f + __expf(-x)); }

__device__ __forceinline__ void transpose_item(const float* W, int K, int N, bf16* WT, LAS float* scr, int item, int lane) {
    const int nblk = N / 32, kb = item / nblk, nb = item % nblk, k0 = 64 * kb, n0 = 32 * nb;
#pragma unroll 8
    for (int i = 0; i < 32; ++i) { const int kk = 2 * i + (lane >> 5); scr[kk * 33 + (lane & 31)] = W[(size_t)(k0 + kk) * N + n0 + (lane & 31)]; }
    asm volatile("s_waitcnt lgkmcnt(0)" ::: "memory");
    const int c = lane & 7;
#pragma unroll
    for (int j = 0; j < 4; ++j) { const int n = (lane >> 3) + 8 * j; const LAS float* s = scr + (8 * c) * 33 + n;
        u32x4 o; o.x = pk2(s[0 * 33], s[1 * 33]); o.y = pk2(s[2 * 33], s[3 * 33]); o.z = pk2(s[4 * 33], s[5 * 33]); o.w = pk2(s[6 * 33], s[7 * 33]);
        *(u32x4*)(WT + (size_t)(n0 + n) * K + k0 + 8 * c) = o; }
    asm volatile("s_waitcnt lgkmcnt(0)" ::: "memory");
}

__device__ __forceinline__ void phase_prep(const Args& a, LAS unsigned char* lds) {
    const int tid = opaque_tid(), lane = tid & 63, wv = tid >> 6;
    const int G = gridDim.x;
    unsigned char* ws = a.ws;
    {
        LAS float* sc = (LAS float*)lds;
        LAS float* red = (LAS float*)(lds + 32768);
        const float* c = a.in[1]; const float* ada_w = a.in[2]; const float* ada_b = a.in[3];
        float* MOD = (float*)(ws + WS_MOD);
        if ((int)blockIdx.x < 192) {
            for (int i = tid; i < 8192; i += 512) sc[i] = siluf_(c[i]);
            __syncthreads();
            for (int unit = blockIdx.x; unit < 192; unit += G) {
                const int l = unit / 96, cb = (unit % 96) * 32, cl = tid & 31, ks = tid >> 5;
                const float* wp = ada_w + (size_t)l * 1024 * 3072 + (size_t)(ks * 64) * 3072 + cb + cl;
                float acc[8];
#pragma unroll
                for (int b = 0; b < 8; ++b) acc[b] = 0.f;
#pragma unroll 4
                for (int k = 0; k < 64; ++k) { const float w = wp[(size_t)k * 3072];
#pragma unroll
                    for (int b = 0; b < 8; ++b) acc[b] += sc[b * 1024 + ks * 64 + k] * w; }
#pragma unroll
                for (int b = 0; b < 8; ++b) red[(ks * 8 + b) * 32 + cl] = acc[b];
                __syncthreads();
                if (tid < 256) { const int b = tid >> 5; float s = 0.f;
#pragma unroll
                    for (int k2 = 0; k2 < 16; ++k2) s += red[(k2 * 8 + b) * 32 + cl];
                    MOD[(l * 8 + b) * 3072 + cb + cl] = s + ada_b[l * 3072 + cb + cl]; }
                __syncthreads();
            }
        }
        __syncthreads();
    }
    {
        LAS float* scr = (LAS float*)(lds + wv * 16384);
        const int gw = blockIdx.x * 8 + wv, NGW = G * 8;
        constexpr int I_IN = (1024 / 64) * (4096 / 32), I_OUT = (2048 / 64) * (1024 / 32);
        for (int it = gw; it < 2 * (I_IN + I_OUT); it += NGW) {
            int r = it;
            if (r < 2 * I_IN) { const int l = r / I_IN; r -= l * I_IN;
                transpose_item(a.in[5] + (size_t)l * 1024 * 4096, 1024, 4096, (bf16*)(ws + WS_WIN) + (size_t)l * 4096 * 1024, scr, r, lane); }
            else { r -= 2 * I_IN; const int l = r / I_OUT; r -= l * I_OUT;
                transpose_item(a.in[16] + (size_t)l * 2048 * 1024, 2048, 1024, (bf16*)(ws + WS_WOUT) + (size_t)l * 1024 * 2048, scr, r, lane); }
        }
    }
    {
        const size_t gt = (size_t)blockIdx.x * 512 + tid, GT = (size_t)G * 512;
        bf16* GWp = (bf16*)(ws + WS_GW); bf16* PWp = (bf16*)(ws + WS_PW);
        const float* ga = a.in[8]; const float* gx = a.in[10]; const float* pw = a.in[13];
        for (size_t i = gt; i < (size_t)2 * 8 * 4 * 64 * 128; i += GT) {
            const int k = (int)(i & 127), n = (int)((i >> 7) & 63), q = (int)((i >> 13) & 3), lh = (int)(i >> 15);
            const float v = (n < 32) ? ga[((size_t)lh * 128 + k) * 128 + q * 32 + n] : gx[((size_t)lh * 128 + k) * 128 + q * 32 + n - 32];
            GWp[i] = (bf16)(pk2(v, 0.f) & 0xffffu);
        }
        for (size_t i = gt; i < (size_t)2 * 4 * 256 * 256; i += GT) {
            const int k = (int)(i & 255), n = (int)((i >> 8) & 255), lg = (int)(i >> 16);
            const float v = pw[((size_t)lg * 256 + k) * 256 + n];
            PWp[i] = (bf16)(pk2(v, 0.f) & 0xffffu);
        }
    }
}

constexpr int RPW = 4;
__device__ __forceinline__ void phase_h0(const Args& a) {
    const int tid = opaque_tid(), lane = tid & 63, wv = tid >> 6;
    const int gw = blockIdx.x * 8 + wv, NGW = gridDim.x * 8;
    const float* x = a.in[0]; const float* g = a.in[4]; const float* MOD = (const float*)(a.ws + WS_MOD);
    bf16* H = (bf16*)(a.ws + WS_H);
    for (int m0 = gw * RPW; m0 < T; m0 += NGW * RPW) {
        f32x4 v[RPW][4];
#pragma unroll
        for (int r = 0; r < RPW; ++r) { const f32x4* xr = (const f32x4*)(x + (size_t)(m0 + r) * D) + lane;
#pragma unroll
            for (int j = 0; j < 4; ++j) v[r][j] = __builtin_nontemporal_load(xr + 64 * j); }
        const int b = m0 >> 12;
        const float* sh = MOD + (size_t)b * 3072; const float* scl = sh + 1024;
#pragma unroll
        for (int r = 0; r < RPW; ++r) {
            float ss = 0.f;
#pragma unroll
            for (int j = 0; j < 4; ++j) ss += (v[r][j].x * v[r][j].x + v[r][j].y * v[r][j].y) + (v[r][j].z * v[r][j].z + v[r][j].w * v[r][j].w);
            const float rstd = 1.0f / sqrtf(wave_sum(ss) * (1.0f / D) + EPS);
            u32x2* o = (u32x2*)(H + (size_t)(m0 + r) * D) + lane;
#pragma unroll
            for (int j = 0; j < 4; ++j) { const int col = 4 * lane + 256 * j;
                const f32x4 gg = *(const f32x4*)(g + col), s4 = *(const f32x4*)(scl + col), h4 = *(const f32x4*)(sh + col);
                const f32x4 rr = v[r][j] * rstd * gg * (s4 + 1.0f) + h4;
                u32x2 w; w.x = pk2(rr.x, rr.y); w.y = pk2(rr.z, rr.w); o[64 * j] = w; }
        }
    }
}

__device__ __forceinline__ void phase_post(const Args& a, int l) {
    const int tid = opaque_tid(), lane = tid & 63, wv = tid >> 6;
    const int gw = blockIdx.x * 8 + wv, NGW = gridDim.x * 8;
    const float* xin = (l == 0) ? a.in[0] : a.out; float* out = a.out;
    const bf16* Y = (const bf16*)(a.ws + WS_Y); bf16* H = (bf16*)(a.ws + WS_H);
    const float* MOD = (const float*)(a.ws + WS_MOD);
    const float* gpost = a.in[17] + l * D; const float* gpre = a.in[4] + (l + 1) * D;
    for (int m0 = gw * RPW; m0 < T; m0 += NGW * RPW) {
        f32x4 xv[RPW][4]; u32x2 yw[RPW][4];
#pragma unroll
        for (int r = 0; r < RPW; ++r) { const f32x4* xr = (const f32x4*)(xin + (size_t)(m0 + r) * D) + lane; const u32x2* yr = (const u32x2*)(Y + (size_t)(m0 + r) * D) + lane;
#pragma unroll
            for (int j = 0; j < 4; ++j) { xv[r][j] = xr[64 * j]; yw[r][j] = yr[64 * j]; } }
        const int b = m0 >> 12;
        const float* gate = MOD + (size_t)(l * 8 + b) * 3072 + 2048;
        const float* sh = MOD + (size_t)(8 + b) * 3072; const float* scl = sh + 1024;
#pragma unroll
        for (int r = 0; r < RPW; ++r) {
            f32x4 yv[4]; float ss = 0.f;
#pragma unroll
            for (int j = 0; j < 4; ++j) { const u32x2 w = yw[r][j]; yv[j] = (f32x4){bflo(w.x), bfhi(w.x), bflo(w.y), bfhi(w.y)};
                ss += (yv[j].x * yv[j].x + yv[j].y * yv[j].y) + (yv[j].z * yv[j].z + yv[j].w * yv[j].w); }
            const float rstd = 1.0f / sqrtf(wave_sum(ss) * (1.0f / D) + EPS);
            float ss2 = 0.f;
#pragma unroll
            for (int j = 0; j < 4; ++j) { const int col = 4 * lane + 256 * j;
                const f32x4 gp = *(const f32x4*)(gpost + col), gt = *(const f32x4*)(gate + col);
                const f32x4 xn = xv[r][j] + gt * (yv[j] * rstd * gp);
                xv[r][j] = xn;
                if (l == 0) *((f32x4*)(out + (size_t)(m0 + r) * D + col)) = xn;
                else __builtin_nontemporal_store(xn, (f32x4*)(out + (size_t)(m0 + r) * D + col));
                ss2 += (xn.x * xn.x + xn.y * xn.y) + (xn.z * xn.z + xn.w * xn.w); }
            if (l == 0) {
                const float rstd2 = 1.0f / sqrtf(wave_sum(ss2) * (1.0f / D) + EPS);
                u32x2* o = (u32x2*)(H + (size_t)(m0 + r) * D) + lane;
#pragma unroll
                for (int j = 0; j < 4; ++j) { const int col = 4 * lane + 256 * j;
                    const f32x4 gg = *(const f32x4*)(gpre + col), s4 = *(const f32x4*)(scl + col), h4 = *(const f32x4*)(sh + col);
                    const f32x4 rr = xv[r][j] * rstd2 * gg * (s4 + 1.0f) + h4;
                    u32x2 w; w.x = pk2(rr.x, rr.y); w.y = pk2(rr.z, rr.w); o[64 * j] = w; }
            }
        }
    }
}
#define XB_TMO      128
#define XB_XCNT(j)  (256  + 64 * (j))
#define XB_XSUB(j)  (1280 + 64 * (j))
#define XB_XGEN(j)  (2304 + 64 * (j))
#define XB_TOP      3328
#define XB_TOPGEN   3392
#define XCD_BAR_WORDS 3456
#define XB_SPIN_CAP (1u << 18)

__device__ __forceinline__ unsigned xb_ld(unsigned* p)              { return __hip_atomic_load(p, __ATOMIC_RELAXED, __HIP_MEMORY_SCOPE_AGENT); }
__device__ __forceinline__ unsigned xb_add(unsigned* p, unsigned v) { return __hip_atomic_fetch_add(p, v, __ATOMIC_RELAXED, __HIP_MEMORY_SCOPE_AGENT); }
__device__ __forceinline__ unsigned xb_xcc_id() { return (unsigned)__builtin_amdgcn_s_getreg((3 << 11) | 20) & 0xFu; }
#define XB_SPIN(cond, bar) do { unsigned _sp = 0; while (cond) { __builtin_amdgcn_s_sleep(1); \
    if ((++_sp & 255u) == 0u) { if (xb_ld(&(bar)[XB_TMO])) break; if (_sp > XB_SPIN_CAP) { atomicAdd(&(bar)[XB_TMO], 1u); break; } } } } while (0)

struct XcdBarrier {
    unsigned* bar; unsigned x;
    volatile LAS unsigned* st;
};

__device__ __forceinline__ XcdBarrier xcd_barrier_post(unsigned* bar, volatile LAS unsigned* st) {
    XcdBarrier b; b.bar = bar; b.x = xb_xcc_id(); b.st = st;
    if (threadIdx.x == 0) (void)xb_add(&bar[XB_XCNT(b.x)], 1u);
    return b;
}
__device__ __forceinline__ void xcd_barrier_complete(unsigned* bar, unsigned x, unsigned& nloc, unsigned& nx) {
    const unsigned G = gridDim.x * gridDim.y * gridDim.z;
    unsigned sum, cnt, mine, sp = 0u;
    for (;;) {
        sum = 0u; cnt = 0u; mine = 0u;
#pragma unroll
        for (unsigned j = 0; j < 16; ++j) { const unsigned c = xb_ld(&bar[XB_XCNT(j)]); sum += c; cnt += (c > 0u) ? 1u : 0u; mine = (j == x) ? c : mine; }
        if (sum == G) break;
        __builtin_amdgcn_s_sleep(1);
        if ((++sp & 255u) == 0u) { if (xb_ld(&bar[XB_TMO])) break; if (sp > XB_SPIN_CAP) { atomicAdd(&bar[XB_TMO], 1u); break; } }
    }
    nloc = mine > 0u ? mine : 1u; nx = cnt > 0u ? cnt : 1u;
}

__device__ __forceinline__ void xcd_barrier(const XcdBarrier& b) {
    asm volatile("s_waitcnt vmcnt(0)" ::: "memory");
    __syncthreads();
    if (threadIdx.x == 0) {
        unsigned* bar = b.bar;
        __builtin_amdgcn_s_waitcnt(0);
        unsigned nloc = b.st[0], nx = b.st[1];
        if (nloc == 0u) { xcd_barrier_complete(bar, b.x, nloc, nx); b.st[0] = nloc; b.st[1] = nx; }
        const unsigned old = xb_add(&bar[XB_XSUB(b.x)], 1u);
        const unsigned gen = old / nloc;
        if (old + 1u == (gen + 1u) * nloc) {
            __builtin_amdgcn_fence(__ATOMIC_RELEASE, "agent");
            asm volatile("s_waitcnt vmcnt(0)" ::: "memory");
            const unsigned og = xb_add(&bar[XB_TOP], 1u);
            const unsigned tg = og / nx;
            if (og + 1u == (tg + 1u) * nx) xb_add(&bar[XB_TOPGEN], 1u);
            else XB_SPIN(xb_ld(&bar[XB_TOPGEN]) == tg, bar);
            __builtin_amdgcn_fence(__ATOMIC_ACQUIRE, "agent");
            xb_add(&bar[XB_XGEN(b.x)], 1u);
            asm volatile("s_waitcnt vmcnt(0)" ::: "memory");
        } else {
            XB_SPIN(xb_ld(&bar[XB_XGEN(b.x)]) == gen, bar);
            __builtin_amdgcn_fence(__ATOMIC_ACQUIRE, "agent");
            asm volatile("s_waitcnt vmcnt(0)" ::: "memory");
        }
    }
    __syncthreads();
}

#define LDS_BARRIER() do { asm volatile("s_waitcnt lgkmcnt(0)" ::: "memory"); __builtin_amdgcn_s_barrier(); asm volatile("" ::: "memory"); } while (0)
constexpr int XROW = 272;
constexpr int CROW = 132;
constexpr int R_XT = 0, R_UT = 35840, R_AT = 70656, R_VT = 87552, R_EP = 104448, R_CWT = 105472, R_WG = 108032;
__device__ __forceinline__ float fast_sigmoid(float x) { return __builtin_amdgcn_rcpf(1.0f + __builtin_amdgcn_exp2f(-1.4426950408889634f * x)); }
__device__ __forceinline__ void rnn_unit(const Args& a, int l, int u, LAS unsigned char* lds) {
    const int tid = opaque_tid(), lane = tid & 63, wv = tid >> 6, fr = lane & 15, fq = lane >> 4;
    const int xcd = u & 7, jj = u >> 3, q = jj & 3, bh = (jj >> 2) * 8 + xcd, b = bh >> 3, h = bh & 7;
    const bf16* PROJ = (const bf16*)(a.ws + WS_PROJ); bf16* YCAT = (bf16*)(a.ws + WS_YCAT);
    const bf16* xr_base = PROJ + (size_t)(b * SEQ) * NPROJ + h * 128;
    const bf16* gr_base = PROJ + (size_t)(b * SEQ) * NPROJ + 1024 + h * 128 + q * 32;
    bf16* y_base = YCAT + (size_t)(b * SEQ) * DMIX + h * 128 + q * 32;
    LAS unsigned char* XT = lds + R_XT; LAS unsigned char* UT = lds + R_UT;
    LAS float* AT = (LAS float*)(lds + R_AT); LAS float* VT = (LAS float*)(lds + R_VT);
    LAS float* EP = (LAS float*)(lds + R_EP);
    LAS unsigned char* WG = lds + R_WG;
    {
        const bf16* gw = (const bf16*)(a.ws + WS_GW) + (size_t)((l * 8 + h) * 4 + q) * 64 * 128;
#pragma unroll
        for (int i = 0; i < 2; ++i) { const int id = tid + 512 * i, row = id >> 4, cc = id & 15; *(LAS u32x4*)(WG + row * XROW + cc * 16) = *(const u32x4*)(gw + row * 128 + cc * 8); }
    }
    const int ck = tid & 15, tg = tid >> 4;
    LAS float* CWT = (LAS float*)(lds + R_CWT);
    for (int i = tid; i < 640; i += 512) { const int r = i >> 7, c = i & 127;
        CWT[i] = (r < 4) ? a.in[6][(size_t)l * 4 * 1024 + r * 1024 + h * 128 + c] : a.in[7][(size_t)l * 1024 + h * 128 + c]; }
    if (tid < 96) {
        const int r = tid >> 5, c = tid & 31, ch = h * 128 + q * 32 + c; float v;
        if (r == 0) v = a.in[9][l * 1024 + ch];
        else if (r == 1) v = a.in[11][l * 1024 + ch];
        else v = 8.0f * 1.4426950408889634f * log1pf(expf(-a.in[12][l * 1024 + ch]));
        EP[r * 32 + c] = v;
    }
    u32x4 pf[4], pfh = (u32x4){0u, 0u, 0u, 0u};
#pragma unroll
    for (int i = 0; i < 4; ++i) { const int id = tid + 512 * i, row = id >> 4, cc = id & 15; pf[i] = *(const u32x4*)(xr_base + (size_t)row * NPROJ + cc * 8); }
    const int sc_ci = lane >> 4, sc_sg = lane & 15, sc_c = wv * 4 + sc_ci;
    float hcar = 0.f;
#pragma unroll
    for (int i = 0; i < 4; ++i) { const int id = tid + 512 * i, row = id >> 4, cc = id & 15; *(LAS u32x4*)(XT + (3 + row) * XROW + cc * 16) = pf[i]; }
    if (tid < 48) *(LAS u32x4*)(XT + (tid >> 4) * XROW + (tid & 15) * 16) = pfh;
    for (int tile = 0; tile < SEQ / 128; ++tile) {
        const int t0 = tile * 128;
        LDS_BARRIER();
        {
            const int t0n = (tile + 1 < SEQ / 128) ? t0 + 128 : t0;
#pragma unroll
            for (int i = 0; i < 4; ++i) { const int id = tid + 512 * i, row = id >> 4, cc = id & 15; pf[i] = *(const u32x4*)(xr_base + (size_t)(t0n + row) * NPROJ + cc * 8); }
            if (tid < 48) pfh = *(const u32x4*)(xr_base + (size_t)(t0n - 3 + (tid >> 4)) * NPROJ + (tid & 15) * 8);
        }
        unsigned short gpre[8];
#pragma unroll
        for (int j = 0; j < 8; ++j) gpre[j] = gr_base[(size_t)(t0 + sc_sg * 8 + j) * NPROJ + sc_c];
        {
            f32x2 o[4][4], cw[4][4];
            {
                const f32x4 b0 = *(const LAS f32x4*)(CWT + 4 * 128 + ck * 8), b1 = *(const LAS f32x4*)(CWT + 4 * 128 + ck * 8 + 4);
#pragma unroll
                for (int i = 0; i < 4; ++i) { o[i][0] = (f32x2){b0.x, b0.y}; o[i][1] = (f32x2){b0.z, b0.w}; o[i][2] = (f32x2){b1.x, b1.y}; o[i][3] = (f32x2){b1.z, b1.w}; }
            }
#pragma unroll
            for (int k = 0; k < 4; ++k) { const f32x4 w0 = *(const LAS f32x4*)(CWT + k * 128 + ck * 8), w1 = *(const LAS f32x4*)(CWT + k * 128 + ck * 8 + 4);
                cw[k][0] = (f32x2){w0.x, w0.y}; cw[k][1] = (f32x2){w0.z, w0.w}; cw[k][2] = (f32x2){w1.x, w1.y}; cw[k][3] = (f32x2){w1.z, w1.w}; }
#pragma unroll
            for (int r = 0; r < 7; ++r) {
                const u32x4 w = *(const LAS u32x4*)(XT + (tg * 4 + r) * XROW + ck * 16);
                const f32x2 xv[4] = {(f32x2){bflo(w.x), bfhi(w.x)}, (f32x2){bflo(w.y), bfhi(w.y)}, (f32x2){bflo(w.z), bfhi(w.z)}, (f32x2){bflo(w.w), bfhi(w.w)}};
#pragma unroll
                for (int i = 0; i < 4; ++i) { const int k = r - i; if (k >= 0 && k < 4) {
#pragma unroll
                    for (int e = 0; e < 4; ++e) o[i][e] = __builtin_elementwise_fma(cw[k][e], xv[e], o[i][e]); } }
            }
#pragma unroll
            for (int i = 0; i < 4; ++i) { u32x4 w; w.x = pk2(o[i][0].x, o[i][0].y); w.y = pk2(o[i][1].x, o[i][1].y); w.z = pk2(o[i][2].x, o[i][2].y); w.w = pk2(o[i][3].x, o[i][3].y);
                *(LAS u32x4*)(UT + (tg * 4 + i) * XROW + ck * 16) = w; }
        }
        LDS_BARRIER();
        {
            f32x4 acc[4];
#pragma unroll
            for (int nb = 0; nb < 4; ++nb) acc[nb] = (f32x4){0.f, 0.f, 0.f, 0.f};
#pragma unroll
            for (int kb = 0; kb < 4; ++kb) { const bf16x8 uf = *(const LAS bf16x8*)(UT + (wv * 16 + fr) * XROW + kb * 64 + fq * 16);
#pragma unroll
                for (int nb = 0; nb < 4; ++nb) acc[nb] = __builtin_amdgcn_mfma_f32_16x16x32_bf16(*(const LAS bf16x8*)(WG + (nb * 16 + fr) * XROW + kb * 64 + fq * 16), uf, acc[nb], 0, 0, 0); }
            const int tk = wv * 16 + fr;
#pragma unroll
            for (int nb2 = 0; nb2 < 2; ++nb2) {
                const int c0 = nb2 * 16 + 4 * fq;
                const u32x2 uw = *(const LAS u32x2*)(UT + tk * XROW + (q * 32 + c0) * 2);
                const f32x4 uu = (f32x4){bflo(uw.x), bfhi(uw.x), bflo(uw.y), bfhi(uw.y)};
                const f32x4 ra = acc[nb2] + *(const LAS f32x4*)(EP + c0), rx = acc[nb2 + 2] + *(const LAS f32x4*)(EP + 32 + c0), sp8 = *(const LAS f32x4*)(EP + 64 + c0);
#pragma unroll
                for (int e = 0; e < 4; ++e) { const float r = fast_sigmoid(ra[e]), ig = fast_sigmoid(rx[e]);
                    const float av = __builtin_amdgcn_exp2f(-r * sp8[e]);
                    const float m2 = fmaxf(__builtin_fmaf(-av, av, 1.0f), 0.f);
                    AT[(c0 + e) * CROW + tk] = av; VT[(c0 + e) * CROW + tk] = __builtin_amdgcn_sqrtf(m2) * (ig * uu[e]); }
            }
        }
        LDS_BARRIER();
        {
            const f32x4 a0 = *(const LAS f32x4*)(AT + sc_c * CROW + sc_sg * 8), a1 = *(const LAS f32x4*)(AT + sc_c * CROW + sc_sg * 8 + 4);
            const f32x4 v0 = *(const LAS f32x4*)(VT + sc_c * CROW + sc_sg * 8), v1 = *(const LAS f32x4*)(VT + sc_c * CROW + sc_sg * 8 + 4);
            const float av[8] = {a0.x, a0.y, a0.z, a0.w, a1.x, a1.y, a1.z, a1.w}, vv[8] = {v0.x, v0.y, v0.z, v0.w, v1.x, v1.y, v1.z, v1.w};
            float hl[8], pp[8]; float hcur = 0.f, pcur = 1.f;
#pragma unroll
            for (int j = 0; j < 8; ++j) { hcur = __builtin_fmaf(av[j], hcur, vv[j]); pcur *= av[j]; hl[j] = hcur; pp[j] = pcur; }
            float P = pcur, H = hcur;
#pragma unroll
            for (int d = 1; d < 16; d <<= 1) { const float Pp = __shfl_up(P, d, 16), Hp = __shfl_up(H, d, 16); if (sc_sg >= d) { H = __builtin_fmaf(P, Hp, H); P *= Pp; } }
            float Pe = __shfl_up(P, 1, 16), He = __shfl_up(H, 1, 16); if (sc_sg == 0) { Pe = 1.f; He = 0.f; }
            const float carry = __builtin_fmaf(Pe, hcar, He);
            const float hend = __builtin_fmaf(P, hcar, H);
            hcar = __shfl(hend, 15, 16);
#pragma unroll
            for (int j = 0; j < 8; ++j) { const float hv = __builtin_fmaf(pp[j], carry, hl[j]); unsigned gw_ = gpre[j]; asm volatile("" : "+v"(gw_)); const float gv = __uint_as_float(gw_ << 16);
                const float yv = hv * gv * fast_sigmoid(gv);
                y_base[(size_t)(t0 + sc_sg * 8 + j) * DMIX + sc_c] = (bf16)(pk2(yv, 0.f) & 0xffffu); }
        }
#pragma unroll
        for (int i = 0; i < 4; ++i) { const int id = tid + 512 * i, row = id >> 4, cc = id & 15; *(LAS u32x4*)(XT + (3 + row) * XROW + cc * 16) = pf[i]; }
        if (tid < 48) *(LAS u32x4*)(XT + (tid >> 4) * XROW + (tid & 15) * 16) = pfh;
    }
    LDS_BARRIER();
}

constexpr int PROW = 528;
constexpr int R_XP = 0, R_PT = 42240;
__device__ __forceinline__ void pool_units(const Args& a, int l, int u, LAS unsigned char* lds) {
    const int tid = opaque_tid(), lane = tid & 63, wv = tid >> 6, fr = lane & 15, fq = lane >> 4;
    const int g = u & 3, bi = u >> 2, win = 2 << g;
    const bf16* PROJ = (const bf16*)(a.ws + WS_PROJ); bf16* YCAT = (bf16*)(a.ws + WS_YCAT);
    LAS unsigned char* XP = lds + R_XP; LAS unsigned char* PT = lds + R_PT;
    const bf16* pw = (const bf16*)(a.ws + WS_PW) + (size_t)(l * 4 + g) * 256 * 256;
    bf16x8 Wf[2][8];
#pragma unroll
    for (int nb = 0; nb < 2; ++nb)
#pragma unroll
        for (int kb = 0; kb < 8; ++kb) Wf[nb][kb] = *(const bf16x8*)(pw + (size_t)(wv * 32 + nb * 16 + fr) * 256 + kb * 32 + fq * 8);
    f32x4 pb[2], ps[2];
#pragma unroll
    for (int nb = 0; nb < 2; ++nb) { const int n = wv * 32 + nb * 16 + 4 * fq;
        pb[nb] = *(const f32x4*)(a.in[14] + (size_t)l * 1024 + g * 256 + n); ps[nb] = *(const f32x4*)(a.in[15] + (size_t)l * 1024 + g * 256 + n); }
    const int ck = tid & 31, tg = tid >> 5;
    u32x4 pf[5];
    {
        const int tile = bi * 8, b = tile >> 6, t0 = (tile & 63) * 64;
        const bf16* xp_base = PROJ + (size_t)(b * SEQ) * NPROJ + 2048 + g * 256;
#pragma unroll
        for (int i = 0; i < 5; ++i) { const int id = tid + 512 * i, row = id >> 5, cc = id & 31, t = t0 - 16 + row;
            const u32x4 v = *(const u32x4*)(xp_base + (size_t)(t < 0 ? 0 : t) * NPROJ + cc * 8); pf[i] = (t < 0) ? (u32x4){0u, 0u, 0u, 0u} : v; }
    }
#pragma unroll
    for (int i = 0; i < 5; ++i) { const int id = tid + 512 * i, row = id >> 5, cc = id & 31; *(LAS u32x4*)(XP + row * PROW + cc * 16) = pf[i]; }
    for (int it = 0; it < 8; ++it) {
        const int tile = bi * 8 + it, b = tile >> 6, t0 = (tile & 63) * 64;
        const bf16* gp_base = PROJ + (size_t)(b * SEQ) * NPROJ + 3072 + g * 256;
        bf16* y_base = YCAT + (size_t)(b * SEQ) * DMIX + 1024 + g * 256;
        LDS_BARRIER();
        {
            const int tile2 = bi * 8 + ((it + 1 < 8) ? it + 1 : it), b2 = tile2 >> 6, t02 = (tile2 & 63) * 64;
            const bf16* xp_base = PROJ + (size_t)(b2 * SEQ) * NPROJ + 2048 + g * 256;
#pragma unroll
            for (int i = 0; i < 5; ++i) { const int id = tid + 512 * i, row = id >> 5, cc = id & 31, t = t02 - 16 + row;
                const u32x4 v = *(const u32x4*)(xp_base + (size_t)(t < 0 ? 0 : t) * NPROJ + cc * 8); pf[i] = (t < 0) ? (u32x4){0u, 0u, 0u, 0u} : v; }
        }
        u32x2 gp[4][2];
#pragma unroll
        for (int tb = 0; tb < 4; ++tb)
#pragma unroll
            for (int nb = 0; nb < 2; ++nb) gp[tb][nb] = *(const u32x2*)(gp_base + (size_t)(t0 + tb * 16 + fr) * NPROJ + wv * 32 + nb * 16 + 4 * fq);
        {
            float s[8];
#pragma unroll
            for (int e = 0; e < 8; ++e) s[e] = 0.f;
            const int r0 = tg * 4 + 16;
            for (int r = r0 - win + 1; r < r0; ++r) { const u32x4 w = *(const LAS u32x4*)(XP + r * PROW + ck * 16);
                s[0] += bflo(w.x); s[1] += bfhi(w.x); s[2] += bflo(w.y); s[3] += bfhi(w.y); s[4] += bflo(w.z); s[5] += bfhi(w.z); s[6] += bflo(w.w); s[7] += bfhi(w.w); }
#pragma unroll
            for (int i = 0; i < 4; ++i) {
                const u32x4 w = *(const LAS u32x4*)(XP + (r0 + i) * PROW + ck * 16);
                const float xv[8] = {bflo(w.x), bfhi(w.x), bflo(w.y), bfhi(w.y), bflo(w.z), bfhi(w.z), bflo(w.w), bfhi(w.w)};
                const int t = t0 + tg * 4 + i; const float inv = __builtin_amdgcn_rcpf((float)((t + 1 < win) ? (t + 1) : win));
                float p[8];
#pragma unroll
                for (int e = 0; e < 8; ++e) { s[e] += xv[e]; p[e] = __builtin_fmaf(s[e], inv, -xv[e]); }
                u32x4 o; o.x = pk2(p[0], p[1]); o.y = pk2(p[2], p[3]); o.z = pk2(p[4], p[5]); o.w = pk2(p[6], p[7]);
                *(LAS u32x4*)(PT + (tg * 4 + i) * PROW + ck * 16) = o;
                const u32x4 wo = *(const LAS u32x4*)(XP + (r0 + i - win + 1) * PROW + ck * 16);
                s[0] -= bflo(wo.x); s[1] -= bfhi(wo.x); s[2] -= bflo(wo.y); s[3] -= bfhi(wo.y); s[4] -= bflo(wo.z); s[5] -= bfhi(wo.z); s[6] -= bflo(wo.w); s[7] -= bfhi(wo.w);
            }
        }
        LDS_BARRIER();
#pragma unroll
        for (int tb = 0; tb < 4; ++tb) {
            f32x4 acc[2] = {(f32x4){0.f, 0.f, 0.f, 0.f}, (f32x4){0.f, 0.f, 0.f, 0.f}};
#pragma unroll
            for (int kb = 0; kb < 8; ++kb) { const bf16x8 pfm = *(const LAS bf16x8*)(PT + (tb * 16 + fr) * PROW + kb * 64 + fq * 16);
#pragma unroll
                for (int nb = 0; nb < 2; ++nb) acc[nb] = __builtin_amdgcn_mfma_f32_16x16x32_bf16(Wf[nb][kb], pfm, acc[nb], 0, 0, 0); }
            const int t = t0 + tb * 16 + fr;
#pragma unroll
            for (int nb = 0; nb < 2; ++nb) { const int n = wv * 32 + nb * 16 + 4 * fq;
                const u32x2 gw2 = gp[tb][nb];
                const f32x4 gv = (f32x4){bflo(gw2.x), bfhi(gw2.x), bflo(gw2.y), bfhi(gw2.y)};
                f32x4 r = (acc[nb] + pb[nb]) * ps[nb];
#pragma unroll
                for (int e = 0; e < 4; ++e) r[e] *= gv[e] * fast_sigmoid(gv[e]);
                u32x2 o; o.x = pk2(r.x, r.y); o.y = pk2(r.z, r.w);
                *(u32x2*)(y_base + (size_t)t * DMIX + n) = o; }
        }
#pragma unroll
        for (int i = 0; i < 5; ++i) { const int id = tid + 512 * i, row = id >> 5, cc = id & 31; *(LAS u32x4*)(XP + row * PROW + cc * 16) = pf[i]; }
    }
    LDS_BARRIER();
}

__device__ __forceinline__ void phase_mixer(const Args& a, int l, LAS unsigned char* lds) {
#ifndef MK_MIX
#define MK_MIX 3
#endif
#ifndef MK_DBL_RNN
#define MK_DBL_RNN 0
#endif
#ifndef MK_DBL_POOL
#define MK_DBL_POOL 0
#endif
    for (int rep = 0; rep < 1 + ((l == 0) ? MK_DBL_RNN : 0); ++rep) for (int u = blockIdx.x; u < 256; u += gridDim.x) rnn_unit(a, l, u, lds);
    for (int rep = 0; rep < 1 + ((l == 0) ? MK_DBL_POOL : 0); ++rep) for (int u = blockIdx.x; u < 256; u += gridDim.x) pool_units(a, l, u, lds);
}
#ifndef MK_DBL_PH
#define MK_DBL_PH -1
#endif
#ifndef MK_MASK
#define MK_MASK 63
#endif
__global__ void __launch_bounds__(512, 2) mk_fwd(Args a) {
    extern __shared__ __attribute__((aligned(16))) unsigned char lds_raw[];
    LAS unsigned char* lds = (LAS unsigned char*)lds_raw;
    cg::grid_group grid = cg::this_grid();
    volatile LAS unsigned* bst = (volatile LAS unsigned*)(lds + LDS_BST_OFF);
    if (threadIdx.x < 4) bst[threadIdx.x] = 0u;
    __syncthreads();
    XcdBarrier xbar = xcd_barrier_post((unsigned*)(a.ws + WS_CTL), bst);
#define GRID_BAR() do { if (a.ph_hi - a.ph_lo > 64) grid.sync(); else xcd_barrier(xbar); } while (0)
    for (int ph = a.ph_lo; ph < a.ph_hi; ++ph) {
#if MK_DBL_PH >= 0
      for (int rep = 0; rep < ((ph == MK_DBL_PH) ? 2 : 1); ++rep) {
        if (rep) GRID_BAR();
#endif
        if (ph == 0) { if (MK_MASK & 1) phase_prep(a, lds); }
        else if (ph == 1) { if (MK_MASK & 2) phase_h0(a); }
        else {
            const int l = (ph - 2) >> 2, sub = (ph - 2) & 3;
            if (sub == 0) { if (MK_MASK & 4) {
                pg8::Gemm g{(const pg8::bf16_t*)(a.ws + WS_H), (const pg8::bf16_t*)(a.ws + WS_WIN) + (size_t)l * NPROJ * D, T, NPROJ, D};
                pg8::StaticOrder S; S.init(T, NPROJ, gridDim.x, (int)blockIdx.x);
                pg8::EpiBf16<0> E{(pg8::bf16_t*)(a.ws + WS_PROJ), NPROJ, nullptr, 0, 0, 1.f};
                pg8::gemm_phase<pg8::EpiBf16<0>, pg8::StaticOrder, PG8_ALIGN, PG8_SP2>(lds, g, S, E); }
            } else if (sub == 1) {
                if (MK_MASK & 8) phase_mixer(a, l, lds);
            } else if (sub == 2) { if (MK_MASK & 16) {
                pg8::Gemm g{(const pg8::bf16_t*)(a.ws + WS_YCAT), (const pg8::bf16_t*)(a.ws + WS_WOUT) + (size_t)l * D * DMIX, T, D, DMIX};
                pg8::StaticOrder S; S.init(T, D, gridDim.x, (int)blockIdx.x);
                pg8::EpiBf16<0> E{(pg8::bf16_t*)(a.ws + WS_Y), D, nullptr, 0, 0, 1.f};
                pg8::gemm_phase<pg8::EpiBf16<0>, pg8::StaticOrder, PG8_ALIGN, PG8_SP2>(lds, g, S, E); }
            } else {
                if (MK_MASK & 32) phase_post(a, l);
            }
        }
#if MK_DBL_PH >= 0
      }
#endif
        if (ph + 1 < a.ph_hi) GRID_BAR();
    }
}

extern "C" void kernel_launch(void* const* d_in, const int* in_sizes, int n_in, void* d_out, int out_size, void* d_ws, size_t ws_size, hipStream_t stream) {
    static int grid = 0;
    if (grid == 0) {
        if (n_in != 18 || in_sizes[0] != T * D || out_size != T * D || ws_size < WS_END) {
            fprintf(stderr, "kernel_launch: unexpected shapes (n_in %d, in0 %d, out %d, ws %zu); nothing launched\n", n_in, n_in > 0 ? in_sizes[0] : -1, out_size, ws_size); grid = -1; return; }
        int dev = 0, cus = 0, per_cu = 0;
        if (hipGetDevice(&dev) != hipSuccess || hipDeviceGetAttribute(&cus, hipDeviceAttributeMultiprocessorCount, dev) != hipSuccess) { grid = -1; return; }
        if (hipFuncSetAttribute((const void*)mk_fwd, hipFuncAttributeMaxDynamicSharedMemorySize, LDS_BYTES) != hipSuccess) { fprintf(stderr, "kernel_launch: hipFuncSetAttribute failed\n"); grid = -1; return; }
        if (hipOccupancyMaxActiveBlocksPerMultiprocessor(&per_cu, (const void*)mk_fwd, 512, LDS_BYTES) != hipSuccess || per_cu < 1) { fprintf(stderr, "kernel_launch: occupancy query says %d blocks per CU\n", per_cu); per_cu = 1; }
        (void)hipGetLastError();
        grid = cus;
    }
    if (grid < 0) return;
    Args a{};
    for (int i = 0; i < 18; ++i) a.in[i] = (const float*)d_in[i];
    a.out = (float*)d_out; a.ws = (unsigned char*)d_ws;
    if (hipMemsetAsync((char*)d_ws + WS_CTL, 0, CTL_BYTES, stream) != hipSuccess) { fprintf(stderr, "kernel_launch: memset of the barrier words failed\n"); return; }
#if MK_N_LAUNCHES == 1
    a.ph_lo = 0; a.ph_hi = NPH;
    void* args[] = {&a};
    const hipError_t e = hipLaunchCooperativeKernel((const void*)mk_fwd, dim3(grid), dim3(512), args, LDS_BYTES, stream);
    if (e != hipSuccess) fprintf(stderr, "kernel_launch: cooperative launch failed: %s (grid %d)\n", hipGetErrorString(e), grid);
#else
    for (int ph = 0; ph < NPH; ++ph) {
        a.ph_lo = ph; a.ph_hi = ph + 1;
        hipLaunchKernelGGL(mk_fwd, dim3(grid), dim3(512), LDS_BYTES, stream, a);
    }
#endif
}
```

```cpp
#include <hip/hip_runtime.h>
#include <hip/hip_cooperative_groups.h>
#include <cstdio>
#include <cstdint>
namespace cg = cooperative_groups;
__device__ __forceinline__ int opaque_tid() { int t = threadIdx.x; asm volatile("" : "+v"(t)); return t; }
#if defined(__HIP_DEVICE_COMPILE__)
#pragma clang attribute push (__attribute__((target("no-packed-fp32-ops"))), apply_to = function)
#endif
__device__ __forceinline__ float u2f(unsigned x) { return __builtin_bit_cast(float, x); }
__device__ __forceinline__ float i2f(int x) { return __builtin_bit_cast(float, x); }
__device__ __forceinline__ int f2i(float x) { return __builtin_bit_cast(int, x); }
__device__ __forceinline__ int lane_id_() { return (int)__builtin_amdgcn_mbcnt_hi(~0u, __builtin_amdgcn_mbcnt_lo(~0u, 0u)); }
__device__ __forceinline__ float shfl_xor_(float v, int o) { return i2f(__builtin_amdgcn_ds_bpermute((lane_id_() ^ o) << 2, f2i(v))); }
__device__ __forceinline__ float row_last_(float v) { return i2f(__builtin_amdgcn_ds_bpermute((lane_id_() | 15) << 2, f2i(v))); }
__device__ __forceinline__ void sync_threads_() { __builtin_amdgcn_fence(__ATOMIC_RELEASE, "workgroup"); __builtin_amdgcn_s_barrier(); __builtin_amdgcn_fence(__ATOMIC_ACQUIRE, "workgroup"); }
namespace pg8 {
#define PG8_LAS __attribute__((address_space(3)))
typedef unsigned short bf16_t;
typedef short bf16x8 __attribute__((ext_vector_type(8)));
typedef float f32x4 __attribute__((ext_vector_type(4)));
typedef unsigned u32x4 __attribute__((ext_vector_type(4)));
constexpr int BM = 256, BK = 64, HALF = 128, HTB = HALF * BK * 2  , STAGE_BYTES = 8 * HTB, NXCD = 8, WGM = 8;

__host__ __device__ __forceinline__ int lds_byte(int r, int c) { const int st = (r >> 4) * 2 + (c >> 5), rr = r & 15, cc = c & 31, ob = rr * 64 + cc * 2; return st * 1024 + (ob ^ (((ob >> 9) & 1) << 5)); }
__host__ __device__ __forceinline__ void stage_rc(int b, int& R, int& C) { const int st = b / 1024, sb = b % 1024, swz = sb ^ (((sb >> 9) & 1) << 5); R = (st >> 1) * 16 + swz / 64; C = (st & 1) * 32 + (swz % 64) / 2; }
__host__ __device__ __forceinline__ int perm32(int rho) { const int n = rho >> 4, i = rho & 15; return 8 * (i >> 2) + 4 * n + (i & 3); }

struct Unit { int pm, pn; };
struct Gemm { const bf16_t* A; const bf16_t* Bt; int M, N, K; };

struct StaticOrder {
    int nM, nN, nwg, G, c;
    __host__ __device__ void init(int M, int N, int G_, int c_) { nM = M / BM; nN = N / BM; nwg = nM * nN; G = G_; c = c_; }
    __host__ __device__ bool next(int i, Unit& u) const {
        const long L = (long)i * G + c; if (L >= nwg) return false;
        int wgid = (int)L; { const int q = nwg / NXCD, r = nwg % NXCD, xcd = wgid % NXCD, off = wgid / NXCD; wgid = (xcd < r ? xcd * (q + 1) : r * (q + 1) + (xcd - r) * q) + off; }
        const int nig = WGM * nN, gid = wgid / nig, fm = gid * WGM, gsz = (nM - fm) < WGM ? (nM - fm) : WGM;
        u.pm = fm + ((wgid % nig) % gsz); u.pn = (wgid % nig) / gsz; return true;
    }
    __device__ __forceinline__ void a_ready(const Unit&) const {}
    __device__ __forceinline__ void done(const Unit&) const {}
};

__device__ __forceinline__ unsigned cvt_pk_bf16(float lo, float hi) { unsigned r; asm volatile("v_cvt_pk_bf16_f32 %0, %1, %2" : "=v"(r) : "v"(lo), "v"(hi)); return r; }
typedef float f32x2 __attribute__((ext_vector_type(2)));
__device__ __forceinline__ f32x2 gelu_pk(f32x2 v) {
    const f32x2 av = __builtin_elementwise_abs(v), d = av * 0.2316418882f + 1.0f;
    f32x2 t; t.x = __builtin_amdgcn_rcpf(d.x); t.y = __builtin_amdgcn_rcpf(d.y);
    f32x2 q = t * 0.5307027145f + (-0.7265760135f); q = q * t + 0.7107068705f; q = q * t + (-0.142248368f); q = q * t + 0.127414796f; q = q * t;
    const f32x2 s = (v * v) * (-0.72134752044f);
    f32x2 e; e.x = __builtin_amdgcn_exp2f(s.x); e.y = __builtin_amdgcn_exp2f(s.y);
    const f32x2 m = v * (q * e), r = v - m;
    f32x2 o; o.x = v.x < 0.f ? m.x : r.x; o.y = v.y < 0.f ? m.y : r.y; return o;
}

template <int ACT  > struct EpiBf16 {
    static constexpr bool PERM = true, AFTER_DRAIN = false; static_assert(ACT == 0 || ACT == 1, "EpiBf16: ACT is 0 (none) or 1 (gelu_pk)");
    bf16_t* O; int ldc; const float* bias; int split_cols; size_t split_stride; float scale0;
    __device__ __forceinline__ void operator()(const f32x4 (&acc)[2][2][4][2], const Unit& u, int wr, int wc, int fr, int fq) const {
        const int row0 = u.pm * BM + wr * 64 + fr; int colt = u.pn * BM; bf16_t* base = O;
        float sc = 1.f; if (split_cols) { const int t = colt / split_cols; base += (size_t)t * split_stride; colt -= t * split_cols; if (t == 0) sc = scale0; }
        const int col0 = colt + wc * 32 + 8 * fq, bcol0 = u.pn * BM + wc * 32 + 8 * fq;
        f32x4 bv[2][2];
#pragma unroll
        for (int bj = 0; bj < 2; ++bj)
#pragma unroll
            for (int n = 0; n < 2; ++n) bv[bj][n] = bias ? *(const f32x4*)(bias + bcol0 + bj * HALF + 4 * n) : (f32x4){0.f, 0.f, 0.f, 0.f};
#pragma unroll
        for (int ai = 0; ai < 2; ++ai)
#pragma unroll
            for (int m = 0; m < 4; ++m) { bf16_t* rowp = base + (size_t)(row0 + ai * HALF + m * 16) * ldc + col0;
#pragma unroll
                for (int bj = 0; bj < 2; ++bj) { f32x4 v0 = acc[ai][bj][m][0] + bv[bj][0], v1 = acc[ai][bj][m][1] + bv[bj][1];
                    if (ACT == 1) { f32x2 a = gelu_pk((f32x2){v0[0], v0[1]}), b = gelu_pk((f32x2){v0[2], v0[3]}), c = gelu_pk((f32x2){v1[0], v1[1]}), d = gelu_pk((f32x2){v1[2], v1[3]});
                        v0 = (f32x4){a.x, a.y, b.x, b.y}; v1 = (f32x4){c.x, c.y, d.x, d.y}; }
                    v0 = v0 * sc; v1 = v1 * sc; u32x4 w; w.x = cvt_pk_bf16(v0[0], v0[1]); w.y = cvt_pk_bf16(v0[2], v0[3]); w.z = cvt_pk_bf16(v1[0], v1[1]); w.w = cvt_pk_bf16(v1[2], v1[3]);
                    *(u32x4*)(rowp + bj * HALF) = w; } }
    }
};
template <class Epi, class Sched, bool ALIGN_EPI = false, bool SP2 = false>
__device__ __forceinline__ void gemm_phase(PG8_LAS unsigned char* lds, const Gemm g, const Sched& S, const Epi& E) {
    const int tid = opaque_tid(), wid = __builtin_amdgcn_readfirstlane(tid >> 6), lane = tid & 63, wr = wid >> 2, wc = wid & 3, fr = lane & 15, fq = lane >> 4;
    const int K = g.K, nt = K / BK;
    unsigned voffA[2], voffB[2];
#pragma unroll
    for (int i = 0; i < 2; ++i) { int R, C; stage_rc(tid * 16 + i * 8192, R, C); const int Rb = Epi::PERM ? ((R & ~31) + perm32(R & 31)) : R;
        voffA[i] = (unsigned)(R * K + C) * 2u; voffB[i] = (unsigned)(Rb * K + C) * 2u; }
    const size_t kstep = (size_t)(BK * 2);
    const size_t hstep = (size_t)HALF * K * 2;
    const size_t tstep = 2 * hstep;
    const unsigned ldsw = (unsigned)wid * 1024u;
    const int aoff = lds_byte(wr * 64 + fr, fq * 8), boff = lds_byte(wc * 32 + fr, fq * 8);
#define PG8_SA(b, h) (((b) * 2 + (h)) * HTB)
#define PG8_SB(b, h) ((4 + (b) * 2 + (h)) * HTB)
#define PG8_STAGE(bufoff, gbase, voff) do { _Pragma("unroll") for (int _i = 0; _i < 2; ++_i) \
        __builtin_amdgcn_global_load_lds((const unsigned*)((const char*)(gbase) + (voff)[_i]), (PG8_LAS unsigned*)(lds + (bufoff) + ldsw + _i * 8192), 16, 0, 0); } while (0)
#define PG8_LDA(dst, b, h) do { _Pragma("unroll") for (int m = 0; m < 4; ++m) _Pragma("unroll") for (int k = 0; k < 2; ++k) dst[m][k] = *(const PG8_LAS bf16x8*)(lds + PG8_SA(b, h) + aoff + m * 2048 + k * 1024); } while (0)
#define PG8_LDB(dst, b, h) do { _Pragma("unroll") for (int n = 0; n < 2; ++n) _Pragma("unroll") for (int k = 0; k < 2; ++k) dst[n][k] = *(const PG8_LAS bf16x8*)(lds + PG8_SB(b, h) + boff + n * 2048 + k * 1024); } while (0)
#define PG8_MMA(ai, bj, At, Bt) do { __builtin_amdgcn_s_setprio(1); _Pragma("unroll") for (int m = 0; m < 4; ++m) _Pragma("unroll") for (int n = 0; n < 2; ++n) _Pragma("unroll") for (int k = 0; k < 2; ++k) \
        acc[ai][bj][m][n] = __builtin_amdgcn_mfma_f32_16x16x32_bf16(Bt[n][k], At[m][k], acc[ai][bj][m][n], 0, 0, 0); __builtin_amdgcn_s_setprio(0); } while (0)
#define PG8_WAIT_V(n) asm volatile("s_waitcnt vmcnt(" #n ")" ::: "memory")
#define PG8_WAIT_L(n) asm volatile("s_waitcnt lgkmcnt(" #n ")" ::: "memory")
#define PG8_BAR __builtin_amdgcn_s_barrier()
#define PG8_SCHED __builtin_amdgcn_sched_barrier(0)
    Unit cur, nxt; int ui = 0;
    if (!S.next(0, cur)) return;
    f32x4 acc[2][2][4][2];
#pragma unroll
    for (int a = 0; a < 2; ++a)
#pragma unroll
        for (int b = 0; b < 2; ++b)
#pragma unroll
            for (int m = 0; m < 4; ++m)
#pragma unroll
                for (int n = 0; n < 2; ++n) acc[a][b][m][n] = (f32x4){0.f, 0.f, 0.f, 0.f};
    bf16x8 At[4][2], B0[2][2], B1[2][2];
    const char* cA = (const char*)g.A + (size_t)cur.pm * tstep; const char* cB = (const char*)g.Bt + (size_t)cur.pn * tstep;
    S.a_ready(cur);
    if constexpr (SP2) {
        PG8_STAGE(PG8_SB(0, 0), cB, voffB); PG8_STAGE(PG8_SB(0, 1), cB + hstep, voffB); PG8_STAGE(PG8_SA(0, 0), cA, voffA); PG8_STAGE(PG8_SA(0, 1), cA + hstep, voffA);
        if (wr == 1) PG8_BAR;
        PG8_WAIT_V(2); PG8_BAR;
        PG8_STAGE(PG8_SB(1, 0), cB + kstep, voffB); PG8_STAGE(PG8_SA(1, 0), cA + kstep, voffA); PG8_STAGE(PG8_SB(1, 1), cB + hstep + kstep, voffB);
        PG8_WAIT_V(6); PG8_BAR;
    } else {
        PG8_STAGE(PG8_SB(0, 0), cB, voffB); PG8_STAGE(PG8_SA(0, 0), cA, voffA); PG8_STAGE(PG8_SB(0, 1), cB + hstep, voffB); PG8_STAGE(PG8_SA(0, 1), cA + hstep, voffA);
        if (wr == 1) PG8_BAR;
        PG8_WAIT_V(4); PG8_BAR;
        PG8_STAGE(PG8_SB(1, 0), cB + kstep, voffB); PG8_STAGE(PG8_SA(1, 0), cA + kstep, voffA); PG8_STAGE(PG8_SB(1, 1), cB + hstep + kstep, voffB);
        PG8_WAIT_V(6); PG8_BAR;
    }
    for (;;) {
        const bool has_next = S.next(ui + 1, nxt);
        const char* nA = has_next ? (const char*)g.A + (size_t)nxt.pm * tstep : cA; const char* nB = has_next ? (const char*)g.Bt + (size_t)nxt.pn * tstep : cB;
        for (int t = 0; t < nt; t += 2) {
            const bool last = (t == nt - 2);
            const char* a1 = cA + (size_t)(t + 1) * kstep;
            const char* a2 = last ? nA : cA + (size_t)(t + 2) * kstep; const char* b2 = last ? nB : cB + (size_t)(t + 2) * kstep;
            const char* a3 = a2 + kstep; const char* b3 = b2 + kstep;
            if (last && has_next) S.a_ready(nxt);
            if constexpr (SP2) {
            PG8_LDB(B0, 0, 0); PG8_LDB(B1, 0, 1); PG8_SCHED; PG8_LDA(At, 0, 0); PG8_STAGE(PG8_SA(1, 1), a1 + hstep, voffA);
            PG8_WAIT_V(8); PG8_WAIT_L(0); PG8_BAR; PG8_MMA(0, 0, At, B0); PG8_MMA(0, 1, At, B1); PG8_BAR; PG8_SCHED;
            PG8_LDA(At, 0, 1); PG8_STAGE(PG8_SB(0, 0), b2, voffB); PG8_STAGE(PG8_SB(0, 1), b2 + hstep, voffB); PG8_STAGE(PG8_SA(0, 0), a2, voffA);
            PG8_WAIT_V(8); PG8_WAIT_L(0); PG8_BAR; PG8_MMA(1, 0, At, B0); PG8_MMA(1, 1, At, B1); PG8_BAR; PG8_SCHED;
            PG8_LDB(B0, 1, 0); PG8_LDB(B1, 1, 1); PG8_SCHED; PG8_LDA(At, 1, 0); PG8_STAGE(PG8_SA(0, 1), a2 + hstep, voffA);
            PG8_WAIT_V(8); PG8_WAIT_L(0); PG8_BAR; PG8_MMA(0, 0, At, B0); PG8_MMA(0, 1, At, B1); PG8_BAR; PG8_SCHED;
            PG8_LDA(At, 1, 1); PG8_STAGE(PG8_SB(1, 0), b3, voffB); PG8_STAGE(PG8_SB(1, 1), b3 + hstep, voffB); PG8_STAGE(PG8_SA(1, 0), a3, voffA);
            PG8_WAIT_V(8); PG8_WAIT_L(0); PG8_BAR; PG8_MMA(1, 0, At, B0); PG8_MMA(1, 1, At, B1); PG8_BAR; PG8_SCHED;
            } else {
            PG8_LDB(B0, 0, 0); PG8_SCHED; PG8_LDA(At, 0, 0); PG8_STAGE(PG8_SA(1, 1), a1 + hstep, voffA);
            PG8_WAIT_L(8); PG8_BAR; PG8_WAIT_L(0); PG8_MMA(0, 0, At, B0); PG8_BAR; PG8_SCHED;
            PG8_LDB(B1, 0, 1); PG8_STAGE(PG8_SB(0, 0), b2, voffB);
            PG8_BAR; PG8_WAIT_L(0); PG8_MMA(0, 1, At, B1); PG8_BAR;
            PG8_LDA(At, 0, 1); PG8_STAGE(PG8_SA(0, 0), a2, voffA);
            PG8_BAR; PG8_WAIT_L(0); PG8_MMA(1, 0, At, B0); PG8_BAR; PG8_SCHED;
            PG8_STAGE(PG8_SB(0, 1), b2 + hstep, voffB);
            PG8_WAIT_V(6); PG8_BAR; PG8_MMA(1, 1, At, B1); PG8_BAR;
            PG8_LDB(B0, 1, 0); PG8_SCHED; PG8_LDA(At, 1, 0); PG8_STAGE(PG8_SA(0, 1), a2 + hstep, voffA);
            PG8_WAIT_L(8); PG8_BAR; PG8_WAIT_L(0); PG8_MMA(0, 0, At, B0); PG8_BAR; PG8_SCHED;
            PG8_LDB(B1, 1, 1); PG8_STAGE(PG8_SB(1, 0), b3, voffB);
            PG8_BAR; PG8_WAIT_L(0); PG8_MMA(0, 1, At, B1); PG8_BAR;
            PG8_LDA(At, 1, 1); PG8_STAGE(PG8_SA(1, 0), a3, voffA);
            PG8_BAR; PG8_WAIT_L(0); PG8_MMA(1, 0, At, B0); PG8_BAR; PG8_SCHED;
            PG8_STAGE(PG8_SB(1, 1), b3 + hstep, voffB);
            PG8_WAIT_V(6); PG8_BAR; PG8_MMA(1, 1, At, B1); PG8_BAR;
            }
        }
        if constexpr (ALIGN_EPI) { if (wr == 0) PG8_BAR; }
        if constexpr (!Epi::AFTER_DRAIN) { E(acc, cur, wr, wc, fr, fq); S.done(cur); }
        if (!has_next) break;
#pragma unroll
        for (int a = 0; a < 2; ++a)
#pragma unroll
            for (int b = 0; b < 2; ++b)
#pragma unroll
                for (int m = 0; m < 4; ++m)
#pragma unroll
                    for (int n = 0; n < 2; ++n) acc[a][b][m][n] = (f32x4){0.f, 0.f, 0.f, 0.f};
        cur = nxt; cA = nA; cB = nB; ++ui;
        if constexpr (ALIGN_EPI) { if (wr == 1) PG8_BAR; }
    }
    PG8_WAIT_V(0);
    if constexpr (!ALIGN_EPI) { if (wr == 0) PG8_BAR; }
    PG8_BAR;
    if constexpr (Epi::AFTER_DRAIN) { E.fused(acc, cur, wr, wc, fr, fq, lds, wid, lane); S.done(cur); }
#undef PG8_SA
#undef PG8_SB
#undef PG8_STAGE
#undef PG8_LDA
#undef PG8_LDB
#undef PG8_MMA
#undef PG8_WAIT_V
#undef PG8_WAIT_L
#undef PG8_BAR
#undef PG8_SCHED
}
}
#ifndef PG8_SP2
#define PG8_SP2 true
#endif
#ifndef PG8_ALIGN
#define PG8_ALIGN true
#endif
#ifndef MK_N_LAUNCHES
#define MK_N_LAUNCHES 1
#endif

constexpr int NB = 8, SEQ = 4096, D = 1024, T = NB * SEQ, NPROJ = 4096, DMIX = 2048;
constexpr int NPH = 10;
constexpr float EPS = 1e-6f;
constexpr size_t MiB = 1u << 20;
constexpr size_t WS_WIN = 0, WS_WOUT = 16 * MiB, WS_GW = 24 * MiB, WS_PW = 25 * MiB, WS_MOD = 26 * MiB;
constexpr size_t WS_H = 32 * MiB, WS_YCAT = 96 * MiB, WS_PROJ = 224 * MiB, WS_Y = WS_PROJ, WS_U = WS_H, WS_END = 480 * MiB;
constexpr size_t WS_CTL = 28 * MiB, CTL_BYTES = 16384;
constexpr int LDS_BYTES = 147456, LDS_BST_OFF = 131072 + 64;

#define LAS __attribute__((address_space(3)))
typedef unsigned short bf16;
typedef float f32x4 __attribute__((ext_vector_type(4)));
typedef float f32x2 __attribute__((ext_vector_type(2)));
typedef unsigned u32x4 __attribute__((ext_vector_type(4)));
typedef unsigned u32x2 __attribute__((ext_vector_type(2)));
typedef short bf16x8 __attribute__((ext_vector_type(8)));

struct Args { const float* in[18]; float* out; unsigned char* ws; int ph_lo, ph_hi; };

__device__ __forceinline__ unsigned pk2(float lo, float hi) { return pg8::cvt_pk_bf16(lo, hi); }
__device__ __forceinline__ float bflo(unsigned w) { return u2f(w << 16); }
__device__ __forceinline__ float bfhi(unsigned w) { return u2f(w & 0xffff0000u); }
__device__ __forceinline__ float wave_sum(float v) {
#pragma unroll
    for (int o = 1; o < 64; o <<= 1) v += shfl_xor_(v, o);
    return v;
}
__device__ __forceinline__ float sigmoidf_(float x) { return 1.0f / (1.0f + __expf(-x)); }
__device__ __forceinline__ float siluf_(float x) { return x / (1.0f + __expf(-x)); }

__device__ __forceinline__ void transpose_tile(const float* W, int K, int N, bf16* WT, LAS float* scr, int k0, int n0, int drow, int lane) {
    {
        f32x4 v[8];
#pragma unroll
        for (int i = 0; i < 8; ++i) v[i] = *(const f32x4*)(W + (size_t)(k0 + (lane >> 3) + 8 * i) * N + n0 + (lane & 7) * 4);
#pragma unroll
        for (int i = 0; i < 8; ++i) { LAS float* d = scr + ((lane >> 3) + 8 * i) * 33 + (lane & 7) * 4; d[0] = v[i].x; d[1] = v[i].y; d[2] = v[i].z; d[3] = v[i].w; }
    }
    asm volatile("s_waitcnt lgkmcnt(0)" ::: "memory");
    const int c = lane & 7;
#pragma unroll
    for (int j = 0; j < 4; ++j) { const int n = (lane >> 3) + 8 * j; const LAS float* s = scr + (8 * c) * 33 + n;
        u32x4 o; o.x = pk2(s[0 * 33], s[1 * 33]); o.y = pk2(s[2 * 33], s[3 * 33]); o.z = pk2(s[4 * 33], s[5 * 33]); o.w = pk2(s[6 * 33], s[7 * 33]);
        *(u32x4*)(WT + (size_t)(drow + n) * K + k0 + 8 * c) = o; }
    asm volatile("s_waitcnt lgkmcnt(0)" ::: "memory");
}
__device__ __forceinline__ void transpose_item(const float* W, int K, int N, bf16* WT, LAS float* scr, int item, int lane) {
    const int nblk = N / 32, kb = item / nblk, nb = item % nblk;
    transpose_tile(W, K, N, WT, scr, 64 * kb, 32 * nb, 32 * nb, lane);
}

__device__ __forceinline__ void phase_prep(const Args& a, LAS unsigned char* lds) {
    const int tid = opaque_tid(), lane = tid & 63, wv = tid >> 6;
    const int G = gridDim.x;
    unsigned char* ws = a.ws;
    {
        LAS float* sc = (LAS float*)lds;
        LAS float* red = (LAS float*)(lds + 32768);
        const float* c = a.in[1]; const float* ada_w = a.in[2]; const float* ada_b = a.in[3];
        float* MOD = (float*)(ws + WS_MOD);
        if ((int)blockIdx.x < 192) {
            for (int i = tid; i < 8192; i += 512) sc[i] = siluf_(c[i]);
            sync_threads_();
            for (int unit = blockIdx.x; unit < 192; unit += G) {
                const int l = unit / 96, cb = (unit % 96) * 32, cl = tid & 31, ks = tid >> 5;
                const float* wp = ada_w + (size_t)l * 1024 * 3072 + (size_t)(ks * 64) * 3072 + cb + cl;
                float acc[8];
#pragma unroll
                for (int b = 0; b < 8; ++b) acc[b] = 0.f;
#pragma unroll 16
                for (int k = 0; k < 64; ++k) { const float w = wp[(size_t)k * 3072];
#pragma unroll
                    for (int b = 0; b < 8; ++b) acc[b] += sc[b * 1024 + ks * 64 + k] * w; }
#pragma unroll
                for (int b = 0; b < 8; ++b) red[(ks * 8 + b) * 32 + cl] = acc[b];
                sync_threads_();
                if (tid < 256) { const int b = tid >> 5; float s = 0.f;
#pragma unroll
                    for (int k2 = 0; k2 < 16; ++k2) s += red[(k2 * 8 + b) * 32 + cl];
                    MOD[(l * 8 + b) * 3072 + cb + cl] = s + ada_b[l * 3072 + cb + cl]; }
                sync_threads_();
            }
        }
        sync_threads_();
    }
    {
        LAS float* scr = (LAS float*)(lds + wv * 16384);
        const int gw = blockIdx.x * 8 + wv, NGW = G * 8;
        constexpr int I_IN = (1024 / 64) * (4096 / 32), I_OUT = (2048 / 64) * (1024 / 32);
        for (int it = gw; it < 2 * (I_IN + I_OUT); it += NGW) {
            int r = it;
            if (r < 2 * I_IN) { const int l = r / I_IN; r -= l * I_IN;
                transpose_item(a.in[5] + (size_t)l * 1024 * 4096, 1024, 4096, (bf16*)(ws + WS_WIN) + (size_t)l * 4096 * 1024, scr, r, lane); }
            else { r -= 2 * I_IN; const int l = r / I_OUT; r -= l * I_OUT;
                transpose_item(a.in[16] + (size_t)l * 2048 * 1024, 2048, 1024, (bf16*)(ws + WS_WOUT) + (size_t)l * 1024 * 2048, scr, r, lane); }
        }
    }
    {
        LAS float* scr = (LAS float*)(lds + wv * 16384);
        const int gw = blockIdx.x * 8 + wv, NGW = G * 8;
        bf16* GWp = (bf16*)(ws + WS_GW); bf16* PWp = (bf16*)(ws + WS_PW);
        for (int it = NGW - 1 - gw; it < 512; it += NGW) {
            if (it < 256) { const int lh = it >> 4, r = it & 15, gate = r >> 3, kb = (r >> 2) & 1, q = r & 3;
                transpose_tile((gate ? a.in[10] : a.in[8]) + (size_t)lh * 128 * 128, 128, 128, GWp + (size_t)lh * 4 * 64 * 128, scr, 64 * kb, 32 * q, q * 64 + gate * 32, lane); }
            else { const int r = it - 256, lg = r >> 5, kb = (r >> 3) & 3, nb = r & 7;
                transpose_tile(a.in[13] + (size_t)lg * 256 * 256, 256, 256, PWp + (size_t)lg * 256 * 256, scr, 64 * kb, 32 * nb, 32 * nb, lane); }
        }
    }
}

constexpr int RPW = 4;
__device__ __forceinline__ void phase_h0(const Args& a) {
    const int tid = opaque_tid(), lane = tid & 63, wv = tid >> 6;
    const int gw = blockIdx.x * 8 + wv, NGW = gridDim.x * 8;
    const float* x = a.in[0]; const float* g = a.in[4]; const float* MOD = (const float*)(a.ws + WS_MOD);
    bf16* H = (bf16*)(a.ws + WS_H);
    for (int m0 = gw * RPW; m0 < T; m0 += NGW * RPW) {
        f32x4 v[RPW][4];
#pragma unroll
        for (int r = 0; r < RPW; ++r) { const f32x4* xr = (const f32x4*)(x + (size_t)(m0 + r) * D) + lane;
#pragma unroll
            for (int j = 0; j < 4; ++j) v[r][j] = __builtin_nontemporal_load(xr + 64 * j); }
        const int b = m0 >> 12;
        const float* sh = MOD + (size_t)b * 3072; const float* scl = sh + 1024;
#pragma unroll
        for (int r = 0; r < RPW; ++r) {
            float ss = 0.f;
#pragma unroll
            for (int j = 0; j < 4; ++j) ss += (v[r][j].x * v[r][j].x + v[r][j].y * v[r][j].y) + (v[r][j].z * v[r][j].z + v[r][j].w * v[r][j].w);
            const float rstd = 1.0f / __builtin_sqrtf(wave_sum(ss) * (1.0f / D) + EPS);
            u32x2* o = (u32x2*)(H + (size_t)(m0 + r) * D) + lane;
#pragma unroll
            for (int j = 0; j < 4; ++j) { const int col = 4 * lane + 256 * j;
                const f32x4 gg = *(const f32x4*)(g + col), s4 = *(const f32x4*)(scl + col), h4 = *(const f32x4*)(sh + col);
                const f32x4 rr = v[r][j] * rstd * gg * (s4 + 1.0f) + h4;
                u32x2 w; w.x = pk2(rr.x, rr.y); w.y = pk2(rr.z, rr.w); o[64 * j] = w; }
        }
    }
}

__device__ __forceinline__ void phase_post(const Args& a, int l) {
    const int tid = opaque_tid(), lane = tid & 63, wv = tid >> 6;
    const int gw = blockIdx.x * 8 + wv, NGW = gridDim.x * 8;
    const float* xin = (l == 0) ? a.in[0] : a.out; float* out = a.out;
    const bf16* Y = (const bf16*)(a.ws + WS_Y); bf16* H = (bf16*)(a.ws + WS_H);
    const float* MOD = (const float*)(a.ws + WS_MOD);
    const float* gpost = a.in[17] + l * D; const float* gpre = a.in[4] + (l + 1) * D;
    for (int m0 = gw * RPW; m0 < T; m0 += NGW * RPW) {
        f32x4 xv[RPW][4]; u32x2 yw[RPW][4];
#pragma unroll
        for (int r = 0; r < RPW; ++r) { const f32x4* xr = (const f32x4*)(xin + (size_t)(m0 + r) * D) + lane; const u32x2* yr = (const u32x2*)(Y + (size_t)(m0 + r) * D) + lane;
#pragma unroll
            for (int j = 0; j < 4; ++j) { xv[r][j] = xr[64 * j]; yw[r][j] = yr[64 * j]; } }
        const int b = m0 >> 12;
        const float* gate = MOD + (size_t)(l * 8 + b) * 3072 + 2048;
        const float* sh = MOD + (size_t)(8 + b) * 3072; const float* scl = sh + 1024;
#pragma unroll
        for (int r = 0; r < RPW; ++r) {
            f32x4 yv[4]; float ss = 0.f;
#pragma unroll
            for (int j = 0; j < 4; ++j) { const u32x2 w = yw[r][j]; yv[j] = (f32x4){bflo(w.x), bfhi(w.x), bflo(w.y), bfhi(w.y)};
                ss += (yv[j].x * yv[j].x + yv[j].y * yv[j].y) + (yv[j].z * yv[j].z + yv[j].w * yv[j].w); }
            const float rstd = 1.0f / __builtin_sqrtf(wave_sum(ss) * (1.0f / D) + EPS);
            float ss2 = 0.f;
#pragma unroll
            for (int j = 0; j < 4; ++j) { const int col = 4 * lane + 256 * j;
                const f32x4 gp = *(const f32x4*)(gpost + col), gt = *(const f32x4*)(gate + col);
                const f32x4 xn = xv[r][j] + gt * (yv[j] * rstd * gp);
                xv[r][j] = xn;
                if (l == 0) *((f32x4*)(out + (size_t)(m0 + r) * D + col)) = xn;
                else __builtin_nontemporal_store(xn, (f32x4*)(out + (size_t)(m0 + r) * D + col));
                ss2 += (xn.x * xn.x + xn.y * xn.y) + (xn.z * xn.z + xn.w * xn.w); }
            if (l == 0) {
                const float rstd2 = 1.0f / __builtin_sqrtf(wave_sum(ss2) * (1.0f / D) + EPS);
                u32x2* o = (u32x2*)(H + (size_t)(m0 + r) * D) + lane;
#pragma unroll
                for (int j = 0; j < 4; ++j) { const int col = 4 * lane + 256 * j;
                    const f32x4 gg = *(const f32x4*)(gpre + col), s4 = *(const f32x4*)(scl + col), h4 = *(const f32x4*)(sh + col);
                    const f32x4 rr = xv[r][j] * rstd2 * gg * (s4 + 1.0f) + h4;
                    u32x2 w; w.x = pk2(rr.x, rr.y); w.y = pk2(rr.z, rr.w); o[64 * j] = w; }
            }
        }
    }
}
#define XB_TMO      128
#define XB_XCNT(j)  (256  + 64 * (j))
#define XB_XSUB(j)  (1280 + 64 * (j))
#define XB_XGEN(j)  (2304 + 64 * (j))
#define XB_TOP      3328
#define XB_TOPGEN   3392
#define XCD_BAR_WORDS 3456
#define XB_SPIN_CAP (1u << 18)

__device__ __forceinline__ unsigned xb_ld(unsigned* p)              { return __hip_atomic_load(p, __ATOMIC_RELAXED, __HIP_MEMORY_SCOPE_AGENT); }
__device__ __forceinline__ unsigned xb_add(unsigned* p, unsigned v) { return __hip_atomic_fetch_add(p, v, __ATOMIC_RELAXED, __HIP_MEMORY_SCOPE_AGENT); }
__device__ __forceinline__ unsigned xb_xcc_id() { return (unsigned)__builtin_amdgcn_s_getreg((3 << 11) | 20) & 0xFu; }
#define XB_SPIN(cond, bar) do { unsigned _sp = 0; while (cond) { __builtin_amdgcn_s_sleep(1); \
    if ((++_sp & 255u) == 0u) { if (xb_ld(&(bar)[XB_TMO])) break; if (_sp > XB_SPIN_CAP) { xb_add(&(bar)[XB_TMO], 1u); break; } } } } while (0)

struct XcdBarrier {
    unsigned* bar; unsigned x;
    volatile LAS unsigned* st;
};

__device__ __forceinline__ XcdBarrier xcd_barrier_post(unsigned* bar, volatile LAS unsigned* st) {
    XcdBarrier b; b.bar = bar; b.x = xb_xcc_id(); b.st = st;
    if (threadIdx.x == 0) (void)xb_add(&bar[XB_XCNT(b.x)], 1u);
    return b;
}
__device__ __forceinline__ void xcd_barrier_complete(unsigned* bar, unsigned x, unsigned& nloc, unsigned& nx) {
    const unsigned G = gridDim.x * gridDim.y * gridDim.z;
    unsigned sum, cnt, mine, sp = 0u;
    for (;;) {
        sum = 0u; cnt = 0u; mine = 0u;
#pragma unroll
        for (unsigned j = 0; j < 16; ++j) { const unsigned c = xb_ld(&bar[XB_XCNT(j)]); sum += c; cnt += (c > 0u) ? 1u : 0u; mine = (j == x) ? c : mine; }
        if (sum == G) break;
        __builtin_amdgcn_s_sleep(1);
        if ((++sp & 255u) == 0u) { if (xb_ld(&bar[XB_TMO])) break; if (sp > XB_SPIN_CAP) { xb_add(&bar[XB_TMO], 1u); break; } }
    }
    nloc = mine > 0u ? mine : 1u; nx = cnt > 0u ? cnt : 1u;
}

__device__ __forceinline__ void xcd_barrier(const XcdBarrier& b) {
    asm volatile("s_waitcnt vmcnt(0)" ::: "memory");
    sync_threads_();
    if (threadIdx.x == 0) {
        unsigned* bar = b.bar;
        __builtin_amdgcn_s_waitcnt(0);
        unsigned nloc = b.st[0], nx = b.st[1];
        if (nloc == 0u) { xcd_barrier_complete(bar, b.x, nloc, nx); b.st[0] = nloc; b.st[1] = nx; }
        const unsigned old = xb_add(&bar[XB_XSUB(b.x)], 1u);
        const unsigned gen = old / nloc;
        if (old + 1u == (gen + 1u) * nloc) {
            __builtin_amdgcn_fence(__ATOMIC_RELEASE, "agent");
            asm volatile("s_waitcnt vmcnt(0)" ::: "memory");
            const unsigned og = xb_add(&bar[XB_TOP], 1u);
            const unsigned tg = og / nx;
            if (og + 1u == (tg + 1u) * nx) xb_add(&bar[XB_TOPGEN], 1u);
            else XB_SPIN(xb_ld(&bar[XB_TOPGEN]) == tg, bar);
            __builtin_amdgcn_fence(__ATOMIC_ACQUIRE, "agent");
            xb_add(&bar[XB_XGEN(b.x)], 1u);
            asm volatile("s_waitcnt vmcnt(0)" ::: "memory");
        } else {
            XB_SPIN(xb_ld(&bar[XB_XGEN(b.x)]) == gen, bar);
            __builtin_amdgcn_fence(__ATOMIC_ACQUIRE, "agent");
            asm volatile("s_waitcnt vmcnt(0)" ::: "memory");
        }
    }
    sync_threads_();
}

#define LDS_BARRIER() do { asm volatile("s_waitcnt lgkmcnt(0)" ::: "memory"); __builtin_amdgcn_s_barrier(); asm volatile("" ::: "memory"); } while (0)
constexpr int XROW = 272;
constexpr int CROW = 132;
constexpr int R_XT = 0, R_UT = 35840, R_AT = 70656, R_VT = 87552, R_EP = 104448, R_CWT = 105472, R_WG = 108032;
template <int D> __device__ __forceinline__ float dpp_row_shr(float old, float src) {
    return i2f(__builtin_amdgcn_update_dpp(f2i(old), f2i(src), 0x110 | D, 0xf, 0xf, false)); }
__device__ __forceinline__ float softplus_small_(float e) { return (e < 0.03f) ? e * (1.0f + e * (-0.5f + e * (0.33333334f + e * (-0.25f + e * 0.2f)))) : __builtin_logf(1.0f + e); }
__device__ __forceinline__ float fast_sigmoid(float x) { return __builtin_amdgcn_rcpf(1.0f + __builtin_amdgcn_exp2f(-1.4426950408889634f * x)); }
__device__ __forceinline__ void rnn_unit(const Args& a, int l, int u, LAS unsigned char* lds) {
    const int tid = opaque_tid(), lane = tid & 63, wv = tid >> 6, fr = lane & 15, fq = lane >> 4;
    const int xcd = u & 7, jj = u >> 3, q = jj & 3, bh = (jj >> 2) * 8 + xcd, b = bh >> 3, h = bh & 7;
    const bf16* PROJ = (const bf16*)(a.ws + WS_PROJ); bf16* YCAT = (bf16*)(a.ws + WS_YCAT);
    const bf16* xr_base = PROJ + (size_t)(b * SEQ) * NPROJ + h * 128;
    const bf16* gr_base = PROJ + (size_t)(b * SEQ) * NPROJ + 1024 + h * 128 + q * 32;
    bf16* y_base = YCAT + (size_t)(b * SEQ) * DMIX + h * 128 + q * 32;
    LAS unsigned char* XT = lds + R_XT; LAS unsigned char* UT = lds + R_UT;
    LAS float* AT = (LAS float*)(lds + R_AT); LAS float* VT = (LAS float*)(lds + R_VT);
    LAS float* EP = (LAS float*)(lds + R_EP);
    LAS unsigned char* WG = lds + R_WG;
    {
        const bf16* gw = (const bf16*)(a.ws + WS_GW) + (size_t)((l * 8 + h) * 4 + q) * 64 * 128;
#pragma unroll
        for (int i = 0; i < 2; ++i) { const int id = tid + 512 * i, row = id >> 4, cc = id & 15; *(LAS u32x4*)(WG + row * XROW + cc * 16) = *(const u32x4*)(gw + row * 128 + cc * 8); }
    }
    const int ck = tid & 15, tg = tid >> 4;
    LAS float* CWT = (LAS float*)(lds + R_CWT);
    for (int i = tid; i < 640; i += 512) { const int r = i >> 7, c = i & 127;
        CWT[i] = (r < 4) ? a.in[6][(size_t)l * 4 * 1024 + r * 1024 + h * 128 + c] : a.in[7][(size_t)l * 1024 + h * 128 + c]; }
    if (tid < 96) {
        const int r = tid >> 5, c = tid & 31, ch = h * 128 + q * 32 + c; float v;
        if (r == 0) v = a.in[9][l * 1024 + ch];
        else if (r == 1) v = a.in[11][l * 1024 + ch];
        else v = 8.0f * 1.4426950408889634f * softplus_small_(__builtin_expf(-a.in[12][l * 1024 + ch]));
        EP[r * 32 + c] = v;
    }
    u32x4 pf[4], pfh = (u32x4){0u, 0u, 0u, 0u};
#pragma unroll
    for (int i = 0; i < 4; ++i) { const int id = tid + 512 * i, row = id >> 4, cc = id & 15; pf[i] = *(const u32x4*)(xr_base + (size_t)row * NPROJ + cc * 8); }
    const int sc_ci = lane >> 4, sc_sg = lane & 15, sc_c = wv * 4 + sc_ci;
    float hcar = 0.f;
    unsigned gcur[8], gnext[8];
#pragma unroll
    for (int j = 0; j < 8; ++j) gcur[j] = gr_base[(size_t)(sc_sg * 8 + j) * NPROJ + sc_c];
#pragma unroll
    for (int j = 0; j < 8; ++j) asm volatile("" : "+v"(gcur[j]));
#pragma unroll
    for (int i = 0; i < 4; ++i) { const int id = tid + 512 * i, row = id >> 4, cc = id & 15; *(LAS u32x4*)(XT + (3 + row) * XROW + cc * 16) = pf[i]; }
    if (tid < 48) *(LAS u32x4*)(XT + (tid >> 4) * XROW + (tid & 15) * 16) = pfh;
    for (int tile = 0; tile < SEQ / 128; ++tile) {
        const int t0 = tile * 128;
        LDS_BARRIER();
        {
            const int t0n = (tile + 1 < SEQ / 128) ? t0 + 128 : t0;
#pragma unroll
            for (int i = 0; i < 4; ++i) { const int id = tid + 512 * i, row = id >> 4, cc = id & 15; pf[i] = *(const u32x4*)(xr_base + (size_t)(t0n + row) * NPROJ + cc * 8); }
            if (tid < 48) pfh = *(const u32x4*)(xr_base + (size_t)(t0n - 3 + (tid >> 4)) * NPROJ + (tid & 15) * 8);
        }
        {
            const int t1 = (tile + 1 < SEQ / 128) ? t0 + 128 : t0;
#pragma unroll
            for (int j = 0; j < 8; ++j) gnext[j] = gr_base[(size_t)(t1 + sc_sg * 8 + j) * NPROJ + sc_c];
        }
        {
            f32x2 o[4][4], cw[4][4];
            {
                const f32x4 b0 = *(const LAS f32x4*)(CWT + 4 * 128 + ck * 8), b1 = *(const LAS f32x4*)(CWT + 4 * 128 + ck * 8 + 4);
#pragma unroll
                for (int i = 0; i < 4; ++i) { o[i][0] = (f32x2){b0.x, b0.y}; o[i][1] = (f32x2){b0.z, b0.w}; o[i][2] = (f32x2){b1.x, b1.y}; o[i][3] = (f32x2){b1.z, b1.w}; }
            }
#pragma unroll
            for (int k = 0; k < 4; ++k) { const f32x4 w0 = *(const LAS f32x4*)(CWT + k * 128 + ck * 8), w1 = *(const LAS f32x4*)(CWT + k * 128 + ck * 8 + 4);
                cw[k][0] = (f32x2){w0.x, w0.y}; cw[k][1] = (f32x2){w0.z, w0.w}; cw[k][2] = (f32x2){w1.x, w1.y}; cw[k][3] = (f32x2){w1.z, w1.w}; }
#pragma unroll
            for (int r = 0; r < 7; ++r) {
                const u32x4 w = *(const LAS u32x4*)(XT + (tg * 4 + r) * XROW + ck * 16);
                const f32x2 xv[4] = {(f32x2){bflo(w.x), bfhi(w.x)}, (f32x2){bflo(w.y), bfhi(w.y)}, (f32x2){bflo(w.z), bfhi(w.z)}, (f32x2){bflo(w.w), bfhi(w.w)}};
#pragma unroll
                for (int i = 0; i < 4; ++i) { const int k = r - i; if (k >= 0 && k < 4) {
#pragma unroll
                    for (int e = 0; e < 4; ++e) o[i][e] = __builtin_elementwise_fma(cw[k][e], xv[e], o[i][e]); } }
            }
#pragma unroll
            for (int i = 0; i < 4; ++i) { u32x4 w; w.x = pk2(o[i][0].x, o[i][0].y); w.y = pk2(o[i][1].x, o[i][1].y); w.z = pk2(o[i][2].x, o[i][2].y); w.w = pk2(o[i][3].x, o[i][3].y);
                *(LAS u32x4*)(UT + (tg * 4 + i) * XROW + ck * 16) = w; }
        }
        asm volatile("s_waitcnt lgkmcnt(0)" ::: "memory");
        {
            f32x4 acc[4];
#pragma unroll
            for (int nb = 0; nb < 4; ++nb) acc[nb] = (f32x4){0.f, 0.f, 0.f, 0.f};
#pragma unroll
            for (int kb = 0; kb < 4; ++kb) { const bf16x8 uf = *(const LAS bf16x8*)(UT + (wv * 16 + fr) * XROW + kb * 64 + fq * 16);
#pragma unroll
                for (int nb = 0; nb < 4; ++nb) acc[nb] = __builtin_amdgcn_mfma_f32_16x16x32_bf16(*(const LAS bf16x8*)(WG + (nb * 16 + fr) * XROW + kb * 64 + fq * 16), uf, acc[nb], 0, 0, 0); }
            const int tk = wv * 16 + fr;
#pragma unroll
            for (int nb2 = 0; nb2 < 2; ++nb2) {
                const int c0 = nb2 * 16 + 4 * fq;
                const u32x2 uw = *(const LAS u32x2*)(UT + tk * XROW + (q * 32 + c0) * 2);
                const f32x4 uu = (f32x4){bflo(uw.x), bfhi(uw.x), bflo(uw.y), bfhi(uw.y)};
                const f32x4 ra = acc[nb2] + *(const LAS f32x4*)(EP + c0), rx = acc[nb2 + 2] + *(const LAS f32x4*)(EP + 32 + c0), sp8 = *(const LAS f32x4*)(EP + 64 + c0);
#pragma unroll
                for (int e = 0; e < 4; ++e) { const float r = fast_sigmoid(ra[e]), ig = fast_sigmoid(rx[e]);
                    const float av = __builtin_amdgcn_exp2f(-r * sp8[e]);
                    const float m2 = __builtin_fmaxf(__builtin_fmaf(-av, av, 1.0f), 0.f);
                    AT[(c0 + e) * CROW + tk] = av; VT[(c0 + e) * CROW + tk] = __builtin_amdgcn_sqrtf(m2) * (ig * uu[e]); }
            }
        }
        LDS_BARRIER();
        {
            const f32x4 a0 = *(const LAS f32x4*)(AT + sc_c * CROW + sc_sg * 8), a1 = *(const LAS f32x4*)(AT + sc_c * CROW + sc_sg * 8 + 4);
            const f32x4 v0 = *(const LAS f32x4*)(VT + sc_c * CROW + sc_sg * 8), v1 = *(const LAS f32x4*)(VT + sc_c * CROW + sc_sg * 8 + 4);
            const float av[8] = {a0.x, a0.y, a0.z, a0.w, a1.x, a1.y, a1.z, a1.w}, vv[8] = {v0.x, v0.y, v0.z, v0.w, v1.x, v1.y, v1.z, v1.w};
            float hl[8], pp[8]; float hcur = 0.f, pcur = 1.f;
#pragma unroll
            for (int j = 0; j < 8; ++j) { hcur = __builtin_fmaf(av[j], hcur, vv[j]); pcur *= av[j]; hl[j] = hcur; pp[j] = pcur; }
            float P = pcur, H = hcur;
            { float Pp = dpp_row_shr<1>(1.f, P), Hp = dpp_row_shr<1>(0.f, H); H = __builtin_fmaf(P, Hp, H); P *= Pp;
              Pp = dpp_row_shr<2>(1.f, P); Hp = dpp_row_shr<2>(0.f, H); H = __builtin_fmaf(P, Hp, H); P *= Pp;
              Pp = dpp_row_shr<4>(1.f, P); Hp = dpp_row_shr<4>(0.f, H); H = __builtin_fmaf(P, Hp, H); P *= Pp;
              Pp = dpp_row_shr<8>(1.f, P); Hp = dpp_row_shr<8>(0.f, H); H = __builtin_fmaf(P, Hp, H); P *= Pp; }
            const float Pe = dpp_row_shr<1>(1.f, P), He = dpp_row_shr<1>(0.f, H);
            const float carry = __builtin_fmaf(Pe, hcar, He);
            const float hend = __builtin_fmaf(P, hcar, H);
            hcar = row_last_(hend);
#pragma unroll
            for (int j = 0; j < 8; ++j) { const float hv = __builtin_fmaf(pp[j], carry, hl[j]); const float gv = u2f(gcur[j] << 16);
                const float yv = hv * gv * fast_sigmoid(gv);
                y_base[(size_t)(t0 + sc_sg * 8 + j) * DMIX + sc_c] = (bf16)(pk2(yv, 0.f) & 0xffffu); }
        }
#pragma unroll
        for (int i = 0; i < 4; ++i) { const int id = tid + 512 * i, row = id >> 4, cc = id & 15; *(LAS u32x4*)(XT + (3 + row) * XROW + cc * 16) = pf[i]; }
        if (tid < 48) *(LAS u32x4*)(XT + (tid >> 4) * XROW + (tid & 15) * 16) = pfh;
#pragma unroll
        for (int j = 0; j < 8; ++j) gcur[j] = gnext[j];
    }
    LDS_BARRIER();
}

constexpr int PROW = 528;
constexpr int R_XP = 0, R_PT = 42240;
__device__ __forceinline__ void pool_units(const Args& a, int l, int u, LAS unsigned char* lds) {
    const int tid = opaque_tid(), lane = tid & 63, wv = tid >> 6, fr = lane & 15, fq = lane >> 4;
    const int g = u & 3, bi = u >> 2, win = 2 << g;
    const bf16* PROJ = (const bf16*)(a.ws + WS_PROJ); bf16* YCAT = (bf16*)(a.ws + WS_YCAT);
    LAS unsigned char* XP = lds + R_XP; LAS unsigned char* PT = lds + R_PT;
    const bf16* pw = (const bf16*)(a.ws + WS_PW) + (size_t)(l * 4 + g) * 256 * 256;
    bf16x8 Wf[2][8];
#pragma unroll
    for (int nb = 0; nb < 2; ++nb)
#pragma unroll
        for (int kb = 0; kb < 8; ++kb) Wf[nb][kb] = *(const bf16x8*)(pw + (size_t)(wv * 32 + nb * 16 + fr) * 256 + kb * 32 + fq * 8);
    f32x4 pb[2], ps[2];
#pragma unroll
    for (int nb = 0; nb < 2; ++nb) { const int n = wv * 32 + nb * 16 + 4 * fq;
        pb[nb] = *(const f32x4*)(a.in[14] + (size_t)l * 1024 + g * 256 + n); ps[nb] = *(const f32x4*)(a.in[15] + (size_t)l * 1024 + g * 256 + n); }
    const int ck = tid & 31, tg = tid >> 5;
    u32x4 pf[5];
    {
        const int tile = bi * 8, b = tile >> 6, t0 = (tile & 63) * 64;
        const bf16* xp_base = PROJ + (size_t)(b * SEQ) * NPROJ + 2048 + g * 256;
#pragma unroll
        for (int i = 0; i < 5; ++i) { const int id = tid + 512 * i, row = id >> 5, cc = id & 31, t = t0 - 16 + row;
            const u32x4 v = *(const u32x4*)(xp_base + (size_t)(t < 0 ? 0 : t) * NPROJ + cc * 8); pf[i] = (t < 0) ? (u32x4){0u, 0u, 0u, 0u} : v; }
    }
#pragma unroll
    for (int i = 0; i < 5; ++i) { const int id = tid + 512 * i, row = id >> 5, cc = id & 31; *(LAS u32x4*)(XP + row * PROW + cc * 16) = pf[i]; }
    u32x2 gp[4][2];
    {
        const int tile = bi * 8, b = tile >> 6, t0 = (tile & 63) * 64;
        const bf16* gp_base0 = PROJ + (size_t)(b * SEQ) * NPROJ + 3072 + g * 256;
#pragma unroll
        for (int tb = 0; tb < 4; ++tb)
#pragma unroll
            for (int nb = 0; nb < 2; ++nb) { gp[tb][nb] = *(const u32x2*)(gp_base0 + (size_t)(t0 + tb * 16 + fr) * NPROJ + wv * 32 + nb * 16 + 4 * fq);
                asm volatile("" : "+v"(gp[tb][nb])); }
    }
    for (int it = 0; it < 8; ++it) {
        const int tile = bi * 8 + it, b = tile >> 6, t0 = (tile & 63) * 64;
        bf16* y_base = YCAT + (size_t)(b * SEQ) * DMIX + 1024 + g * 256;
        LDS_BARRIER();
        {
            const int tile2 = bi * 8 + ((it + 1 < 8) ? it + 1 : it), b2 = tile2 >> 6, t02 = (tile2 & 63) * 64;
            const bf16* xp_base = PROJ + (size_t)(b2 * SEQ) * NPROJ + 2048 + g * 256;
#pragma unroll
            for (int i = 0; i < 5; ++i) { const int id = tid + 512 * i, row = id >> 5, cc = id & 31, t = t02 - 16 + row;
                const u32x4 v = *(const u32x4*)(xp_base + (size_t)(t < 0 ? 0 : t) * NPROJ + cc * 8); pf[i] = (t < 0) ? (u32x4){0u, 0u, 0u, 0u} : v; }
        }
        u32x2 gpn[4][2];
        {
            const int tile2 = bi * 8 + ((it + 1 < 8) ? it + 1 : it), b2 = tile2 >> 6, t02 = (tile2 & 63) * 64;
            const bf16* gp_base2 = PROJ + (size_t)(b2 * SEQ) * NPROJ + 3072 + g * 256;
#pragma unroll
            for (int tb = 0; tb < 4; ++tb)
#pragma unroll
                for (int nb = 0; nb < 2; ++nb) gpn[tb][nb] = *(const u32x2*)(gp_base2 + (size_t)(t02 + tb * 16 + fr) * NPROJ + wv * 32 + nb * 16 + 4 * fq);
        }
        {
            float s[8];
#pragma unroll
            for (int e = 0; e < 8; ++e) s[e] = 0.f;
            const int r0 = tg * 4 + 16;
            for (int r = r0 - win + 1; r < r0; ++r) { const u32x4 w = *(const LAS u32x4*)(XP + r * PROW + ck * 16);
                s[0] += bflo(w.x); s[1] += bfhi(w.x); s[2] += bflo(w.y); s[3] += bfhi(w.y); s[4] += bflo(w.z); s[5] += bfhi(w.z); s[6] += bflo(w.w); s[7] += bfhi(w.w); }
#pragma unroll
            for (int i = 0; i < 4; ++i) {
                const u32x4 w = *(const LAS u32x4*)(XP + (r0 + i) * PROW + ck * 16);
                const float xv[8] = {bflo(w.x), bfhi(w.x), bflo(w.y), bfhi(w.y), bflo(w.z), bfhi(w.z), bflo(w.w), bfhi(w.w)};
                const int t = t0 + tg * 4 + i; const float inv = __builtin_amdgcn_rcpf((float)((t + 1 < win) ? (t + 1) : win));
                float p[8];
#pragma unroll
                for (int e = 0; e < 8; ++e) { s[e] += xv[e]; p[e] = __builtin_fmaf(s[e], inv, -xv[e]); }
                u32x4 o; o.x = pk2(p[0], p[1]); o.y = pk2(p[2], p[3]); o.z = pk2(p[4], p[5]); o.w = pk2(p[6], p[7]);
                *(LAS u32x4*)(PT + (tg * 4 + i) * PROW + ck * 16) = o;
                const u32x4 wo = *(const LAS u32x4*)(XP + (r0 + i - win + 1) * PROW + ck * 16);
                s[0] -= bflo(wo.x); s[1] -= bfhi(wo.x); s[2] -= bflo(wo.y); s[3] -= bfhi(wo.y); s[4] -= bflo(wo.z); s[5] -= bfhi(wo.z); s[6] -= bflo(wo.w); s[7] -= bfhi(wo.w);
            }
        }
        LDS_BARRIER();
#pragma unroll
        for (int tb = 0; tb < 4; ++tb) {
            f32x4 acc[2] = {(f32x4){0.f, 0.f, 0.f, 0.f}, (f32x4){0.f, 0.f, 0.f, 0.f}};
#pragma unroll
            for (int kb = 0; kb < 8; ++kb) { const bf16x8 pfm = *(const LAS bf16x8*)(PT + (tb * 16 + fr) * PROW + kb * 64 + fq * 16);
#pragma unroll
                for (int nb = 0; nb < 2; ++nb) acc[nb] = __builtin_amdgcn_mfma_f32_16x16x32_bf16(Wf[nb][kb], pfm, acc[nb], 0, 0, 0); }
            const int t = t0 + tb * 16 + fr;
#pragma unroll
            for (int nb = 0; nb < 2; ++nb) { const int n = wv * 32 + nb * 16 + 4 * fq;
                const u32x2 gw2 = gp[tb][nb];
                const f32x4 gv = (f32x4){bflo(gw2.x), bfhi(gw2.x), bflo(gw2.y), bfhi(gw2.y)};
                f32x4 r = (acc[nb] + pb[nb]) * ps[nb];
#pragma unroll
                for (int e = 0; e < 4; ++e) r[e] *= gv[e] * fast_sigmoid(gv[e]);
                u32x2 o; o.x = pk2(r.x, r.y); o.y = pk2(r.z, r.w);
                *(u32x2*)(y_base + (size_t)t * DMIX + n) = o; }
        }
#pragma unroll
        for (int i = 0; i < 5; ++i) { const int id = tid + 512 * i, row = id >> 5, cc = id & 31; *(LAS u32x4*)(XP + row * PROW + cc * 16) = pf[i]; }
#pragma unroll
        for (int tb = 0; tb < 4; ++tb)
#pragma unroll
            for (int nb = 0; nb < 2; ++nb) gp[tb][nb] = gpn[tb][nb];
    }
    LDS_BARRIER();
}

__device__ __forceinline__ void phase_mixer(const Args& a, int l, LAS unsigned char* lds) {
#ifndef MK_MIX
#define MK_MIX 3
#endif
#ifndef MK_DBL_RNN
#define MK_DBL_RNN 0
#endif
#ifndef MK_DBL_POOL
#define MK_DBL_POOL 0
#endif
    for (int rep = 0; rep < 1 + ((l == 0) ? MK_DBL_RNN : 0); ++rep) for (int u = blockIdx.x; u < 256; u += gridDim.x) rnn_unit(a, l, u, lds);
    for (int rep = 0; rep < 1 + ((l == 0) ? MK_DBL_POOL : 0); ++rep) for (int u = blockIdx.x; u < 256; u += gridDim.x) pool_units(a, l, u, lds);
}
#ifndef MK_DBL_PH
#define MK_DBL_PH -1
#endif
#ifndef MK_MASK
#define MK_MASK 63
#endif
__global__ void __launch_bounds__(512, 2) mk_fwd(Args a) {
    extern __shared__ __attribute__((aligned(16))) unsigned char lds_raw[];
    LAS unsigned char* lds = (LAS unsigned char*)lds_raw;
    cg::grid_group grid = cg::this_grid();
    volatile LAS unsigned* bst = (volatile LAS unsigned*)(lds + LDS_BST_OFF);
    if (threadIdx.x < 4) bst[threadIdx.x] = 0u;
    sync_threads_();
    XcdBarrier xbar = xcd_barrier_post((unsigned*)(a.ws + WS_CTL), bst);
#define GRID_BAR() do { if (a.ph_hi - a.ph_lo > 64) grid.sync(); else xcd_barrier(xbar); } while (0)
    for (int ph = a.ph_lo; ph < a.ph_hi; ++ph) {
#if MK_DBL_PH >= 0
      for (int rep = 0; rep < ((ph == MK_DBL_PH) ? 2 : 1); ++rep) {
        if (rep) GRID_BAR();
#endif
        if (ph == 0) { if (MK_MASK & 1) phase_prep(a, lds); }
        else if (ph == 1) { if (MK_MASK & 2) phase_h0(a); }
        else {
            const int l = (ph - 2) >> 2, sub = (ph - 2) & 3;
            if (sub == 0) { if (MK_MASK & 4) {
                pg8::Gemm g{(const pg8::bf16_t*)(a.ws + WS_H), (const pg8::bf16_t*)(a.ws + WS_WIN) + (size_t)l * NPROJ * D, T, NPROJ, D};
                pg8::StaticOrder S; S.init(T, NPROJ, gridDim.x, (int)blockIdx.x);
                pg8::EpiBf16<0> E{(pg8::bf16_t*)(a.ws + WS_PROJ), NPROJ, nullptr, 0, 0, 1.f};
                pg8::gemm_phase<pg8::EpiBf16<0>, pg8::StaticOrder, PG8_ALIGN, PG8_SP2>(lds, g, S, E); }
            } else if (sub == 1) {
                if (MK_MASK & 8) phase_mixer(a, l, lds);
            } else if (sub == 2) { if (MK_MASK & 16) {
                pg8::Gemm g{(const pg8::bf16_t*)(a.ws + WS_YCAT), (const pg8::bf16_t*)(a.ws + WS_WOUT) + (size_t)l * D * DMIX, T, D, DMIX};
                pg8::StaticOrder S; S.init(T, D, gridDim.x, (int)blockIdx.x);
                pg8::EpiBf16<0> E{(pg8::bf16_t*)(a.ws + WS_Y), D, nullptr, 0, 0, 1.f};
                pg8::gemm_phase<pg8::EpiBf16<0>, pg8::StaticOrder, PG8_ALIGN, PG8_SP2>(lds, g, S, E); }
            } else {
                if (MK_MASK & 32) phase_post(a, l);
            }
        }
#if MK_DBL_PH >= 0
      }
#endif
        if (ph + 1 < a.ph_hi) GRID_BAR();
    }
}

#if defined(__HIP_DEVICE_COMPILE__)
#pragma clang attribute pop
#endif

extern "C" void kernel_launch(void* const* d_in, const int* in_sizes, int n_in, void* d_out, int out_size, void* d_ws, size_t ws_size, hipStream_t stream) {
    static int grid = 0;
    if (grid == 0) {
        if (n_in != 18 || in_sizes[0] != T * D || out_size != T * D || ws_size < WS_END) {
            fprintf(stderr, "kernel_launch: unexpected shapes (n_in %d, in0 %d, out %d, ws %zu); nothing launched\n", n_in, n_in > 0 ? in_sizes[0] : -1, out_size, ws_size); grid = -1; return; }
        int dev = 0, cus = 0, per_cu = 0;
        if (hipGetDevice(&dev) != hipSuccess || hipDeviceGetAttribute(&cus, hipDeviceAttributeMultiprocessorCount, dev) != hipSuccess) { grid = -1; return; }
        if (hipFuncSetAttribute((const void*)mk_fwd, hipFuncAttributeMaxDynamicSharedMemorySize, LDS_BYTES) != hipSuccess) { fprintf(stderr, "kernel_launch: hipFuncSetAttribute failed\n"); grid = -1; return; }
        if (hipOccupancyMaxActiveBlocksPerMultiprocessor(&per_cu, (const void*)mk_fwd, 512, LDS_BYTES) != hipSuccess || per_cu < 1) { fprintf(stderr, "kernel_launch: occupancy query says %d blocks per CU\n", per_cu); per_cu = 1; }
        (void)hipGetLastError();
        grid = cus;
    }
    if (grid < 0) return;
    Args a{};
    for (int i = 0; i < 18; ++i) a.in[i] = (const float*)d_in[i];
    a.out = (float*)d_out; a.ws = (unsigned char*)d_ws;
    if (hipMemsetAsync((char*)d_ws + WS_CTL, 0, CTL_BYTES, stream) != hipSuccess) { fprintf(stderr, "kernel_launch: memset of the barrier words failed\n"); return; }
#if MK_N_LAUNCHES == 1
    a.ph_lo = 0; a.ph_hi = NPH;
    void* args[] = {&a};
    const hipError_t e = hipLaunchCooperativeKernel((const void*)mk_fwd, dim3(grid), dim3(512), args, LDS_BYTES, stream);
    if (e != hipSuccess) fprintf(stderr, "kernel_launch: cooperative launch failed: %s (grid %d)\n", hipGetErrorString(e), grid);
#else
    for (int ph = 0; ph < NPH; ++ph) {
        a.ph_lo = ph; a.ph_hi = ph + 1;
        hipLaunchKernelGGL(mk_fwd, dim3(grid), dim3(512), LDS_BYTES, stream, a);
    }
#endif
}
```

```cpp
#include <hip/hip_runtime.h>
#include <hip/hip_cooperative_groups.h>
#include <cstdio>
#include <cstdint>
namespace cg = cooperative_groups;
__device__ __forceinline__ int opaque_tid() { int t = threadIdx.x; asm volatile("" : "+v"(t)); return t; }
#if defined(__HIP_DEVICE_COMPILE__)
#pragma clang attribute push (__attribute__((target("no-packed-fp32-ops"))), apply_to = function)
#endif
__device__ __forceinline__ float u2f(unsigned x) { return __builtin_bit_cast(float, x); }
__device__ __forceinline__ float i2f(int x) { return __builtin_bit_cast(float, x); }
__device__ __forceinline__ int f2i(float x) { return __builtin_bit_cast(int, x); }
__device__ __forceinline__ int lane_id_() { return (int)__builtin_amdgcn_mbcnt_hi(~0u, __builtin_amdgcn_mbcnt_lo(~0u, 0u)); }
__device__ __forceinline__ float shfl_xor_(float v, int o) { return i2f(__builtin_amdgcn_ds_bpermute((lane_id_() ^ o) << 2, f2i(v))); }
__device__ __forceinline__ float row_last_(float v) { return i2f(__builtin_amdgcn_ds_bpermute((lane_id_() | 15) << 2, f2i(v))); }
__device__ __forceinline__ void sync_threads_() { __builtin_amdgcn_fence(__ATOMIC_RELEASE, "workgroup"); __builtin_amdgcn_s_barrier(); __builtin_amdgcn_fence(__ATOMIC_ACQUIRE, "workgroup"); }
namespace pg8 {
#define PG8_LAS __attribute__((address_space(3)))
typedef unsigned short bf16_t;
typedef short bf16x8 __attribute__((ext_vector_type(8)));
typedef float f32x4 __attribute__((ext_vector_type(4)));
typedef unsigned u32x4 __attribute__((ext_vector_type(4)));
constexpr int BM = 256, BK = 64, HALF = 128, HTB = HALF * BK * 2  , STAGE_BYTES = 8 * HTB, NXCD = 8, WGM = 8;

__host__ __device__ __forceinline__ int lds_byte(int r, int c) { const int st = (r >> 4) * 2 + (c >> 5), rr = r & 15, cc = c & 31, ob = rr * 64 + cc * 2; return st * 1024 + (ob ^ (((ob >> 9) & 1) << 5)); }
__host__ __device__ __forceinline__ void stage_rc(int b, int& R, int& C) { const int st = b / 1024, sb = b % 1024, swz = sb ^ (((sb >> 9) & 1) << 5); R = (st >> 1) * 16 + swz / 64; C = (st & 1) * 32 + (swz % 64) / 2; }
__host__ __device__ __forceinline__ int perm32(int rho) { const int n = rho >> 4, i = rho & 15; return 8 * (i >> 2) + 4 * n + (i & 3); }

struct Unit { int pm, pn; };
struct Gemm { const bf16_t* A; const bf16_t* Bt; int M, N, K; };

struct StaticOrder {
    int nM, nN, nwg, G, c;
    __host__ __device__ void init(int M, int N, int G_, int c_) { nM = M / BM; nN = N / BM; nwg = nM * nN; G = G_; c = c_; }
    __host__ __device__ bool next(int i, Unit& u) const {
        const long L = (long)i * G + c; if (L >= nwg) return false;
        int wgid = (int)L; { const int q = nwg / NXCD, r = nwg % NXCD, xcd = wgid % NXCD, off = wgid / NXCD; wgid = (xcd < r ? xcd * (q + 1) : r * (q + 1) + (xcd - r) * q) + off; }
        const int nig = WGM * nN, gid = wgid / nig, fm = gid * WGM, gsz = (nM - fm) < WGM ? (nM - fm) : WGM;
        u.pm = fm + ((wgid % nig) % gsz); u.pn = (wgid % nig) / gsz; return true;
    }
    __device__ __forceinline__ void a_ready(const Unit&) const {}
    __device__ __forceinline__ void done(const Unit&) const {}
};

__device__ __forceinline__ unsigned cvt_pk_bf16(float lo, float hi) { unsigned r; asm volatile("v_cvt_pk_bf16_f32 %0, %1, %2" : "=v"(r) : "v"(lo), "v"(hi)); return r; }
typedef float f32x2 __attribute__((ext_vector_type(2)));
__device__ __forceinline__ f32x2 gelu_pk(f32x2 v) {
    const f32x2 av = __builtin_elementwise_abs(v), d = av * 0.2316418882f + 1.0f;
    f32x2 t; t.x = __builtin_amdgcn_rcpf(d.x); t.y = __builtin_amdgcn_rcpf(d.y);
    f32x2 q = t * 0.5307027145f + (-0.7265760135f); q = q * t + 0.7107068705f; q = q * t + (-0.142248368f); q = q * t + 0.127414796f; q = q * t;
    const f32x2 s = (v * v) * (-0.72134752044f);
    f32x2 e; e.x = __builtin_amdgcn_exp2f(s.x); e.y = __builtin_amdgcn_exp2f(s.y);
    const f32x2 m = v * (q * e), r = v - m;
    f32x2 o; o.x = v.x < 0.f ? m.x : r.x; o.y = v.y < 0.f ? m.y : r.y; return o;
}

template <int ACT  > struct EpiBf16 {
    static constexpr bool PERM = true, AFTER_DRAIN = false; static_assert(ACT == 0 || ACT == 1, "EpiBf16: ACT is 0 (none) or 1 (gelu_pk)");
    bf16_t* O; int ldc; const float* bias; int split_cols; size_t split_stride; float scale0;
    __device__ __forceinline__ void operator()(const f32x4 (&acc)[2][2][4][2], const Unit& u, int wr, int wc, int fr, int fq) const {
        const int row0 = u.pm * BM + wr * 64 + fr; int colt = u.pn * BM; bf16_t* base = O;
        float sc = 1.f; if (split_cols) { const int t = colt / split_cols; base += (size_t)t * split_stride; colt -= t * split_cols; if (t == 0) sc = scale0; }
        const int col0 = colt + wc * 32 + 8 * fq, bcol0 = u.pn * BM + wc * 32 + 8 * fq;
        f32x4 bv[2][2];
#pragma unroll
        for (int bj = 0; bj < 2; ++bj)
#pragma unroll
            for (int n = 0; n < 2; ++n) bv[bj][n] = bias ? *(const f32x4*)(bias + bcol0 + bj * HALF + 4 * n) : (f32x4){0.f, 0.f, 0.f, 0.f};
#pragma unroll
        for (int ai = 0; ai < 2; ++ai)
#pragma unroll
            for (int m = 0; m < 4; ++m) { bf16_t* rowp = base + (size_t)(row0 + ai * HALF + m * 16) * ldc + col0;
#pragma unroll
                for (int bj = 0; bj < 2; ++bj) { f32x4 v0 = acc[ai][bj][m][0] + bv[bj][0], v1 = acc[ai][bj][m][1] + bv[bj][1];
                    if (ACT == 1) { f32x2 a = gelu_pk((f32x2){v0[0], v0[1]}), b = gelu_pk((f32x2){v0[2], v0[3]}), c = gelu_pk((f32x2){v1[0], v1[1]}), d = gelu_pk((f32x2){v1[2], v1[3]});
                        v0 = (f32x4){a.x, a.y, b.x, b.y}; v1 = (f32x4){c.x, c.y, d.x, d.y}; }
                    v0 = v0 * sc; v1 = v1 * sc; u32x4 w; w.x = cvt_pk_bf16(v0[0], v0[1]); w.y = cvt_pk_bf16(v0[2], v0[3]); w.z = cvt_pk_bf16(v1[0], v1[1]); w.w = cvt_pk_bf16(v1[2], v1[3]);
                    *(u32x4*)(rowp + bj * HALF) = w; } }
    }
};
template <class Epi, class Sched, bool ALIGN_EPI = false, bool SP2 = false>
__device__ __forceinline__ void gemm_phase(PG8_LAS unsigned char* lds, const Gemm g, const Sched& S, const Epi& E) {
    const int tid = opaque_tid(), wid = __builtin_amdgcn_readfirstlane(tid >> 6), lane = tid & 63, wr = wid >> 2, wc = wid & 3, fr = lane & 15, fq = lane >> 4;
    const int K = g.K, nt = K / BK;
    unsigned voffA[2], voffB[2];
#pragma unroll
    for (int i = 0; i < 2; ++i) { int R, C; stage_rc(tid * 16 + i * 8192, R, C); const int Rb = Epi::PERM ? ((R & ~31) + perm32(R & 31)) : R;
        voffA[i] = (unsigned)(R * K + C) * 2u; voffB[i] = (unsigned)(Rb * K + C) * 2u; }
    const size_t kstep = (size_t)(BK * 2);
    const size_t hstep = (size_t)HALF * K * 2;
    const size_t tstep = 2 * hstep;
    const unsigned ldsw = (unsigned)wid * 1024u;
    const int aoff = lds_byte(wr * 64 + fr, fq * 8), boff = lds_byte(wc * 32 + fr, fq * 8);
#define PG8_SA(b, h) (((b) * 2 + (h)) * HTB)
#define PG8_SB(b, h) ((4 + (b) * 2 + (h)) * HTB)
#define PG8_STAGE(bufoff, gbase, voff) do { _Pragma("unroll") for (int _i = 0; _i < 2; ++_i) \
        __builtin_amdgcn_global_load_lds((const unsigned*)((const char*)(gbase) + (voff)[_i]), (PG8_LAS unsigned*)(lds + (bufoff) + ldsw + _i * 8192), 16, 0, 0); } while (0)
#define PG8_LDA(dst, b, h) do { _Pragma("unroll") for (int m = 0; m < 4; ++m) _Pragma("unroll") for (int k = 0; k < 2; ++k) dst[m][k] = *(const PG8_LAS bf16x8*)(lds + PG8_SA(b, h) + aoff + m * 2048 + k * 1024); } while (0)
#define PG8_LDB(dst, b, h) do { _Pragma("unroll") for (int n = 0; n < 2; ++n) _Pragma("unroll") for (int k = 0; k < 2; ++k) dst[n][k] = *(const PG8_LAS bf16x8*)(lds + PG8_SB(b, h) + boff + n * 2048 + k * 1024); } while (0)
#define PG8_MMA(ai, bj, At, Bt) do { __builtin_amdgcn_s_setprio(1); _Pragma("unroll") for (int m = 0; m < 4; ++m) _Pragma("unroll") for (int n = 0; n < 2; ++n) _Pragma("unroll") for (int k = 0; k < 2; ++k) \
        acc[ai][bj][m][n] = __builtin_amdgcn_mfma_f32_16x16x32_bf16(Bt[n][k], At[m][k], acc[ai][bj][m][n], 0, 0, 0); __builtin_amdgcn_s_setprio(0); } while (0)
#define PG8_WAIT_V(n) asm volatile("s_waitcnt vmcnt(" #n ")" ::: "memory")
#define PG8_WAIT_L(n) asm volatile("s_waitcnt lgkmcnt(" #n ")" ::: "memory")
#define PG8_BAR __builtin_amdgcn_s_barrier()
#define PG8_SCHED __builtin_amdgcn_sched_barrier(0)
    Unit cur, nxt; int ui = 0;
    if (!S.next(0, cur)) return;
    f32x4 acc[2][2][4][2];
#pragma unroll
    for (int a = 0; a < 2; ++a)
#pragma unroll
        for (int b = 0; b < 2; ++b)
#pragma unroll
            for (int m = 0; m < 4; ++m)
#pragma unroll
                for (int n = 0; n < 2; ++n) acc[a][b][m][n] = (f32x4){0.f, 0.f, 0.f, 0.f};
    bf16x8 At[4][2], B0[2][2], B1[2][2];
    const char* cA = (const char*)g.A + (size_t)cur.pm * tstep; const char* cB = (const char*)g.Bt + (size_t)cur.pn * tstep;
    S.a_ready(cur);
    if constexpr (SP2) {
        PG8_STAGE(PG8_SB(0, 0), cB, voffB); PG8_STAGE(PG8_SB(0, 1), cB + hstep, voffB); PG8_STAGE(PG8_SA(0, 0), cA, voffA); PG8_STAGE(PG8_SA(0, 1), cA + hstep, voffA);
        if (wr == 1) PG8_BAR;
        PG8_WAIT_V(2); PG8_BAR;
        PG8_STAGE(PG8_SB(1, 0), cB + kstep, voffB); PG8_STAGE(PG8_SA(1, 0), cA + kstep, voffA); PG8_STAGE(PG8_SB(1, 1), cB + hstep + kstep, voffB);
        PG8_WAIT_V(6); PG8_BAR;
    } else {
        PG8_STAGE(PG8_SB(0, 0), cB, voffB); PG8_STAGE(PG8_SA(0, 0), cA, voffA); PG8_STAGE(PG8_SB(0, 1), cB + hstep, voffB); PG8_STAGE(PG8_SA(0, 1), cA + hstep, voffA);
        if (wr == 1) PG8_BAR;
        PG8_WAIT_V(4); PG8_BAR;
        PG8_STAGE(PG8_SB(1, 0), cB + kstep, voffB); PG8_STAGE(PG8_SA(1, 0), cA + kstep, voffA); PG8_STAGE(PG8_SB(1, 1), cB + hstep + kstep, voffB);
        PG8_WAIT_V(6); PG8_BAR;
    }
    for (;;) {
        const bool has_next = S.next(ui + 1, nxt);
        const char* nA = has_next ? (const char*)g.A + (size_t)nxt.pm * tstep : cA; const char* nB = has_next ? (const char*)g.Bt + (size_t)nxt.pn * tstep : cB;
        for (int t = 0; t < nt; t += 2) {
            const bool last = (t == nt - 2);
            const char* a1 = cA + (size_t)(t + 1) * kstep;
            const char* a2 = last ? nA : cA + (size_t)(t + 2) * kstep; const char* b2 = last ? nB : cB + (size_t)(t + 2) * kstep;
            const char* a3 = a2 + kstep; const char* b3 = b2 + kstep;
            if (last && has_next) S.a_ready(nxt);
            if constexpr (SP2) {
            PG8_LDB(B0, 0, 0); PG8_LDB(B1, 0, 1); PG8_SCHED; PG8_LDA(At, 0, 0); PG8_STAGE(PG8_SA(1, 1), a1 + hstep, voffA);
            PG8_WAIT_V(8); PG8_WAIT_L(0); PG8_BAR; PG8_MMA(0, 0, At, B0); PG8_MMA(0, 1, At, B1); PG8_BAR; PG8_SCHED;
            PG8_LDA(At, 0, 1); PG8_STAGE(PG8_SB(0, 0), b2, voffB); PG8_STAGE(PG8_SB(0, 1), b2 + hstep, voffB); PG8_STAGE(PG8_SA(0, 0), a2, voffA);
            PG8_WAIT_V(8); PG8_WAIT_L(0); PG8_BAR; PG8_MMA(1, 0, At, B0); PG8_MMA(1, 1, At, B1); PG8_BAR; PG8_SCHED;
            PG8_LDB(B0, 1, 0); PG8_LDB(B1, 1, 1); PG8_SCHED; PG8_LDA(At, 1, 0); PG8_STAGE(PG8_SA(0, 1), a2 + hstep, voffA);
            PG8_WAIT_V(8); PG8_WAIT_L(0); PG8_BAR; PG8_MMA(0, 0, At, B0); PG8_MMA(0, 1, At, B1); PG8_BAR; PG8_SCHED;
            PG8_LDA(At, 1, 1); PG8_STAGE(PG8_SB(1, 0), b3, voffB); PG8_STAGE(PG8_SB(1, 1), b3 + hstep, voffB); PG8_STAGE(PG8_SA(1, 0), a3, voffA);
            PG8_WAIT_V(8); PG8_WAIT_L(0); PG8_BAR; PG8_MMA(1, 0, At, B0); PG8_MMA(1, 1, At, B1); PG8_BAR; PG8_SCHED;
            } else {
            PG8_LDB(B0, 0, 0); PG8_SCHED; PG8_LDA(At, 0, 0); PG8_STAGE(PG8_SA(1, 1), a1 + hstep, voffA);
            PG8_WAIT_L(8); PG8_BAR; PG8_WAIT_L(0); PG8_MMA(0, 0, At, B0); PG8_BAR; PG8_SCHED;
            PG8_LDB(B1, 0, 1); PG8_STAGE(PG8_SB(0, 0), b2, voffB);
            PG8_BAR; PG8_WAIT_L(0); PG8_MMA(0, 1, At, B1); PG8_BAR;
            PG8_LDA(At, 0, 1); PG8_STAGE(PG8_SA(0, 0), a2, voffA);
            PG8_BAR; PG8_WAIT_L(0); PG8_MMA(1, 0, At, B0); PG8_BAR; PG8_SCHED;
            PG8_STAGE(PG8_SB(0, 1), b2 + hstep, voffB);
            PG8_WAIT_V(6); PG8_BAR; PG8_MMA(1, 1, At, B1); PG8_BAR;
            PG8_LDB(B0, 1, 0); PG8_SCHED; PG8_LDA(At, 1, 0); PG8_STAGE(PG8_SA(0, 1), a2 + hstep, voffA);
            PG8_WAIT_L(8); PG8_BAR; PG8_WAIT_L(0); PG8_MMA(0, 0, At, B0); PG8_BAR; PG8_SCHED;
            PG8_LDB(B1, 1, 1); PG8_STAGE(PG8_SB(1, 0), b3, voffB);
            PG8_BAR; PG8_WAIT_L(0); PG8_MMA(0, 1, At, B1); PG8_BAR;
            PG8_LDA(At, 1, 1); PG8_STAGE(PG8_SA(1, 0), a3, voffA);
            PG8_BAR; PG8_WAIT_L(0); PG8_MMA(1, 0, At, B0); PG8_BAR; PG8_SCHED;
            PG8_STAGE(PG8_SB(1, 1), b3 + hstep, voffB);
            PG8_WAIT_V(6); PG8_BAR; PG8_MMA(1, 1, At, B1); PG8_BAR;
            }
        }
        if constexpr (ALIGN_EPI) { if (wr == 0) PG8_BAR; }
        if constexpr (!Epi::AFTER_DRAIN) { E(acc, cur, wr, wc, fr, fq); S.done(cur); }
        if (!has_next) break;
#pragma unroll
        for (int a = 0; a < 2; ++a)
#pragma unroll
            for (int b = 0; b < 2; ++b)
#pragma unroll
                for (int m = 0; m < 4; ++m)
#pragma unroll
                    for (int n = 0; n < 2; ++n) acc[a][b][m][n] = (f32x4){0.f, 0.f, 0.f, 0.f};
        cur = nxt; cA = nA; cB = nB; ++ui;
        if constexpr (ALIGN_EPI) { if (wr == 1) PG8_BAR; }
    }
    PG8_WAIT_V(0);
    if constexpr (!ALIGN_EPI) { if (wr == 0) PG8_BAR; }
    PG8_BAR;
    if constexpr (Epi::AFTER_DRAIN) { E.fused(acc, cur, wr, wc, fr, fq, lds, wid, lane); S.done(cur); }
#undef PG8_SA
#undef PG8_SB
#undef PG8_STAGE
#undef PG8_LDA
#undef PG8_LDB
#undef PG8_MMA
#undef PG8_WAIT_V
#undef PG8_WAIT_L
#undef PG8_BAR
#undef PG8_SCHED
}
}
#ifndef PG8_SP2
#define PG8_SP2 true
#endif
#ifndef PG8_ALIGN
#define PG8_ALIGN true
#endif
#ifndef MK_N_LAUNCHES
#define MK_N_LAUNCHES 1
#endif

constexpr int NB = 8, SEQ = 4096, D = 1024, T = NB * SEQ, NPROJ = 4096, DMIX = 2048;
constexpr int NPH = 10;
constexpr float EPS = 1e-6f;
constexpr size_t MiB = 1u << 20;
constexpr size_t WS_WIN = 0, WS_WOUT = 16 * MiB, WS_GW = 24 * MiB, WS_PW = 25 * MiB, WS_MOD = 26 * MiB;
constexpr size_t WS_H = 32 * MiB, WS_YCAT = 96 * MiB, WS_PROJ = 224 * MiB, WS_Y = WS_PROJ, WS_U = WS_H, WS_END = 480 * MiB;
constexpr size_t WS_CTL = 28 * MiB, CTL_BYTES = 16384;
constexpr int LDS_BYTES = 147456, LDS_BST_OFF = 131072 + 64;

#define LAS __attribute__((address_space(3)))
typedef unsigned short bf16;
typedef float f32x4 __attribute__((ext_vector_type(4)));
typedef float f32x2 __attribute__((ext_vector_type(2)));
typedef unsigned u32x4 __attribute__((ext_vector_type(4)));
typedef unsigned u32x2 __attribute__((ext_vector_type(2)));
typedef short bf16x8 __attribute__((ext_vector_type(8)));

struct Args { const float* in[18]; float* out; unsigned char* ws; int ph_lo, ph_hi; };

__device__ __forceinline__ unsigned pk2(float lo, float hi) { return pg8::cvt_pk_bf16(lo, hi); }
__device__ __forceinline__ float bflo(unsigned w) { return u2f(w << 16); }
__device__ __forceinline__ float bfhi(unsigned w) { return u2f(w & 0xffff0000u); }
__device__ __forceinline__ float wave_sum(float v) {
#pragma unroll
    for (int o = 1; o < 64; o <<= 1) v += shfl_xor_(v, o);
    return v;
}
__device__ __forceinline__ float sigmoidf_(float x) { return 1.0f / (1.0f + __expf(-x)); }
__device__ __forceinline__ float siluf_(float x) { return x / (1.0f + __expf(-x)); }

__device__ __forceinline__ void transpose_tile(const float* W, int K, int N, bf16* WT, LAS float* scr, int k0, int n0, int drow, int lane) {
    {
        f32x4 v[8];
#pragma unroll
        for (int i = 0; i < 8; ++i) v[i] = *(const f32x4*)(W + (size_t)(k0 + (lane >> 3) + 8 * i) * N + n0 + (lane & 7) * 4);
#pragma unroll
        for (int i = 0; i < 8; ++i) { LAS float* d = scr + ((lane >> 3) + 8 * i) * 33 + (lane & 7) * 4; d[0] = v[i].x; d[1] = v[i].y; d[2] = v[i].z; d[3] = v[i].w; }
    }
    asm volatile("s_waitcnt lgkmcnt(0)" ::: "memory");
    const int c = lane & 7;
#pragma unroll
    for (int j = 0; j < 4; ++j) { const int n = (lane >> 3) + 8 * j; const LAS float* s = scr + (8 * c) * 33 + n;
        u32x4 o; o.x = pk2(s[0 * 33], s[1 * 33]); o.y = pk2(s[2 * 33], s[3 * 33]); o.z = pk2(s[4 * 33], s[5 * 33]); o.w = pk2(s[6 * 33], s[7 * 33]);
        *(u32x4*)(WT + (size_t)(drow + n) * K + k0 + 8 * c) = o; }
    asm volatile("s_waitcnt lgkmcnt(0)" ::: "memory");
}
__device__ __forceinline__ void transpose_item(const float* W, int K, int N, bf16* WT, LAS float* scr, int item, int lane) {
    const int nblk = N / 32, kb = item / nblk, nb = item % nblk;
    transpose_tile(W, K, N, WT, scr, 64 * kb, 32 * nb, 32 * nb, lane);
}

__device__ __forceinline__ void phase_prep(const Args& a, LAS unsigned char* lds) {
    const int tid = opaque_tid(), lane = tid & 63, wv = tid >> 6;
    const int G = gridDim.x;
    unsigned char* ws = a.ws;
    {
        LAS float* sc = (LAS float*)lds;
        LAS float* red = (LAS float*)(lds + 32768);
        const float* c = a.in[1]; const float* ada_w = a.in[2]; const float* ada_b = a.in[3];
        float* MOD = (float*)(ws + WS_MOD);
        if ((int)blockIdx.x < 192) {
            for (int i = tid; i < 8192; i += 512) sc[i] = siluf_(c[i]);
            sync_threads_();
            for (int unit = blockIdx.x; unit < 192; unit += G) {
                const int l = unit / 96, cb = (unit % 96) * 32, cl = tid & 31, ks = tid >> 5;
                const float* wp = ada_w + (size_t)l * 1024 * 3072 + (size_t)(ks * 64) * 3072 + cb + cl;
                float acc[8];
#pragma unroll
                for (int b = 0; b < 8; ++b) acc[b] = 0.f;
#pragma unroll 16
                for (int k = 0; k < 64; ++k) { const float w = wp[(size_t)k * 3072];
#pragma unroll
                    for (int b = 0; b < 8; ++b) acc[b] += sc[b * 1024 + ks * 64 + k] * w; }
#pragma unroll
                for (int b = 0; b < 8; ++b) red[(ks * 8 + b) * 32 + cl] = acc[b];
                sync_threads_();
                if (tid < 256) { const int b = tid >> 5; float s = 0.f;
#pragma unroll
                    for (int k2 = 0; k2 < 16; ++k2) s += red[(k2 * 8 + b) * 32 + cl];
                    MOD[(l * 8 + b) * 3072 + cb + cl] = s + ada_b[l * 3072 + cb + cl]; }
                sync_threads_();
            }
        }
        sync_threads_();
    }
    {
        LAS float* scr = (LAS float*)(lds + wv * 16384);
        const int gw = blockIdx.x * 8 + wv, NGW = G * 8;
        constexpr int I_IN = (1024 / 64) * (4096 / 32), I_OUT = (2048 / 64) * (1024 / 32);
        for (int it = gw; it < 2 * (I_IN + I_OUT); it += NGW) {
            int r = it;
            if (r < 2 * I_IN) { const int l = r / I_IN; r -= l * I_IN;
                transpose_item(a.in[5] + (size_t)l * 1024 * 4096, 1024, 4096, (bf16*)(ws + WS_WIN) + (size_t)l * 4096 * 1024, scr, r, lane); }
            else { r -= 2 * I_IN; const int l = r / I_OUT; r -= l * I_OUT;
                transpose_item(a.in[16] + (size_t)l * 2048 * 1024, 2048, 1024, (bf16*)(ws + WS_WOUT) + (size_t)l * 1024 * 2048, scr, r, lane); }
        }
    }
    {
        LAS float* scr = (LAS float*)(lds + wv * 16384);
        const int gw = blockIdx.x * 8 + wv, NGW = G * 8;
        bf16* GWp = (bf16*)(ws + WS_GW); bf16* PWp = (bf16*)(ws + WS_PW);
        for (int it = NGW - 1 - gw; it < 512; it += NGW) {
            if (it < 256) { const int lh = it >> 4, r = it & 15, gate = r >> 3, kb = (r >> 2) & 1, q = r & 3;
                transpose_tile((gate ? a.in[10] : a.in[8]) + (size_t)lh * 128 * 128, 128, 128, GWp + (size_t)lh * 4 * 64 * 128, scr, 64 * kb, 32 * q, q * 64 + gate * 32, lane); }
            else { const int r = it - 256, lg = r >> 5, kb = (r >> 3) & 3, nb = r & 7;
                transpose_tile(a.in[13] + (size_t)lg * 256 * 256, 256, 256, PWp + (size_t)lg * 256 * 256, scr, 64 * kb, 32 * nb, 32 * nb, lane); }
        }
    }
}

constexpr int RPW = 4;
__device__ __forceinline__ void phase_h0(const Args& a) {
    const int tid = opaque_tid(), lane = tid & 63, wv = tid >> 6;
    const int gw = blockIdx.x * 8 + wv, NGW = gridDim.x * 8;
    const float* x = a.in[0]; const float* g = a.in[4]; const float* MOD = (const float*)(a.ws + WS_MOD);
    bf16* H = (bf16*)(a.ws + WS_H);
    for (int m0 = gw * RPW; m0 < T; m0 += NGW * RPW) {
        f32x4 v[RPW][4];
#pragma unroll
        for (int r = 0; r < RPW; ++r) { const f32x4* xr = (const f32x4*)(x + (size_t)(m0 + r) * D) + lane;
#pragma unroll
            for (int j = 0; j < 4; ++j) v[r][j] = __builtin_nontemporal_load(xr + 64 * j); }
        const int b = m0 >> 12;
        const float* sh = MOD + (size_t)b * 3072; const float* scl = sh + 1024;
#pragma unroll
        for (int r = 0; r < RPW; ++r) {
            float ss = 0.f;
#pragma unroll
            for (int j = 0; j < 4; ++j) ss += (v[r][j].x * v[r][j].x + v[r][j].y * v[r][j].y) + (v[r][j].z * v[r][j].z + v[r][j].w * v[r][j].w);
            const float rstd = 1.0f / __builtin_sqrtf(wave_sum(ss) * (1.0f / D) + EPS);
            u32x2* o = (u32x2*)(H + (size_t)(m0 + r) * D) + lane;
#pragma unroll
            for (int j = 0; j < 4; ++j) { const int col = 4 * lane + 256 * j;
                const f32x4 gg = *(const f32x4*)(g + col), s4 = *(const f32x4*)(scl + col), h4 = *(const f32x4*)(sh + col);
                const f32x4 rr = v[r][j] * rstd * gg * (s4 + 1.0f) + h4;
                u32x2 w; w.x = pk2(rr.x, rr.y); w.y = pk2(rr.z, rr.w); o[64 * j] = w; }
        }
    }
}

__device__ __forceinline__ void phase_post(const Args& a, int l) {
    const int tid = opaque_tid(), lane = tid & 63, wv = tid >> 6;
    const int gw = blockIdx.x * 8 + wv, NGW = gridDim.x * 8;
    const float* xin = (l == 0) ? a.in[0] : a.out; float* out = a.out;
    const bf16* Y = (const bf16*)(a.ws + WS_Y); bf16* H = (bf16*)(a.ws + WS_H);
    const float* MOD = (const float*)(a.ws + WS_MOD);
    const float* gpost = a.in[17] + l * D; const float* gpre = a.in[4] + (l + 1) * D;
    for (int m0 = gw * RPW; m0 < T; m0 += NGW * RPW) {
        f32x4 xv[RPW][4]; u32x2 yw[RPW][4];
#pragma unroll
        for (int r = 0; r < RPW; ++r) { const f32x4* xr = (const f32x4*)(xin + (size_t)(m0 + r) * D) + lane; const u32x2* yr = (const u32x2*)(Y + (size_t)(m0 + r) * D) + lane;
#pragma unroll
            for (int j = 0; j < 4; ++j) { xv[r][j] = xr[64 * j]; yw[r][j] = yr[64 * j]; } }
        const int b = m0 >> 12;
        const float* gate = MOD + (size_t)(l * 8 + b) * 3072 + 2048;
        const float* sh = MOD + (size_t)(8 + b) * 3072; const float* scl = sh + 1024;
#pragma unroll
        for (int r = 0; r < RPW; ++r) {
            f32x4 yv[4]; float ss = 0.f;
#pragma unroll
            for (int j = 0; j < 4; ++j) { const u32x2 w = yw[r][j]; yv[j] = (f32x4){bflo(w.x), bfhi(w.x), bflo(w.y), bfhi(w.y)};
                ss += (yv[j].x * yv[j].x + yv[j].y * yv[j].y) + (yv[j].z * yv[j].z + yv[j].w * yv[j].w); }
            const float rstd = 1.0f / __builtin_sqrtf(wave_sum(ss) * (1.0f / D) + EPS);
            float ss2 = 0.f;
#pragma unroll
            for (int j = 0; j < 4; ++j) { const int col = 4 * lane + 256 * j;
                const f32x4 gp = *(const f32x4*)(gpost + col), gt = *(const f32x4*)(gate + col);
                const f32x4 xn = xv[r][j] + gt * (yv[j] * rstd * gp);
                xv[r][j] = xn;
                if (l == 0) *((f32x4*)(out + (size_t)(m0 + r) * D + col)) = xn;
                else __builtin_nontemporal_store(xn, (f32x4*)(out + (size_t)(m0 + r) * D + col));
                ss2 += (xn.x * xn.x + xn.y * xn.y) + (xn.z * xn.z + xn.w * xn.w); }
            if (l == 0) {
                const float rstd2 = 1.0f / __builtin_sqrtf(wave_sum(ss2) * (1.0f / D) + EPS);
                u32x2* o = (u32x2*)(H + (size_t)(m0 + r) * D) + lane;
#pragma unroll
                for (int j = 0; j < 4; ++j) { const int col = 4 * lane + 256 * j;
                    const f32x4 gg = *(const f32x4*)(gpre + col), s4 = *(const f32x4*)(scl + col), h4 = *(const f32x4*)(sh + col);
                    const f32x4 rr = xv[r][j] * rstd2 * gg * (s4 + 1.0f) + h4;
                    u32x2 w; w.x = pk2(rr.x, rr.y); w.y = pk2(rr.z, rr.w); o[64 * j] = w; }
            }
        }
    }
}
#define XB_TMO      128
#define XB_XCNT(j)  (256  + 64 * (j))
#define XB_XSUB(j)  (1280 + 64 * (j))
#define XB_XGEN(j)  (2304 + 64 * (j))
#define XB_TOP      3328
#define XB_TOPGEN   3392
#define XCD_BAR_WORDS 3456
#define XB_SPIN_CAP (1u << 18)

__device__ __forceinline__ unsigned xb_ld(unsigned* p)              { return __hip_atomic_load(p, __ATOMIC_RELAXED, __HIP_MEMORY_SCOPE_AGENT); }
__device__ __forceinline__ unsigned xb_add(unsigned* p, unsigned v) { return __hip_atomic_fetch_add(p, v, __ATOMIC_RELAXED, __HIP_MEMORY_SCOPE_AGENT); }
__device__ __forceinline__ unsigned xb_xcc_id() { return (unsigned)__builtin_amdgcn_s_getreg((3 << 11) | 20) & 0xFu; }
#define XB_SPIN(cond, bar) do { unsigned _sp = 0; while (cond) { __builtin_amdgcn_s_sleep(1); \
    if ((++_sp & 255u) == 0u) { if (xb_ld(&(bar)[XB_TMO])) break; if (_sp > XB_SPIN_CAP) { xb_add(&(bar)[XB_TMO], 1u); break; } } } } while (0)

struct XcdBarrier {
    unsigned* bar; unsigned x;
    volatile LAS unsigned* st;
};

__device__ __forceinline__ XcdBarrier xcd_barrier_post(unsigned* bar, volatile LAS unsigned* st) {
    XcdBarrier b; b.bar = bar; b.x = xb_xcc_id(); b.st = st;
    if (threadIdx.x == 0) (void)xb_add(&bar[XB_XCNT(b.x)], 1u);
    return b;
}
__device__ __forceinline__ void xcd_barrier_complete(unsigned* bar, unsigned x, unsigned& nloc, unsigned& nx) {
    const unsigned G = gridDim.x * gridDim.y * gridDim.z;
    unsigned sum, cnt, mine, sp = 0u;
    for (;;) {
        sum = 0u; cnt = 0u; mine = 0u;
#pragma unroll
        for (unsigned j = 0; j < 16; ++j) { const unsigned c = xb_ld(&bar[XB_XCNT(j)]); sum += c; cnt += (c > 0u) ? 1u : 0u; mine = (j == x) ? c : mine; }
        if (sum == G) break;
        __builtin_amdgcn_s_sleep(1);
        if ((++sp & 255u) == 0u) { if (xb_ld(&bar[XB_TMO])) break; if (sp > XB_SPIN_CAP) { xb_add(&bar[XB_TMO], 1u); break; } }
    }
    nloc = mine > 0u ? mine : 1u; nx = cnt > 0u ? cnt : 1u;
}

__device__ __forceinline__ void xcd_barrier(const XcdBarrier& b) {
    asm volatile("s_waitcnt vmcnt(0)" ::: "memory");
    sync_threads_();
    if (threadIdx.x == 0) {
        unsigned* bar = b.bar;
        __builtin_amdgcn_s_waitcnt(0);
        unsigned nloc = b.st[0], nx = b.st[1];
        if (nloc == 0u) { xcd_barrier_complete(bar, b.x, nloc, nx); b.st[0] = nloc; b.st[1] = nx; }
        const unsigned old = xb_add(&bar[XB_XSUB(b.x)], 1u);
        const unsigned gen = old / nloc;
        if (old + 1u == (gen + 1u) * nloc) {
            __builtin_amdgcn_fence(__ATOMIC_RELEASE, "agent");
            asm volatile("s_waitcnt vmcnt(0)" ::: "memory");
            const unsigned og = xb_add(&bar[XB_TOP], 1u);
            const unsigned tg = og / nx;
            if (og + 1u == (tg + 1u) * nx) xb_add(&bar[XB_TOPGEN], 1u);
            else XB_SPIN(xb_ld(&bar[XB_TOPGEN]) == tg, bar);
            __builtin_amdgcn_fence(__ATOMIC_ACQUIRE, "agent");
            xb_add(&bar[XB_XGEN(b.x)], 1u);
            asm volatile("s_waitcnt vmcnt(0)" ::: "memory");
        } else {
            XB_SPIN(xb_ld(&bar[XB_XGEN(b.x)]) == gen, bar);
            __builtin_amdgcn_fence(__ATOMIC_ACQUIRE, "agent");
            asm volatile("s_waitcnt vmcnt(0)" ::: "memory");
        }
    }
    sync_threads_();
}

#define LDS_BARRIER() do { asm volatile("s_waitcnt lgkmcnt(0)" ::: "memory"); __builtin_amdgcn_s_barrier(); asm volatile("" ::: "memory"); } while (0)
constexpr int XROW = 272;
constexpr int CROW = 132;
constexpr int R_XT = 0, R_UT = 35840, R_AT = 70656, R_VT = 87552, R_EP = 104448, R_CWT = 105472, R_GT = 108032, R_YT = 116736;
template <int D> __device__ __forceinline__ float dpp_row_shr(float old, float src) {
    return i2f(__builtin_amdgcn_update_dpp(f2i(old), f2i(src), 0x110 | D, 0xf, 0xf, false)); }
__device__ __forceinline__ float softplus_small_(float e) { return (e < 0.03f) ? e * (1.0f + e * (-0.5f + e * (0.33333334f + e * (-0.25f + e * 0.2f)))) : __builtin_logf(1.0f + e); }
__device__ __forceinline__ float fast_sigmoid(float x) { return __builtin_amdgcn_rcpf(1.0f + __builtin_amdgcn_exp2f(-1.4426950408889634f * x)); }
__device__ __forceinline__ void rnn_unit(const Args& a, int l, int u, LAS unsigned char* lds) {
    const int tid = opaque_tid(), lane = tid & 63, wv = tid >> 6, fr = lane & 15, fq = lane >> 4;
    const int xcd = u & 7, jj = u >> 3, q = jj & 3, bh = (jj >> 2) * 8 + xcd, b = bh >> 3, h = bh & 7;
    const bf16* PROJ = (const bf16*)(a.ws + WS_PROJ); bf16* YCAT = (bf16*)(a.ws + WS_YCAT);
    const bf16* xr_base = PROJ + (size_t)(b * SEQ) * NPROJ + h * 128;
    const bf16* gr_base = PROJ + (size_t)(b * SEQ) * NPROJ + 1024 + h * 128 + q * 32;
    bf16* y_base = YCAT + (size_t)(b * SEQ) * DMIX + h * 128 + q * 32;
    LAS unsigned char* XT = lds + R_XT; LAS unsigned char* UT = lds + R_UT;
    LAS float* AT = (LAS float*)(lds + R_AT); LAS float* VT = (LAS float*)(lds + R_VT);
    LAS unsigned char* GT = lds + R_GT; LAS unsigned char* YT = lds + R_YT;
    const int io_tk = tid >> 2, io_cq = tid & 3;
    const int ck = tid & 15, tg = tid >> 4;
    LAS float* CWT = (LAS float*)(lds + R_CWT);
    for (int i = tid; i < 640; i += 512) { const int r = i >> 7, c = i & 127;
        CWT[i] = (r < 4) ? a.in[6][(size_t)l * 4 * 1024 + r * 1024 + h * 128 + c] : a.in[7][(size_t)l * 1024 + h * 128 + c]; }
    bf16x8 Wf[4][4];
    {
        const bf16* gwp = (const bf16*)(a.ws + WS_GW) + (size_t)((l * 8 + h) * 4 + q) * 64 * 128;
#pragma unroll
        for (int nb = 0; nb < 4; ++nb)
#pragma unroll
            for (int kb = 0; kb < 4; ++kb) Wf[nb][kb] = *(const bf16x8*)(gwp + (nb * 16 + fr) * 128 + kb * 32 + fq * 8);
    }
    LAS float* EP = (LAS float*)(lds + R_EP);
    if (tid < 96) {
        const int r = tid >> 5, c = tid & 31, ch = h * 128 + q * 32 + c; float v;
        if (r == 0) v = a.in[9][l * 1024 + ch];
        else if (r == 1) v = a.in[11][l * 1024 + ch];
        else v = 8.0f * 1.4426950408889634f * softplus_small_(__builtin_expf(-a.in[12][l * 1024 + ch]));
        EP[r * 32 + c] = v;
    }
    u32x4 pf[4], pfh = (u32x4){0u, 0u, 0u, 0u};
#pragma unroll
    for (int i = 0; i < 4; ++i) { const int id = tid + 512 * i, row = id >> 4, cc = id & 15; pf[i] = *(const u32x4*)(xr_base + (size_t)row * NPROJ + cc * 8); }
    u32x4 gpf = *(const u32x4*)(gr_base + (size_t)io_tk * NPROJ + io_cq * 8);
    const int sc_ci = lane >> 4, sc_sg = lane & 15, sc_c = wv * 4 + sc_ci;
    float hcar = 0.f;
#pragma unroll
    for (int i = 0; i < 4; ++i) { const int id = tid + 512 * i, row = id >> 4, cc = id & 15; *(LAS u32x4*)(XT + (3 + row) * XROW + cc * 16) = pf[i]; }
    if (tid < 48) *(LAS u32x4*)(XT + (tid >> 4) * XROW + (tid & 15) * 16) = pfh;
    for (int tile = 0; tile < SEQ / 128; ++tile) {
        const int t0 = tile * 128;
        LDS_BARRIER();
        {
            const int t0n = (tile + 1 < SEQ / 128) ? t0 + 128 : t0;
#pragma unroll
            for (int i = 0; i < 4; ++i) { const int id = tid + 512 * i, row = id >> 4, cc = id & 15; pf[i] = *(const u32x4*)(xr_base + (size_t)(t0n + row) * NPROJ + cc * 8); }
            if (tid < 48) pfh = *(const u32x4*)(xr_base + (size_t)(t0n - 3 + (tid >> 4)) * NPROJ + (tid & 15) * 8);
        }
        {
            if (tile > 0) {
                unsigned short yv_[8];
#pragma unroll
                for (int e = 0; e < 8; ++e) yv_[e] = *(const LAS unsigned short*)(YT + (io_cq * 8 + e) * XROW + io_tk * 2);
                u32x4 w; w.x = yv_[0] | ((unsigned)yv_[1] << 16); w.y = yv_[2] | ((unsigned)yv_[3] << 16); w.z = yv_[4] | ((unsigned)yv_[5] << 16); w.w = yv_[6] | ((unsigned)yv_[7] << 16);
                *(u32x4*)(y_base + (size_t)(t0 - 128 + io_tk) * DMIX + io_cq * 8) = w;
            }
            const unsigned gwv[4] = {gpf.x, gpf.y, gpf.z, gpf.w};
#pragma unroll
            for (int e2 = 0; e2 < 4; ++e2) { *(LAS unsigned short*)(GT + (io_cq * 8 + 2 * e2) * XROW + io_tk * 2) = (unsigned short)(gwv[e2] & 0xffffu);
                *(LAS unsigned short*)(GT + (io_cq * 8 + 2 * e2 + 1) * XROW + io_tk * 2) = (unsigned short)(gwv[e2] >> 16); }
            const int t1 = (tile + 1 < SEQ / 128) ? t0 + 128 : t0;
            gpf = *(const u32x4*)(gr_base + (size_t)(t1 + io_tk) * NPROJ + io_cq * 8);
        }
        {
            f32x2 o[4][4], cw[4][4];
            {
                const f32x4 b0 = *(const LAS f32x4*)(CWT + 4 * 128 + ck * 8), b1 = *(const LAS f32x4*)(CWT + 4 * 128 + ck * 8 + 4);
#pragma unroll
                for (int i = 0; i < 4; ++i) { o[i][0] = (f32x2){b0.x, b0.y}; o[i][1] = (f32x2){b0.z, b0.w}; o[i][2] = (f32x2){b1.x, b1.y}; o[i][3] = (f32x2){b1.z, b1.w}; }
            }
#pragma unroll
            for (int k = 0; k < 4; ++k) { const f32x4 w0 = *(const LAS f32x4*)(CWT + k * 128 + ck * 8), w1 = *(const LAS f32x4*)(CWT + k * 128 + ck * 8 + 4);
                cw[k][0] = (f32x2){w0.x, w0.y}; cw[k][1] = (f32x2){w0.z, w0.w}; cw[k][2] = (f32x2){w1.x, w1.y}; cw[k][3] = (f32x2){w1.z, w1.w}; }
#pragma unroll
            for (int r = 0; r < 7; ++r) {
                const u32x4 w = *(const LAS u32x4*)(XT + (tg * 4 + r) * XROW + ck * 16);
                const f32x2 xv[4] = {(f32x2){bflo(w.x), bfhi(w.x)}, (f32x2){bflo(w.y), bfhi(w.y)}, (f32x2){bflo(w.z), bfhi(w.z)}, (f32x2){bflo(w.w), bfhi(w.w)}};
#pragma unroll
                for (int i = 0; i < 4; ++i) { const int k = r - i; if (k >= 0 && k < 4) {
#pragma unroll
                    for (int e = 0; e < 4; ++e) o[i][e] = __builtin_elementwise_fma(cw[k][e], xv[e], o[i][e]); } }
            }
#pragma unroll
            for (int i = 0; i < 4; ++i) { u32x4 w; w.x = pk2(o[i][0].x, o[i][0].y); w.y = pk2(o[i][1].x, o[i][1].y); w.z = pk2(o[i][2].x, o[i][2].y); w.w = pk2(o[i][3].x, o[i][3].y);
                *(LAS u32x4*)(UT + (tg * 4 + i) * XROW + ck * 16) = w; }
        }
        asm volatile("s_waitcnt lgkmcnt(0)" ::: "memory");
        {
            f32x4 acc[4];
#pragma unroll
            for (int nb = 0; nb < 4; ++nb) acc[nb] = (f32x4){0.f, 0.f, 0.f, 0.f};
#pragma unroll
            for (int kb = 0; kb < 4; ++kb) { const bf16x8 uf = *(const LAS bf16x8*)(UT + (wv * 16 + fr) * XROW + kb * 64 + fq * 16);
#pragma unroll
                for (int nb = 0; nb < 4; ++nb) acc[nb] = __builtin_amdgcn_mfma_f32_16x16x32_bf16(Wf[nb][kb], uf, acc[nb], 0, 0, 0); }
            const int tk = wv * 16 + fr;
#pragma unroll
            for (int nb2 = 0; nb2 < 2; ++nb2) {
                const int c0 = nb2 * 16 + 4 * fq;
                const u32x2 uw = *(const LAS u32x2*)(UT + tk * XROW + (q * 32 + c0) * 2);
                const f32x4 uu = (f32x4){bflo(uw.x), bfhi(uw.x), bflo(uw.y), bfhi(uw.y)};
                const f32x4 ra = acc[nb2] + *(const LAS f32x4*)(EP + c0), rx = acc[nb2 + 2] + *(const LAS f32x4*)(EP + 32 + c0), sp8 = *(const LAS f32x4*)(EP + 64 + c0);
#pragma unroll
                for (int e = 0; e < 4; ++e) { const float r = fast_sigmoid(ra[e]), ig = fast_sigmoid(rx[e]);
                    const float av = __builtin_amdgcn_exp2f(-r * sp8[e]);
                    const float m2 = __builtin_fmaxf(__builtin_fmaf(-av, av, 1.0f), 0.f);
                    AT[(c0 + e) * CROW + tk] = av; VT[(c0 + e) * CROW + tk] = __builtin_amdgcn_sqrtf(m2) * (ig * uu[e]); }
            }
        }
        LDS_BARRIER();
        {
            const f32x4 a0 = *(const LAS f32x4*)(AT + sc_c * CROW + sc_sg * 8), a1 = *(const LAS f32x4*)(AT + sc_c * CROW + sc_sg * 8 + 4);
            const f32x4 v0 = *(const LAS f32x4*)(VT + sc_c * CROW + sc_sg * 8), v1 = *(const LAS f32x4*)(VT + sc_c * CROW + sc_sg * 8 + 4);
            const float av[8] = {a0.x, a0.y, a0.z, a0.w, a1.x, a1.y, a1.z, a1.w}, vv[8] = {v0.x, v0.y, v0.z, v0.w, v1.x, v1.y, v1.z, v1.w};
            float hl[8], pp[8]; float hcur = 0.f, pcur = 1.f;
#pragma unroll
            for (int j = 0; j < 8; ++j) { hcur = __builtin_fmaf(av[j], hcur, vv[j]); pcur *= av[j]; hl[j] = hcur; pp[j] = pcur; }
            float P = pcur, H = hcur;
            { float Pp = dpp_row_shr<1>(1.f, P), Hp = dpp_row_shr<1>(0.f, H); H = __builtin_fmaf(P, Hp, H); P *= Pp;
              Pp = dpp_row_shr<2>(1.f, P); Hp = dpp_row_shr<2>(0.f, H); H = __builtin_fmaf(P, Hp, H); P *= Pp;
              Pp = dpp_row_shr<4>(1.f, P); Hp = dpp_row_shr<4>(0.f, H); H = __builtin_fmaf(P, Hp, H); P *= Pp;
              Pp = dpp_row_shr<8>(1.f, P); Hp = dpp_row_shr<8>(0.f, H); H = __builtin_fmaf(P, Hp, H); P *= Pp; }
            const float Pe = dpp_row_shr<1>(1.f, P), He = dpp_row_shr<1>(0.f, H);
            const float carry = __builtin_fmaf(Pe, hcar, He);
            const float hend = __builtin_fmaf(P, hcar, H);
            hcar = row_last_(hend);
            const u32x4 gq = *(const LAS u32x4*)(GT + sc_c * XROW + sc_sg * 16);
            const float gvv[8] = {bflo(gq.x), bfhi(gq.x), bflo(gq.y), bfhi(gq.y), bflo(gq.z), bfhi(gq.z), bflo(gq.w), bfhi(gq.w)};
            float yy[8];
#pragma unroll
            for (int j = 0; j < 8; ++j) { const float hv = __builtin_fmaf(pp[j], carry, hl[j]); yy[j] = hv * gvv[j] * fast_sigmoid(gvv[j]); }
            u32x4 yw_; yw_.x = pk2(yy[0], yy[1]); yw_.y = pk2(yy[2], yy[3]); yw_.z = pk2(yy[4], yy[5]); yw_.w = pk2(yy[6], yy[7]);
            *(LAS u32x4*)(YT + sc_c * XROW + sc_sg * 16) = yw_;
        }
#pragma unroll
        for (int i = 0; i < 4; ++i) { const int id = tid + 512 * i, row = id >> 4, cc = id & 15; *(LAS u32x4*)(XT + (3 + row) * XROW + cc * 16) = pf[i]; }
        if (tid < 48) *(LAS u32x4*)(XT + (tid >> 4) * XROW + (tid & 15) * 16) = pfh;
    }
    LDS_BARRIER();
    {
        unsigned short yv_[8];
#pragma unroll
        for (int e = 0; e < 8; ++e) yv_[e] = *(const LAS unsigned short*)(YT + (io_cq * 8 + e) * XROW + io_tk * 2);
        u32x4 w; w.x = yv_[0] | ((unsigned)yv_[1] << 16); w.y = yv_[2] | ((unsigned)yv_[3] << 16); w.z = yv_[4] | ((unsigned)yv_[5] << 16); w.w = yv_[6] | ((unsigned)yv_[7] << 16);
        *(u32x4*)(y_base + (size_t)(SEQ - 128 + io_tk) * DMIX + io_cq * 8) = w;
    }
    LDS_BARRIER();
}

constexpr int PROW = 528;
constexpr int R_XP = 0, R_PT = 42240;
__device__ __forceinline__ void pool_units(const Args& a, int l, int u, LAS unsigned char* lds) {
    const int tid = opaque_tid(), lane = tid & 63, wv = tid >> 6, fr = lane & 15, fq = lane >> 4;
    const int g = u & 3, bi = u >> 2, win = 2 << g;
    const bf16* PROJ = (const bf16*)(a.ws + WS_PROJ); bf16* YCAT = (bf16*)(a.ws + WS_YCAT);
    LAS unsigned char* XP = lds + R_XP; LAS unsigned char* PT = lds + R_PT;
    const bf16* pw = (const bf16*)(a.ws + WS_PW) + (size_t)(l * 4 + g) * 256 * 256;
    bf16x8 Wf[2][8];
#pragma unroll
    for (int nb = 0; nb < 2; ++nb)
#pragma unroll
        for (int kb = 0; kb < 8; ++kb) Wf[nb][kb] = *(const bf16x8*)(pw + (size_t)(wv * 32 + nb * 16 + fr) * 256 + kb * 32 + fq * 8);
    f32x4 pb[2], ps[2];
#pragma unroll
    for (int nb = 0; nb < 2; ++nb) { const int n = wv * 32 + nb * 16 + 4 * fq;
        pb[nb] = *(const f32x4*)(a.in[14] + (size_t)l * 1024 + g * 256 + n); ps[nb] = *(const f32x4*)(a.in[15] + (size_t)l * 1024 + g * 256 + n); }
    const int ck = tid & 31, tg = tid >> 5;
    u32x4 pf[5];
    {
        const int tile = bi * 8, b = tile >> 6, t0 = (tile & 63) * 64;
        const bf16* xp_base = PROJ + (size_t)(b * SEQ) * NPROJ + 2048 + g * 256;
#pragma unroll
        for (int i = 0; i < 5; ++i) { const int id = tid + 512 * i, row = id >> 5, cc = id & 31, t = t0 - 16 + row;
            const u32x4 v = *(const u32x4*)(xp_base + (size_t)(t < 0 ? 0 : t) * NPROJ + cc * 8); pf[i] = (t < 0) ? (u32x4){0u, 0u, 0u, 0u} : v; }
    }
#pragma unroll
    for (int i = 0; i < 5; ++i) { const int id = tid + 512 * i, row = id >> 5, cc = id & 31; *(LAS u32x4*)(XP + row * PROW + cc * 16) = pf[i]; }
    u32x2 gp[4][2];
    {
        const int tile = bi * 8, b = tile >> 6, t0 = (tile & 63) * 64;
        const bf16* gp_base0 = PROJ + (size_t)(b * SEQ) * NPROJ + 3072 + g * 256;
#pragma unroll
        for (int tb = 0; tb < 4; ++tb)
#pragma unroll
            for (int nb = 0; nb < 2; ++nb) { gp[tb][nb] = *(const u32x2*)(gp_base0 + (size_t)(t0 + tb * 16 + fr) * NPROJ + wv * 32 + nb * 16 + 4 * fq);
                asm volatile("" : "+v"(gp[tb][nb])); }
    }
    for (int it = 0; it < 8; ++it) {
        const int tile = bi * 8 + it, b = tile >> 6, t0 = (tile & 63) * 64;
        bf16* y_base = YCAT + (size_t)(b * SEQ) * DMIX + 1024 + g * 256;
        LDS_BARRIER();
        {
            const int tile2 = bi * 8 + ((it + 1 < 8) ? it + 1 : it), b2 = tile2 >> 6, t02 = (tile2 & 63) * 64;
            const bf16* xp_base = PROJ + (size_t)(b2 * SEQ) * NPROJ + 2048 + g * 256;
#pragma unroll
            for (int i = 0; i < 5; ++i) { const int id = tid + 512 * i, row = id >> 5, cc = id & 31, t = t02 - 16 + row;
                const u32x4 v = *(const u32x4*)(xp_base + (size_t)(t < 0 ? 0 : t) * NPROJ + cc * 8); pf[i] = (t < 0) ? (u32x4){0u, 0u, 0u, 0u} : v; }
        }
        u32x2 gpn[4][2];
        {
            const int tile2 = bi * 8 + ((it + 1 < 8) ? it + 1 : it), b2 = tile2 >> 6, t02 = (tile2 & 63) * 64;
            const bf16* gp_base2 = PROJ + (size_t)(b2 * SEQ) * NPROJ + 3072 + g * 256;
#pragma unroll
            for (int tb = 0; tb < 4; ++tb)
#pragma unroll
                for (int nb = 0; nb < 2; ++nb) gpn[tb][nb] = *(const u32x2*)(gp_base2 + (size_t)(t02 + tb * 16 + fr) * NPROJ + wv * 32 + nb * 16 + 4 * fq);
        }
        {
            float s[8];
#pragma unroll
            for (int e = 0; e < 8; ++e) s[e] = 0.f;
            const int r0 = tg * 4 + 16;
            for (int r = r0 - win + 1; r < r0; ++r) { const u32x4 w = *(const LAS u32x4*)(XP + r * PROW + ck * 16);
                s[0] += bflo(w.x); s[1] += bfhi(w.x); s[2] += bflo(w.y); s[3] += bfhi(w.y); s[4] += bflo(w.z); s[5] += bfhi(w.z); s[6] += bflo(w.w); s[7] += bfhi(w.w); }
#pragma unroll
            for (int i = 0; i < 4; ++i) {
                const u32x4 w = *(const LAS u32x4*)(XP + (r0 + i) * PROW + ck * 16);
                const float xv[8] = {bflo(w.x), bfhi(w.x), bflo(w.y), bfhi(w.y), bflo(w.z), bfhi(w.z), bflo(w.w), bfhi(w.w)};
                const int t = t0 + tg * 4 + i; const float inv = __builtin_amdgcn_rcpf((float)((t + 1 < win) ? (t + 1) : win));
                float p[8];
#pragma unroll
                for (int e = 0; e < 8; ++e) { s[e] += xv[e]; p[e] = __builtin_fmaf(s[e], inv, -xv[e]); }
                u32x4 o; o.x = pk2(p[0], p[1]); o.y = pk2(p[2], p[3]); o.z = pk2(p[4], p[5]); o.w = pk2(p[6], p[7]);
                *(LAS u32x4*)(PT + (tg * 4 + i) * PROW + ck * 16) = o;
                const u32x4 wo = *(const LAS u32x4*)(XP + (r0 + i - win + 1) * PROW + ck * 16);
                s[0] -= bflo(wo.x); s[1] -= bfhi(wo.x); s[2] -= bflo(wo.y); s[3] -= bfhi(wo.y); s[4] -= bflo(wo.z); s[5] -= bfhi(wo.z); s[6] -= bflo(wo.w); s[7] -= bfhi(wo.w);
            }
        }
        LDS_BARRIER();
#pragma unroll
        for (int tb = 0; tb < 4; ++tb) {
            f32x4 acc[2] = {(f32x4){0.f, 0.f, 0.f, 0.f}, (f32x4){0.f, 0.f, 0.f, 0.f}};
#pragma unroll
            for (int kb = 0; kb < 8; ++kb) { const bf16x8 pfm = *(const LAS bf16x8*)(PT + (tb * 16 + fr) * PROW + kb * 64 + fq * 16);
#pragma unroll
                for (int nb = 0; nb < 2; ++nb) acc[nb] = __builtin_amdgcn_mfma_f32_16x16x32_bf16(Wf[nb][kb], pfm, acc[nb], 0, 0, 0); }
            const int t = t0 + tb * 16 + fr;
#pragma unroll
            for (int nb = 0; nb < 2; ++nb) { const int n = wv * 32 + nb * 16 + 4 * fq;
                const u32x2 gw2 = gp[tb][nb];
                const f32x4 gv = (f32x4){bflo(gw2.x), bfhi(gw2.x), bflo(gw2.y), bfhi(gw2.y)};
                f32x4 r = (acc[nb] + pb[nb]) * ps[nb];
#pragma unroll
                for (int e = 0; e < 4; ++e) r[e] *= gv[e] * fast_sigmoid(gv[e]);
                u32x2 o; o.x = pk2(r.x, r.y); o.y = pk2(r.z, r.w);
                *(u32x2*)(y_base + (size_t)t * DMIX + n) = o; }
        }
#pragma unroll
        for (int i = 0; i < 5; ++i) { const int id = tid + 512 * i, row = id >> 5, cc = id & 31; *(LAS u32x4*)(XP + row * PROW + cc * 16) = pf[i]; }
#pragma unroll
        for (int tb = 0; tb < 4; ++tb)
#pragma unroll
            for (int nb = 0; nb < 2; ++nb) gp[tb][nb] = gpn[tb][nb];
    }
    LDS_BARRIER();
}

__device__ __forceinline__ void phase_mixer(const Args& a, int l, LAS unsigned char* lds) {
#ifndef MK_MIX
#define MK_MIX 3
#endif
#ifndef MK_DBL_RNN
#define MK_DBL_RNN 0
#endif
#ifndef MK_DBL_POOL
#define MK_DBL_POOL 0
#endif
    for (int rep = 0; rep < 1 + ((l == 0) ? MK_DBL_RNN : 0); ++rep) for (int u = blockIdx.x; u < 256; u += gridDim.x) rnn_unit(a, l, u, lds);
    for (int rep = 0; rep < 1 + ((l == 0) ? MK_DBL_POOL : 0); ++rep) for (int u = blockIdx.x; u < 256; u += gridDim.x) pool_units(a, l, u, lds);
}
#ifndef MK_DBL_PH
#define MK_DBL_PH -1
#endif
#ifndef MK_MASK
#define MK_MASK 63
#endif
__global__ void __launch_bounds__(512, 2) mk_fwd(Args a) {
    extern __shared__ __attribute__((aligned(16))) unsigned char lds_raw[];
    LAS unsigned char* lds = (LAS unsigned char*)lds_raw;
    cg::grid_group grid = cg::this_grid();
    volatile LAS unsigned* bst = (volatile LAS unsigned*)(lds + LDS_BST_OFF);
    if (threadIdx.x < 4) bst[threadIdx.x] = 0u;
    sync_threads_();
    XcdBarrier xbar = xcd_barrier_post((unsigned*)(a.ws + WS_CTL), bst);
#define GRID_BAR() do { if (a.ph_hi - a.ph_lo > 64) grid.sync(); else xcd_barrier(xbar); } while (0)
    for (int ph = a.ph_lo; ph < a.ph_hi; ++ph) {
#if MK_DBL_PH >= 0
      for (int rep = 0; rep < ((ph == MK_DBL_PH) ? 2 : 1); ++rep) {
        if (rep) GRID_BAR();
#endif
        if (ph == 0) { if (MK_MASK & 1) phase_prep(a, lds); }
        else if (ph == 1) { if (MK_MASK & 2) phase_h0(a); }
        else {
            const int l = (ph - 2) >> 2, sub = (ph - 2) & 3;
            if (sub == 0) { if (MK_MASK & 4) {
                pg8::Gemm g{(const pg8::bf16_t*)(a.ws + WS_H), (const pg8::bf16_t*)(a.ws + WS_WIN) + (size_t)l * NPROJ * D, T, NPROJ, D};
                pg8::StaticOrder S; S.init(T, NPROJ, gridDim.x, (int)blockIdx.x);
                pg8::EpiBf16<0> E{(pg8::bf16_t*)(a.ws + WS_PROJ), NPROJ, nullptr, 0, 0, 1.f};
                pg8::gemm_phase<pg8::EpiBf16<0>, pg8::StaticOrder, PG8_ALIGN, PG8_SP2>(lds, g, S, E); }
            } else if (sub == 1) {
                if (MK_MASK & 8) phase_mixer(a, l, lds);
            } else if (sub == 2) { if (MK_MASK & 16) {
                pg8::Gemm g{(const pg8::bf16_t*)(a.ws + WS_YCAT), (const pg8::bf16_t*)(a.ws + WS_WOUT) + (size_t)l * D * DMIX, T, D, DMIX};
                pg8::StaticOrder S; S.init(T, D, gridDim.x, (int)blockIdx.x);
                pg8::EpiBf16<0> E{(pg8::bf16_t*)(a.ws + WS_Y), D, nullptr, 0, 0, 1.f};
                pg8::gemm_phase<pg8::EpiBf16<0>, pg8::StaticOrder, PG8_ALIGN, PG8_SP2>(lds, g, S, E); }
            } else {
                if (MK_MASK & 32) phase_post(a, l);
            }
        }
#if MK_DBL_PH >= 0
      }
#endif
        if (ph + 1 < a.ph_hi) GRID_BAR();
    }
}

#if defined(__HIP_DEVICE_COMPILE__)
#pragma clang attribute pop
#endif

extern "C" void kernel_launch(void* const* d_in, const int* in_sizes, int n_in, void* d_out, int out_size, void* d_ws, size_t ws_size, hipStream_t stream) {
    static int grid = 0;
    if (grid == 0) {
        if (n_in != 18 || in_sizes[0] != T * D || out_size != T * D || ws_size < WS_END) {
            fprintf(stderr, "kernel_launch: unexpected shapes (n_in %d, in0 %d, out %d, ws %zu); nothing launched\n", n_in, n_in > 0 ? in_sizes[0] : -1, out_size, ws_size); grid = -1; return; }
        int dev = 0, cus = 0, per_cu = 0;
        if (hipGetDevice(&dev) != hipSuccess || hipDeviceGetAttribute(&cus, hipDeviceAttributeMultiprocessorCount, dev) != hipSuccess) { grid = -1; return; }
        if (hipFuncSetAttribute((const void*)mk_fwd, hipFuncAttributeMaxDynamicSharedMemorySize, LDS_BYTES) != hipSuccess) { fprintf(stderr, "kernel_launch: hipFuncSetAttribute failed\n"); grid = -1; return; }
        if (hipOccupancyMaxActiveBlocksPerMultiprocessor(&per_cu, (const void*)mk_fwd, 512, LDS_BYTES) != hipSuccess || per_cu < 1) { fprintf(stderr, "kernel_launch: occupancy query says %d blocks per CU\n", per_cu); per_cu = 1; }
        (void)hipGetLastError();
        grid = cus;
    }
    if (grid < 0) return;
    Args a{};
    for (int i = 0; i < 18; ++i) a.in[i] = (const float*)d_in[i];
    a.out = (float*)d_out; a.ws = (unsigned char*)d_ws;
    if (hipMemsetAsync((char*)d_ws + WS_CTL, 0, CTL_BYTES, stream) != hipSuccess) { fprintf(stderr, "kernel_launch: memset of the barrier words failed\n"); return; }
#if MK_N_LAUNCHES == 1
    a.ph_lo = 0; a.ph_hi = NPH;
    void* args[] = {&a};
    const hipError_t e = hipLaunchCooperativeKernel((const void*)mk_fwd, dim3(grid), dim3(512), args, LDS_BYTES, stream);
    if (e != hipSuccess) fprintf(stderr, "kernel_launch: cooperative launch failed: %s (grid %d)\n", hipGetErrorString(e), grid);
#else
    for (int ph = 0; ph < NPH; ++ph) {
        a.ph_lo = ph; a.ph_hi = ph + 1;
        hipLaunchKernelGGL(mk_fwd, dim3(grid), dim3(512), LDS_BYTES, stream, a);
    }
#endif
}
```

```cpp
#include <hip/hip_runtime.h>
#include <hip/hip_cooperative_groups.h>
#include <cstdio>
#include <cstdint>
namespace cg = cooperative_groups;
__device__ __forceinline__ int opaque_tid() { int t = threadIdx.x; asm volatile("" : "+v"(t)); return t; }
#if defined(__HIP_DEVICE_COMPILE__)
#pragma clang attribute push (__attribute__((target("no-packed-fp32-ops"))), apply_to = function)
#endif
__device__ __forceinline__ float u2f(unsigned x) { return __builtin_bit_cast(float, x); }
__device__ __forceinline__ float i2f(int x) { return __builtin_bit_cast(float, x); }
__device__ __forceinline__ int f2i(float x) { return __builtin_bit_cast(int, x); }
__device__ __forceinline__ int lane_id_() { return (int)__builtin_amdgcn_mbcnt_hi(~0u, __builtin_amdgcn_mbcnt_lo(~0u, 0u)); }
__device__ __forceinline__ float shfl_xor_(float v, int o) { return i2f(__builtin_amdgcn_ds_bpermute((lane_id_() ^ o) << 2, f2i(v))); }
__device__ __forceinline__ float row_last_(float v) { return i2f(__builtin_amdgcn_ds_bpermute((lane_id_() | 15) << 2, f2i(v))); }
__device__ __forceinline__ void sync_threads_() { __builtin_amdgcn_fence(__ATOMIC_RELEASE, "workgroup"); __builtin_amdgcn_s_barrier(); __builtin_amdgcn_fence(__ATOMIC_ACQUIRE, "workgroup"); }
namespace pg8 {
#define PG8_LAS __attribute__((address_space(3)))
typedef unsigned short bf16_t;
typedef short bf16x8 __attribute__((ext_vector_type(8)));
typedef float f32x4 __attribute__((ext_vector_type(4)));
typedef unsigned u32x4 __attribute__((ext_vector_type(4)));
constexpr int BM = 256, BK = 64, HALF = 128, HTB = HALF * BK * 2  , STAGE_BYTES = 8 * HTB, NXCD = 8, WGM = 8;

__host__ __device__ __forceinline__ int lds_byte(int r, int c) { const int st = (r >> 4) * 2 + (c >> 5), rr = r & 15, cc = c & 31, ob = rr * 64 + cc * 2; return st * 1024 + (ob ^ (((ob >> 9) & 1) << 5)); }
__host__ __device__ __forceinline__ void stage_rc(int b, int& R, int& C) { const int st = b / 1024, sb = b % 1024, swz = sb ^ (((sb >> 9) & 1) << 5); R = (st >> 1) * 16 + swz / 64; C = (st & 1) * 32 + (swz % 64) / 2; }
__host__ __device__ __forceinline__ int perm32(int rho) { const int n = rho >> 4, i = rho & 15; return 8 * (i >> 2) + 4 * n + (i & 3); }

struct Unit { int pm, pn; };
struct Gemm { const bf16_t* A; const bf16_t* Bt; int M, N, K; };

struct StaticOrder {
    int nM, nN, nwg, G, c;
    __host__ __device__ void init(int M, int N, int G_, int c_) { nM = M / BM; nN = N / BM; nwg = nM * nN; G = G_; c = c_; }
    __host__ __device__ bool next(int i, Unit& u) const {
        const long L = (long)i * G + c; if (L >= nwg) return false;
        int wgid = (int)L; { const int q = nwg / NXCD, r = nwg % NXCD, xcd = wgid % NXCD, off = wgid / NXCD; wgid = (xcd < r ? xcd * (q + 1) : r * (q + 1) + (xcd - r) * q) + off; }
        const int nig = WGM * nN, gid = wgid / nig, fm = gid * WGM, gsz = (nM - fm) < WGM ? (nM - fm) : WGM;
        u.pm = fm + ((wgid % nig) % gsz); u.pn = (wgid % nig) / gsz; return true;
    }
    __device__ __forceinline__ void a_ready(const Unit&) const {}
    __device__ __forceinline__ void done(const Unit&) const {}
};

__device__ __forceinline__ unsigned cvt_pk_bf16(float lo, float hi) { unsigned r; asm volatile("v_cvt_pk_bf16_f32 %0, %1, %2" : "=v"(r) : "v"(lo), "v"(hi)); return r; }
typedef float f32x2 __attribute__((ext_vector_type(2)));
__device__ __forceinline__ f32x2 gelu_pk(f32x2 v) {
    const f32x2 av = __builtin_elementwise_abs(v), d = av * 0.2316418882f + 1.0f;
    f32x2 t; t.x = __builtin_amdgcn_rcpf(d.x); t.y = __builtin_amdgcn_rcpf(d.y);
    f32x2 q = t * 0.5307027145f + (-0.7265760135f); q = q * t + 0.7107068705f; q = q * t + (-0.142248368f); q = q * t + 0.127414796f; q = q * t;
    const f32x2 s = (v * v) * (-0.72134752044f);
    f32x2 e; e.x = __builtin_amdgcn_exp2f(s.x); e.y = __builtin_amdgcn_exp2f(s.y);
    const f32x2 m = v * (q * e), r = v - m;
    f32x2 o; o.x = v.x < 0.f ? m.x : r.x; o.y = v.y < 0.f ? m.y : r.y; return o;
}

template <int ACT  > struct EpiBf16 {
    static constexpr bool PERM = true, AFTER_DRAIN = false; static_assert(ACT == 0 || ACT == 1, "EpiBf16: ACT is 0 (none) or 1 (gelu_pk)");
    bf16_t* O; int ldc; const float* bias; int split_cols; size_t split_stride; float scale0;
    __device__ __forceinline__ void operator()(const f32x4 (&acc)[2][2][4][2], const Unit& u, int wr, int wc, int fr, int fq) const {
        const int row0 = u.pm * BM + wr * 64 + fr; int colt = u.pn * BM; bf16_t* base = O;
        float sc = 1.f; if (split_cols) { const int t = colt / split_cols; base += (size_t)t * split_stride; colt -= t * split_cols; if (t == 0) sc = scale0; }
        const int col0 = colt + wc * 32 + 8 * fq, bcol0 = u.pn * BM + wc * 32 + 8 * fq;
        f32x4 bv[2][2];
#pragma unroll
        for (int bj = 0; bj < 2; ++bj)
#pragma unroll
            for (int n = 0; n < 2; ++n) bv[bj][n] = bias ? *(const f32x4*)(bias + bcol0 + bj * HALF + 4 * n) : (f32x4){0.f, 0.f, 0.f, 0.f};
#pragma unroll
        for (int ai = 0; ai < 2; ++ai)
#pragma unroll
            for (int m = 0; m < 4; ++m) { bf16_t* rowp = base + (size_t)(row0 + ai * HALF + m * 16) * ldc + col0;
#pragma unroll
                for (int bj = 0; bj < 2; ++bj) { f32x4 v0 = acc[ai][bj][m][0] + bv[bj][0], v1 = acc[ai][bj][m][1] + bv[bj][1];
                    if (ACT == 1) { f32x2 a = gelu_pk((f32x2){v0[0], v0[1]}), b = gelu_pk((f32x2){v0[2], v0[3]}), c = gelu_pk((f32x2){v1[0], v1[1]}), d = gelu_pk((f32x2){v1[2], v1[3]});
                        v0 = (f32x4){a.x, a.y, b.x, b.y}; v1 = (f32x4){c.x, c.y, d.x, d.y}; }
                    v0 = v0 * sc; v1 = v1 * sc; u32x4 w; w.x = cvt_pk_bf16(v0[0], v0[1]); w.y = cvt_pk_bf16(v0[2], v0[3]); w.z = cvt_pk_bf16(v1[0], v1[1]); w.w = cvt_pk_bf16(v1[2], v1[3]);
                    *(u32x4*)(rowp + bj * HALF) = w; } }
    }
};
template <class Epi, class Sched, bool ALIGN_EPI = false, bool SP2 = false>
__device__ __forceinline__ void gemm_phase(PG8_LAS unsigned char* lds, const Gemm g, const Sched& S, const Epi& E) {
    const int tid = opaque_tid(), wid = __builtin_amdgcn_readfirstlane(tid >> 6), lane = tid & 63, wr = wid >> 2, wc = wid & 3, fr = lane & 15, fq = lane >> 4;
    const int K = g.K, nt = K / BK;
    unsigned voffA[2], voffB[2];
#pragma unroll
    for (int i = 0; i < 2; ++i) { int R, C; stage_rc(tid * 16 + i * 8192, R, C); const int Rb = Epi::PERM ? ((R & ~31) + perm32(R & 31)) : R;
        voffA[i] = (unsigned)(R * K + C) * 2u; voffB[i] = (unsigned)(Rb * K + C) * 2u; }
    const size_t kstep = (size_t)(BK * 2);
    const size_t hstep = (size_t)HALF * K * 2;
    const size_t tstep = 2 * hstep;
    const unsigned ldsw = (unsigned)wid * 1024u;
    const int aoff = lds_byte(wr * 64 + fr, fq * 8), boff = lds_byte(wc * 32 + fr, fq * 8);
#define PG8_SA(b, h) (((b) * 2 + (h)) * HTB)
#define PG8_SB(b, h) ((4 + (b) * 2 + (h)) * HTB)
#define PG8_STAGE(bufoff, gbase, voff) do { _Pragma("unroll") for (int _i = 0; _i < 2; ++_i) \
        __builtin_amdgcn_global_load_lds((const unsigned*)((const char*)(gbase) + (voff)[_i]), (PG8_LAS unsigned*)(lds + (bufoff) + ldsw + _i * 8192), 16, 0, 0); } while (0)
#define PG8_LDA(dst, b, h) do { _Pragma("unroll") for (int m = 0; m < 4; ++m) _Pragma("unroll") for (int k = 0; k < 2; ++k) dst[m][k] = *(const PG8_LAS bf16x8*)(lds + PG8_SA(b, h) + aoff + m * 2048 + k * 1024); } while (0)
#define PG8_LDB(dst, b, h) do { _Pragma("unroll") for (int n = 0; n < 2; ++n) _Pragma("unroll") for (int k = 0; k < 2; ++k) dst[n][k] = *(const PG8_LAS bf16x8*)(lds + PG8_SB(b, h) + boff + n * 2048 + k * 1024); } while (0)
#define PG8_MMA(ai, bj, At, Bt) do { __builtin_amdgcn_s_setprio(1); _Pragma("unroll") for (int m = 0; m < 4; ++m) _Pragma("unroll") for (int n = 0; n < 2; ++n) _Pragma("unroll") for (int k = 0; k < 2; ++k) \
        acc[ai][bj][m][n] = __builtin_amdgcn_mfma_f32_16x16x32_bf16(Bt[n][k], At[m][k], acc[ai][bj][m][n], 0, 0, 0); __builtin_amdgcn_s_setprio(0); } while (0)
#define PG8_WAIT_V(n) asm volatile("s_waitcnt vmcnt(" #n ")" ::: "memory")
#define PG8_WAIT_L(n) asm volatile("s_waitcnt lgkmcnt(" #n ")" ::: "memory")
#define PG8_BAR __builtin_amdgcn_s_barrier()
#define PG8_SCHED __builtin_amdgcn_sched_barrier(0)
    Unit cur, nxt; int ui = 0;
    if (!S.next(0, cur)) return;
    f32x4 acc[2][2][4][2];
#pragma unroll
    for (int a = 0; a < 2; ++a)
#pragma unroll
        for (int b = 0; b < 2; ++b)
#pragma unroll
            for (int m = 0; m < 4; ++m)
#pragma unroll
                for (int n = 0; n < 2; ++n) acc[a][b][m][n] = (f32x4){0.f, 0.f, 0.f, 0.f};
    bf16x8 At[4][2], B0[2][2], B1[2][2];
    const char* cA = (const char*)g.A + (size_t)cur.pm * tstep; const char* cB = (const char*)g.Bt + (size_t)cur.pn * tstep;
    S.a_ready(cur);
    if constexpr (SP2) {
        PG8_STAGE(PG8_SB(0, 0), cB, voffB); PG8_STAGE(PG8_SB(0, 1), cB + hstep, voffB); PG8_STAGE(PG8_SA(0, 0), cA, voffA); PG8_STAGE(PG8_SA(0, 1), cA + hstep, voffA);
        if (wr == 1) PG8_BAR;
        PG8_WAIT_V(2); PG8_BAR;
        PG8_STAGE(PG8_SB(1, 0), cB + kstep, voffB); PG8_STAGE(PG8_SA(1, 0), cA + kstep, voffA); PG8_STAGE(PG8_SB(1, 1), cB + hstep + kstep, voffB);
        PG8_WAIT_V(6); PG8_BAR;
    } else {
        PG8_STAGE(PG8_SB(0, 0), cB, voffB); PG8_STAGE(PG8_SA(0, 0), cA, voffA); PG8_STAGE(PG8_SB(0, 1), cB + hstep, voffB); PG8_STAGE(PG8_SA(0, 1), cA + hstep, voffA);
        if (wr == 1) PG8_BAR;
        PG8_WAIT_V(4); PG8_BAR;
        PG8_STAGE(PG8_SB(1, 0), cB + kstep, voffB); PG8_STAGE(PG8_SA(1, 0), cA + kstep, voffA); PG8_STAGE(PG8_SB(1, 1), cB + hstep + kstep, voffB);
        PG8_WAIT_V(6); PG8_BAR;
    }
    for (;;) {
        const bool has_next = S.next(ui + 1, nxt);
        const char* nA = has_next ? (const char*)g.A + (size_t)nxt.pm * tstep : cA; const char* nB = has_next ? (const char*)g.Bt + (size_t)nxt.pn * tstep : cB;
        for (int t = 0; t < nt; t += 2) {
            const bool last = (t == nt - 2);
            const char* a1 = cA + (size_t)(t + 1) * kstep;
            const char* a2 = last ? nA : cA + (size_t)(t + 2) * kstep; const char* b2 = last ? nB : cB + (size_t)(t + 2) * kstep;
            const char* a3 = a2 + kstep; const char* b3 = b2 + kstep;
            if (last && has_next) S.a_ready(nxt);
            if constexpr (SP2) {
            PG8_LDB(B0, 0, 0); PG8_LDB(B1, 0, 1); PG8_SCHED; PG8_LDA(At, 0, 0); PG8_STAGE(PG8_SA(1, 1), a1 + hstep, voffA);
            PG8_WAIT_V(8); PG8_WAIT_L(0); PG8_BAR; PG8_MMA(0, 0, At, B0); PG8_MMA(0, 1, At, B1); PG8_BAR; PG8_SCHED;
            PG8_LDA(At, 0, 1); PG8_STAGE(PG8_SB(0, 0), b2, voffB); PG8_STAGE(PG8_SB(0, 1), b2 + hstep, voffB); PG8_STAGE(PG8_SA(0, 0), a2, voffA);
            PG8_WAIT_V(8); PG8_WAIT_L(0); PG8_BAR; PG8_MMA(1, 0, At, B0); PG8_MMA(1, 1, At, B1); PG8_BAR; PG8_SCHED;
            PG8_LDB(B0, 1, 0); PG8_LDB(B1, 1, 1); PG8_SCHED; PG8_LDA(At, 1, 0); PG8_STAGE(PG8_SA(0, 1), a2 + hstep, voffA);
            PG8_WAIT_V(8); PG8_WAIT_L(0); PG8_BAR; PG8_MMA(0, 0, At, B0); PG8_MMA(0, 1, At, B1); PG8_BAR; PG8_SCHED;
            PG8_LDA(At, 1, 1); PG8_STAGE(PG8_SB(1, 0), b3, voffB); PG8_STAGE(PG8_SB(1, 1), b3 + hstep, voffB); PG8_STAGE(PG8_SA(1, 0), a3, voffA);
            PG8_WAIT_V(8); PG8_WAIT_L(0); PG8_BAR; PG8_MMA(1, 0, At, B0); PG8_MMA(1, 1, At, B1); PG8_BAR; PG8_SCHED;
            } else {
            PG8_LDB(B0, 0, 0); PG8_SCHED; PG8_LDA(At, 0, 0); PG8_STAGE(PG8_SA(1, 1), a1 + hstep, voffA);
            PG8_WAIT_L(8); PG8_BAR; PG8_WAIT_L(0); PG8_MMA(0, 0, At, B0); PG8_BAR; PG8_SCHED;
            PG8_LDB(B1, 0, 1); PG8_STAGE(PG8_SB(0, 0), b2, voffB);
            PG8_BAR; PG8_WAIT_L(0); PG8_MMA(0, 1, At, B1); PG8_BAR;
            PG8_LDA(At, 0, 1); PG8_STAGE(PG8_SA(0, 0), a2, voffA);
            PG8_BAR; PG8_WAIT_L(0); PG8_MMA(1, 0, At, B0); PG8_BAR; PG8_SCHED;
            PG8_STAGE(PG8_SB(0, 1), b2 + hstep, voffB);
            PG8_WAIT_V(6); PG8_BAR; PG8_MMA(1, 1, At, B1); PG8_BAR;
            PG8_LDB(B0, 1, 0); PG8_SCHED; PG8_LDA(At, 1, 0); PG8_STAGE(PG8_SA(0, 1), a2 + hstep, voffA);
            PG8_WAIT_L(8); PG8_BAR; PG8_WAIT_L(0); PG8_MMA(0, 0, At, B0); PG8_BAR; PG8_SCHED;
            PG8_LDB(B1, 1, 1); PG8_STAGE(PG8_SB(1, 0), b3, voffB);
            PG8_BAR; PG8_WAIT_L(0); PG8_MMA(0, 1, At, B1); PG8_BAR;
            PG8_LDA(At, 1, 1); PG8_STAGE(PG8_SA(1, 0), a3, voffA);
            PG8_BAR; PG8_WAIT_L(0); PG8_MMA(1, 0, At, B0); PG8_BAR; PG8_SCHED;
            PG8_STAGE(PG8_SB(1, 1), b3 + hstep, voffB);
            PG8_WAIT_V(6); PG8_BAR; PG8_MMA(1, 1, At, B1); PG8_BAR;
            }
        }
        if constexpr (ALIGN_EPI) { if (wr == 0) PG8_BAR; }
        if constexpr (!Epi::AFTER_DRAIN) { E(acc, cur, wr, wc, fr, fq); S.done(cur); }
        if (!has_next) break;
#pragma unroll
        for (int a = 0; a < 2; ++a)
#pragma unroll
            for (int b = 0; b < 2; ++b)
#pragma unroll
                for (int m = 0; m < 4; ++m)
#pragma unroll
                    for (int n = 0; n < 2; ++n) acc[a][b][m][n] = (f32x4){0.f, 0.f, 0.f, 0.f};
        cur = nxt; cA = nA; cB = nB; ++ui;
        if constexpr (ALIGN_EPI) { if (wr == 1) PG8_BAR; }
    }
    PG8_WAIT_V(0);
    if constexpr (!ALIGN_EPI) { if (wr == 0) PG8_BAR; }
    PG8_BAR;
    if constexpr (Epi::AFTER_DRAIN) { E.fused(acc, cur, wr, wc, fr, fq, lds, wid, lane); S.done(cur); }
#undef PG8_SA
#undef PG8_SB
#undef PG8_STAGE
#undef PG8_LDA
#undef PG8_LDB
#undef PG8_MMA
#undef PG8_WAIT_V
#undef PG8_WAIT_L
#undef PG8_BAR
#undef PG8_SCHED
}
}
#ifndef PG8_SP2
#define PG8_SP2 true
#endif
#ifndef PG8_ALIGN
#define PG8_ALIGN true
#endif
#ifndef MK_N_LAUNCHES
#define MK_N_LAUNCHES 1
#endif

constexpr int NB = 8, SEQ = 4096, D = 1024, T = NB * SEQ, NPROJ = 4096, DMIX = 2048;
constexpr int NPH = 10;
constexpr float EPS = 1e-6f;
constexpr size_t MiB = 1u << 20;
constexpr size_t WS_WIN = 0, WS_WOUT = 16 * MiB, WS_GW = 24 * MiB, WS_PW = 25 * MiB, WS_MOD = 26 * MiB;
constexpr size_t WS_H = 32 * MiB, WS_YCAT = 96 * MiB, WS_PROJ = 224 * MiB, WS_Y = WS_PROJ, WS_U = WS_H, WS_END = 480 * MiB;
constexpr size_t WS_CTL = 28 * MiB, CTL_BYTES = 16384;
constexpr int LDS_BYTES = 147456, LDS_BST_OFF = 131072 + 64;

#define LAS __attribute__((address_space(3)))
typedef unsigned short bf16;
typedef float f32x4 __attribute__((ext_vector_type(4)));
typedef float f32x2 __attribute__((ext_vector_type(2)));
typedef unsigned u32x4 __attribute__((ext_vector_type(4)));
typedef unsigned u32x2 __attribute__((ext_vector_type(2)));
typedef short bf16x8 __attribute__((ext_vector_type(8)));

struct Args { const float* in[18]; float* out; unsigned char* ws; int ph_lo, ph_hi; };

__device__ __forceinline__ unsigned pk2(float lo, float hi) { return pg8::cvt_pk_bf16(lo, hi); }
__device__ __forceinline__ float bflo(unsigned w) { return u2f(w << 16); }
__device__ __forceinline__ float bfhi(unsigned w) { return u2f(w & 0xffff0000u); }
__device__ __forceinline__ float wave_sum(float v) {
#pragma unroll
    for (int o = 1; o < 64; o <<= 1) v += shfl_xor_(v, o);
    return v;
}
__device__ __forceinline__ float sigmoidf_(float x) { return 1.0f / (1.0f + __expf(-x)); }
__device__ __forceinline__ float siluf_(float x) { return x / (1.0f + __expf(-x)); }

__device__ __forceinline__ void transpose_tile(const float* W, int K, int N, bf16* WT, LAS float* scr, int k0, int n0, int drow, int lane) {
    {
        f32x4 v[8];
#pragma unroll
        for (int i = 0; i < 8; ++i) v[i] = *(const f32x4*)(W + (size_t)(k0 + (lane >> 3) + 8 * i) * N + n0 + (lane & 7) * 4);
#pragma unroll
        for (int i = 0; i < 8; ++i) { LAS float* d = scr + ((lane >> 3) + 8 * i) * 33 + (lane & 7) * 4; d[0] = v[i].x; d[1] = v[i].y; d[2] = v[i].z; d[3] = v[i].w; }
    }
    asm volatile("s_waitcnt lgkmcnt(0)" ::: "memory");
    const int c = lane & 7;
#pragma unroll
    for (int j = 0; j < 4; ++j) { const int n = (lane >> 3) + 8 * j; const LAS float* s = scr + (8 * c) * 33 + n;
        u32x4 o; o.x = pk2(s[0 * 33], s[1 * 33]); o.y = pk2(s[2 * 33], s[3 * 33]); o.z = pk2(s[4 * 33], s[5 * 33]); o.w = pk2(s[6 * 33], s[7 * 33]);
        *(u32x4*)(WT + (size_t)(drow + n) * K + k0 + 8 * c) = o; }
    asm volatile("s_waitcnt lgkmcnt(0)" ::: "memory");
}
__device__ __forceinline__ void transpose_item(const float* W, int K, int N, bf16* WT, LAS float* scr, int item, int lane) {
    const int nblk = N / 32, kb = item / nblk, nb = item % nblk;
    transpose_tile(W, K, N, WT, scr, 64 * kb, 32 * nb, 32 * nb, lane);
}

__device__ __forceinline__ void phase_prep(const Args& a, LAS unsigned char* lds) {
    const int tid = opaque_tid(), lane = tid & 63, wv = tid >> 6;
    const int G = gridDim.x;
    unsigned char* ws = a.ws;
    {
        LAS float* sc = (LAS float*)lds;
        LAS float* red = (LAS float*)(lds + 32768);
        const float* c = a.in[1]; const float* ada_w = a.in[2]; const float* ada_b = a.in[3];
        float* MOD = (float*)(ws + WS_MOD);
        if ((int)blockIdx.x < 192) {
            for (int i = tid; i < 8192; i += 512) sc[i] = siluf_(c[i]);
            sync_threads_();
            for (int unit = blockIdx.x; unit < 192; unit += G) {
                const int l = unit / 96, cb = (unit % 96) * 32, cl = tid & 31, ks = tid >> 5;
                const float* wp = ada_w + (size_t)l * 1024 * 3072 + (size_t)(ks * 64) * 3072 + cb + cl;
                float acc[8];
#pragma unroll
                for (int b = 0; b < 8; ++b) acc[b] = 0.f;
#pragma unroll 16
                for (int k = 0; k < 64; ++k) { const float w = wp[(size_t)k * 3072];
#pragma unroll
                    for (int b = 0; b < 8; ++b) acc[b] += sc[b * 1024 + ks * 64 + k] * w; }
#pragma unroll
                for (int b = 0; b < 8; ++b) red[(ks * 8 + b) * 32 + cl] = acc[b];
                sync_threads_();
                if (tid < 256) { const int b = tid >> 5; float s = 0.f;
#pragma unroll
                    for (int k2 = 0; k2 < 16; ++k2) s += red[(k2 * 8 + b) * 32 + cl];
                    MOD[(l * 8 + b) * 3072 + cb + cl] = s + ada_b[l * 3072 + cb + cl]; }
                sync_threads_();
            }
        }
        sync_threads_();
    }
    {
        LAS float* scr = (LAS float*)(lds + wv * 16384);
        const int gw = blockIdx.x * 8 + wv, NGW = G * 8;
        constexpr int I_IN = (1024 / 64) * (4096 / 32), I_OUT = (2048 / 64) * (1024 / 32);
        for (int it = gw; it < 2 * (I_IN + I_OUT); it += NGW) {
            int r = it;
            if (r < 2 * I_IN) { const int l = r / I_IN; r -= l * I_IN;
                transpose_item(a.in[5] + (size_t)l * 1024 * 4096, 1024, 4096, (bf16*)(ws + WS_WIN) + (size_t)l * 4096 * 1024, scr, r, lane); }
            else { r -= 2 * I_IN; const int l = r / I_OUT; r -= l * I_OUT;
                transpose_item(a.in[16] + (size_t)l * 2048 * 1024, 2048, 1024, (bf16*)(ws + WS_WOUT) + (size_t)l * 1024 * 2048, scr, r, lane); }
        }
    }
    {
        LAS float* scr = (LAS float*)(lds + wv * 16384);
        const int gw = blockIdx.x * 8 + wv, NGW = G * 8;
        bf16* GWp = (bf16*)(ws + WS_GW); bf16* PWp = (bf16*)(ws + WS_PW);
        for (int it = NGW - 1 - gw; it < 512; it += NGW) {
            if (it < 256) { const int lh = it >> 4, r = it & 15, gate = r >> 3, kb = (r >> 2) & 1, q = r & 3;
                transpose_tile((gate ? a.in[10] : a.in[8]) + (size_t)lh * 128 * 128, 128, 128, GWp + (size_t)lh * 4 * 64 * 128, scr, 64 * kb, 32 * q, q * 64 + gate * 32, lane); }
            else { const int r = it - 256, lg = r >> 5, kb = (r >> 3) & 3, nb = r & 7;
                transpose_tile(a.in[13] + (size_t)lg * 256 * 256, 256, 256, PWp + (size_t)lg * 256 * 256, scr, 64 * kb, 32 * nb, 32 * nb, lane); }
        }
    }
}

constexpr int RPW = 4;
__device__ __forceinline__ void phase_h0(const Args& a) {
    const int tid = opaque_tid(), lane = tid & 63, wv = tid >> 6;
    const int gw = blockIdx.x * 8 + wv, NGW = gridDim.x * 8;
    const float* x = a.in[0]; const float* g = a.in[4]; const float* MOD = (const float*)(a.ws + WS_MOD);
    bf16* H = (bf16*)(a.ws + WS_H);
    for (int m0 = gw * RPW; m0 < T; m0 += NGW * RPW) {
        f32x4 v[RPW][4];
#pragma unroll
        for (int r = 0; r < RPW; ++r) { const f32x4* xr = (const f32x4*)(x + (size_t)(m0 + r) * D) + lane;
#pragma unroll
            for (int j = 0; j < 4; ++j) v[r][j] = __builtin_nontemporal_load(xr + 64 * j); }
        const int b = m0 >> 12;
        const float* sh = MOD + (size_t)b * 3072; const float* scl = sh + 1024;
#pragma unroll
        for (int r = 0; r < RPW; ++r) {
            float ss = 0.f;
#pragma unroll
            for (int j = 0; j < 4; ++j) ss += (v[r][j].x * v[r][j].x + v[r][j].y * v[r][j].y) + (v[r][j].z * v[r][j].z + v[r][j].w * v[r][j].w);
            const float rstd = 1.0f / __builtin_sqrtf(wave_sum(ss) * (1.0f / D) + EPS);
            u32x2* o = (u32x2*)(H + (size_t)(m0 + r) * D) + lane;
#pragma unroll
            for (int j = 0; j < 4; ++j) { const int col = 4 * lane + 256 * j;
                const f32x4 gg = *(const f32x4*)(g + col), s4 = *(const f32x4*)(scl + col), h4 = *(const f32x4*)(sh + col);
                const f32x4 rr = v[r][j] * rstd * gg * (s4 + 1.0f) + h4;
                u32x2 w; w.x = pk2(rr.x, rr.y); w.y = pk2(rr.z, rr.w); o[64 * j] = w; }
        }
    }
}

__device__ __forceinline__ void phase_post(const Args& a, int l) {
    const int tid = opaque_tid(), lane = tid & 63, wv = tid >> 6;
    const int gw = blockIdx.x * 8 + wv, NGW = gridDim.x * 8;
    const float* xin = (l == 0) ? a.in[0] : a.out; float* out = a.out;
    const bf16* Y = (const bf16*)(a.ws + WS_Y); bf16* H = (bf16*)(a.ws + WS_H);
    const float* MOD = (const float*)(a.ws + WS_MOD);
    const float* gpost = a.in[17] + l * D; const float* gpre = a.in[4] + (l + 1) * D;
    for (int m0 = gw * RPW; m0 < T; m0 += NGW * RPW) {
        f32x4 xv[RPW][4]; u32x2 yw[RPW][4];
#pragma unroll
        for (int r = 0; r < RPW; ++r) { const f32x4* xr = (const f32x4*)(xin + (size_t)(m0 + r) * D) + lane; const u32x2* yr = (const u32x2*)(Y + (size_t)(m0 + r) * D) + lane;
#pragma unroll
            for (int j = 0; j < 4; ++j) { xv[r][j] = xr[64 * j]; yw[r][j] = yr[64 * j]; } }
        const int b = m0 >> 12;
        const float* gate = MOD + (size_t)(l * 8 + b) * 3072 + 2048;
        const float* sh = MOD + (size_t)(8 + b) * 3072; const float* scl = sh + 1024;
#pragma unroll
        for (int r = 0; r < RPW; ++r) {
            f32x4 yv[4]; float ss = 0.f;
#pragma unroll
            for (int j = 0; j < 4; ++j) { const u32x2 w = yw[r][j]; yv[j] = (f32x4){bflo(w.x), bfhi(w.x), bflo(w.y), bfhi(w.y)};
                ss += (yv[j].x * yv[j].x + yv[j].y * yv[j].y) + (yv[j].z * yv[j].z + yv[j].w * yv[j].w); }
            const float rstd = 1.0f / __builtin_sqrtf(wave_sum(ss) * (1.0f / D) + EPS);
            float ss2 = 0.f;
#pragma unroll
            for (int j = 0; j < 4; ++j) { const int col = 4 * lane + 256 * j;
                const f32x4 gp = *(const f32x4*)(gpost + col), gt = *(const f32x4*)(gate + col);
                const f32x4 xn = xv[r][j] + gt * (yv[j] * rstd * gp);
                xv[r][j] = xn;
                if (l == 0) *((f32x4*)(out + (size_t)(m0 + r) * D + col)) = xn;
                else __builtin_nontemporal_store(xn, (f32x4*)(out + (size_t)(m0 + r) * D + col));
                ss2 += (xn.x * xn.x + xn.y * xn.y) + (xn.z * xn.z + xn.w * xn.w); }
            if (l == 0) {
                const float rstd2 = 1.0f / __builtin_sqrtf(wave_sum(ss2) * (1.0f / D) + EPS);
                u32x2* o = (u32x2*)(H + (size_t)(m0 + r) * D) + lane;
#pragma unroll
                for (int j = 0; j < 4; ++j) { const int col = 4 * lane + 256 * j;
                    const f32x4 gg = *(const f32x4*)(gpre + col), s4 = *(const f32x4*)(scl + col), h4 = *(const f32x4*)(sh + col);
                    const f32x4 rr = xv[r][j] * rstd2 * gg * (s4 + 1.0f) + h4;
                    u32x2 w; w.x = pk2(rr.x, rr.y); w.y = pk2(rr.z, rr.w); o[64 * j] = w; }
            }
        }
    }
}
#define XB_TMO      128
#define XB_XCNT(j)  (256  + 64 * (j))
#define XB_XSUB(j)  (1280 + 64 * (j))
#define XB_XGEN(j)  (2304 + 64 * (j))
#define XB_TOP      3328
#define XB_TOPGEN   3392
#define XCD_BAR_WORDS 3456
#define XB_SPIN_CAP (1u << 18)

__device__ __forceinline__ unsigned xb_ld(unsigned* p)              { return __hip_atomic_load(p, __ATOMIC_RELAXED, __HIP_MEMORY_SCOPE_AGENT); }
__device__ __forceinline__ unsigned xb_add(unsigned* p, unsigned v) { return __hip_atomic_fetch_add(p, v, __ATOMIC_RELAXED, __HIP_MEMORY_SCOPE_AGENT); }
__device__ __forceinline__ unsigned xb_xcc_id() { return (unsigned)__builtin_amdgcn_s_getreg((3 << 11) | 20) & 0xFu; }
#define XB_SPIN(cond, bar) do { unsigned _sp = 0; while (cond) { __builtin_amdgcn_s_sleep(1); \
    if ((++_sp & 255u) == 0u) { if (xb_ld(&(bar)[XB_TMO])) break; if (_sp > XB_SPIN_CAP) { xb_add(&(bar)[XB_TMO], 1u); break; } } } } while (0)

struct XcdBarrier {
    unsigned* bar; unsigned x;
    volatile LAS unsigned* st;
};

__device__ __forceinline__ XcdBarrier xcd_barrier_post(unsigned* bar, volatile LAS unsigned* st) {
    XcdBarrier b; b.bar = bar; b.x = xb_xcc_id(); b.st = st;
    if (threadIdx.x == 0) (void)xb_add(&bar[XB_XCNT(b.x)], 1u);
    return b;
}
__device__ __forceinline__ void xcd_barrier_complete(unsigned* bar, unsigned x, unsigned& nloc, unsigned& nx) {
    const unsigned G = gridDim.x * gridDim.y * gridDim.z;
    unsigned sum, cnt, mine, sp = 0u;
    for (;;) {
        sum = 0u; cnt = 0u; mine = 0u;
#pragma unroll
        for (unsigned j = 0; j < 16; ++j) { const unsigned c = xb_ld(&bar[XB_XCNT(j)]); sum += c; cnt += (c > 0u) ? 1u : 0u; mine = (j == x) ? c : mine; }
        if (sum == G) break;
        __builtin_amdgcn_s_sleep(1);
        if ((++sp & 255u) == 0u) { if (xb_ld(&bar[XB_TMO])) break; if (sp > XB_SPIN_CAP) { xb_add(&bar[XB_TMO], 1u); break; } }
    }
    nloc = mine > 0u ? mine : 1u; nx = cnt > 0u ? cnt : 1u;
}

__device__ __forceinline__ void xcd_barrier(const XcdBarrier& b) {
    asm volatile("s_waitcnt vmcnt(0)" ::: "memory");
    sync_threads_();
    if (threadIdx.x == 0) {
        unsigned* bar = b.bar;
        __builtin_amdgcn_s_waitcnt(0);
        unsigned nloc = b.st[0], nx = b.st[1];
        if (nloc == 0u) { xcd_barrier_complete(bar, b.x, nloc, nx); b.st[0] = nloc; b.st[1] = nx; }
        const unsigned old = xb_add(&bar[XB_XSUB(b.x)], 1u);
        const unsigned gen = old / nloc;
        if (old + 1u == (gen + 1u) * nloc) {
            __builtin_amdgcn_fence(__ATOMIC_RELEASE, "agent");
            asm volatile("s_waitcnt vmcnt(0)" ::: "memory");
            const unsigned og = xb_add(&bar[XB_TOP], 1u);
            const unsigned tg = og / nx;
            if (og + 1u == (tg + 1u) * nx) xb_add(&bar[XB_TOPGEN], 1u);
            else XB_SPIN(xb_ld(&bar[XB_TOPGEN]) == tg, bar);
            __builtin_amdgcn_fence(__ATOMIC_ACQUIRE, "agent");
            xb_add(&bar[XB_XGEN(b.x)], 1u);
            asm volatile("s_waitcnt vmcnt(0)" ::: "memory");
        } else {
            XB_SPIN(xb_ld(&bar[XB_XGEN(b.x)]) == gen, bar);
            __builtin_amdgcn_fence(__ATOMIC_ACQUIRE, "agent");
            asm volatile("s_waitcnt vmcnt(0)" ::: "memory");
        }
    }
    sync_threads_();
}

#define LDS_BARRIER() do { asm volatile("s_waitcnt lgkmcnt(0)" ::: "memory"); __builtin_amdgcn_s_barrier(); asm volatile("" ::: "memory"); } while (0)
constexpr int XROW = 272;
constexpr int CROW = 132;
constexpr int R_XT = 0, R_UT = 35840, R_AT = 70656, R_VT = 87552, R_EP = 104448, R_CWT = 105472, R_GT = 108032, R_YT = 116736;
template <int D> __device__ __forceinline__ float dpp_row_shr(float old, float src) {
    return i2f(__builtin_amdgcn_update_dpp(f2i(old), f2i(src), 0x110 | D, 0xf, 0xf, false)); }
__device__ __forceinline__ float softplus_small_(float e) { return (e < 0.03f) ? e * (1.0f + e * (-0.5f + e * (0.33333334f + e * (-0.25f + e * 0.2f)))) : __builtin_logf(1.0f + e); }
__device__ __forceinline__ float fast_sigmoid(float x) { return __builtin_amdgcn_rcpf(1.0f + __builtin_amdgcn_exp2f(-1.4426950408889634f * x)); }
__device__ __forceinline__ void rnn_unit(const Args& a, int l, int u, LAS unsigned char* lds) {
    const int tid = opaque_tid(), lane = tid & 63, wv = tid >> 6, fr = lane & 15, fq = lane >> 4;
    const int xcd = u & 7, jj = u >> 3, q = jj & 3, bh = (jj >> 2) * 8 + xcd, b = bh >> 3, h = bh & 7;
    const bf16* PROJ = (const bf16*)(a.ws + WS_PROJ); bf16* YCAT = (bf16*)(a.ws + WS_YCAT);
    const bf16* xr_base = PROJ + (size_t)(b * SEQ) * NPROJ + h * 128;
    const bf16* gr_base = PROJ + (size_t)(b * SEQ) * NPROJ + 1024 + h * 128 + q * 32;
    bf16* y_base = YCAT + (size_t)(b * SEQ) * DMIX + h * 128 + q * 32;
    LAS unsigned char* XT = lds + R_XT; LAS unsigned char* UT = lds + R_UT;
    LAS float* AT = (LAS float*)(lds + R_AT); LAS float* VT = (LAS float*)(lds + R_VT);
    LAS unsigned char* GT = lds + R_GT; LAS unsigned char* YT = lds + R_YT;
    const int io_tk = tid >> 2, io_cq = tid & 3;
    const int ck = tid & 15, tg = tid >> 4;
    LAS float* CWT = (LAS float*)(lds + R_CWT);
    for (int i = tid; i < 640; i += 512) { const int r = i >> 7, c = i & 127;
        CWT[i] = (r < 4) ? a.in[6][(size_t)l * 4 * 1024 + r * 1024 + h * 128 + c] : a.in[7][(size_t)l * 1024 + h * 128 + c]; }
    bf16x8 Wf[4][4];
    {
        const bf16* gwp = (const bf16*)(a.ws + WS_GW) + (size_t)((l * 8 + h) * 4 + q) * 64 * 128;
#pragma unroll
        for (int nb = 0; nb < 4; ++nb)
#pragma unroll
            for (int kb = 0; kb < 4; ++kb) Wf[nb][kb] = *(const bf16x8*)(gwp + (nb * 16 + fr) * 128 + kb * 32 + fq * 8);
    }
    LAS float* EP = (LAS float*)(lds + R_EP);
    if (tid < 96) {
        const int r = tid >> 5, c = tid & 31, ch = h * 128 + q * 32 + c; float v;
        if (r == 0) v = a.in[9][l * 1024 + ch];
        else if (r == 1) v = a.in[11][l * 1024 + ch];
        else v = 8.0f * 1.4426950408889634f * softplus_small_(__builtin_expf(-a.in[12][l * 1024 + ch]));
        EP[r * 32 + c] = v;
    }
    u32x4 pf[4], pfh = (u32x4){0u, 0u, 0u, 0u};
#pragma unroll
    for (int i = 0; i < 4; ++i) { const int id = tid + 512 * i, row = id >> 4, cc = id & 15; pf[i] = *(const u32x4*)(xr_base + (size_t)row * NPROJ + cc * 8); }
    u32x4 gpf = *(const u32x4*)(gr_base + (size_t)io_tk * NPROJ + io_cq * 8);
    const int sc_ci = lane >> 4, sc_sg = lane & 15, sc_c = wv * 4 + sc_ci;
    float hcar = 0.f;
#pragma unroll
    for (int i = 0; i < 4; ++i) { const int id = tid + 512 * i, row = id >> 4, cc = id & 15; *(LAS u32x4*)(XT + (3 + row) * XROW + cc * 16) = pf[i]; }
    if (tid < 48) *(LAS u32x4*)(XT + (tid >> 4) * XROW + (tid & 15) * 16) = pfh;
    for (int tile = 0; tile < SEQ / 128; ++tile) {
        const int t0 = tile * 128;
        LDS_BARRIER();
        {
            const int t0n = (tile + 1 < SEQ / 128) ? t0 + 128 : t0;
#pragma unroll
            for (int i = 0; i < 4; ++i) { const int id = tid + 512 * i, row = id >> 4, cc = id & 15; pf[i] = *(const u32x4*)(xr_base + (size_t)(t0n + row) * NPROJ + cc * 8); }
            if (tid < 48) pfh = *(const u32x4*)(xr_base + (size_t)(t0n - 3 + (tid >> 4)) * NPROJ + (tid & 15) * 8);
        }
        {
            if (tile > 0) {
                unsigned short yv_[8];
#pragma unroll
                for (int e = 0; e < 8; ++e) yv_[e] = *(const LAS unsigned short*)(YT + (io_cq * 8 + e) * XROW + io_tk * 2);
                u32x4 w; w.x = yv_[0] | ((unsigned)yv_[1] << 16); w.y = yv_[2] | ((unsigned)yv_[3] << 16); w.z = yv_[4] | ((unsigned)yv_[5] << 16); w.w = yv_[6] | ((unsigned)yv_[7] << 16);
                *(u32x4*)(y_base + (size_t)(t0 - 128 + io_tk) * DMIX + io_cq * 8) = w;
            }
            const unsigned gwv[4] = {gpf.x, gpf.y, gpf.z, gpf.w};
#pragma unroll
            for (int e2 = 0; e2 < 4; ++e2) { *(LAS unsigned short*)(GT + (io_cq * 8 + 2 * e2) * XROW + io_tk * 2) = (unsigned short)(gwv[e2] & 0xffffu);
                *(LAS unsigned short*)(GT + (io_cq * 8 + 2 * e2 + 1) * XROW + io_tk * 2) = (unsigned short)(gwv[e2] >> 16); }
            const int t1 = (tile + 1 < SEQ / 128) ? t0 + 128 : t0;
            gpf = *(const u32x4*)(gr_base + (size_t)(t1 + io_tk) * NPROJ + io_cq * 8);
        }
        {
            f32x2 o[4][4], cw[4][4];
            {
                const f32x4 b0 = *(const LAS f32x4*)(CWT + 4 * 128 + ck * 8), b1 = *(const LAS f32x4*)(CWT + 4 * 128 + ck * 8 + 4);
#pragma unroll
                for (int i = 0; i < 4; ++i) { o[i][0] = (f32x2){b0.x, b0.y}; o[i][1] = (f32x2){b0.z, b0.w}; o[i][2] = (f32x2){b1.x, b1.y}; o[i][3] = (f32x2){b1.z, b1.w}; }
            }
#pragma unroll
            for (int k = 0; k < 4; ++k) { const f32x4 w0 = *(const LAS f32x4*)(CWT + k * 128 + ck * 8), w1 = *(const LAS f32x4*)(CWT + k * 128 + ck * 8 + 4);
                cw[k][0] = (f32x2){w0.x, w0.y}; cw[k][1] = (f32x2){w0.z, w0.w}; cw[k][2] = (f32x2){w1.x, w1.y}; cw[k][3] = (f32x2){w1.z, w1.w}; }
#pragma unroll
            for (int r = 0; r < 7; ++r) {
                const u32x4 w = *(const LAS u32x4*)(XT + (tg * 4 + r) * XROW + ck * 16);
                const f32x2 xv[4] = {(f32x2){bflo(w.x), bfhi(w.x)}, (f32x2){bflo(w.y), bfhi(w.y)}, (f32x2){bflo(w.z), bfhi(w.z)}, (f32x2){bflo(w.w), bfhi(w.w)}};
#pragma unroll
                for (int i = 0; i < 4; ++i) { const int k = r - i; if (k >= 0 && k < 4) {
#pragma unroll
                    for (int e = 0; e < 4; ++e) o[i][e] = __builtin_elementwise_fma(cw[k][e], xv[e], o[i][e]); } }
            }
#pragma unroll
            for (int i = 0; i < 4; ++i) { u32x4 w; w.x = pk2(o[i][0].x, o[i][0].y); w.y = pk2(o[i][1].x, o[i][1].y); w.z = pk2(o[i][2].x, o[i][2].y); w.w = pk2(o[i][3].x, o[i][3].y);
                *(LAS u32x4*)(UT + (tg * 4 + i) * XROW + ck * 16) = w; }
        }
        asm volatile("s_waitcnt lgkmcnt(0)" ::: "memory");
        {
            f32x4 acc[4];
#pragma unroll
            for (int nb = 0; nb < 4; ++nb) acc[nb] = (f32x4){0.f, 0.f, 0.f, 0.f};
#pragma unroll
            for (int kb = 0; kb < 4; ++kb) { const bf16x8 uf = *(const LAS bf16x8*)(UT + (wv * 16 + fr) * XROW + kb * 64 + fq * 16);
#pragma unroll
                for (int nb = 0; nb < 4; ++nb) acc[nb] = __builtin_amdgcn_mfma_f32_16x16x32_bf16(Wf[nb][kb], uf, acc[nb], 0, 0, 0); }
            const int tk = wv * 16 + fr;
#pragma unroll
            for (int nb2 = 0; nb2 < 2; ++nb2) {
                const int c0 = nb2 * 16 + 4 * fq;
                const u32x2 uw = *(const LAS u32x2*)(UT + tk * XROW + (q * 32 + c0) * 2);
                const f32x4 uu = (f32x4){bflo(uw.x), bfhi(uw.x), bflo(uw.y), bfhi(uw.y)};
                const f32x4 ra = acc[nb2] + *(const LAS f32x4*)(EP + c0), rx = acc[nb2 + 2] + *(const LAS f32x4*)(EP + 32 + c0), sp8 = *(const LAS f32x4*)(EP + 64 + c0);
#pragma unroll
                for (int e = 0; e < 4; ++e) { const float r = fast_sigmoid(ra[e]), ig = fast_sigmoid(rx[e]);
                    const float av = __builtin_amdgcn_exp2f(-r * sp8[e]);
                    const float m2 = __builtin_fmaxf(__builtin_fmaf(-av, av, 1.0f), 0.f);
                    AT[(c0 + e) * CROW + tk] = av; VT[(c0 + e) * CROW + tk] = __builtin_amdgcn_sqrtf(m2) * (ig * uu[e]); }
            }
        }
        LDS_BARRIER();
        {
            const f32x4 a0 = *(const LAS f32x4*)(AT + sc_c * CROW + sc_sg * 8), a1 = *(const LAS f32x4*)(AT + sc_c * CROW + sc_sg * 8 + 4);
            const f32x4 v0 = *(const LAS f32x4*)(VT + sc_c * CROW + sc_sg * 8), v1 = *(const LAS f32x4*)(VT + sc_c * CROW + sc_sg * 8 + 4);
            const float av[8] = {a0.x, a0.y, a0.z, a0.w, a1.x, a1.y, a1.z, a1.w}, vv[8] = {v0.x, v0.y, v0.z, v0.w, v1.x, v1.y, v1.z, v1.w};
            float hl[8], pp[8]; float hcur = 0.f, pcur = 1.f;
#pragma unroll
            for (int j = 0; j < 8; ++j) { hcur = __builtin_fmaf(av[j], hcur, vv[j]); pcur *= av[j]; hl[j] = hcur; pp[j] = pcur; }
            float P = pcur, H = hcur;
            { float Pp = dpp_row_shr<1>(1.f, P), Hp = dpp_row_shr<1>(0.f, H); H = __builtin_fmaf(P, Hp, H); P *= Pp;
              Pp = dpp_row_shr<2>(1.f, P); Hp = dpp_row_shr<2>(0.f, H); H = __builtin_fmaf(P, Hp, H); P *= Pp;
              Pp = dpp_row_shr<4>(1.f, P); Hp = dpp_row_shr<4>(0.f, H); H = __builtin_fmaf(P, Hp, H); P *= Pp;
              Pp = dpp_row_shr<8>(1.f, P); Hp = dpp_row_shr<8>(0.f, H); H = __builtin_fmaf(P, Hp, H); P *= Pp; }
            const float Pe = dpp_row_shr<1>(1.f, P), He = dpp_row_shr<1>(0.f, H);
            const float carry = __builtin_fmaf(Pe, hcar, He);
            const float hend = __builtin_fmaf(P, hcar, H);
            hcar = row_last_(hend);
            const u32x4 gq = *(const LAS u32x4*)(GT + sc_c * XROW + sc_sg * 16);
            const float gvv[8] = {bflo(gq.x), bfhi(gq.x), bflo(gq.y), bfhi(gq.y), bflo(gq.z), bfhi(gq.z), bflo(gq.w), bfhi(gq.w)};
            float yy[8];
#pragma unroll
            for (int j = 0; j < 8; ++j) { const float hv = __builtin_fmaf(pp[j], carry, hl[j]); yy[j] = hv * gvv[j] * fast_sigmoid(gvv[j]); }
            u32x4 yw_; yw_.x = pk2(yy[0], yy[1]); yw_.y = pk2(yy[2], yy[3]); yw_.z = pk2(yy[4], yy[5]); yw_.w = pk2(yy[6], yy[7]);
            *(LAS u32x4*)(YT + sc_c * XROW + sc_sg * 16) = yw_;
        }
#pragma unroll
        for (int i = 0; i < 4; ++i) { const int id = tid + 512 * i, row = id >> 4, cc = id & 15; *(LAS u32x4*)(XT + (3 + row) * XROW + cc * 16) = pf[i]; }
        if (tid < 48) *(LAS u32x4*)(XT + (tid >> 4) * XROW + (tid & 15) * 16) = pfh;
    }
    LDS_BARRIER();
    {
        unsigned short yv_[8];
#pragma unroll
        for (int e = 0; e < 8; ++e) yv_[e] = *(const LAS unsigned short*)(YT + (io_cq * 8 + e) * XROW + io_tk * 2);
        u32x4 w; w.x = yv_[0] | ((unsigned)yv_[1] << 16); w.y = yv_[2] | ((unsigned)yv_[3] << 16); w.z = yv_[4] | ((unsigned)yv_[5] << 16); w.w = yv_[6] | ((unsigned)yv_[7] << 16);
        *(u32x4*)(y_base + (size_t)(SEQ - 128 + io_tk) * DMIX + io_cq * 8) = w;
    }
    LDS_BARRIER();
}

constexpr int PROW = 528;
constexpr int R_XP = 0, R_PT = 42240;
__device__ __forceinline__ void pool_units(const Args& a, int l, int u, LAS unsigned char* lds) {
    const int tid = opaque_tid(), lane = tid & 63, wv = tid >> 6, fr = lane & 15, fq = lane >> 4;
    const int g = u & 3, bi = u >> 2, win = 2 << g;
    const bf16* PROJ = (const bf16*)(a.ws + WS_PROJ); bf16* YCAT = (bf16*)(a.ws + WS_YCAT);
    LAS unsigned char* XP = lds + R_XP; LAS unsigned char* PT = lds + R_PT;
    const bf16* pw = (const bf16*)(a.ws + WS_PW) + (size_t)(l * 4 + g) * 256 * 256;
    bf16x8 Wf[2][8];
#pragma unroll
    for (int nb = 0; nb < 2; ++nb)
#pragma unroll
        for (int kb = 0; kb < 8; ++kb) Wf[nb][kb] = *(const bf16x8*)(pw + (size_t)(wv * 32 + 8 * (fr >> 2) + 4 * nb + (fr & 3)) * 256 + kb * 32 + fq * 8);
    f32x4 pb[2], ps[2];
#pragma unroll
    for (int nb = 0; nb < 2; ++nb) { const int n = wv * 32 + 8 * fq + 4 * nb;
        pb[nb] = *(const f32x4*)(a.in[14] + (size_t)l * 1024 + g * 256 + n); ps[nb] = *(const f32x4*)(a.in[15] + (size_t)l * 1024 + g * 256 + n); }
    const int ck = tid & 31, tg = tid >> 5;
    u32x4 pf[5];
    {
        const int tile = bi * 8, b = tile >> 6, t0 = (tile & 63) * 64;
        const bf16* xp_base = PROJ + (size_t)(b * SEQ) * NPROJ + 2048 + g * 256;
#pragma unroll
        for (int i = 0; i < 5; ++i) { const int id = tid + 512 * i, row = id >> 5, cc = id & 31, t = t0 - 16 + row;
            const u32x4 v = *(const u32x4*)(xp_base + (size_t)(t < 0 ? 0 : t) * NPROJ + cc * 8); pf[i] = (t < 0) ? (u32x4){0u, 0u, 0u, 0u} : v; }
    }
#pragma unroll
    for (int i = 0; i < 5; ++i) { const int id = tid + 512 * i, row = id >> 5, cc = id & 31; *(LAS u32x4*)(XP + row * PROW + cc * 16) = pf[i]; }
    u32x4 gp[4];
    {
        const int tile = bi * 8, b = tile >> 6, t0 = (tile & 63) * 64;
        const bf16* gp_base0 = PROJ + (size_t)(b * SEQ) * NPROJ + 3072 + g * 256;
#pragma unroll
        for (int tb = 0; tb < 4; ++tb)
        { gp[tb] = *(const u32x4*)(gp_base0 + (size_t)(t0 + tb * 16 + fr) * NPROJ + wv * 32 + 8 * fq);
                asm volatile("" : "+v"(gp[tb])); }
    }
    for (int it = 0; it < 8; ++it) {
        const int tile = bi * 8 + it, b = tile >> 6, t0 = (tile & 63) * 64;
        bf16* y_base = YCAT + (size_t)(b * SEQ) * DMIX + 1024 + g * 256;
        LDS_BARRIER();
        {
            const int tile2 = bi * 8 + ((it + 1 < 8) ? it + 1 : it), b2 = tile2 >> 6, t02 = (tile2 & 63) * 64;
            const bf16* xp_base = PROJ + (size_t)(b2 * SEQ) * NPROJ + 2048 + g * 256;
#pragma unroll
            for (int i = 0; i < 5; ++i) { const int id = tid + 512 * i, row = id >> 5, cc = id & 31, t = t02 - 16 + row;
                const u32x4 v = *(const u32x4*)(xp_base + (size_t)(t < 0 ? 0 : t) * NPROJ + cc * 8); pf[i] = (t < 0) ? (u32x4){0u, 0u, 0u, 0u} : v; }
        }
        u32x4 gpn[4];
        {
            const int tile2 = bi * 8 + ((it + 1 < 8) ? it + 1 : it), b2 = tile2 >> 6, t02 = (tile2 & 63) * 64;
            const bf16* gp_base2 = PROJ + (size_t)(b2 * SEQ) * NPROJ + 3072 + g * 256;
#pragma unroll
            for (int tb = 0; tb < 4; ++tb)
                gpn[tb] = *(const u32x4*)(gp_base2 + (size_t)(t02 + tb * 16 + fr) * NPROJ + wv * 32 + 8 * fq);
        }
        {
            float s[8];
#pragma unroll
            for (int e = 0; e < 8; ++e) s[e] = 0.f;
            const int r0 = tg * 4 + 16;
            for (int r = r0 - win + 1; r < r0; ++r) { const u32x4 w = *(const LAS u32x4*)(XP + r * PROW + ck * 16);
                s[0] += bflo(w.x); s[1] += bfhi(w.x); s[2] += bflo(w.y); s[3] += bfhi(w.y); s[4] += bflo(w.z); s[5] += bfhi(w.z); s[6] += bflo(w.w); s[7] += bfhi(w.w); }
#pragma unroll
            for (int i = 0; i < 4; ++i) {
                const u32x4 w = *(const LAS u32x4*)(XP + (r0 + i) * PROW + ck * 16);
                const float xv[8] = {bflo(w.x), bfhi(w.x), bflo(w.y), bfhi(w.y), bflo(w.z), bfhi(w.z), bflo(w.w), bfhi(w.w)};
                const int t = t0 + tg * 4 + i; const float inv = __builtin_amdgcn_rcpf((float)((t + 1 < win) ? (t + 1) : win));
                float p[8];
#pragma unroll
                for (int e = 0; e < 8; ++e) { s[e] += xv[e]; p[e] = __builtin_fmaf(s[e], inv, -xv[e]); }
                u32x4 o; o.x = pk2(p[0], p[1]); o.y = pk2(p[2], p[3]); o.z = pk2(p[4], p[5]); o.w = pk2(p[6], p[7]);
                *(LAS u32x4*)(PT + (tg * 4 + i) * PROW + ck * 16) = o;
                const u32x4 wo = *(const LAS u32x4*)(XP + (r0 + i - win + 1) * PROW + ck * 16);
                s[0] -= bflo(wo.x); s[1] -= bfhi(wo.x); s[2] -= bflo(wo.y); s[3] -= bfhi(wo.y); s[4] -= bflo(wo.z); s[5] -= bfhi(wo.z); s[6] -= bflo(wo.w); s[7] -= bfhi(wo.w);
            }
        }
        LDS_BARRIER();
#pragma unroll
        for (int tb = 0; tb < 4; ++tb) {
            f32x4 acc[2] = {(f32x4){0.f, 0.f, 0.f, 0.f}, (f32x4){0.f, 0.f, 0.f, 0.f}};
#pragma unroll
            for (int kb = 0; kb < 8; ++kb) { const bf16x8 pfm = *(const LAS bf16x8*)(PT + (tb * 16 + fr) * PROW + kb * 64 + fq * 16);
#pragma unroll
                for (int nb = 0; nb < 2; ++nb) acc[nb] = __builtin_amdgcn_mfma_f32_16x16x32_bf16(Wf[nb][kb], pfm, acc[nb], 0, 0, 0); }
            const int t = t0 + tb * 16 + fr;
            u32x4 o;
#pragma unroll
            for (int nb = 0; nb < 2; ++nb) {
                const unsigned g0 = nb ? gp[tb].z : gp[tb].x, g1 = nb ? gp[tb].w : gp[tb].y;
                const f32x4 gv = (f32x4){bflo(g0), bfhi(g0), bflo(g1), bfhi(g1)};
                f32x4 r = (acc[nb] + pb[nb]) * ps[nb];
#pragma unroll
                for (int e = 0; e < 4; ++e) r[e] *= gv[e] * fast_sigmoid(gv[e]);
                if (nb == 0) { o.x = pk2(r.x, r.y); o.y = pk2(r.z, r.w); } else { o.z = pk2(r.x, r.y); o.w = pk2(r.z, r.w); } }
            *(u32x4*)(y_base + (size_t)t * DMIX + wv * 32 + 8 * fq) = o;
        }
#pragma unroll
        for (int i = 0; i < 5; ++i) { const int id = tid + 512 * i, row = id >> 5, cc = id & 31; *(LAS u32x4*)(XP + row * PROW + cc * 16) = pf[i]; }
#pragma unroll
        for (int tb = 0; tb < 4; ++tb)
            gp[tb] = gpn[tb];
    }
    LDS_BARRIER();
}

__device__ __forceinline__ void phase_mixer(const Args& a, int l, LAS unsigned char* lds) {
#ifndef MK_MIX
#define MK_MIX 3
#endif
#ifndef MK_DBL_RNN
#define MK_DBL_RNN 0
#endif
#ifndef MK_DBL_POOL
#define MK_DBL_POOL 0
#endif
    for (int rep = 0; rep < 1 + ((l == 0) ? MK_DBL_RNN : 0); ++rep) for (int u = blockIdx.x; u < 256; u += gridDim.x) rnn_unit(a, l, u, lds);
    for (int rep = 0; rep < 1 + ((l == 0) ? MK_DBL_POOL : 0); ++rep) for (int u = blockIdx.x; u < 256; u += gridDim.x) pool_units(a, l, u, lds);
}
#ifndef MK_DBL_PH
#define MK_DBL_PH -1
#endif
#ifndef MK_MASK
#define MK_MASK 63
#endif
__global__ void __launch_bounds__(512, 2) mk_fwd(Args a) {
    extern __shared__ __attribute__((aligned(16))) unsigned char lds_raw[];
    LAS unsigned char* lds = (LAS unsigned char*)lds_raw;
    cg::grid_group grid = cg::this_grid();
    volatile LAS unsigned* bst = (volatile LAS unsigned*)(lds + LDS_BST_OFF);
    if (threadIdx.x < 4) bst[threadIdx.x] = 0u;
    sync_threads_();
    XcdBarrier xbar = xcd_barrier_post((unsigned*)(a.ws + WS_CTL), bst);
#define GRID_BAR() do { if (a.ph_hi - a.ph_lo > 64) grid.sync(); else xcd_barrier(xbar); } while (0)
    for (int ph = a.ph_lo; ph < a.ph_hi; ++ph) {
#if MK_DBL_PH >= 0
      for (int rep = 0; rep < ((ph == MK_DBL_PH) ? 2 : 1); ++rep) {
        if (rep) GRID_BAR();
#endif
        if (ph == 0) { if (MK_MASK & 1) phase_prep(a, lds); }
        else if (ph == 1) { if (MK_MASK & 2) phase_h0(a); }
        else {
            const int l = (ph - 2) >> 2, sub = (ph - 2) & 3;
            if (sub == 0) { if (MK_MASK & 4) {
                pg8::Gemm g{(const pg8::bf16_t*)(a.ws + WS_H), (const pg8::bf16_t*)(a.ws + WS_WIN) + (size_t)l * NPROJ * D, T, NPROJ, D};
                pg8::StaticOrder S; S.init(T, NPROJ, gridDim.x, (int)blockIdx.x);
                pg8::EpiBf16<0> E{(pg8::bf16_t*)(a.ws + WS_PROJ), NPROJ, nullptr, 0, 0, 1.f};
                pg8::gemm_phase<pg8::EpiBf16<0>, pg8::StaticOrder, PG8_ALIGN, PG8_SP2>(lds, g, S, E); }
            } else if (sub == 1) {
                if (MK_MASK & 8) phase_mixer(a, l, lds);
            } else if (sub == 2) { if (MK_MASK & 16) {
                pg8::Gemm g{(const pg8::bf16_t*)(a.ws + WS_YCAT), (const pg8::bf16_t*)(a.ws + WS_WOUT) + (size_t)l * D * DMIX, T, D, DMIX};
                pg8::StaticOrder S; S.init(T, D, gridDim.x, (int)blockIdx.x);
                pg8::EpiBf16<0> E{(pg8::bf16_t*)(a.ws + WS_Y), D, nullptr, 0, 0, 1.f};
                pg8::gemm_phase<pg8::EpiBf16<0>, pg8::StaticOrder, PG8_ALIGN, PG8_SP2>(lds, g, S, E); }
            } else {
                if (MK_MASK & 32) phase_post(a, l);
            }
        }
#if MK_DBL_PH >= 0
      }
#endif
        if (ph + 1 < a.ph_hi) GRID_BAR();
    }
}

#if defined(__HIP_DEVICE_COMPILE__)
#pragma clang attribute pop
#endif

extern "C" void kernel_launch(void* const* d_in, const int* in_sizes, int n_in, void* d_out, int out_size, void* d_ws, size_t ws_size, hipStream_t stream) {
    static int grid = 0;
    if (grid == 0) {
        if (n_in != 18 || in_sizes[0] != T * D || out_size != T * D || ws_size < WS_END) {
            fprintf(stderr, "kernel_launch: unexpected shapes (n_in %d, in0 %d, out %d, ws %zu); nothing launched\n", n_in, n_in > 0 ? in_sizes[0] : -1, out_size, ws_size); grid = -1; return; }
        int dev = 0, cus = 0, per_cu = 0;
        if (hipGetDevice(&dev) != hipSuccess || hipDeviceGetAttribute(&cus, hipDeviceAttributeMultiprocessorCount, dev) != hipSuccess) { grid = -1; return; }
        if (hipFuncSetAttribute((const void*)mk_fwd, hipFuncAttributeMaxDynamicSharedMemorySize, LDS_BYTES) != hipSuccess) { fprintf(stderr, "kernel_launch: hipFuncSetAttribute failed\n"); grid = -1; return; }
        if (hipOccupancyMaxActiveBlocksPerMultiprocessor(&per_cu, (const void*)mk_fwd, 512, LDS_BYTES) != hipSuccess || per_cu < 1) { fprintf(stderr, "kernel_launch: occupancy query says %d blocks per CU\n", per_cu); per_cu = 1; }
        (void)hipGetLastError();
        grid = cus;
    }
    if (grid < 0) return;
    Args a{};
    for (int i = 0; i < 18; ++i) a.in[i] = (const float*)d_in[i];
    a.out = (float*)d_out; a.ws = (unsigned char*)d_ws;
    if (hipMemsetAsync((char*)d_ws + WS_CTL, 0, CTL_BYTES, stream) != hipSuccess) { fprintf(stderr, "kernel_launch: memset of the barrier words failed\n"); return; }
#if MK_N_LAUNCHES == 1
    a.ph_lo = 0; a.ph_hi = NPH;
    void* args[] = {&a};
    const hipError_t e = hipLaunchCooperativeKernel((const void*)mk_fwd, dim3(grid), dim3(512), args, LDS_BYTES, stream);
    if (e != hipSuccess) fprintf(stderr, "kernel_launch: cooperative launch failed: %s (grid %d)\n", hipGetErrorString(e), grid);
#else
    for (int ph = 0; ph < NPH; ++ph) {
        a.ph_lo = ph; a.ph_hi = ph + 1;
        hipLaunchKernelGGL(mk_fwd, dim3(grid), dim3(512), LDS_BYTES, stream, a);
    }
#endif
}
```

```cpp
#include <hip/hip_runtime.h>
#include <hip/hip_cooperative_groups.h>
#include <cstdio>
#include <cstdint>
namespace cg = cooperative_groups;
__device__ __forceinline__ int opaque_tid() { int t = threadIdx.x; asm volatile("" : "+v"(t)); return t; }
#if defined(__HIP_DEVICE_COMPILE__)
#pragma clang attribute push (__attribute__((target("no-packed-fp32-ops"))), apply_to = function)
#endif
__device__ __forceinline__ float u2f(unsigned x) { return __builtin_bit_cast(float, x); }
__device__ __forceinline__ float i2f(int x) { return __builtin_bit_cast(float, x); }
__device__ __forceinline__ int f2i(float x) { return __builtin_bit_cast(int, x); }
__device__ __forceinline__ int lane_id_() { return (int)__builtin_amdgcn_mbcnt_hi(~0u, __builtin_amdgcn_mbcnt_lo(~0u, 0u)); }
__device__ __forceinline__ float shfl_xor_(float v, int o) { return i2f(__builtin_amdgcn_ds_bpermute((lane_id_() ^ o) << 2, f2i(v))); }
__device__ __forceinline__ float row_last_(float v) { return i2f(__builtin_amdgcn_ds_bpermute((lane_id_() | 15) << 2, f2i(v))); }
__device__ __forceinline__ void sync_threads_() { __builtin_amdgcn_fence(__ATOMIC_RELEASE, "workgroup"); __builtin_amdgcn_s_barrier(); __builtin_amdgcn_fence(__ATOMIC_ACQUIRE, "workgroup"); }
namespace pg8 {
#define PG8_LAS __attribute__((address_space(3)))
typedef unsigned short bf16_t;
typedef short bf16x8 __attribute__((ext_vector_type(8)));
typedef float f32x4 __attribute__((ext_vector_type(4)));
typedef unsigned u32x4 __attribute__((ext_vector_type(4)));
constexpr int BM = 256, BK = 64, HALF = 128, HTB = HALF * BK * 2  , STAGE_BYTES = 8 * HTB, NXCD = 8, WGM = 8;

__host__ __device__ __forceinline__ int lds_byte(int r, int c) { const int st = (r >> 4) * 2 + (c >> 5), rr = r & 15, cc = c & 31, ob = rr * 64 + cc * 2; return st * 1024 + (ob ^ (((ob >> 9) & 1) << 5)); }
__host__ __device__ __forceinline__ void stage_rc(int b, int& R, int& C) { const int st = b / 1024, sb = b % 1024, swz = sb ^ (((sb >> 9) & 1) << 5); R = (st >> 1) * 16 + swz / 64; C = (st & 1) * 32 + (swz % 64) / 2; }
__host__ __device__ __forceinline__ int perm32(int rho) { const int n = rho >> 4, i = rho & 15; return 8 * (i >> 2) + 4 * n + (i & 3); }

struct Unit { int pm, pn; };
struct Gemm { const bf16_t* A; const bf16_t* Bt; int M, N, K; };

struct StaticOrder {
    int nM, nN, nwg, G, c;
    __host__ __device__ void init(int M, int N, int G_, int c_) { nM = M / BM; nN = N / BM; nwg = nM * nN; G = G_; c = c_; }
    __host__ __device__ bool next(int i, Unit& u) const {
        const long L = (long)i * G + c; if (L >= nwg) return false;
        int wgid = (int)L; { const int q = nwg / NXCD, r = nwg % NXCD, xcd = wgid % NXCD, off = wgid / NXCD; wgid = (xcd < r ? xcd * (q + 1) : r * (q + 1) + (xcd - r) * q) + off; }
        const int nig = WGM * nN, gid = wgid / nig, fm = gid * WGM, gsz = (nM - fm) < WGM ? (nM - fm) : WGM;
        u.pm = fm + ((wgid % nig) % gsz); u.pn = (wgid % nig) / gsz; return true;
    }
    __device__ __forceinline__ void a_ready(const Unit&) const {}
    __device__ __forceinline__ void done(const Unit&) const {}
};

__device__ __forceinline__ unsigned cvt_pk_bf16(float lo, float hi) { unsigned r; asm volatile("v_cvt_pk_bf16_f32 %0, %1, %2" : "=v"(r) : "v"(lo), "v"(hi)); return r; }
typedef float f32x2 __attribute__((ext_vector_type(2)));
__device__ __forceinline__ f32x2 gelu_pk(f32x2 v) {
    const f32x2 av = __builtin_elementwise_abs(v), d = av * 0.2316418882f + 1.0f;
    f32x2 t; t.x = __builtin_amdgcn_rcpf(d.x); t.y = __builtin_amdgcn_rcpf(d.y);
    f32x2 q = t * 0.5307027145f + (-0.7265760135f); q = q * t + 0.7107068705f; q = q * t + (-0.142248368f); q = q * t + 0.127414796f; q = q * t;
    const f32x2 s = (v * v) * (-0.72134752044f);
    f32x2 e; e.x = __builtin_amdgcn_exp2f(s.x); e.y = __builtin_amdgcn_exp2f(s.y);
    const f32x2 m = v * (q * e), r = v - m;
    f32x2 o; o.x = v.x < 0.f ? m.x : r.x; o.y = v.y < 0.f ? m.y : r.y; return o;
}

template <int ACT  > struct EpiBf16 {
    static constexpr bool PERM = true, AFTER_DRAIN = false; static_assert(ACT == 0 || ACT == 1, "EpiBf16: ACT is 0 (none) or 1 (gelu_pk)");
    bf16_t* O; int ldc; const float* bias; int split_cols; size_t split_stride; float scale0;
    __device__ __forceinline__ void operator()(const f32x4 (&acc)[2][2][4][2], const Unit& u, int wr, int wc, int fr, int fq) const {
        const int row0 = u.pm * BM + wr * 64 + fr; int colt = u.pn * BM; bf16_t* base = O;
        float sc = 1.f; if (split_cols) { const int t = colt / split_cols; base += (size_t)t * split_stride; colt -= t * split_cols; if (t == 0) sc = scale0; }
        const int col0 = colt + wc * 32 + 8 * fq, bcol0 = u.pn * BM + wc * 32 + 8 * fq;
        f32x4 bv[2][2];
#pragma unroll
        for (int bj = 0; bj < 2; ++bj)
#pragma unroll
            for (int n = 0; n < 2; ++n) bv[bj][n] = bias ? *(const f32x4*)(bias + bcol0 + bj * HALF + 4 * n) : (f32x4){0.f, 0.f, 0.f, 0.f};
#pragma unroll
        for (int ai = 0; ai < 2; ++ai)
#pragma unroll
            for (int m = 0; m < 4; ++m) { bf16_t* rowp = base + (size_t)(row0 + ai * HALF + m * 16) * ldc + col0;
#pragma unroll
                for (int bj = 0; bj < 2; ++bj) { f32x4 v0 = acc[ai][bj][m][0] + bv[bj][0], v1 = acc[ai][bj][m][1] + bv[bj][1];
                    if (ACT == 1) { f32x2 a = gelu_pk((f32x2){v0[0], v0[1]}), b = gelu_pk((f32x2){v0[2], v0[3]}), c = gelu_pk((f32x2){v1[0], v1[1]}), d = gelu_pk((f32x2){v1[2], v1[3]});
                        v0 = (f32x4){a.x, a.y, b.x, b.y}; v1 = (f32x4){c.x, c.y, d.x, d.y}; }
                    v0 = v0 * sc; v1 = v1 * sc; u32x4 w; w.x = cvt_pk_bf16(v0[0], v0[1]); w.y = cvt_pk_bf16(v0[2], v0[3]); w.z = cvt_pk_bf16(v1[0], v1[1]); w.w = cvt_pk_bf16(v1[2], v1[3]);
                    *(u32x4*)(rowp + bj * HALF) = w; } }
    }
};
template <class Epi, class Sched, bool ALIGN_EPI = false, bool SP2 = false>
__device__ __forceinline__ void gemm_phase(PG8_LAS unsigned char* lds, const Gemm g, const Sched& S, const Epi& E) {
    const int tid = opaque_tid(), wid = __builtin_amdgcn_readfirstlane(tid >> 6), lane = tid & 63, wr = wid >> 2, wc = wid & 3, fr = lane & 15, fq = lane >> 4;
    const int K = g.K, nt = K / BK;
    unsigned voffA[2], voffB[2];
#pragma unroll
    for (int i = 0; i < 2; ++i) { int R, C; stage_rc(tid * 16 + i * 8192, R, C); const int Rb = Epi::PERM ? ((R & ~31) + perm32(R & 31)) : R;
        voffA[i] = (unsigned)(R * K + C) * 2u; voffB[i] = (unsigned)(Rb * K + C) * 2u; }
    const size_t kstep = (size_t)(BK * 2);
    const size_t hstep = (size_t)HALF * K * 2;
    const size_t tstep = 2 * hstep;
    const unsigned ldsw = (unsigned)wid * 1024u;
    const int aoff = lds_byte(wr * 64 + fr, fq * 8), boff = lds_byte(wc * 32 + fr, fq * 8);
#define PG8_SA(b, h) (((b) * 2 + (h)) * HTB)
#define PG8_SB(b, h) ((4 + (b) * 2 + (h)) * HTB)
#define PG8_STAGE(bufoff, gbase, voff) do { _Pragma("unroll") for (int _i = 0; _i < 2; ++_i) \
        __builtin_amdgcn_global_load_lds((const unsigned*)((const char*)(gbase) + (voff)[_i]), (PG8_LAS unsigned*)(lds + (bufoff) + ldsw + _i * 8192), 16, 0, 0); } while (0)
#define PG8_LDA(dst, b, h) do { _Pragma("unroll") for (int m = 0; m < 4; ++m) _Pragma("unroll") for (int k = 0; k < 2; ++k) dst[m][k] = *(const PG8_LAS bf16x8*)(lds + PG8_SA(b, h) + aoff + m * 2048 + k * 1024); } while (0)
#define PG8_LDB(dst, b, h) do { _Pragma("unroll") for (int n = 0; n < 2; ++n) _Pragma("unroll") for (int k = 0; k < 2; ++k) dst[n][k] = *(const PG8_LAS bf16x8*)(lds + PG8_SB(b, h) + boff + n * 2048 + k * 1024); } while (0)
#define PG8_MMA(ai, bj, At, Bt) do { __builtin_amdgcn_s_setprio(1); _Pragma("unroll") for (int m = 0; m < 4; ++m) _Pragma("unroll") for (int n = 0; n < 2; ++n) _Pragma("unroll") for (int k = 0; k < 2; ++k) \
        acc[ai][bj][m][n] = __builtin_amdgcn_mfma_f32_16x16x32_bf16(Bt[n][k], At[m][k], acc[ai][bj][m][n], 0, 0, 0); __builtin_amdgcn_s_setprio(0); } while (0)
#define PG8_WAIT_V(n) asm volatile("s_waitcnt vmcnt(" #n ")" ::: "memory")
#define PG8_WAIT_L(n) asm volatile("s_waitcnt lgkmcnt(" #n ")" ::: "memory")
#define PG8_BAR __builtin_amdgcn_s_barrier()
#define PG8_SCHED __builtin_amdgcn_sched_barrier(0)
    Unit cur, nxt; int ui = 0;
    if (!S.next(0, cur)) return;
    f32x4 acc[2][2][4][2];
#pragma unroll
    for (int a = 0; a < 2; ++a)
#pragma unroll
        for (int b = 0; b < 2; ++b)
#pragma unroll
            for (int m = 0; m < 4; ++m)
#pragma unroll
                for (int n = 0; n < 2; ++n) acc[a][b][m][n] = (f32x4){0.f, 0.f, 0.f, 0.f};
    bf16x8 At[4][2], B0[2][2], B1[2][2];
    const char* cA = (const char*)g.A + (size_t)cur.pm * tstep; const char* cB = (const char*)g.Bt + (size_t)cur.pn * tstep;
    S.a_ready(cur);
    if constexpr (SP2) {
        PG8_STAGE(PG8_SB(0, 0), cB, voffB); PG8_STAGE(PG8_SB(0, 1), cB + hstep, voffB); PG8_STAGE(PG8_SA(0, 0), cA, voffA); PG8_STAGE(PG8_SA(0, 1), cA + hstep, voffA);
        if (wr == 1) PG8_BAR;
        PG8_WAIT_V(2); PG8_BAR;
        PG8_STAGE(PG8_SB(1, 0), cB + kstep, voffB); PG8_STAGE(PG8_SA(1, 0), cA + kstep, voffA); PG8_STAGE(PG8_SB(1, 1), cB + hstep + kstep, voffB);
        PG8_WAIT_V(6); PG8_BAR;
    } else {
        PG8_STAGE(PG8_SB(0, 0), cB, voffB); PG8_STAGE(PG8_SA(0, 0), cA, voffA); PG8_STAGE(PG8_SB(0, 1), cB + hstep, voffB); PG8_STAGE(PG8_SA(0, 1), cA + hstep, voffA);
        if (wr == 1) PG8_BAR;
        PG8_WAIT_V(4); PG8_BAR;
        PG8_STAGE(PG8_SB(1, 0), cB + kstep, voffB); PG8_STAGE(PG8_SA(1, 0), cA + kstep, voffA); PG8_STAGE(PG8_SB(1, 1), cB + hstep + kstep, voffB);
        PG8_WAIT_V(6); PG8_BAR;
    }
    for (;;) {
        const bool has_next = S.next(ui + 1, nxt);
        const char* nA = has_next ? (const char*)g.A + (size_t)nxt.pm * tstep : cA; const char* nB = has_next ? (const char*)g.Bt + (size_t)nxt.pn * tstep : cB;
        for (int t = 0; t < nt; t += 2) {
            const bool last = (t == nt - 2);
            const char* a1 = cA + (size_t)(t + 1) * kstep;
            const char* a2 = last ? nA : cA + (size_t)(t + 2) * kstep; const char* b2 = last ? nB : cB + (size_t)(t + 2) * kstep;
            const char* a3 = a2 + kstep; const char* b3 = b2 + kstep;
            if (last && has_next) S.a_ready(nxt);
            if constexpr (SP2) {
            PG8_LDB(B0, 0, 0); PG8_LDB(B1, 0, 1); PG8_SCHED; PG8_LDA(At, 0, 0); PG8_STAGE(PG8_SA(1, 1), a1 + hstep, voffA);
            PG8_WAIT_V(8); PG8_WAIT_L(0); PG8_BAR; PG8_MMA(0, 0, At, B0); PG8_MMA(0, 1, At, B1); PG8_BAR; PG8_SCHED;
            PG8_LDA(At, 0, 1); PG8_STAGE(PG8_SB(0, 0), b2, voffB); PG8_STAGE(PG8_SB(0, 1), b2 + hstep, voffB); PG8_STAGE(PG8_SA(0, 0), a2, voffA);
            PG8_WAIT_V(8); PG8_WAIT_L(0); PG8_BAR; PG8_MMA(1, 0, At, B0); PG8_MMA(1, 1, At, B1); PG8_BAR; PG8_SCHED;
            PG8_LDB(B0, 1, 0); PG8_LDB(B1, 1, 1); PG8_SCHED; PG8_LDA(At, 1, 0); PG8_STAGE(PG8_SA(0, 1), a2 + hstep, voffA);
            PG8_WAIT_V(8); PG8_WAIT_L(0); PG8_BAR; PG8_MMA(0, 0, At, B0); PG8_MMA(0, 1, At, B1); PG8_BAR; PG8_SCHED;
            PG8_LDA(At, 1, 1); PG8_STAGE(PG8_SB(1, 0), b3, voffB); PG8_STAGE(PG8_SB(1, 1), b3 + hstep, voffB); PG8_STAGE(PG8_SA(1, 0), a3, voffA);
            PG8_WAIT_V(8); PG8_WAIT_L(0); PG8_BAR; PG8_MMA(1, 0, At, B0); PG8_MMA(1, 1, At, B1); PG8_BAR; PG8_SCHED;
            } else {
            PG8_LDB(B0, 0, 0); PG8_SCHED; PG8_LDA(At, 0, 0); PG8_STAGE(PG8_SA(1, 1), a1 + hstep, voffA);
            PG8_WAIT_L(8); PG8_BAR; PG8_WAIT_L(0); PG8_MMA(0, 0, At, B0); PG8_BAR; PG8_SCHED;
            PG8_LDB(B1, 0, 1); PG8_STAGE(PG8_SB(0, 0), b2, voffB);
            PG8_BAR; PG8_WAIT_L(0); PG8_MMA(0, 1, At, B1); PG8_BAR;
            PG8_LDA(At, 0, 1); PG8_STAGE(PG8_SA(0, 0), a2, voffA);
            PG8_BAR; PG8_WAIT_L(0); PG8_MMA(1, 0, At, B0); PG8_BAR; PG8_SCHED;
            PG8_STAGE(PG8_SB(0, 1), b2 + hstep, voffB);
            PG8_WAIT_V(6); PG8_BAR; PG8_MMA(1, 1, At, B1); PG8_BAR;
            PG8_LDB(B0, 1, 0); PG8_SCHED; PG8_LDA(At, 1, 0); PG8_STAGE(PG8_SA(0, 1), a2 + hstep, voffA);
            PG8_WAIT_L(8); PG8_BAR; PG8_WAIT_L(0); PG8_MMA(0, 0, At, B0); PG8_BAR; PG8_SCHED;
            PG8_LDB(B1, 1, 1); PG8_STAGE(PG8_SB(1, 0), b3, voffB);
            PG8_BAR; PG8_WAIT_L(0); PG8_MMA(0, 1, At, B1); PG8_BAR;
            PG8_LDA(At, 1, 1); PG8_STAGE(PG8_SA(1, 0), a3, voffA);
            PG8_BAR; PG8_WAIT_L(0); PG8_MMA(1, 0, At, B0); PG8_BAR; PG8_SCHED;
            PG8_STAGE(PG8_SB(1, 1), b3 + hstep, voffB);
            PG8_WAIT_V(6); PG8_BAR; PG8_MMA(1, 1, At, B1); PG8_BAR;
            }
        }
        if constexpr (ALIGN_EPI) { if (wr == 0) PG8_BAR; }
        if constexpr (!Epi::AFTER_DRAIN) { E(acc, cur, wr, wc, fr, fq); S.done(cur); }
        if (!has_next) break;
#pragma unroll
        for (int a = 0; a < 2; ++a)
#pragma unroll
            for (int b = 0; b < 2; ++b)
#pragma unroll
                for (int m = 0; m < 4; ++m)
#pragma unroll
                    for (int n = 0; n < 2; ++n) acc[a][b][m][n] = (f32x4){0.f, 0.f, 0.f, 0.f};
        cur = nxt; cA = nA; cB = nB; ++ui;
        if constexpr (ALIGN_EPI) { if (wr == 1) PG8_BAR; }
    }
    PG8_WAIT_V(0);
    if constexpr (!ALIGN_EPI) { if (wr == 0) PG8_BAR; }
    PG8_BAR;
    if constexpr (Epi::AFTER_DRAIN) { E.fused(acc, cur, wr, wc, fr, fq, lds, wid, lane); S.done(cur); }
#undef PG8_SA
#undef PG8_SB
#undef PG8_STAGE
#undef PG8_LDA
#undef PG8_LDB
#undef PG8_MMA
#undef PG8_WAIT_V
#undef PG8_WAIT_L
#undef PG8_BAR
#undef PG8_SCHED
}
}
#ifndef PG8_SP2
#define PG8_SP2 true
#endif
#ifndef PG8_ALIGN
#define PG8_ALIGN true
#endif
#ifndef MK_N_LAUNCHES
#define MK_N_LAUNCHES 1
#endif

constexpr int NB = 8, SEQ = 4096, D = 1024, T = NB * SEQ, NPROJ = 4096, DMIX = 2048;
constexpr int NPH = 10;
constexpr float EPS = 1e-6f;
constexpr size_t MiB = 1u << 20;
constexpr size_t WS_WIN = 0, WS_WOUT = 16 * MiB, WS_GW = 24 * MiB, WS_PW = 25 * MiB, WS_MOD = 26 * MiB;
constexpr size_t WS_H = 32 * MiB, WS_YCAT = 96 * MiB, WS_PROJ = 224 * MiB, WS_Y = WS_PROJ, WS_U = WS_H, WS_END = 480 * MiB;
constexpr size_t WS_CTL = 28 * MiB, CTL_BYTES = 16384;
constexpr int LDS_BYTES = 147456, LDS_BST_OFF = 131072 + 64;

#define LAS __attribute__((address_space(3)))
typedef unsigned short bf16;
typedef float f32x4 __attribute__((ext_vector_type(4)));
typedef float f32x2 __attribute__((ext_vector_type(2)));
typedef unsigned u32x4 __attribute__((ext_vector_type(4)));
typedef unsigned u32x2 __attribute__((ext_vector_type(2)));
typedef short bf16x8 __attribute__((ext_vector_type(8)));

struct Args { const float* in[18]; float* out; unsigned char* ws; int ph_lo, ph_hi; };

__device__ __forceinline__ unsigned pk2(float lo, float hi) { return pg8::cvt_pk_bf16(lo, hi); }
__device__ __forceinline__ float bflo(unsigned w) { return u2f(w << 16); }
__device__ __forceinline__ float bfhi(unsigned w) { return u2f(w & 0xffff0000u); }
__device__ __forceinline__ float wave_sum(float v) {
#pragma unroll
    for (int o = 1; o < 64; o <<= 1) v += shfl_xor_(v, o);
    return v;
}
__device__ __forceinline__ float sigmoidf_(float x) { return 1.0f / (1.0f + __expf(-x)); }
__device__ __forceinline__ float siluf_(float x) { return x / (1.0f + __expf(-x)); }

__device__ __forceinline__ void transpose_tile(const float* W, int K, int N, bf16* WT, LAS float* scr, int k0, int n0, int drow, int lane, float wscale = 1.0f) {
    {
        f32x4 v[8];
#pragma unroll
        for (int i = 0; i < 8; ++i) v[i] = *(const f32x4*)(W + (size_t)(k0 + (lane >> 3) + 8 * i) * N + n0 + (lane & 7) * 4);
#pragma unroll
        for (int i = 0; i < 8; ++i) { LAS float* d = scr + ((lane >> 3) + 8 * i) * 33 + (lane & 7) * 4; d[0] = v[i].x * wscale; d[1] = v[i].y * wscale; d[2] = v[i].z * wscale; d[3] = v[i].w * wscale; }
    }
    asm volatile("s_waitcnt lgkmcnt(0)" ::: "memory");
    const int c = lane & 7;
#pragma unroll
    for (int j = 0; j < 4; ++j) { const int n = (lane >> 3) + 8 * j; const LAS float* s = scr + (8 * c) * 33 + n;
        u32x4 o; o.x = pk2(s[0 * 33], s[1 * 33]); o.y = pk2(s[2 * 33], s[3 * 33]); o.z = pk2(s[4 * 33], s[5 * 33]); o.w = pk2(s[6 * 33], s[7 * 33]);
        *(u32x4*)(WT + (size_t)(drow + n) * K + k0 + 8 * c) = o; }
    asm volatile("s_waitcnt lgkmcnt(0)" ::: "memory");
}
__device__ __forceinline__ void transpose_item(const float* W, int K, int N, bf16* WT, LAS float* scr, int item, int lane) {
    const int nblk = N / 32, kb = item / nblk, nb = item % nblk;
    transpose_tile(W, K, N, WT, scr, 64 * kb, 32 * nb, 32 * nb, lane);
}

__device__ __forceinline__ void phase_prep(const Args& a, LAS unsigned char* lds) {
    const int tid = opaque_tid(), lane = tid & 63, wv = tid >> 6;
    const int G = gridDim.x;
    unsigned char* ws = a.ws;
    {
        LAS float* sc = (LAS float*)lds;
        LAS float* red = (LAS float*)(lds + 32768);
        const float* c = a.in[1]; const float* ada_w = a.in[2]; const float* ada_b = a.in[3];
        float* MOD = (float*)(ws + WS_MOD);
        if ((int)blockIdx.x < 192) {
            for (int i = tid; i < 8192; i += 512) sc[i] = siluf_(c[i]);
            sync_threads_();
            for (int unit = blockIdx.x; unit < 192; unit += G) {
                const int l = unit / 96, cb = (unit % 96) * 32, cl = tid & 31, ks = tid >> 5;
                const float* wp = ada_w + (size_t)l * 1024 * 3072 + (size_t)(ks * 64) * 3072 + cb + cl;
                float acc[8];
#pragma unroll
                for (int b = 0; b < 8; ++b) acc[b] = 0.f;
#pragma unroll 16
                for (int k = 0; k < 64; ++k) { const float w = wp[(size_t)k * 3072];
#pragma unroll
                    for (int b = 0; b < 8; ++b) acc[b] += sc[b * 1024 + ks * 64 + k] * w; }
#pragma unroll
                for (int b = 0; b < 8; ++b) red[(ks * 8 + b) * 32 + cl] = acc[b];
                sync_threads_();
                if (tid < 256) { const int b = tid >> 5; float s = 0.f;
#pragma unroll
                    for (int k2 = 0; k2 < 16; ++k2) s += red[(k2 * 8 + b) * 32 + cl];
                    MOD[(l * 8 + b) * 3072 + cb + cl] = s + ada_b[l * 3072 + cb + cl]; }
                sync_threads_();
            }
        }
        sync_threads_();
    }
    {
        LAS float* scr = (LAS float*)(lds + wv * 16384);
        const int gw = blockIdx.x * 8 + wv, NGW = G * 8;
        constexpr int I_IN = (1024 / 64) * (4096 / 32), I_OUT = (2048 / 64) * (1024 / 32);
        for (int it = gw; it < 2 * (I_IN + I_OUT); it += NGW) {
            int r = it;
            if (r < 2 * I_IN) { const int l = r / I_IN; r -= l * I_IN;
                transpose_item(a.in[5] + (size_t)l * 1024 * 4096, 1024, 4096, (bf16*)(ws + WS_WIN) + (size_t)l * 4096 * 1024, scr, r, lane); }
            else { r -= 2 * I_IN; const int l = r / I_OUT; r -= l * I_OUT;
                transpose_item(a.in[16] + (size_t)l * 2048 * 1024, 2048, 1024, (bf16*)(ws + WS_WOUT) + (size_t)l * 1024 * 2048, scr, r, lane); }
        }
    }
    {
        LAS float* scr = (LAS float*)(lds + wv * 16384);
        const int gw = blockIdx.x * 8 + wv, NGW = G * 8;
        bf16* GWp = (bf16*)(ws + WS_GW); bf16* PWp = (bf16*)(ws + WS_PW);
        for (int it = NGW - 1 - gw; it < 512; it += NGW) {
            if (it < 256) { const int lh = it >> 4, r = it & 15, gate = r >> 3, kb = (r >> 2) & 1, q = r & 3;
                transpose_tile((gate ? a.in[10] : a.in[8]) + (size_t)lh * 128 * 128, 128, 128, GWp + (size_t)lh * 4 * 64 * 128, scr, 64 * kb, 32 * q, q * 64 + gate * 32, lane, -1.4426950408889634f); }
            else { const int r = it - 256, lg = r >> 5, kb = (r >> 3) & 3, nb = r & 7;
                transpose_tile(a.in[13] + (size_t)lg * 256 * 256, 256, 256, PWp + (size_t)lg * 256 * 256, scr, 64 * kb, 32 * nb, 32 * nb, lane); }
        }
    }
}

constexpr int RPW = 4;
__device__ __forceinline__ void phase_h0(const Args& a) {
    const int tid = opaque_tid(), lane = tid & 63, wv = tid >> 6;
    const int gw = blockIdx.x * 8 + wv, NGW = gridDim.x * 8;
    const float* x = a.in[0]; const float* g = a.in[4]; const float* MOD = (const float*)(a.ws + WS_MOD);
    bf16* H = (bf16*)(a.ws + WS_H);
    for (int m0 = gw * RPW; m0 < T; m0 += NGW * RPW) {
        f32x4 v[RPW][4];
#pragma unroll
        for (int r = 0; r < RPW; ++r) { const f32x4* xr = (const f32x4*)(x + (size_t)(m0 + r) * D) + lane;
#pragma unroll
            for (int j = 0; j < 4; ++j) v[r][j] = __builtin_nontemporal_load(xr + 64 * j); }
        const int b = m0 >> 12;
        const float* sh = MOD + (size_t)b * 3072; const float* scl = sh + 1024;
#pragma unroll
        for (int r = 0; r < RPW; ++r) {
            float ss = 0.f;
#pragma unroll
            for (int j = 0; j < 4; ++j) ss += (v[r][j].x * v[r][j].x + v[r][j].y * v[r][j].y) + (v[r][j].z * v[r][j].z + v[r][j].w * v[r][j].w);
            const float rstd = 1.0f / __builtin_sqrtf(wave_sum(ss) * (1.0f / D) + EPS);
            u32x2* o = (u32x2*)(H + (size_t)(m0 + r) * D) + lane;
#pragma unroll
            for (int j = 0; j < 4; ++j) { const int col = 4 * lane + 256 * j;
                const f32x4 gg = *(const f32x4*)(g + col), s4 = *(const f32x4*)(scl + col), h4 = *(const f32x4*)(sh + col);
                const f32x4 rr = v[r][j] * rstd * gg * (s4 + 1.0f) + h4;
                u32x2 w; w.x = pk2(rr.x, rr.y); w.y = pk2(rr.z, rr.w); o[64 * j] = w; }
        }
    }
}

__device__ __forceinline__ void phase_post(const Args& a, int l) {
    const int tid = opaque_tid(), lane = tid & 63, wv = tid >> 6;
    const int gw = blockIdx.x * 8 + wv, NGW = gridDim.x * 8;
    const float* xin = (l == 0) ? a.in[0] : a.out; float* out = a.out;
    const bf16* Y = (const bf16*)(a.ws + WS_Y); bf16* H = (bf16*)(a.ws + WS_H);
    const float* MOD = (const float*)(a.ws + WS_MOD);
    const float* gpost = a.in[17] + l * D; const float* gpre = a.in[4] + (l + 1) * D;
    for (int m0 = gw * RPW; m0 < T; m0 += NGW * RPW) {
        f32x4 xv[RPW][4]; u32x2 yw[RPW][4];
#pragma unroll
        for (int r = 0; r < RPW; ++r) { const f32x4* xr = (const f32x4*)(xin + (size_t)(m0 + r) * D) + lane; const u32x2* yr = (const u32x2*)(Y + (size_t)(m0 + r) * D) + lane;
#pragma unroll
            for (int j = 0; j < 4; ++j) { xv[r][j] = xr[64 * j]; yw[r][j] = yr[64 * j]; } }
        const int b = m0 >> 12;
        const float* gate = MOD + (size_t)(l * 8 + b) * 3072 + 2048;
        const float* sh = MOD + (size_t)(8 + b) * 3072; const float* scl = sh + 1024;
#pragma unroll
        for (int r = 0; r < RPW; ++r) {
            f32x4 yv[4]; float ss = 0.f;
#pragma unroll
            for (int j = 0; j < 4; ++j) { const u32x2 w = yw[r][j]; yv[j] = (f32x4){bflo(w.x), bfhi(w.x), bflo(w.y), bfhi(w.y)};
                ss += (yv[j].x * yv[j].x + yv[j].y * yv[j].y) + (yv[j].z * yv[j].z + yv[j].w * yv[j].w); }
            const float rstd = 1.0f / __builtin_sqrtf(wave_sum(ss) * (1.0f / D) + EPS);
            float ss2 = 0.f;
#pragma unroll
            for (int j = 0; j < 4; ++j) { const int col = 4 * lane + 256 * j;
                const f32x4 gp = *(const f32x4*)(gpost + col), gt = *(const f32x4*)(gate + col);
                const f32x4 xn = xv[r][j] + gt * (yv[j] * rstd * gp);
                xv[r][j] = xn;
                if (l == 0) *((f32x4*)(out + (size_t)(m0 + r) * D + col)) = xn;
                else __builtin_nontemporal_store(xn, (f32x4*)(out + (size_t)(m0 + r) * D + col));
                ss2 += (xn.x * xn.x + xn.y * xn.y) + (xn.z * xn.z + xn.w * xn.w); }
            if (l == 0) {
                const float rstd2 = 1.0f / __builtin_sqrtf(wave_sum(ss2) * (1.0f / D) + EPS);
                u32x2* o = (u32x2*)(H + (size_t)(m0 + r) * D) + lane;
#pragma unroll
                for (int j = 0; j < 4; ++j) { const int col = 4 * lane + 256 * j;
                    const f32x4 gg = *(const f32x4*)(gpre + col), s4 = *(const f32x4*)(scl + col), h4 = *(const f32x4*)(sh + col);
                    const f32x4 rr = xv[r][j] * rstd2 * gg * (s4 + 1.0f) + h4;
                    u32x2 w; w.x = pk2(rr.x, rr.y); w.y = pk2(rr.z, rr.w); o[64 * j] = w; }
            }
        }
    }
}
#define XB_TMO      128
#define XB_XCNT(j)  (256  + 64 * (j))
#define XB_XSUB(j)  (1280 + 64 * (j))
#define XB_XGEN(j)  (2304 + 64 * (j))
#define XB_TOP      3328
#define XB_TOPGEN   3392
#define XCD_BAR_WORDS 3456
#define XB_SPIN_CAP (1u << 18)

__device__ __forceinline__ unsigned xb_ld(unsigned* p)              { return __hip_atomic_load(p, __ATOMIC_RELAXED, __HIP_MEMORY_SCOPE_AGENT); }
__device__ __forceinline__ unsigned xb_add(unsigned* p, unsigned v) { return __hip_atomic_fetch_add(p, v, __ATOMIC_RELAXED, __HIP_MEMORY_SCOPE_AGENT); }
__device__ __forceinline__ unsigned xb_xcc_id() { return (unsigned)__builtin_amdgcn_s_getreg((3 << 11) | 20) & 0xFu; }
#define XB_SPIN(cond, bar) do { unsigned _sp = 0; while (cond) { __builtin_amdgcn_s_sleep(1); \
    if ((++_sp & 255u) == 0u) { if (xb_ld(&(bar)[XB_TMO])) break; if (_sp > XB_SPIN_CAP) { xb_add(&(bar)[XB_TMO], 1u); break; } } } } while (0)

struct XcdBarrier {
    unsigned* bar; unsigned x;
    volatile LAS unsigned* st;
};

__device__ __forceinline__ XcdBarrier xcd_barrier_post(unsigned* bar, volatile LAS unsigned* st) {
    XcdBarrier b; b.bar = bar; b.x = xb_xcc_id(); b.st = st;
    if (threadIdx.x == 0) (void)xb_add(&bar[XB_XCNT(b.x)], 1u);
    return b;
}
__device__ __forceinline__ void xcd_barrier_complete(unsigned* bar, unsigned x, unsigned& nloc, unsigned& nx) {
    const unsigned G = gridDim.x * gridDim.y * gridDim.z;
    unsigned sum, cnt, mine, sp = 0u;
    for (;;) {
        sum = 0u; cnt = 0u; mine = 0u;
#pragma unroll
        for (unsigned j = 0; j < 16; ++j) { const unsigned c = xb_ld(&bar[XB_XCNT(j)]); sum += c; cnt += (c > 0u) ? 1u : 0u; mine = (j == x) ? c : mine; }
        if (sum == G) break;
        __builtin_amdgcn_s_sleep(1);
        if ((++sp & 255u) == 0u) { if (xb_ld(&bar[XB_TMO])) break; if (sp > XB_SPIN_CAP) { xb_add(&bar[XB_TMO], 1u); break; } }
    }
    nloc = mine > 0u ? mine : 1u; nx = cnt > 0u ? cnt : 1u;
}

__device__ __forceinline__ void xcd_barrier(const XcdBarrier& b) {
    asm volatile("s_waitcnt vmcnt(0)" ::: "memory");
    sync_threads_();
    if (threadIdx.x == 0) {
        unsigned* bar = b.bar;
        __builtin_amdgcn_s_waitcnt(0);
        unsigned nloc = b.st[0], nx = b.st[1];
        if (nloc == 0u) { xcd_barrier_complete(bar, b.x, nloc, nx); b.st[0] = nloc; b.st[1] = nx; }
        const unsigned old = xb_add(&bar[XB_XSUB(b.x)], 1u);
        const unsigned gen = old / nloc;
        if (old + 1u == (gen + 1u) * nloc) {
            __builtin_amdgcn_fence(__ATOMIC_RELEASE, "agent");
            asm volatile("s_waitcnt vmcnt(0)" ::: "memory");
            const unsigned og = xb_add(&bar[XB_TOP], 1u);
            const unsigned tg = og / nx;
            if (og + 1u == (tg + 1u) * nx) xb_add(&bar[XB_TOPGEN], 1u);
            else XB_SPIN(xb_ld(&bar[XB_TOPGEN]) == tg, bar);
            __builtin_amdgcn_fence(__ATOMIC_ACQUIRE, "agent");
            xb_add(&bar[XB_XGEN(b.x)], 1u);
            asm volatile("s_waitcnt vmcnt(0)" ::: "memory");
        } else {
            XB_SPIN(xb_ld(&bar[XB_XGEN(b.x)]) == gen, bar);
            __builtin_amdgcn_fence(__ATOMIC_ACQUIRE, "agent");
            asm volatile("s_waitcnt vmcnt(0)" ::: "memory");
        }
    }
    sync_threads_();
}

#define LDS_BARRIER() do { asm volatile("s_waitcnt lgkmcnt(0)" ::: "memory"); __builtin_amdgcn_s_barrier(); asm volatile("" ::: "memory"); } while (0)
constexpr int XROW = 272;
constexpr int CROW = 132;
constexpr int R_XT = 0, R_UT = 35840, R_AT = 70656, R_VT = 87552, R_EP = 104448, R_CWT = 105472, R_GT = 108032, R_YT = 116736;
template <int D> __device__ __forceinline__ float dpp_row_shr(float old, float src) {
    return i2f(__builtin_amdgcn_update_dpp(f2i(old), f2i(src), 0x110 | D, 0xf, 0xf, false)); }
__device__ __forceinline__ float softplus_small_(float e) { return (e < 0.03f) ? e * (1.0f + e * (-0.5f + e * (0.33333334f + e * (-0.25f + e * 0.2f)))) : __builtin_logf(1.0f + e); }
__device__ __forceinline__ float fast_sigmoid(float x) { return __builtin_amdgcn_rcpf(1.0f + __builtin_amdgcn_exp2f(-1.4426950408889634f * x)); }
__device__ __forceinline__ void rnn_unit(const Args& a, int l, int u, LAS unsigned char* lds) {
    const int tid = opaque_tid(), lane = tid & 63, wv = tid >> 6, fr = lane & 15, fq = lane >> 4;
    const int xcd = u & 7, jj = u >> 3, q = jj & 3, bh = (jj >> 2) * 8 + xcd, b = bh >> 3, h = bh & 7;
    const bf16* PROJ = (const bf16*)(a.ws + WS_PROJ); bf16* YCAT = (bf16*)(a.ws + WS_YCAT);
    const bf16* xr_base = PROJ + (size_t)(b * SEQ) * NPROJ + h * 128;
    const bf16* gr_base = PROJ + (size_t)(b * SEQ) * NPROJ + 1024 + h * 128 + q * 32;
    bf16* y_base = YCAT + (size_t)(b * SEQ) * DMIX + h * 128 + q * 32;
    LAS unsigned char* XT = lds + R_XT; LAS unsigned char* UT = lds + R_UT;
    LAS float* AT = (LAS float*)(lds + R_AT); LAS float* VT = (LAS float*)(lds + R_VT);
    LAS unsigned char* GT = lds + R_GT; LAS unsigned char* YT = lds + R_YT;
    const int io_tk = tid >> 2, io_cq = tid & 3;
    const int ck = tid & 15, tg = tid >> 4;
    LAS float* CWT = (LAS float*)(lds + R_CWT);
    for (int i = tid; i < 640; i += 512) { const int r = i >> 7, c = i & 127;
        CWT[i] = (r < 4) ? a.in[6][(size_t)l * 4 * 1024 + r * 1024 + h * 128 + c] : a.in[7][(size_t)l * 1024 + h * 128 + c]; }
    bf16x8 Wf[4][4];
    {
        const bf16* gwp = (const bf16*)(a.ws + WS_GW) + (size_t)((l * 8 + h) * 4 + q) * 64 * 128;
#pragma unroll
        for (int nb = 0; nb < 4; ++nb)
#pragma unroll
            for (int kb = 0; kb < 4; ++kb) Wf[nb][kb] = *(const bf16x8*)(gwp + (nb * 16 + fr) * 128 + kb * 32 + fq * 8);
    }
    LAS float* EP = (LAS float*)(lds + R_EP);
    if (tid < 96) {
        const int r = tid >> 5, c = tid & 31, ch = h * 128 + q * 32 + c; float v;
        if (r == 0) v = -1.4426950408889634f * a.in[9][l * 1024 + ch];
        else if (r == 1) v = -1.4426950408889634f * a.in[11][l * 1024 + ch];
        else v = 8.0f * 1.4426950408889634f * softplus_small_(__builtin_expf(-a.in[12][l * 1024 + ch]));
        EP[r * 32 + c] = v;
    }
    u32x4 pf[4], pfh = (u32x4){0u, 0u, 0u, 0u};
#pragma unroll
    for (int i = 0; i < 4; ++i) { const int id = tid + 512 * i, row = id >> 4, cc = id & 15; pf[i] = *(const u32x4*)(xr_base + (size_t)row * NPROJ + cc * 8); }
    u32x4 gpf = *(const u32x4*)(gr_base + (size_t)io_tk * NPROJ + io_cq * 8);
    const int sc_ci = lane >> 4, sc_sg = lane & 15, sc_c = wv * 4 + sc_ci;
    float hcar = 0.f;
#pragma unroll
    for (int i = 0; i < 4; ++i) { const int id = tid + 512 * i, row = id >> 4, cc = id & 15; *(LAS u32x4*)(XT + (3 + row) * XROW + cc * 16) = pf[i]; }
    if (tid < 48) *(LAS u32x4*)(XT + (tid >> 4) * XROW + (tid & 15) * 16) = pfh;
    for (int tile = 0; tile < SEQ / 128; ++tile) {
        const int t0 = tile * 128;
        LDS_BARRIER();
        {
            const int t0n = (tile + 1 < SEQ / 128) ? t0 + 128 : t0;
#pragma unroll
            for (int i = 0; i < 4; ++i) { const int id = tid + 512 * i, row = id >> 4, cc = id & 15; pf[i] = *(const u32x4*)(xr_base + (size_t)(t0n + row) * NPROJ + cc * 8); }
            if (tid < 48) pfh = *(const u32x4*)(xr_base + (size_t)(t0n - 3 + (tid >> 4)) * NPROJ + (tid & 15) * 8);
        }
        {
            if (tile > 0) {
                unsigned short yv_[8];
#pragma unroll
                for (int e = 0; e < 8; ++e) yv_[e] = *(const LAS unsigned short*)(YT + (io_cq * 8 + e) * XROW + io_tk * 2);
                u32x4 w; w.x = yv_[0] | ((unsigned)yv_[1] << 16); w.y = yv_[2] | ((unsigned)yv_[3] << 16); w.z = yv_[4] | ((unsigned)yv_[5] << 16); w.w = yv_[6] | ((unsigned)yv_[7] << 16);
                *(u32x4*)(y_base + (size_t)(t0 - 128 + io_tk) * DMIX + io_cq * 8) = w;
            }
            const unsigned gwv[4] = {gpf.x, gpf.y, gpf.z, gpf.w};
#pragma unroll
            for (int e2 = 0; e2 < 4; ++e2) { *(LAS unsigned short*)(GT + (io_cq * 8 + 2 * e2) * XROW + io_tk * 2) = (unsigned short)(gwv[e2] & 0xffffu);
                *(LAS unsigned short*)(GT + (io_cq * 8 + 2 * e2 + 1) * XROW + io_tk * 2) = (unsigned short)(gwv[e2] >> 16); }
            const int t1 = (tile + 1 < SEQ / 128) ? t0 + 128 : t0;
            gpf = *(const u32x4*)(gr_base + (size_t)(t1 + io_tk) * NPROJ + io_cq * 8);
        }
        {
            f32x2 o[4][4], cw[4][4];
            {
                const f32x4 b0 = *(const LAS f32x4*)(CWT + 4 * 128 + ck * 8), b1 = *(const LAS f32x4*)(CWT + 4 * 128 + ck * 8 + 4);
#pragma unroll
                for (int i = 0; i < 4; ++i) { o[i][0] = (f32x2){b0.x, b0.y}; o[i][1] = (f32x2){b0.z, b0.w}; o[i][2] = (f32x2){b1.x, b1.y}; o[i][3] = (f32x2){b1.z, b1.w}; }
            }
#pragma unroll
            for (int k = 0; k < 4; ++k) { const f32x4 w0 = *(const LAS f32x4*)(CWT + k * 128 + ck * 8), w1 = *(const LAS f32x4*)(CWT + k * 128 + ck * 8 + 4);
                cw[k][0] = (f32x2){w0.x, w0.y}; cw[k][1] = (f32x2){w0.z, w0.w}; cw[k][2] = (f32x2){w1.x, w1.y}; cw[k][3] = (f32x2){w1.z, w1.w}; }
#pragma unroll
            for (int r = 0; r < 7; ++r) {
                const u32x4 w = *(const LAS u32x4*)(XT + (tg * 4 + r) * XROW + ck * 16);
                const f32x2 xv[4] = {(f32x2){bflo(w.x), bfhi(w.x)}, (f32x2){bflo(w.y), bfhi(w.y)}, (f32x2){bflo(w.z), bfhi(w.z)}, (f32x2){bflo(w.w), bfhi(w.w)}};
#pragma unroll
                for (int i = 0; i < 4; ++i) { const int k = r - i; if (k >= 0 && k < 4) {
#pragma unroll
                    for (int e = 0; e < 4; ++e) o[i][e] = __builtin_elementwise_fma(cw[k][e], xv[e], o[i][e]); } }
            }
#pragma unroll
            for (int i = 0; i < 4; ++i) { u32x4 w; w.x = pk2(o[i][0].x, o[i][0].y); w.y = pk2(o[i][1].x, o[i][1].y); w.z = pk2(o[i][2].x, o[i][2].y); w.w = pk2(o[i][3].x, o[i][3].y);
                *(LAS u32x4*)(UT + (tg * 4 + i) * XROW + ck * 16) = w; }
        }
        asm volatile("s_waitcnt lgkmcnt(0)" ::: "memory");
        {
            f32x4 acc[4];
#pragma unroll
            for (int nb = 0; nb < 4; ++nb) acc[nb] = (f32x4){0.f, 0.f, 0.f, 0.f};
#pragma unroll
            for (int kb = 0; kb < 4; ++kb) { const bf16x8 uf = *(const LAS bf16x8*)(UT + (wv * 16 + fr) * XROW + kb * 64 + fq * 16);
#pragma unroll
                for (int nb = 0; nb < 4; ++nb) acc[nb] = __builtin_amdgcn_mfma_f32_16x16x32_bf16(Wf[nb][kb], uf, acc[nb], 0, 0, 0); }
            const int tk = wv * 16 + fr;
#pragma unroll
            for (int nb2 = 0; nb2 < 2; ++nb2) {
                const int c0 = nb2 * 16 + 4 * fq;
                const u32x2 uw = *(const LAS u32x2*)(UT + tk * XROW + (q * 32 + c0) * 2);
                const f32x4 uu = (f32x4){bflo(uw.x), bfhi(uw.x), bflo(uw.y), bfhi(uw.y)};
                const f32x4 ra = acc[nb2] + *(const LAS f32x4*)(EP + c0), rx = acc[nb2 + 2] + *(const LAS f32x4*)(EP + 32 + c0), sp8 = *(const LAS f32x4*)(EP + 64 + c0);
#pragma unroll
                for (int e = 0; e < 4; ++e) { const float r = __builtin_amdgcn_rcpf(1.0f + __builtin_amdgcn_exp2f(ra[e])), ig = __builtin_amdgcn_rcpf(1.0f + __builtin_amdgcn_exp2f(rx[e]));
                    const float av = __builtin_amdgcn_exp2f(-r * sp8[e]);
                    const float m2 = __builtin_fmaxf(__builtin_fmaf(-av, av, 1.0f), 0.f);
                    AT[(c0 + e) * CROW + tk] = av; VT[(c0 + e) * CROW + tk] = __builtin_amdgcn_sqrtf(m2) * (ig * uu[e]); }
            }
        }
        LDS_BARRIER();
        {
            const f32x4 a0 = *(const LAS f32x4*)(AT + sc_c * CROW + sc_sg * 8), a1 = *(const LAS f32x4*)(AT + sc_c * CROW + sc_sg * 8 + 4);
            const f32x4 v0 = *(const LAS f32x4*)(VT + sc_c * CROW + sc_sg * 8), v1 = *(const LAS f32x4*)(VT + sc_c * CROW + sc_sg * 8 + 4);
            const float av[8] = {a0.x, a0.y, a0.z, a0.w, a1.x, a1.y, a1.z, a1.w}, vv[8] = {v0.x, v0.y, v0.z, v0.w, v1.x, v1.y, v1.z, v1.w};
            float hl[8], pp[8]; float hcur = 0.f, pcur = 1.f;
#pragma unroll
            for (int j = 0; j < 8; ++j) { hcur = __builtin_fmaf(av[j], hcur, vv[j]); pcur *= av[j]; hl[j] = hcur; pp[j] = pcur; }
            float P = pcur, H = hcur;
            { float Pp = dpp_row_shr<1>(1.f, P), Hp = dpp_row_shr<1>(0.f, H); H = __builtin_fmaf(P, Hp, H); P *= Pp;
              Pp = dpp_row_shr<2>(1.f, P); Hp = dpp_row_shr<2>(0.f, H); H = __builtin_fmaf(P, Hp, H); P *= Pp;
              Pp = dpp_row_shr<4>(1.f, P); Hp = dpp_row_shr<4>(0.f, H); H = __builtin_fmaf(P, Hp, H); P *= Pp;
              Pp = dpp_row_shr<8>(1.f, P); Hp = dpp_row_shr<8>(0.f, H); H = __builtin_fmaf(P, Hp, H); P *= Pp; }
            const float Pe = dpp_row_shr<1>(1.f, P), He = dpp_row_shr<1>(0.f, H);
            const float carry = __builtin_fmaf(Pe, hcar, He);
            const float hend = __builtin_fmaf(P, hcar, H);
            hcar = row_last_(hend);
            const u32x4 gq = *(const LAS u32x4*)(GT + sc_c * XROW + sc_sg * 16);
            const float gvv[8] = {bflo(gq.x), bfhi(gq.x), bflo(gq.y), bfhi(gq.y), bflo(gq.z), bfhi(gq.z), bflo(gq.w), bfhi(gq.w)};
            float yy[8];
#pragma unroll
            for (int j = 0; j < 8; ++j) { const float hv = __builtin_fmaf(pp[j], carry, hl[j]); yy[j] = hv * gvv[j] * fast_sigmoid(gvv[j]); }
            u32x4 yw_; yw_.x = pk2(yy[0], yy[1]); yw_.y = pk2(yy[2], yy[3]); yw_.z = pk2(yy[4], yy[5]); yw_.w = pk2(yy[6], yy[7]);
            *(LAS u32x4*)(YT + sc_c * XROW + sc_sg * 16) = yw_;
        }
#pragma unroll
        for (int i = 0; i < 4; ++i) { const int id = tid + 512 * i, row = id >> 4, cc = id & 15; *(LAS u32x4*)(XT + (3 + row) * XROW + cc * 16) = pf[i]; }
        if (tid < 48) *(LAS u32x4*)(XT + (tid >> 4) * XROW + (tid & 15) * 16) = pfh;
    }
    LDS_BARRIER();
    {
        unsigned short yv_[8];
#pragma unroll
        for (int e = 0; e < 8; ++e) yv_[e] = *(const LAS unsigned short*)(YT + (io_cq * 8 + e) * XROW + io_tk * 2);
        u32x4 w; w.x = yv_[0] | ((unsigned)yv_[1] << 16); w.y = yv_[2] | ((unsigned)yv_[3] << 16); w.z = yv_[4] | ((unsigned)yv_[5] << 16); w.w = yv_[6] | ((unsigned)yv_[7] << 16);
        *(u32x4*)(y_base + (size_t)(SEQ - 128 + io_tk) * DMIX + io_cq * 8) = w;
    }
    LDS_BARRIER();
}

constexpr int PROW = 528;
constexpr int R_XP = 0, R_PT = 42240;
__device__ __forceinline__ void pool_units(const Args& a, int l, int u, LAS unsigned char* lds) {
    const int tid = opaque_tid(), lane = tid & 63, wv = tid >> 6, fr = lane & 15, fq = lane >> 4;
    const int g = u & 3, bi = u >> 2, win = 2 << g;
    const bf16* PROJ = (const bf16*)(a.ws + WS_PROJ); bf16* YCAT = (bf16*)(a.ws + WS_YCAT);
    LAS unsigned char* XP = lds + R_XP; LAS unsigned char* PT = lds + R_PT;
    const bf16* pw = (const bf16*)(a.ws + WS_PW) + (size_t)(l * 4 + g) * 256 * 256;
    bf16x8 Wf[2][8];
#pragma unroll
    for (int nb = 0; nb < 2; ++nb)
#pragma unroll
        for (int kb = 0; kb < 8; ++kb) Wf[nb][kb] = *(const bf16x8*)(pw + (size_t)(wv * 32 + 8 * (fr >> 2) + 4 * nb + (fr & 3)) * 256 + kb * 32 + fq * 8);
    f32x4 pb[2], ps[2];
#pragma unroll
    for (int nb = 0; nb < 2; ++nb) { const int n = wv * 32 + 8 * fq + 4 * nb;
        pb[nb] = *(const f32x4*)(a.in[14] + (size_t)l * 1024 + g * 256 + n); ps[nb] = *(const f32x4*)(a.in[15] + (size_t)l * 1024 + g * 256 + n); }
    const int ck = tid & 31, tg = tid >> 5;
    u32x4 pf[5];
    {
        const int tile = bi * 8, b = tile >> 6, t0 = (tile & 63) * 64;
        const bf16* xp_base = PROJ + (size_t)(b * SEQ) * NPROJ + 2048 + g * 256;
#pragma unroll
        for (int i = 0; i < 5; ++i) { const int id = tid + 512 * i, row = id >> 5, cc = id & 31, t = t0 - 16 + row;
            const u32x4 v = *(const u32x4*)(xp_base + (size_t)(t < 0 ? 0 : t) * NPROJ + cc * 8); pf[i] = (t < 0) ? (u32x4){0u, 0u, 0u, 0u} : v; }
    }
#pragma unroll
    for (int i = 0; i < 5; ++i) { const int id = tid + 512 * i, row = id >> 5, cc = id & 31; *(LAS u32x4*)(XP + row * PROW + cc * 16) = pf[i]; }
    u32x4 gp[4];
    {
        const int tile = bi * 8, b = tile >> 6, t0 = (tile & 63) * 64;
        const bf16* gp_base0 = PROJ + (size_t)(b * SEQ) * NPROJ + 3072 + g * 256;
#pragma unroll
        for (int tb = 0; tb < 4; ++tb)
        { gp[tb] = *(const u32x4*)(gp_base0 + (size_t)(t0 + tb * 16 + fr) * NPROJ + wv * 32 + 8 * fq);
                asm volatile("" : "+v"(gp[tb])); }
    }
    for (int it = 0; it < 8; ++it) {
        const int tile = bi * 8 + it, b = tile >> 6, t0 = (tile & 63) * 64;
        bf16* y_base = YCAT + (size_t)(b * SEQ) * DMIX + 1024 + g * 256;
        LDS_BARRIER();
        {
            const int tile2 = bi * 8 + ((it + 1 < 8) ? it + 1 : it), b2 = tile2 >> 6, t02 = (tile2 & 63) * 64;
            const bf16* xp_base = PROJ + (size_t)(b2 * SEQ) * NPROJ + 2048 + g * 256;
#pragma unroll
            for (int i = 0; i < 5; ++i) { const int id = tid + 512 * i, row = id >> 5, cc = id & 31, t = t02 - 16 + row;
                const u32x4 v = *(const u32x4*)(xp_base + (size_t)(t < 0 ? 0 : t) * NPROJ + cc * 8); pf[i] = (t < 0) ? (u32x4){0u, 0u, 0u, 0u} : v; }
        }
        u32x4 gpn[4];
        {
            const int tile2 = bi * 8 + ((it + 1 < 8) ? it + 1 : it), b2 = tile2 >> 6, t02 = (tile2 & 63) * 64;
            const bf16* gp_base2 = PROJ + (size_t)(b2 * SEQ) * NPROJ + 3072 + g * 256;
#pragma unroll
            for (int tb = 0; tb < 4; ++tb)
                gpn[tb] = *(const u32x4*)(gp_base2 + (size_t)(t02 + tb * 16 + fr) * NPROJ + wv * 32 + 8 * fq);
        }
        {
            float s[8];
#pragma unroll
            for (int e = 0; e < 8; ++e) s[e] = 0.f;
            const int r0 = tg * 4 + 16;
            for (int r = r0 - win + 1; r < r0; ++r) { const u32x4 w = *(const LAS u32x4*)(XP + r * PROW + ck * 16);
                s[0] += bflo(w.x); s[1] += bfhi(w.x); s[2] += bflo(w.y); s[3] += bfhi(w.y); s[4] += bflo(w.z); s[5] += bfhi(w.z); s[6] += bflo(w.w); s[7] += bfhi(w.w); }
#pragma unroll
            for (int i = 0; i < 4; ++i) {
                const u32x4 w = *(const LAS u32x4*)(XP + (r0 + i) * PROW + ck * 16);
                const float xv[8] = {bflo(w.x), bfhi(w.x), bflo(w.y), bfhi(w.y), bflo(w.z), bfhi(w.z), bflo(w.w), bfhi(w.w)};
                const int t = t0 + tg * 4 + i; const float inv = __builtin_amdgcn_rcpf((float)((t + 1 < win) ? (t + 1) : win));
                float p[8];
#pragma unroll
                for (int e = 0; e < 8; ++e) { s[e] += xv[e]; p[e] = __builtin_fmaf(s[e], inv, -xv[e]); }
                u32x4 o; o.x = pk2(p[0], p[1]); o.y = pk2(p[2], p[3]); o.z = pk2(p[4], p[5]); o.w = pk2(p[6], p[7]);
                *(LAS u32x4*)(PT + (tg * 4 + i) * PROW + ck * 16) = o;
                const u32x4 wo = *(const LAS u32x4*)(XP + (r0 + i - win + 1) * PROW + ck * 16);
                s[0] -= bflo(wo.x); s[1] -= bfhi(wo.x); s[2] -= bflo(wo.y); s[3] -= bfhi(wo.y); s[4] -= bflo(wo.z); s[5] -= bfhi(wo.z); s[6] -= bflo(wo.w); s[7] -= bfhi(wo.w);
            }
        }
        LDS_BARRIER();
#pragma unroll
        for (int tb = 0; tb < 4; ++tb) {
            f32x4 acc[2] = {(f32x4){0.f, 0.f, 0.f, 0.f}, (f32x4){0.f, 0.f, 0.f, 0.f}};
#pragma unroll
            for (int kb = 0; kb < 8; ++kb) { const bf16x8 pfm = *(const LAS bf16x8*)(PT + (tb * 16 + fr) * PROW + kb * 64 + fq * 16);
#pragma unroll
                for (int nb = 0; nb < 2; ++nb) acc[nb] = __builtin_amdgcn_mfma_f32_16x16x32_bf16(Wf[nb][kb], pfm, acc[nb], 0, 0, 0); }
            const int t = t0 + tb * 16 + fr;
            u32x4 o;
#pragma unroll
            for (int nb = 0; nb < 2; ++nb) {
                const unsigned g0 = nb ? gp[tb].z : gp[tb].x, g1 = nb ? gp[tb].w : gp[tb].y;
                const f32x4 gv = (f32x4){bflo(g0), bfhi(g0), bflo(g1), bfhi(g1)};
                f32x4 r = (acc[nb] + pb[nb]) * ps[nb];
#pragma unroll
                for (int e = 0; e < 4; ++e) r[e] *= gv[e] * fast_sigmoid(gv[e]);
                if (nb == 0) { o.x = pk2(r.x, r.y); o.y = pk2(r.z, r.w); } else { o.z = pk2(r.x, r.y); o.w = pk2(r.z, r.w); } }
            *(u32x4*)(y_base + (size_t)t * DMIX + wv * 32 + 8 * fq) = o;
        }
#pragma unroll
        for (int i = 0; i < 5; ++i) { const int id = tid + 512 * i, row = id >> 5, cc = id & 31; *(LAS u32x4*)(XP + row * PROW + cc * 16) = pf[i]; }
#pragma unroll
        for (int tb = 0; tb < 4; ++tb)
            gp[tb] = gpn[tb];
    }
    LDS_BARRIER();
}

__device__ __forceinline__ void phase_mixer(const Args& a, int l, LAS unsigned char* lds) {
#ifndef MK_MIX
#define MK_MIX 3
#endif
#ifndef MK_DBL_RNN
#define MK_DBL_RNN 0
#endif
#ifndef MK_DBL_POOL
#define MK_DBL_POOL 0
#endif
    for (int rep = 0; rep < 1 + ((l == 0) ? MK_DBL_RNN : 0); ++rep) for (int u = blockIdx.x; u < 256; u += gridDim.x) rnn_unit(a, l, u, lds);
    for (int rep = 0; rep < 1 + ((l == 0) ? MK_DBL_POOL : 0); ++rep) for (int u = blockIdx.x; u < 256; u += gridDim.x) pool_units(a, l, u, lds);
}
#ifndef MK_DBL_PH
#define MK_DBL_PH -1
#endif
#ifndef MK_MASK
#define MK_MASK 63
#endif
__global__ void __launch_bounds__(512, 2) mk_fwd(Args a) {
    extern __shared__ __attribute__((aligned(16))) unsigned char lds_raw[];
    LAS unsigned char* lds = (LAS unsigned char*)lds_raw;
    cg::grid_group grid = cg::this_grid();
    volatile LAS unsigned* bst = (volatile LAS unsigned*)(lds + LDS_BST_OFF);
    if (threadIdx.x < 4) bst[threadIdx.x] = 0u;
    sync_threads_();
    XcdBarrier xbar = xcd_barrier_post((unsigned*)(a.ws + WS_CTL), bst);
#define GRID_BAR() do { if (a.ph_hi - a.ph_lo > 64) grid.sync(); else xcd_barrier(xbar); } while (0)
    for (int ph = a.ph_lo; ph < a.ph_hi; ++ph) {
#if MK_DBL_PH >= 0
      for (int rep = 0; rep < ((ph == MK_DBL_PH) ? 2 : 1); ++rep) {
        if (rep) GRID_BAR();
#endif
        if (ph == 0) { if (MK_MASK & 1) phase_prep(a, lds); }
        else if (ph == 1) { if (MK_MASK & 2) phase_h0(a); }
        else {
            const int l = (ph - 2) >> 2, sub = (ph - 2) & 3;
            if (sub == 0) { if (MK_MASK & 4) {
                pg8::Gemm g{(const pg8::bf16_t*)(a.ws + WS_H), (const pg8::bf16_t*)(a.ws + WS_WIN) + (size_t)l * NPROJ * D, T, NPROJ, D};
                pg8::StaticOrder S; S.init(T, NPROJ, gridDim.x, (int)blockIdx.x);
                pg8::EpiBf16<0> E{(pg8::bf16_t*)(a.ws + WS_PROJ), NPROJ, nullptr, 0, 0, 1.f};
                pg8::gemm_phase<pg8::EpiBf16<0>, pg8::StaticOrder, PG8_ALIGN, PG8_SP2>(lds, g, S, E); }
            } else if (sub == 1) {
                if (MK_MASK & 8) phase_mixer(a, l, lds);
            } else if (sub == 2) { if (MK_MASK & 16) {
                pg8::Gemm g{(const pg8::bf16_t*)(a.ws + WS_YCAT), (const pg8::bf16_t*)(a.ws + WS_WOUT) + (size_t)l * D * DMIX, T, D, DMIX};
                pg8::StaticOrder S; S.init(T, D, gridDim.x, (int)blockIdx.x);
                pg8::EpiBf16<0> E{(pg8::bf16_t*)(a.ws + WS_Y), D, nullptr, 0, 0, 1.f};
                pg8::gemm_phase<pg8::EpiBf16<0>, pg8::StaticOrder, PG8_ALIGN, PG8_SP2>(lds, g, S, E); }
            } else {
                if (MK_MASK & 32) phase_post(a, l);
            }
        }
#if MK_DBL_PH >= 0
      }
#endif
        if (ph + 1 < a.ph_hi) GRID_BAR();
    }
}

#if defined(__HIP_DEVICE_COMPILE__)
#pragma clang attribute pop
#endif

extern "C" void kernel_launch(void* const* d_in, const int* in_sizes, int n_in, void* d_out, int out_size, void* d_ws, size_t ws_size, hipStream_t stream) {
    static int grid = 0;
    if (grid == 0) {
        if (n_in != 18 || in_sizes[0] != T * D || out_size != T * D || ws_size < WS_END) {
            fprintf(stderr, "kernel_launch: unexpected shapes (n_in %d, in0 %d, out %d, ws %zu); nothing launched\n", n_in, n_in > 0 ? in_sizes[0] : -1, out_size, ws_size); grid = -1; return; }
        int dev = 0, cus = 0, per_cu = 0;
        if (hipGetDevice(&dev) != hipSuccess || hipDeviceGetAttribute(&cus, hipDeviceAttributeMultiprocessorCount, dev) != hipSuccess) { grid = -1; return; }
        if (hipFuncSetAttribute((const void*)mk_fwd, hipFuncAttributeMaxDynamicSharedMemorySize, LDS_BYTES) != hipSuccess) { fprintf(stderr, "kernel_launch: hipFuncSetAttribute failed\n"); grid = -1; return; }
        if (hipOccupancyMaxActiveBlocksPerMultiprocessor(&per_cu, (const void*)mk_fwd, 512, LDS_BYTES) != hipSuccess || per_cu < 1) { fprintf(stderr, "kernel_launch: occupancy query says %d blocks per CU\n", per_cu); per_cu = 1; }
        (void)hipGetLastError();
        grid = cus;
    }
    if (grid < 0) return;
    Args a{};
    for (int i = 0; i < 18; ++i) a.in[i] = (const float*)d_in[i];
    a.out = (float*)d_out; a.ws = (unsigned char*)d_ws;
    if (hipMemsetAsync((char*)d_ws + WS_CTL, 0, CTL_BYTES, stream) != hipSuccess) { fprintf(stderr, "kernel_launch: memset of the barrier words failed\n"); return; }
#if MK_N_LAUNCHES == 1
    a.ph_lo = 0; a.ph_hi = NPH;
    void* args[] = {&a};
    const hipError_t e = hipLaunchCooperativeKernel((const void*)mk_fwd, dim3(grid), dim3(512), args, LDS_BYTES, stream);
    if (e != hipSuccess) fprintf(stderr, "kernel_launch: cooperative launch failed: %s (grid %d)\n", hipGetErrorString(e), grid);
#else
    for (int ph = 0; ph < NPH; ++ph) {
        a.ph_lo = ph; a.ph_hi = ph + 1;
        hipLaunchKernelGGL(mk_fwd, dim3(grid), dim3(512), LDS_BYTES, stream, a);
    }
#endif
}
```

```cpp
#include <hip/hip_runtime.h>
#include <hip/hip_cooperative_groups.h>
#include <cstdio>
#include <cstdint>
namespace cg = cooperative_groups;
__device__ __forceinline__ int opaque_tid() { int t = threadIdx.x; asm volatile("" : "+v"(t)); return t; }
#if defined(__HIP_DEVICE_COMPILE__)
#pragma clang attribute push (__attribute__((target("no-packed-fp32-ops"))), apply_to = function)
#endif
__device__ __forceinline__ float u2f(unsigned x) { return __builtin_bit_cast(float, x); }
__device__ __forceinline__ float i2f(int x) { return __builtin_bit_cast(float, x); }
__device__ __forceinline__ int f2i(float x) { return __builtin_bit_cast(int, x); }
__device__ __forceinline__ int lane_id_() { return (int)__builtin_amdgcn_mbcnt_hi(~0u, __builtin_amdgcn_mbcnt_lo(~0u, 0u)); }
__device__ __forceinline__ float shfl_xor_(float v, int o) { return i2f(__builtin_amdgcn_ds_bpermute((lane_id_() ^ o) << 2, f2i(v))); }
__device__ __forceinline__ float row_last_(float v) { return i2f(__builtin_amdgcn_ds_bpermute((lane_id_() | 15) << 2, f2i(v))); }
__device__ __forceinline__ void sync_threads_() { __builtin_amdgcn_fence(__ATOMIC_RELEASE, "workgroup"); __builtin_amdgcn_s_barrier(); __builtin_amdgcn_fence(__ATOMIC_ACQUIRE, "workgroup"); }
namespace pg8 {
#define PG8_LAS __attribute__((address_space(3)))
typedef unsigned short bf16_t;
typedef short bf16x8 __attribute__((ext_vector_type(8)));
typedef float f32x4 __attribute__((ext_vector_type(4)));
typedef unsigned u32x4 __attribute__((ext_vector_type(4)));
constexpr int BM = 256, BK = 64, HALF = 128, HTB = HALF * BK * 2  , STAGE_BYTES = 8 * HTB, NXCD = 8, WGM = 8;

__host__ __device__ __forceinline__ int lds_byte(int r, int c) { const int st = (r >> 4) * 2 + (c >> 5), rr = r & 15, cc = c & 31, ob = rr * 64 + cc * 2; return st * 1024 + (ob ^ (((ob >> 9) & 1) << 5)); }
__host__ __device__ __forceinline__ void stage_rc(int b, int& R, int& C) { const int st = b / 1024, sb = b % 1024, swz = sb ^ (((sb >> 9) & 1) << 5); R = (st >> 1) * 16 + swz / 64; C = (st & 1) * 32 + (swz % 64) / 2; }
__host__ __device__ __forceinline__ int perm32(int rho) { const int n = rho >> 4, i = rho & 15; return 8 * (i >> 2) + 4 * n + (i & 3); }

struct Unit { int pm, pn; };
struct Gemm { const bf16_t* A; const bf16_t* Bt; int M, N, K; };

struct StaticOrder {
    int nM, nN, nwg, G, c;
    __host__ __device__ void init(int M, int N, int G_, int c_) { nM = M / BM; nN = N / BM; nwg = nM * nN; G = G_; c = c_; }
    __host__ __device__ bool next(int i, Unit& u) const {
        const long L = (long)i * G + c; if (L >= nwg) return false;
        int wgid = (int)L; { const int q = nwg / NXCD, r = nwg % NXCD, xcd = wgid % NXCD, off = wgid / NXCD; wgid = (xcd < r ? xcd * (q + 1) : r * (q + 1) + (xcd - r) * q) + off; }
        const int nig = WGM * nN, gid = wgid / nig, fm = gid * WGM, gsz = (nM - fm) < WGM ? (nM - fm) : WGM;
        u.pm = fm + ((wgid % nig) % gsz); u.pn = (wgid % nig) / gsz; return true;
    }
    __device__ __forceinline__ void a_ready(const Unit&) const {}
    __device__ __forceinline__ void done(const Unit&) const {}
};

__device__ __forceinline__ unsigned cvt_pk_bf16(float lo, float hi) { unsigned r; asm volatile("v_cvt_pk_bf16_f32 %0, %1, %2" : "=v"(r) : "v"(lo), "v"(hi)); return r; }
typedef float f32x2 __attribute__((ext_vector_type(2)));
__device__ __forceinline__ f32x2 gelu_pk(f32x2 v) {
    const f32x2 av = __builtin_elementwise_abs(v), d = av * 0.2316418882f + 1.0f;
    f32x2 t; t.x = __builtin_amdgcn_rcpf(d.x); t.y = __builtin_amdgcn_rcpf(d.y);
    f32x2 q = t * 0.5307027145f + (-0.7265760135f); q = q * t + 0.7107068705f; q = q * t + (-0.142248368f); q = q * t + 0.127414796f; q = q * t;
    const f32x2 s = (v * v) * (-0.72134752044f);
    f32x2 e; e.x = __builtin_amdgcn_exp2f(s.x); e.y = __builtin_amdgcn_exp2f(s.y);
    const f32x2 m = v * (q * e), r = v - m;
    f32x2 o; o.x = v.x < 0.f ? m.x : r.x; o.y = v.y < 0.f ? m.y : r.y; return o;
}

template <int ACT  > struct EpiBf16 {
    static constexpr bool PERM = true, AFTER_DRAIN = false; static_assert(ACT == 0 || ACT == 1, "EpiBf16: ACT is 0 (none) or 1 (gelu_pk)");
    bf16_t* O; int ldc; const float* bias; int split_cols; size_t split_stride; float scale0;
    __device__ __forceinline__ void operator()(const f32x4 (&acc)[2][2][4][2], const Unit& u, int wr, int wc, int fr, int fq) const {
        const int row0 = u.pm * BM + wr * 64 + fr; int colt = u.pn * BM; bf16_t* base = O;
        float sc = 1.f; if (split_cols) { const int t = colt / split_cols; base += (size_t)t * split_stride; colt -= t * split_cols; if (t == 0) sc = scale0; }
        const int col0 = colt + wc * 32 + 8 * fq, bcol0 = u.pn * BM + wc * 32 + 8 * fq;
        f32x4 bv[2][2];
#pragma unroll
        for (int bj = 0; bj < 2; ++bj)
#pragma unroll
            for (int n = 0; n < 2; ++n) bv[bj][n] = bias ? *(const f32x4*)(bias + bcol0 + bj * HALF + 4 * n) : (f32x4){0.f, 0.f, 0.f, 0.f};
#pragma unroll
        for (int ai = 0; ai < 2; ++ai)
#pragma unroll
            for (int m = 0; m < 4; ++m) { bf16_t* rowp = base + (size_t)(row0 + ai * HALF + m * 16) * ldc + col0;
#pragma unroll
                for (int bj = 0; bj < 2; ++bj) { f32x4 v0 = acc[ai][bj][m][0] + bv[bj][0], v1 = acc[ai][bj][m][1] + bv[bj][1];
                    if (ACT == 1) { f32x2 a = gelu_pk((f32x2){v0[0], v0[1]}), b = gelu_pk((f32x2){v0[2], v0[3]}), c = gelu_pk((f32x2){v1[0], v1[1]}), d = gelu_pk((f32x2){v1[2], v1[3]});
                        v0 = (f32x4){a.x, a.y, b.x, b.y}; v1 = (f32x4){c.x, c.y, d.x, d.y}; }
                    v0 = v0 * sc; v1 = v1 * sc; u32x4 w; w.x = cvt_pk_bf16(v0[0], v0[1]); w.y = cvt_pk_bf16(v0[2], v0[3]); w.z = cvt_pk_bf16(v1[0], v1[1]); w.w = cvt_pk_bf16(v1[2], v1[3]);
                    *(u32x4*)(rowp + bj * HALF) = w; } }
    }
};
template <class Epi, class Sched, bool ALIGN_EPI = false, bool SP2 = false>
__device__ __forceinline__ void gemm_phase(PG8_LAS unsigned char* lds, const Gemm g, const Sched& S, const Epi& E) {
    const int tid = opaque_tid(), wid = __builtin_amdgcn_readfirstlane(tid >> 6), lane = tid & 63, wr = wid >> 2, wc = wid & 3, fr = lane & 15, fq = lane >> 4;
    const int K = g.K, nt = K / BK;
    unsigned voffA[2], voffB[2];
#pragma unroll
    for (int i = 0; i < 2; ++i) { int R, C; stage_rc(tid * 16 + i * 8192, R, C); const int Rb = Epi::PERM ? ((R & ~31) + perm32(R & 31)) : R;
        voffA[i] = (unsigned)(R * K + C) * 2u; voffB[i] = (unsigned)(Rb * K + C) * 2u; }
    const size_t kstep = (size_t)(BK * 2);
    const size_t hstep = (size_t)HALF * K * 2;
    const size_t tstep = 2 * hstep;
    const unsigned ldsw = (unsigned)wid * 1024u;
    const int aoff = lds_byte(wr * 64 + fr, fq * 8), boff = lds_byte(wc * 32 + fr, fq * 8);
#define PG8_SA(b, h) (((b) * 2 + (h)) * HTB)
#define PG8_SB(b, h) ((4 + (b) * 2 + (h)) * HTB)
#define PG8_STAGE(bufoff, gbase, voff) do { _Pragma("unroll") for (int _i = 0; _i < 2; ++_i) \
        __builtin_amdgcn_global_load_lds((const unsigned*)((const char*)(gbase) + (voff)[_i]), (PG8_LAS unsigned*)(lds + (bufoff) + ldsw + _i * 8192), 16, 0, 0); } while (0)
#define PG8_LDA(dst, b, h) do { _Pragma("unroll") for (int m = 0; m < 4; ++m) _Pragma("unroll") for (int k = 0; k < 2; ++k) dst[m][k] = *(const PG8_LAS bf16x8*)(lds + PG8_SA(b, h) + aoff + m * 2048 + k * 1024); } while (0)
#define PG8_LDB(dst, b, h) do { _Pragma("unroll") for (int n = 0; n < 2; ++n) _Pragma("unroll") for (int k = 0; k < 2; ++k) dst[n][k] = *(const PG8_LAS bf16x8*)(lds + PG8_SB(b, h) + boff + n * 2048 + k * 1024); } while (0)
#define PG8_MMA(ai, bj, At, Bt) do { __builtin_amdgcn_s_setprio(1); _Pragma("unroll") for (int m = 0; m < 4; ++m) _Pragma("unroll") for (int n = 0; n < 2; ++n) _Pragma("unroll") for (int k = 0; k < 2; ++k) \
        acc[ai][bj][m][n] = __builtin_amdgcn_mfma_f32_16x16x32_bf16(Bt[n][k], At[m][k], acc[ai][bj][m][n], 0, 0, 0); __builtin_amdgcn_s_setprio(0); } while (0)
#define PG8_WAIT_V(n) asm volatile("s_waitcnt vmcnt(" #n ")" ::: "memory")
#define PG8_WAIT_L(n) asm volatile("s_waitcnt lgkmcnt(" #n ")" ::: "memory")
#define PG8_BAR __builtin_amdgcn_s_barrier()
#define PG8_SCHED __builtin_amdgcn_sched_barrier(0)
    Unit cur, nxt; int ui = 0;
    if (!S.next(0, cur)) return;
    f32x4 acc[2][2][4][2];
#pragma unroll
    for (int a = 0; a < 2; ++a)
#pragma unroll
        for (int b = 0; b < 2; ++b)
#pragma unroll
            for (int m = 0; m < 4; ++m)
#pragma unroll
                for (int n = 0; n < 2; ++n) acc[a][b][m][n] = (f32x4){0.f, 0.f, 0.f, 0.f};
    bf16x8 At[4][2], B0[2][2], B1[2][2];
    const char* cA = (const char*)g.A + (size_t)cur.pm * tstep; const char* cB = (const char*)g.Bt + (size_t)cur.pn * tstep;
    S.a_ready(cur);
    if constexpr (SP2) {
        PG8_STAGE(PG8_SB(0, 0), cB, voffB); PG8_STAGE(PG8_SB(0, 1), cB + hstep, voffB); PG8_STAGE(PG8_SA(0, 0), cA, voffA); PG8_STAGE(PG8_SA(0, 1), cA + hstep, voffA);
        if (wr == 1) PG8_BAR;
        PG8_WAIT_V(2); PG8_BAR;
        PG8_STAGE(PG8_SB(1, 0), cB + kstep, voffB); PG8_STAGE(PG8_SA(1, 0), cA + kstep, voffA); PG8_STAGE(PG8_SB(1, 1), cB + hstep + kstep, voffB);
        PG8_WAIT_V(6); PG8_BAR;
    } else {
        PG8_STAGE(PG8_SB(0, 0), cB, voffB); PG8_STAGE(PG8_SA(0, 0), cA, voffA); PG8_STAGE(PG8_SB(0, 1), cB + hstep, voffB); PG8_STAGE(PG8_SA(0, 1), cA + hstep, voffA);
        if (wr == 1) PG8_BAR;
        PG8_WAIT_V(4); PG8_BAR;
        PG8_STAGE(PG8_SB(1, 0), cB + kstep, voffB); PG8_STAGE(PG8_SA(1, 0), cA + kstep, voffA); PG8_STAGE(PG8_SB(1, 1), cB + hstep + kstep, voffB);
        PG8_WAIT_V(6); PG8_BAR;
    }
    for (;;) {
        const bool has_next = S.next(ui + 1, nxt);
        const char* nA = has_next ? (const char*)g.A + (size_t)nxt.pm * tstep : cA; const char* nB = has_next ? (const char*)g.Bt + (size_t)nxt.pn * tstep : cB;
        for (int t = 0; t < nt; t += 2) {
            const bool last = (t == nt - 2);
            const char* a1 = cA + (size_t)(t + 1) * kstep;
            const char* a2 = last ? nA : cA + (size_t)(t + 2) * kstep; const char* b2 = last ? nB : cB + (size_t)(t + 2) * kstep;
            const char* a3 = a2 + kstep; const char* b3 = b2 + kstep;
            if (last && has_next) S.a_ready(nxt);
            if constexpr (SP2) {
            PG8_LDB(B0, 0, 0); PG8_LDB(B1, 0, 1); PG8_SCHED; PG8_LDA(At, 0, 0); PG8_STAGE(PG8_SA(1, 1), a1 + hstep, voffA);
            PG8_WAIT_V(8); PG8_WAIT_L(0); PG8_BAR; PG8_MMA(0, 0, At, B0); PG8_MMA(0, 1, At, B1); PG8_BAR; PG8_SCHED;
            PG8_LDA(At, 0, 1); PG8_STAGE(PG8_SB(0, 0), b2, voffB); PG8_STAGE(PG8_SB(0, 1), b2 + hstep, voffB); PG8_STAGE(PG8_SA(0, 0), a2, voffA);
            PG8_WAIT_V(8); PG8_WAIT_L(0); PG8_BAR; PG8_MMA(1, 0, At, B0); PG8_MMA(1, 1, At, B1); PG8_BAR; PG8_SCHED;
            PG8_LDB(B0, 1, 0); PG8_LDB(B1, 1, 1); PG8_SCHED; PG8_LDA(At, 1, 0); PG8_STAGE(PG8_SA(0, 1), a2 + hstep, voffA);
            PG8_WAIT_V(8); PG8_WAIT_L(0); PG8_BAR; PG8_MMA(0, 0, At, B0); PG8_MMA(0, 1, At, B1); PG8_BAR; PG8_SCHED;
            PG8_LDA(At, 1, 1); PG8_STAGE(PG8_SB(1, 0), b3, voffB); PG8_STAGE(PG8_SB(1, 1), b3 + hstep, voffB); PG8_STAGE(PG8_SA(1, 0), a3, voffA);
            PG8_WAIT_V(8); PG8_WAIT_L(0); PG8_BAR; PG8_MMA(1, 0, At, B0); PG8_MMA(1, 1, At, B1); PG8_BAR; PG8_SCHED;
            } else {
            PG8_LDB(B0, 0, 0); PG8_SCHED; PG8_LDA(At, 0, 0); PG8_STAGE(PG8_SA(1, 1), a1 + hstep, voffA);
            PG8_WAIT_L(8); PG8_BAR; PG8_WAIT_L(0); PG8_MMA(0, 0, At, B0); PG8_BAR; PG8_SCHED;
            PG8_LDB(B1, 0, 1); PG8_STAGE(PG8_SB(0, 0), b2, voffB);
            PG8_BAR; PG8_WAIT_L(0); PG8_MMA(0, 1, At, B1); PG8_BAR;
            PG8_LDA(At, 0, 1); PG8_STAGE(PG8_SA(0, 0), a2, voffA);
            PG8_BAR; PG8_WAIT_L(0); PG8_MMA(1, 0, At, B0); PG8_BAR; PG8_SCHED;
            PG8_STAGE(PG8_SB(0, 1), b2 + hstep, voffB);
            PG8_WAIT_V(6); PG8_BAR; PG8_MMA(1, 1, At, B1); PG8_BAR;
            PG8_LDB(B0, 1, 0); PG8_SCHED; PG8_LDA(At, 1, 0); PG8_STAGE(PG8_SA(0, 1), a2 + hstep, voffA);
            PG8_WAIT_L(8); PG8_BAR; PG8_WAIT_L(0); PG8_MMA(0, 0, At, B0); PG8_BAR; PG8_SCHED;
            PG8_LDB(B1, 1, 1); PG8_STAGE(PG8_SB(1, 0), b3, voffB);
            PG8_BAR; PG8_WAIT_L(0); PG8_MMA(0, 1, At, B1); PG8_BAR;
            PG8_LDA(At, 1, 1); PG8_STAGE(PG8_SA(1, 0), a3, voffA);
            PG8_BAR; PG8_WAIT_L(0); PG8_MMA(1, 0, At, B0); PG8_BAR; PG8_SCHED;
            PG8_STAGE(PG8_SB(1, 1), b3 + hstep, voffB);
            PG8_WAIT_V(6); PG8_BAR; PG8_MMA(1, 1, At, B1); PG8_BAR;
            }
        }
        if constexpr (ALIGN_EPI) { if (wr == 0) PG8_BAR; }
        if constexpr (!Epi::AFTER_DRAIN) { E(acc, cur, wr, wc, fr, fq); S.done(cur); }
        if (!has_next) break;
#pragma unroll
        for (int a = 0; a < 2; ++a)
#pragma unroll
            for (int b = 0; b < 2; ++b)
#pragma unroll
                for (int m = 0; m < 4; ++m)
#pragma unroll
                    for (int n = 0; n < 2; ++n) acc[a][b][m][n] = (f32x4){0.f, 0.f, 0.f, 0.f};
        cur = nxt; cA = nA; cB = nB; ++ui;
        if constexpr (ALIGN_EPI) { if (wr == 1) PG8_BAR; }
    }
    PG8_WAIT_V(0);
    if constexpr (!ALIGN_EPI) { if (wr == 0) PG8_BAR; }
    PG8_BAR;
    if constexpr (Epi::AFTER_DRAIN) { E.fused(acc, cur, wr, wc, fr, fq, lds, wid, lane); S.done(cur); }
#undef PG8_SA
#undef PG8_SB
#undef PG8_STAGE
#undef PG8_LDA
#undef PG8_LDB
#undef PG8_MMA
#undef PG8_WAIT_V
#undef PG8_WAIT_L
#undef PG8_BAR
#undef PG8_SCHED
}
}
#ifndef PG8_SP2
#define PG8_SP2 true
#endif
#ifndef PG8_ALIGN
#define PG8_ALIGN true
#endif
#ifndef MK_N_LAUNCHES
#define MK_N_LAUNCHES 1
#endif

constexpr int NB = 8, SEQ = 4096, D = 1024, T = NB * SEQ, NPROJ = 4096, DMIX = 2048;
constexpr int NPH = 10;
constexpr float EPS = 1e-6f;
constexpr size_t MiB = 1u << 20;
constexpr size_t WS_WIN = 0, WS_WOUT = 16 * MiB, WS_GW = 24 * MiB, WS_PW = 25 * MiB, WS_MOD = 26 * MiB;
constexpr size_t WS_H = 32 * MiB, WS_YCAT = 96 * MiB, WS_PROJ = 224 * MiB, WS_Y = WS_PROJ, WS_U = WS_H, WS_END = 480 * MiB;
constexpr size_t WS_CTL = 28 * MiB, CTL_BYTES = 16384;
constexpr int LDS_BYTES = 147456, LDS_BST_OFF = 131072 + 64;

#define LAS __attribute__((address_space(3)))
typedef unsigned short bf16;
typedef float f32x4 __attribute__((ext_vector_type(4)));
typedef float f32x2 __attribute__((ext_vector_type(2)));
typedef unsigned u32x4 __attribute__((ext_vector_type(4)));
typedef unsigned u32x2 __attribute__((ext_vector_type(2)));
typedef short bf16x8 __attribute__((ext_vector_type(8)));

struct Args { const float* in[18]; float* out; unsigned char* ws; int ph_lo, ph_hi; };

__device__ __forceinline__ unsigned pk2(float lo, float hi) { return pg8::cvt_pk_bf16(lo, hi); }
__device__ __forceinline__ float bflo(unsigned w) { return u2f(w << 16); }
__device__ __forceinline__ float bfhi(unsigned w) { return u2f(w & 0xffff0000u); }
__device__ __forceinline__ float wave_sum(float v) {
#pragma unroll
    for (int o = 1; o < 64; o <<= 1) v += shfl_xor_(v, o);
    return v;
}
__device__ __forceinline__ float sigmoidf_(float x) { return 1.0f / (1.0f + __expf(-x)); }
__device__ __forceinline__ float siluf_(float x) { return x / (1.0f + __expf(-x)); }

__device__ __forceinline__ void transpose_tile(const float* W, int K, int N, bf16* WT, LAS float* scr, int k0, int n0, int drow, int lane, float wscale = 1.0f) {
    {
        f32x4 v[8];
#pragma unroll
        for (int i = 0; i < 8; ++i) v[i] = *(const f32x4*)(W + (size_t)(k0 + (lane >> 3) + 8 * i) * N + n0 + (lane & 7) * 4);
#pragma unroll
        for (int i = 0; i < 8; ++i) { LAS float* d = scr + ((lane >> 3) + 8 * i) * 33 + (lane & 7) * 4; d[0] = v[i].x * wscale; d[1] = v[i].y * wscale; d[2] = v[i].z * wscale; d[3] = v[i].w * wscale; }
    }
    asm volatile("s_waitcnt lgkmcnt(0)" ::: "memory");
    const int c = lane & 7;
#pragma unroll
    for (int j = 0; j < 4; ++j) { const int n = (lane >> 3) + 8 * j; const LAS float* s = scr + (8 * c) * 33 + n;
        u32x4 o; o.x = pk2(s[0 * 33], s[1 * 33]); o.y = pk2(s[2 * 33], s[3 * 33]); o.z = pk2(s[4 * 33], s[5 * 33]); o.w = pk2(s[6 * 33], s[7 * 33]);
        *(u32x4*)(WT + (size_t)(drow + n) * K + k0 + 8 * c) = o; }
    asm volatile("s_waitcnt lgkmcnt(0)" ::: "memory");
}
__device__ __forceinline__ void transpose_item(const float* W, int K, int N, bf16* WT, LAS float* scr, int item, int lane) {
    const int nblk = N / 32, kb = item / nblk, nb = item % nblk;
    transpose_tile(W, K, N, WT, scr, 64 * kb, 32 * nb, 32 * nb, lane);
}

__device__ __forceinline__ void phase_prep(const Args& a, LAS unsigned char* lds) {
    const int tid = opaque_tid(), lane = tid & 63, wv = tid >> 6;
    const int G = gridDim.x;
    unsigned char* ws = a.ws;
    {
        LAS float* sc = (LAS float*)lds;
        LAS float* red = (LAS float*)(lds + 32768);
        const float* c = a.in[1]; const float* ada_w = a.in[2]; const float* ada_b = a.in[3];
        float* MOD = (float*)(ws + WS_MOD);
        if ((int)blockIdx.x < 192) {
            for (int i = tid; i < 8192; i += 512) sc[i] = siluf_(c[i]);
            sync_threads_();
            for (int unit = blockIdx.x; unit < 192; unit += G) {
                const int l = unit / 96, cb = (unit % 96) * 32, cl = tid & 31, ks = tid >> 5;
                const float* wp = ada_w + (size_t)l * 1024 * 3072 + (size_t)(ks * 64) * 3072 + cb + cl;
                float acc[8];
#pragma unroll
                for (int b = 0; b < 8; ++b) acc[b] = 0.f;
#pragma unroll 16
                for (int k = 0; k < 64; ++k) { const float w = wp[(size_t)k * 3072];
#pragma unroll
                    for (int b = 0; b < 8; ++b) acc[b] += sc[b * 1024 + ks * 64 + k] * w; }
#pragma unroll
                for (int b = 0; b < 8; ++b) red[(ks * 8 + b) * 32 + cl] = acc[b];
                sync_threads_();
                if (tid < 256) { const int b = tid >> 5; float s = 0.f;
#pragma unroll
                    for (int k2 = 0; k2 < 16; ++k2) s += red[(k2 * 8 + b) * 32 + cl];
                    MOD[(l * 8 + b) * 3072 + cb + cl] = s + ada_b[l * 3072 + cb + cl]; }
                sync_threads_();
            }
        }
        sync_threads_();
    }
    {
        LAS float* scr = (LAS float*)(lds + wv * 16384);
        const int gw = blockIdx.x * 8 + wv, NGW = G * 8;
        constexpr int I_IN = (1024 / 64) * (4096 / 32), I_OUT = (2048 / 64) * (1024 / 32);
        for (int it = gw; it < 2 * (I_IN + I_OUT); it += NGW) {
            int r = it;
            if (r < 2 * I_IN) { const int l = r / I_IN; r -= l * I_IN;
                transpose_item(a.in[5] + (size_t)l * 1024 * 4096, 1024, 4096, (bf16*)(ws + WS_WIN) + (size_t)l * 4096 * 1024, scr, r, lane); }
            else { r -= 2 * I_IN; const int l = r / I_OUT; r -= l * I_OUT;
                transpose_item(a.in[16] + (size_t)l * 2048 * 1024, 2048, 1024, (bf16*)(ws + WS_WOUT) + (size_t)l * 1024 * 2048, scr, r, lane); }
        }
    }
    {
        LAS float* scr = (LAS float*)(lds + wv * 16384);
        const int gw = blockIdx.x * 8 + wv, NGW = G * 8;
        bf16* GWp = (bf16*)(ws + WS_GW); bf16* PWp = (bf16*)(ws + WS_PW);
        for (int it = NGW - 1 - gw; it < 512; it += NGW) {
            if (it < 256) { const int lh = it >> 4, r = it & 15, gate = r >> 3, kb = (r >> 2) & 1, q = r & 3;
                transpose_tile((gate ? a.in[10] : a.in[8]) + (size_t)lh * 128 * 128, 128, 128, GWp + (size_t)lh * 4 * 64 * 128, scr, 64 * kb, 32 * q, q * 64 + gate * 32, lane, -1.4426950408889634f); }
            else { const int r = it - 256, lg = r >> 5, kb = (r >> 3) & 3, nb = r & 7;
                transpose_tile(a.in[13] + (size_t)lg * 256 * 256, 256, 256, PWp + (size_t)lg * 256 * 256, scr, 64 * kb, 32 * nb, 32 * nb, lane); }
        }
    }
}

constexpr int RPW = 4;
__device__ __forceinline__ void phase_h0(const Args& a) {
    const int tid = opaque_tid(), lane = tid & 63, wv = tid >> 6;
    const int gw = blockIdx.x * 8 + wv, NGW = gridDim.x * 8;
    const float* x = a.in[0]; const float* g = a.in[4]; const float* MOD = (const float*)(a.ws + WS_MOD);
    bf16* H = (bf16*)(a.ws + WS_H);
    const int WPB = NGW / NB, b = gw / WPB, wq = gw % WPB;
    const float* sh = MOD + (size_t)b * 3072; const float* scl = sh + 1024;
    f32x4 A1[4], SH[4];
#pragma unroll
    for (int j = 0; j < 4; ++j) { const int col = 4 * lane + 256 * j; A1[j] = *(const f32x4*)(g + col) * (*(const f32x4*)(scl + col) + 1.0f); SH[j] = *(const f32x4*)(sh + col); }
    for (int mr = wq * RPW; mr < SEQ; mr += WPB * RPW) {
        const int m0 = b * SEQ + mr;
        f32x4 v[RPW][4];
#pragma unroll
        for (int r = 0; r < RPW; ++r) { const f32x4* xr = (const f32x4*)(x + (size_t)(m0 + r) * D) + lane;
#pragma unroll
            for (int j = 0; j < 4; ++j) v[r][j] = __builtin_nontemporal_load(xr + 64 * j); }
#pragma unroll
        for (int r = 0; r < RPW; ++r) {
            float ss = 0.f;
#pragma unroll
            for (int j = 0; j < 4; ++j) ss += (v[r][j].x * v[r][j].x + v[r][j].y * v[r][j].y) + (v[r][j].z * v[r][j].z + v[r][j].w * v[r][j].w);
            const float rstd = 1.0f / __builtin_sqrtf(wave_sum(ss) * (1.0f / D) + EPS);
            u32x2* o = (u32x2*)(H + (size_t)(m0 + r) * D) + lane;
#pragma unroll
            for (int j = 0; j < 4; ++j) {
                const f32x4 rr = (v[r][j] * rstd) * A1[j] + SH[j];
                u32x2 w; w.x = pk2(rr.x, rr.y); w.y = pk2(rr.z, rr.w); o[64 * j] = w; }
        }
    }
}

__device__ __forceinline__ void phase_post(const Args& a, int l) {
    const int tid = opaque_tid(), lane = tid & 63, wv = tid >> 6;
    const int gw = blockIdx.x * 8 + wv, NGW = gridDim.x * 8;
    const float* xin = (l == 0) ? a.in[0] : a.out; float* out = a.out;
    const bf16* Y = (const bf16*)(a.ws + WS_Y); bf16* H = (bf16*)(a.ws + WS_H);
    const float* MOD = (const float*)(a.ws + WS_MOD);
    const float* gpost = a.in[17] + l * D; const float* gpre = a.in[4] + (l + 1) * D;
    const int WPB = NGW / NB, b = gw / WPB, wq = gw % WPB;
    const float* gate = MOD + (size_t)(l * 8 + b) * 3072 + 2048;
    const float* sh = MOD + (size_t)(8 + b) * 3072; const float* scl = sh + 1024;
    f32x4 GP[4], A1[4], SH[4];
#pragma unroll
    for (int j = 0; j < 4; ++j) { const int col = 4 * lane + 256 * j; GP[j] = *(const f32x4*)(gate + col) * *(const f32x4*)(gpost + col);
        if (l == 0) { A1[j] = *(const f32x4*)(gpre + col) * (*(const f32x4*)(scl + col) + 1.0f); SH[j] = *(const f32x4*)(sh + col); } }
    for (int mr = wq * RPW; mr < SEQ; mr += WPB * RPW) {
        const int m0 = b * SEQ + mr;
        f32x4 xv[RPW][4]; u32x2 yw[RPW][4];
#pragma unroll
        for (int r = 0; r < RPW; ++r) { const f32x4* xr = (const f32x4*)(xin + (size_t)(m0 + r) * D) + lane; const u32x2* yr = (const u32x2*)(Y + (size_t)(m0 + r) * D) + lane;
#pragma unroll
            for (int j = 0; j < 4; ++j) { xv[r][j] = xr[64 * j]; yw[r][j] = yr[64 * j]; } }
#pragma unroll
        for (int r = 0; r < RPW; ++r) {
            f32x4 yv[4]; float ss = 0.f;
#pragma unroll
            for (int j = 0; j < 4; ++j) { const u32x2 w = yw[r][j]; yv[j] = (f32x4){bflo(w.x), bfhi(w.x), bflo(w.y), bfhi(w.y)};
                ss += (yv[j].x * yv[j].x + yv[j].y * yv[j].y) + (yv[j].z * yv[j].z + yv[j].w * yv[j].w); }
            const float rstd = 1.0f / __builtin_sqrtf(wave_sum(ss) * (1.0f / D) + EPS);
            float ss2 = 0.f;
#pragma unroll
            for (int j = 0; j < 4; ++j) { const int col = 4 * lane + 256 * j;
                const f32x4 xn = xv[r][j] + (yv[j] * rstd) * GP[j];
                xv[r][j] = xn;
                if (l == 0) *((f32x4*)(out + (size_t)(m0 + r) * D + col)) = xn;
                else __builtin_nontemporal_store(xn, (f32x4*)(out + (size_t)(m0 + r) * D + col));
                ss2 += (xn.x * xn.x + xn.y * xn.y) + (xn.z * xn.z + xn.w * xn.w); }
            if (l == 0) {
                const float rstd2 = 1.0f / __builtin_sqrtf(wave_sum(ss2) * (1.0f / D) + EPS);
                u32x2* o = (u32x2*)(H + (size_t)(m0 + r) * D) + lane;
#pragma unroll
                for (int j = 0; j < 4; ++j) {
                    const f32x4 rr = (xv[r][j] * rstd2) * A1[j] + SH[j];
                    u32x2 w; w.x = pk2(rr.x, rr.y); w.y = pk2(rr.z, rr.w); o[64 * j] = w; }
            }
        }
    }
}
#define XB_TMO      128
#define XB_XCNT(j)  (256  + 64 * (j))
#define XB_XSUB(j)  (1280 + 64 * (j))
#define XB_XGEN(j)  (2304 + 64 * (j))
#define XB_TOP      3328
#define XB_TOPGEN   3392
#define XCD_BAR_WORDS 3456
#define XB_SPIN_CAP (1u << 18)

__device__ __forceinline__ unsigned xb_ld(unsigned* p)              { return __hip_atomic_load(p, __ATOMIC_RELAXED, __HIP_MEMORY_SCOPE_AGENT); }
__device__ __forceinline__ unsigned xb_add(unsigned* p, unsigned v) { return __hip_atomic_fetch_add(p, v, __ATOMIC_RELAXED, __HIP_MEMORY_SCOPE_AGENT); }
__device__ __forceinline__ unsigned xb_xcc_id() { return (unsigned)__builtin_amdgcn_s_getreg((3 << 11) | 20) & 0xFu; }
#define XB_SPIN(cond, bar) do { unsigned _sp = 0; while (cond) { __builtin_amdgcn_s_sleep(1); \
    if ((++_sp & 255u) == 0u) { if (xb_ld(&(bar)[XB_TMO])) break; if (_sp > XB_SPIN_CAP) { xb_add(&(bar)[XB_TMO], 1u); break; } } } } while (0)

struct XcdBarrier {
    unsigned* bar; unsigned x;
    volatile LAS unsigned* st;
};

__device__ __forceinline__ XcdBarrier xcd_barrier_post(unsigned* bar, volatile LAS unsigned* st) {
    XcdBarrier b; b.bar = bar; b.x = xb_xcc_id(); b.st = st;
    if (threadIdx.x == 0) (void)xb_add(&bar[XB_XCNT(b.x)], 1u);
    return b;
}
__device__ __forceinline__ void xcd_barrier_complete(unsigned* bar, unsigned x, unsigned& nloc, unsigned& nx) {
    const unsigned G = gridDim.x * gridDim.y * gridDim.z;
    unsigned sum, cnt, mine, sp = 0u;
    for (;;) {
        sum = 0u; cnt = 0u; mine = 0u;
#pragma unroll
        for (unsigned j = 0; j < 16; ++j) { const unsigned c = xb_ld(&bar[XB_XCNT(j)]); sum += c; cnt += (c > 0u) ? 1u : 0u; mine = (j == x) ? c : mine; }
        if (sum == G) break;
        __builtin_amdgcn_s_sleep(1);
        if ((++sp & 255u) == 0u) { if (xb_ld(&bar[XB_TMO])) break; if (sp > XB_SPIN_CAP) { xb_add(&bar[XB_TMO], 1u); break; } }
    }
    nloc = mine > 0u ? mine : 1u; nx = cnt > 0u ? cnt : 1u;
}

__device__ __forceinline__ void xcd_barrier(const XcdBarrier& b) {
    asm volatile("s_waitcnt vmcnt(0)" ::: "memory");
    sync_threads_();
    if (threadIdx.x == 0) {
        unsigned* bar = b.bar;
        __builtin_amdgcn_s_waitcnt(0);
        unsigned nloc = b.st[0], nx = b.st[1];
        if (nloc == 0u) { xcd_barrier_complete(bar, b.x, nloc, nx); b.st[0] = nloc; b.st[1] = nx; }
        const unsigned old = xb_add(&bar[XB_XSUB(b.x)], 1u);
        const unsigned gen = old / nloc;
        if (old + 1u == (gen + 1u) * nloc) {
            __builtin_amdgcn_fence(__ATOMIC_RELEASE, "agent");
            asm volatile("s_waitcnt vmcnt(0)" ::: "memory");
            const unsigned og = xb_add(&bar[XB_TOP], 1u);
            const unsigned tg = og / nx;
            if (og + 1u == (tg + 1u) * nx) xb_add(&bar[XB_TOPGEN], 1u);
            else XB_SPIN(xb_ld(&bar[XB_TOPGEN]) == tg, bar);
            __builtin_amdgcn_fence(__ATOMIC_ACQUIRE, "agent");
            xb_add(&bar[XB_XGEN(b.x)], 1u);
            asm volatile("s_waitcnt vmcnt(0)" ::: "memory");
        } else {
            XB_SPIN(xb_ld(&bar[XB_XGEN(b.x)]) == gen, bar);
            __builtin_amdgcn_fence(__ATOMIC_ACQUIRE, "agent");
            asm volatile("s_waitcnt vmcnt(0)" ::: "memory");
        }
    }
    sync_threads_();
}

#define LDS_BARRIER() do { asm volatile("s_waitcnt lgkmcnt(0)" ::: "memory"); __builtin_amdgcn_s_barrier(); asm volatile("" ::: "memory"); } while (0)
constexpr int XROW = 272;
constexpr int CROW = 132;
constexpr int R_XT = 0, R_UT = 35840, R_AT = 70656, R_VT = 87552, R_EP = 104448, R_CWT = 105472, R_GT = 108032, R_YT = 116736;
template <int D> __device__ __forceinline__ float dpp_row_shr(float old, float src) {
    return i2f(__builtin_amdgcn_update_dpp(f2i(old), f2i(src), 0x110 | D, 0xf, 0xf, false)); }
__device__ __forceinline__ float softplus_small_(float e) { return (e < 0.03f) ? e * (1.0f + e * (-0.5f + e * (0.33333334f + e * (-0.25f + e * 0.2f)))) : __builtin_logf(1.0f + e); }
__device__ __forceinline__ float fast_sigmoid(float x) { return __builtin_amdgcn_rcpf(1.0f + __builtin_amdgcn_exp2f(-1.4426950408889634f * x)); }
__device__ __forceinline__ void rnn_unit(const Args& a, int l, int u, LAS unsigned char* lds) {
    const int tid = opaque_tid(), lane = tid & 63, wv = tid >> 6, fr = lane & 15, fq = lane >> 4;
    const int xcd = u & 7, jj = u >> 3, q = jj & 3, bh = (jj >> 2) * 8 + xcd, b = bh >> 3, h = bh & 7;
    const bf16* PROJ = (const bf16*)(a.ws + WS_PROJ); bf16* YCAT = (bf16*)(a.ws + WS_YCAT);
    const bf16* xr_base = PROJ + (size_t)(b * SEQ) * NPROJ + h * 128;
    const bf16* gr_base = PROJ + (size_t)(b * SEQ) * NPROJ + 1024 + h * 128 + q * 32;
    bf16* y_base = YCAT + (size_t)(b * SEQ) * DMIX + h * 128 + q * 32;
    LAS unsigned char* XT = lds + R_XT; LAS unsigned char* UT = lds + R_UT;
    LAS float* AT = (LAS float*)(lds + R_AT); LAS float* VT = (LAS float*)(lds + R_VT);
    LAS unsigned char* GT = lds + R_GT; LAS unsigned char* YT = lds + R_YT;
    const int io_tk = tid >> 2, io_cq = tid & 3;
    const int ck = tid & 15, tg = tid >> 4;
    LAS float* CWT = (LAS float*)(lds + R_CWT);
    for (int i = tid; i < 640; i += 512) { const int r = i >> 7, c = i & 127;
        CWT[i] = (r < 4) ? a.in[6][(size_t)l * 4 * 1024 + r * 1024 + h * 128 + c] : a.in[7][(size_t)l * 1024 + h * 128 + c]; }
    bf16x8 Wf[4][4];
    {
        const bf16* gwp = (const bf16*)(a.ws + WS_GW) + (size_t)((l * 8 + h) * 4 + q) * 64 * 128;
#pragma unroll
        for (int nb = 0; nb < 4; ++nb)
#pragma unroll
            for (int kb = 0; kb < 4; ++kb) Wf[nb][kb] = *(const bf16x8*)(gwp + (nb * 16 + fr) * 128 + kb * 32 + fq * 8);
    }
    LAS float* EP = (LAS float*)(lds + R_EP);
    if (tid < 96) {
        const int r = tid >> 5, c = tid & 31, ch = h * 128 + q * 32 + c; float v;
        if (r == 0) v = -1.4426950408889634f * a.in[9][l * 1024 + ch];
        else if (r == 1) v = -1.4426950408889634f * a.in[11][l * 1024 + ch];
        else v = 8.0f * 1.4426950408889634f * softplus_small_(__builtin_expf(-a.in[12][l * 1024 + ch]));
        EP[r * 32 + c] = v;
    }
    u32x4 pf[4], pfh = (u32x4){0u, 0u, 0u, 0u};
#pragma unroll
    for (int i = 0; i < 4; ++i) { const int id = tid + 512 * i, row = id >> 4, cc = id & 15; pf[i] = *(const u32x4*)(xr_base + (size_t)row * NPROJ + cc * 8); }
    u32x4 gpf = *(const u32x4*)(gr_base + (size_t)io_tk * NPROJ + io_cq * 8);
    const int sc_ci = lane >> 4, sc_sg = lane & 15, sc_c = wv * 4 + sc_ci;
    float hcar = 0.f;
#pragma unroll
    for (int i = 0; i < 4; ++i) { const int id = tid + 512 * i, row = id >> 4, cc = id & 15; *(LAS u32x4*)(XT + (3 + row) * XROW + cc * 16) = pf[i]; }
    if (tid < 48) *(LAS u32x4*)(XT + (tid >> 4) * XROW + (tid & 15) * 16) = pfh;
    for (int tile = 0; tile < SEQ / 128; ++tile) {
        const int t0 = tile * 128;
        LDS_BARRIER();
        {
            const int t0n = (tile + 1 < SEQ / 128) ? t0 + 128 : t0;
#pragma unroll
            for (int i = 0; i < 4; ++i) { const int id = tid + 512 * i, row = id >> 4, cc = id & 15; pf[i] = *(const u32x4*)(xr_base + (size_t)(t0n + row) * NPROJ + cc * 8); }
            if (tid < 48) pfh = *(const u32x4*)(xr_base + (size_t)(t0n - 3 + (tid >> 4)) * NPROJ + (tid & 15) * 8);
        }
        {
            if (tile > 0) {
                unsigned short yv_[8];
#pragma unroll
                for (int e = 0; e < 8; ++e) yv_[e] = *(const LAS unsigned short*)(YT + (io_cq * 8 + e) * XROW + io_tk * 2);
                u32x4 w; w.x = yv_[0] | ((unsigned)yv_[1] << 16); w.y = yv_[2] | ((unsigned)yv_[3] << 16); w.z = yv_[4] | ((unsigned)yv_[5] << 16); w.w = yv_[6] | ((unsigned)yv_[7] << 16);
                *(u32x4*)(y_base + (size_t)(t0 - 128 + io_tk) * DMIX + io_cq * 8) = w;
            }
            const unsigned gwv[4] = {gpf.x, gpf.y, gpf.z, gpf.w};
#pragma unroll
            for (int e2 = 0; e2 < 4; ++e2) { *(LAS unsigned short*)(GT + (io_cq * 8 + 2 * e2) * XROW + io_tk * 2) = (unsigned short)(gwv[e2] & 0xffffu);
                *(LAS unsigned short*)(GT + (io_cq * 8 + 2 * e2 + 1) * XROW + io_tk * 2) = (unsigned short)(gwv[e2] >> 16); }
            const int t1 = (tile + 1 < SEQ / 128) ? t0 + 128 : t0;
            gpf = *(const u32x4*)(gr_base + (size_t)(t1 + io_tk) * NPROJ + io_cq * 8);
        }
        {
            f32x2 o[4][4], cw[4][4];
            {
                const f32x4 b0 = *(const LAS f32x4*)(CWT + 4 * 128 + ck * 8), b1 = *(const LAS f32x4*)(CWT + 4 * 128 + ck * 8 + 4);
#pragma unroll
                for (int i = 0; i < 4; ++i) { o[i][0] = (f32x2){b0.x, b0.y}; o[i][1] = (f32x2){b0.z, b0.w}; o[i][2] = (f32x2){b1.x, b1.y}; o[i][3] = (f32x2){b1.z, b1.w}; }
            }
#pragma unroll
            for (int k = 0; k < 4; ++k) { const f32x4 w0 = *(const LAS f32x4*)(CWT + k * 128 + ck * 8), w1 = *(const LAS f32x4*)(CWT + k * 128 + ck * 8 + 4);
                cw[k][0] = (f32x2){w0.x, w0.y}; cw[k][1] = (f32x2){w0.z, w0.w}; cw[k][2] = (f32x2){w1.x, w1.y}; cw[k][3] = (f32x2){w1.z, w1.w}; }
#pragma unroll
            for (int r = 0; r < 7; ++r) {
                const u32x4 w = *(const LAS u32x4*)(XT + (tg * 4 + r) * XROW + ck * 16);
                const f32x2 xv[4] = {(f32x2){bflo(w.x), bfhi(w.x)}, (f32x2){bflo(w.y), bfhi(w.y)}, (f32x2){bflo(w.z), bfhi(w.z)}, (f32x2){bflo(w.w), bfhi(w.w)}};
#pragma unroll
                for (int i = 0; i < 4; ++i) { const int k = r - i; if (k >= 0 && k < 4) {
#pragma unroll
                    for (int e = 0; e < 4; ++e) o[i][e] = __builtin_elementwise_fma(cw[k][e], xv[e], o[i][e]); } }
            }
#pragma unroll
            for (int i = 0; i < 4; ++i) { u32x4 w; w.x = pk2(o[i][0].x, o[i][0].y); w.y = pk2(o[i][1].x, o[i][1].y); w.z = pk2(o[i][2].x, o[i][2].y); w.w = pk2(o[i][3].x, o[i][3].y);
                *(LAS u32x4*)(UT + (tg * 4 + i) * XROW + ck * 16) = w; }
        }
        asm volatile("s_waitcnt lgkmcnt(0)" ::: "memory");
        {
            f32x4 acc[4];
#pragma unroll
            for (int nb = 0; nb < 4; ++nb) acc[nb] = (f32x4){0.f, 0.f, 0.f, 0.f};
#pragma unroll
            for (int kb = 0; kb < 4; ++kb) { const bf16x8 uf = *(const LAS bf16x8*)(UT + (wv * 16 + fr) * XROW + kb * 64 + fq * 16);
#pragma unroll
                for (int nb = 0; nb < 4; ++nb) acc[nb] = __builtin_amdgcn_mfma_f32_16x16x32_bf16(Wf[nb][kb], uf, acc[nb], 0, 0, 0); }
            const int tk = wv * 16 + fr;
#pragma unroll
            for (int nb2 = 0; nb2 < 2; ++nb2) {
                const int c0 = nb2 * 16 + 4 * fq;
                const u32x2 uw = *(const LAS u32x2*)(UT + tk * XROW + (q * 32 + c0) * 2);
                const f32x4 uu = (f32x4){bflo(uw.x), bfhi(uw.x), bflo(uw.y), bfhi(uw.y)};
                const f32x4 ra = acc[nb2] + *(const LAS f32x4*)(EP + c0), rx = acc[nb2 + 2] + *(const LAS f32x4*)(EP + 32 + c0), sp8 = *(const LAS f32x4*)(EP + 64 + c0);
#pragma unroll
                for (int e = 0; e < 4; ++e) { const float r = __builtin_amdgcn_rcpf(1.0f + __builtin_amdgcn_exp2f(ra[e])), ig = __builtin_amdgcn_rcpf(1.0f + __builtin_amdgcn_exp2f(rx[e]));
                    const float av = __builtin_amdgcn_exp2f(-r * sp8[e]);
                    const float m2 = __builtin_fmaxf(__builtin_fmaf(-av, av, 1.0f), 0.f);
                    AT[(c0 + e) * CROW + tk] = av; VT[(c0 + e) * CROW + tk] = __builtin_amdgcn_sqrtf(m2) * (ig * uu[e]); }
            }
        }
        LDS_BARRIER();
        {
            const f32x4 a0 = *(const LAS f32x4*)(AT + sc_c * CROW + sc_sg * 8), a1 = *(const LAS f32x4*)(AT + sc_c * CROW + sc_sg * 8 + 4);
            const f32x4 v0 = *(const LAS f32x4*)(VT + sc_c * CROW + sc_sg * 8), v1 = *(const LAS f32x4*)(VT + sc_c * CROW + sc_sg * 8 + 4);
            const float av[8] = {a0.x, a0.y, a0.z, a0.w, a1.x, a1.y, a1.z, a1.w}, vv[8] = {v0.x, v0.y, v0.z, v0.w, v1.x, v1.y, v1.z, v1.w};
            float hl[8], pp[8]; float hcur = 0.f, pcur = 1.f;
#pragma unroll
            for (int j = 0; j < 8; ++j) { hcur = __builtin_fmaf(av[j], hcur, vv[j]); pcur *= av[j]; hl[j] = hcur; pp[j] = pcur; }
            float P = pcur, H = hcur;
            { float Pp = dpp_row_shr<1>(1.f, P), Hp = dpp_row_shr<1>(0.f, H); H = __builtin_fmaf(P, Hp, H); P *= Pp;
              Pp = dpp_row_shr<2>(1.f, P); Hp = dpp_row_shr<2>(0.f, H); H = __builtin_fmaf(P, Hp, H); P *= Pp;
              Pp = dpp_row_shr<4>(1.f, P); Hp = dpp_row_shr<4>(0.f, H); H = __builtin_fmaf(P, Hp, H); P *= Pp;
              Pp = dpp_row_shr<8>(1.f, P); Hp = dpp_row_shr<8>(0.f, H); H = __builtin_fmaf(P, Hp, H); P *= Pp; }
            const float Pe = dpp_row_shr<1>(1.f, P), He = dpp_row_shr<1>(0.f, H);
            const float carry = __builtin_fmaf(Pe, hcar, He);
            const float hend = __builtin_fmaf(P, hcar, H);
            hcar = row_last_(hend);
            const u32x4 gq = *(const LAS u32x4*)(GT + sc_c * XROW + sc_sg * 16);
            const float gvv[8] = {bflo(gq.x), bfhi(gq.x), bflo(gq.y), bfhi(gq.y), bflo(gq.z), bfhi(gq.z), bflo(gq.w), bfhi(gq.w)};
            float yy[8];
#pragma unroll
            for (int j = 0; j < 8; ++j) { const float hv = __builtin_fmaf(pp[j], carry, hl[j]); yy[j] = hv * gvv[j] * fast_sigmoid(gvv[j]); }
            u32x4 yw_; yw_.x = pk2(yy[0], yy[1]); yw_.y = pk2(yy[2], yy[3]); yw_.z = pk2(yy[4], yy[5]); yw_.w = pk2(yy[6], yy[7]);
            *(LAS u32x4*)(YT + sc_c * XROW + sc_sg * 16) = yw_;
        }
#pragma unroll
        for (int i = 0; i < 4; ++i) { const int id = tid + 512 * i, row = id >> 4, cc = id & 15; *(LAS u32x4*)(XT + (3 + row) * XROW + cc * 16) = pf[i]; }
        if (tid < 48) *(LAS u32x4*)(XT + (tid >> 4) * XROW + (tid & 15) * 16) = pfh;
    }
    LDS_BARRIER();
    {
        unsigned short yv_[8];
#pragma unroll
        for (int e = 0; e < 8; ++e) yv_[e] = *(const LAS unsigned short*)(YT + (io_cq * 8 + e) * XROW + io_tk * 2);
        u32x4 w; w.x = yv_[0] | ((unsigned)yv_[1] << 16); w.y = yv_[2] | ((unsigned)yv_[3] << 16); w.z = yv_[4] | ((unsigned)yv_[5] << 16); w.w = yv_[6] | ((unsigned)yv_[7] << 16);
        *(u32x4*)(y_base + (size_t)(SEQ - 128 + io_tk) * DMIX + io_cq * 8) = w;
    }
    LDS_BARRIER();
}

constexpr int PROW = 528;
constexpr int R_XP = 0, R_PT = 42240;
__device__ __forceinline__ void pool_units(const Args& a, int l, int u, LAS unsigned char* lds) {
    const int tid = opaque_tid(), lane = tid & 63, wv = tid >> 6, fr = lane & 15, fq = lane >> 4;
    const int g = u & 3, bi = u >> 2, win = 2 << g;
    const bf16* PROJ = (const bf16*)(a.ws + WS_PROJ); bf16* YCAT = (bf16*)(a.ws + WS_YCAT);
    LAS unsigned char* XP = lds + R_XP; LAS unsigned char* PT = lds + R_PT;
    const bf16* pw = (const bf16*)(a.ws + WS_PW) + (size_t)(l * 4 + g) * 256 * 256;
    bf16x8 Wf[2][8];
#pragma unroll
    for (int nb = 0; nb < 2; ++nb)
#pragma unroll
        for (int kb = 0; kb < 8; ++kb) Wf[nb][kb] = *(const bf16x8*)(pw + (size_t)(wv * 32 + 8 * (fr >> 2) + 4 * nb + (fr & 3)) * 256 + kb * 32 + fq * 8);
    f32x4 pb[2], ps[2];
#pragma unroll
    for (int nb = 0; nb < 2; ++nb) { const int n = wv * 32 + 8 * fq + 4 * nb;
        pb[nb] = *(const f32x4*)(a.in[14] + (size_t)l * 1024 + g * 256 + n); ps[nb] = *(const f32x4*)(a.in[15] + (size_t)l * 1024 + g * 256 + n); }
    const int ck = tid & 31, tg = tid >> 5;
    u32x4 pf[5];
    {
        const int tile = bi * 8, b = tile >> 6, t0 = (tile & 63) * 64;
        const bf16* xp_base = PROJ + (size_t)(b * SEQ) * NPROJ + 2048 + g * 256;
#pragma unroll
        for (int i = 0; i < 5; ++i) { const int id = tid + 512 * i, row = id >> 5, cc = id & 31, t = t0 - 16 + row;
            const u32x4 v = *(const u32x4*)(xp_base + (size_t)(t < 0 ? 0 : t) * NPROJ + cc * 8); pf[i] = (t < 0) ? (u32x4){0u, 0u, 0u, 0u} : v; }
    }
#pragma unroll
    for (int i = 0; i < 5; ++i) { const int id = tid + 512 * i, row = id >> 5, cc = id & 31; *(LAS u32x4*)(XP + row * PROW + cc * 16) = pf[i]; }
    u32x4 gp[4];
    {
        const int tile = bi * 8, b = tile >> 6, t0 = (tile & 63) * 64;
        const bf16* gp_base0 = PROJ + (size_t)(b * SEQ) * NPROJ + 3072 + g * 256;
#pragma unroll
        for (int tb = 0; tb < 4; ++tb)
        { gp[tb] = *(const u32x4*)(gp_base0 + (size_t)(t0 + tb * 16 + fr) * NPROJ + wv * 32 + 8 * fq);
                asm volatile("" : "+v"(gp[tb])); }
    }
    for (int it = 0; it < 8; ++it) {
        const int tile = bi * 8 + it, b = tile >> 6, t0 = (tile & 63) * 64;
        bf16* y_base = YCAT + (size_t)(b * SEQ) * DMIX + 1024 + g * 256;
        LDS_BARRIER();
        {
            const int tile2 = bi * 8 + ((it + 1 < 8) ? it + 1 : it), b2 = tile2 >> 6, t02 = (tile2 & 63) * 64;
            const bf16* xp_base = PROJ + (size_t)(b2 * SEQ) * NPROJ + 2048 + g * 256;
#pragma unroll
            for (int i = 0; i < 5; ++i) { const int id = tid + 512 * i, row = id >> 5, cc = id & 31, t = t02 - 16 + row;
                const u32x4 v = *(const u32x4*)(xp_base + (size_t)(t < 0 ? 0 : t) * NPROJ + cc * 8); pf[i] = (t < 0) ? (u32x4){0u, 0u, 0u, 0u} : v; }
        }
        u32x4 gpn[4];
        {
            const int tile2 = bi * 8 + ((it + 1 < 8) ? it + 1 : it), b2 = tile2 >> 6, t02 = (tile2 & 63) * 64;
            const bf16* gp_base2 = PROJ + (size_t)(b2 * SEQ) * NPROJ + 3072 + g * 256;
#pragma unroll
            for (int tb = 0; tb < 4; ++tb)
                gpn[tb] = *(const u32x4*)(gp_base2 + (size_t)(t02 + tb * 16 + fr) * NPROJ + wv * 32 + 8 * fq);
        }
        {
            float s[8];
#pragma unroll
            for (int e = 0; e < 8; ++e) s[e] = 0.f;
            const int r0 = tg * 4 + 16;
            for (int r = r0 - win + 1; r < r0; ++r) { const u32x4 w = *(const LAS u32x4*)(XP + r * PROW + ck * 16);
                s[0] += bflo(w.x); s[1] += bfhi(w.x); s[2] += bflo(w.y); s[3] += bfhi(w.y); s[4] += bflo(w.z); s[5] += bfhi(w.z); s[6] += bflo(w.w); s[7] += bfhi(w.w); }
#pragma unroll
            for (int i = 0; i < 4; ++i) {
                const u32x4 w = *(const LAS u32x4*)(XP + (r0 + i) * PROW + ck * 16);
                const float xv[8] = {bflo(w.x), bfhi(w.x), bflo(w.y), bfhi(w.y), bflo(w.z), bfhi(w.z), bflo(w.w), bfhi(w.w)};
                const int t = t0 + tg * 4 + i; const float inv = __builtin_amdgcn_rcpf((float)((t + 1 < win) ? (t + 1) : win));
                float p[8];
#pragma unroll
                for (int e = 0; e < 8; ++e) { s[e] += xv[e]; p[e] = __builtin_fmaf(s[e], inv, -xv[e]); }
                u32x4 o; o.x = pk2(p[0], p[1]); o.y = pk2(p[2], p[3]); o.z = pk2(p[4], p[5]); o.w = pk2(p[6], p[7]);
                *(LAS u32x4*)(PT + (tg * 4 + i) * PROW + ck * 16) = o;
                const u32x4 wo = *(const LAS u32x4*)(XP + (r0 + i - win + 1) * PROW + ck * 16);
                s[0] -= bflo(wo.x); s[1] -= bfhi(wo.x); s[2] -= bflo(wo.y); s[3] -= bfhi(wo.y); s[4] -= bflo(wo.z); s[5] -= bfhi(wo.z); s[6] -= bflo(wo.w); s[7] -= bfhi(wo.w);
            }
        }
        LDS_BARRIER();
#pragma unroll
        for (int tb = 0; tb < 4; ++tb) {
            f32x4 acc[2] = {(f32x4){0.f, 0.f, 0.f, 0.f}, (f32x4){0.f, 0.f, 0.f, 0.f}};
#pragma unroll
            for (int kb = 0; kb < 8; ++kb) { const bf16x8 pfm = *(const LAS bf16x8*)(PT + (tb * 16 + fr) * PROW + kb * 64 + fq * 16);
#pragma unroll
                for (int nb = 0; nb < 2; ++nb) acc[nb] = __builtin_amdgcn_mfma_f32_16x16x32_bf16(Wf[nb][kb], pfm, acc[nb], 0, 0, 0); }
            const int t = t0 + tb * 16 + fr;
            u32x4 o;
#pragma unroll
            for (int nb = 0; nb < 2; ++nb) {
                const unsigned g0 = nb ? gp[tb].z : gp[tb].x, g1 = nb ? gp[tb].w : gp[tb].y;
                const f32x4 gv = (f32x4){bflo(g0), bfhi(g0), bflo(g1), bfhi(g1)};
                f32x4 r = (acc[nb] + pb[nb]) * ps[nb];
#pragma unroll
                for (int e = 0; e < 4; ++e) r[e] *= gv[e] * fast_sigmoid(gv[e]);
                if (nb == 0) { o.x = pk2(r.x, r.y); o.y = pk2(r.z, r.w); } else { o.z = pk2(r.x, r.y); o.w = pk2(r.z, r.w); } }
            *(u32x4*)(y_base + (size_t)t * DMIX + wv * 32 + 8 * fq) = o;
        }
#pragma unroll
        for (int i = 0; i < 5; ++i) { const int id = tid + 512 * i, row = id >> 5, cc = id & 31; *(LAS u32x4*)(XP + row * PROW + cc * 16) = pf[i]; }
#pragma unroll
        for (int tb = 0; tb < 4; ++tb)
            gp[tb] = gpn[tb];
    }
    LDS_BARRIER();
}

__device__ __forceinline__ void phase_mixer(const Args& a, int l, LAS unsigned char* lds) {
#ifndef MK_MIX
#define MK_MIX 3
#endif
#ifndef MK_DBL_RNN
#define MK_DBL_RNN 0
#endif
#ifndef MK_DBL_POOL
#define MK_DBL_POOL 0
#endif
    for (int rep = 0; rep < 1 + ((l == 0) ? MK_DBL_RNN : 0); ++rep) for (int u = blockIdx.x; u < 256; u += gridDim.x) rnn_unit(a, l, u, lds);
    for (int rep = 0; rep < 1 + ((l == 0) ? MK_DBL_POOL : 0); ++rep) for (int u = blockIdx.x; u < 256; u += gridDim.x) pool_units(a, l, u, lds);
}
#ifndef MK_DBL_PH
#define MK_DBL_PH -1
#endif
#ifndef MK_MASK
#define MK_MASK 63
#endif
__global__ void __launch_bounds__(512, 2) mk_fwd(Args a) {
    extern __shared__ __attribute__((aligned(16))) unsigned char lds_raw[];
    LAS unsigned char* lds = (LAS unsigned char*)lds_raw;
    cg::grid_group grid = cg::this_grid();
    volatile LAS unsigned* bst = (volatile LAS unsigned*)(lds + LDS_BST_OFF);
    if (threadIdx.x < 4) bst[threadIdx.x] = 0u;
    sync_threads_();
    XcdBarrier xbar = xcd_barrier_post((unsigned*)(a.ws + WS_CTL), bst);
#define GRID_BAR() do { if (a.ph_hi - a.ph_lo > 64) grid.sync(); else xcd_barrier(xbar); } while (0)
    for (int ph = a.ph_lo; ph < a.ph_hi; ++ph) {
#if MK_DBL_PH >= 0
      for (int rep = 0; rep < ((ph == MK_DBL_PH) ? 2 : 1); ++rep) {
        if (rep) GRID_BAR();
#endif
        if (ph == 0) { if (MK_MASK & 1) phase_prep(a, lds); }
        else if (ph == 1) { if (MK_MASK & 2) phase_h0(a); }
        else {
            const int l = (ph - 2) >> 2, sub = (ph - 2) & 3;
            if (sub == 0) { if (MK_MASK & 4) {
                pg8::Gemm g{(const pg8::bf16_t*)(a.ws + WS_H), (const pg8::bf16_t*)(a.ws + WS_WIN) + (size_t)l * NPROJ * D, T, NPROJ, D};
                pg8::StaticOrder S; S.init(T, NPROJ, gridDim.x, (int)blockIdx.x);
                pg8::EpiBf16<0> E{(pg8::bf16_t*)(a.ws + WS_PROJ), NPROJ, nullptr, 0, 0, 1.f};
                pg8::gemm_phase<pg8::EpiBf16<0>, pg8::StaticOrder, PG8_ALIGN, PG8_SP2>(lds, g, S, E); }
            } else if (sub == 1) {
                if (MK_MASK & 8) phase_mixer(a, l, lds);
            } else if (sub == 2) { if (MK_MASK & 16) {
                pg8::Gemm g{(const pg8::bf16_t*)(a.ws + WS_YCAT), (const pg8::bf16_t*)(a.ws + WS_WOUT) + (size_t)l * D * DMIX, T, D, DMIX};
                pg8::StaticOrder S; S.init(T, D, gridDim.x, (int)blockIdx.x);
                pg8::EpiBf16<0> E{(pg8::bf16_t*)(a.ws + WS_Y), D, nullptr, 0, 0, 1.f};
                pg8::gemm_phase<pg8::EpiBf16<0>, pg8::StaticOrder, PG8_ALIGN, PG8_SP2>(lds, g, S, E); }
            } else {
                if (MK_MASK & 32) phase_post(a, l);
            }
        }
#if MK_DBL_PH >= 0
      }
#endif
        if (ph + 1 < a.ph_hi) GRID_BAR();
    }
}

#if defined(__HIP_DEVICE_COMPILE__)
#pragma clang attribute pop
#endif

extern "C" void kernel_launch(void* const* d_in, const int* in_sizes, int n_in, void* d_out, int out_size, void* d_ws, size_t ws_size, hipStream_t stream) {
    static int grid = 0;
    if (grid == 0) {
        if (n_in != 18 || in_sizes[0] != T * D || out_size != T * D || ws_size < WS_END) {
            fprintf(stderr, "kernel_launch: unexpected shapes (n_in %d, in0 %d, out %d, ws %zu); nothing launched\n", n_in, n_in > 0 ? in_sizes[0] : -1, out_size, ws_size); grid = -1; return; }
        int dev = 0, cus = 0, per_cu = 0;
        if (hipGetDevice(&dev) != hipSuccess || hipDeviceGetAttribute(&cus, hipDeviceAttributeMultiprocessorCount, dev) != hipSuccess) { grid = -1; return; }
        if (hipFuncSetAttribute((const void*)mk_fwd, hipFuncAttributeMaxDynamicSharedMemorySize, LDS_BYTES) != hipSuccess) { fprintf(stderr, "kernel_launch: hipFuncSetAttribute failed\n"); grid = -1; return; }
        if (hipOccupancyMaxActiveBlocksPerMultiprocessor(&per_cu, (const void*)mk_fwd, 512, LDS_BYTES) != hipSuccess || per_cu < 1) { fprintf(stderr, "kernel_launch: occupancy query says %d blocks per CU\n", per_cu); per_cu = 1; }
        (void)hipGetLastError();
        grid = cus;
    }
    if (grid < 0) return;
    Args a{};
    for (int i = 0; i < 18; ++i) a.in[i] = (const float*)d_in[i];
    a.out = (float*)d_out; a.ws = (unsigned char*)d_ws;
    if (hipMemsetAsync((char*)d_ws + WS_CTL, 0, CTL_BYTES, stream) != hipSuccess) { fprintf(stderr, "kernel_launch: memset of the barrier words failed\n"); return; }
#if MK_N_LAUNCHES == 1
    a.ph_lo = 0; a.ph_hi = NPH;
    void* args[] = {&a};
    const hipError_t e = hipLaunchCooperativeKernel((const void*)mk_fwd, dim3(grid), dim3(512), args, LDS_BYTES, stream);
    if (e != hipSuccess) fprintf(stderr, "kernel_launch: cooperative launch failed: %s (grid %d)\n", hipGetErrorString(e), grid);
#else
    for (int ph = 0; ph < NPH; ++ph) {
        a.ph_lo = ph; a.ph_hi = ph + 1;
        hipLaunchKernelGGL(mk_fwd, dim3(grid), dim3(512), LDS_BYTES, stream, a);
    }
#endif
}
```

```cpp
#include <hip/hip_runtime.h>
#include <hip/hip_cooperative_groups.h>
#include <cstdio>
#include <cstdint>
namespace cg = cooperative_groups;
__device__ __forceinline__ int opaque_tid() { int t = threadIdx.x; asm volatile("" : "+v"(t)); return t; }
#if defined(__HIP_DEVICE_COMPILE__)
#pragma clang attribute push (__attribute__((target("no-packed-fp32-ops"))), apply_to = function)
#endif
__device__ __forceinline__ float u2f(unsigned x) { return __builtin_bit_cast(float, x); }
__device__ __forceinline__ float i2f(int x) { return __builtin_bit_cast(float, x); }
__device__ __forceinline__ int f2i(float x) { return __builtin_bit_cast(int, x); }
__device__ __forceinline__ int lane_id_() { return (int)__builtin_amdgcn_mbcnt_hi(~0u, __builtin_amdgcn_mbcnt_lo(~0u, 0u)); }
__device__ __forceinline__ float shfl_xor_(float v, int o) { return i2f(__builtin_amdgcn_ds_bpermute((lane_id_() ^ o) << 2, f2i(v))); }
__device__ __forceinline__ float row_last_(float v) { return i2f(__builtin_amdgcn_ds_bpermute((lane_id_() | 15) << 2, f2i(v))); }
__device__ __forceinline__ void sync_threads_() { __builtin_amdgcn_fence(__ATOMIC_RELEASE, "workgroup"); __builtin_amdgcn_s_barrier(); __builtin_amdgcn_fence(__ATOMIC_ACQUIRE, "workgroup"); }
namespace pg8 {
#define PG8_LAS __attribute__((address_space(3)))
typedef unsigned short bf16_t;
typedef short bf16x8 __attribute__((ext_vector_type(8)));
typedef float f32x4 __attribute__((ext_vector_type(4)));
typedef unsigned u32x4 __attribute__((ext_vector_type(4)));
constexpr int BM = 256, BK = 64, HALF = 128, HTB = HALF * BK * 2  , STAGE_BYTES = 8 * HTB, NXCD = 8, WGM = 8;

__host__ __device__ __forceinline__ int lds_byte(int r, int c) { const int st = (r >> 4) * 2 + (c >> 5), rr = r & 15, cc = c & 31, ob = rr * 64 + cc * 2; return st * 1024 + (ob ^ (((ob >> 9) & 1) << 5)); }
__host__ __device__ __forceinline__ void stage_rc(int b, int& R, int& C) { const int st = b / 1024, sb = b % 1024, swz = sb ^ (((sb >> 9) & 1) << 5); R = (st >> 1) * 16 + swz / 64; C = (st & 1) * 32 + (swz % 64) / 2; }
__host__ __device__ __forceinline__ int perm32(int rho) { const int n = rho >> 4, i = rho & 15; return 8 * (i >> 2) + 4 * n + (i & 3); }

struct Unit { int pm, pn; };
struct Gemm { const bf16_t* A; const bf16_t* Bt; int M, N, K; };

struct StaticOrder {
    int nM, nN, nwg, G, c;
    __host__ __device__ void init(int M, int N, int G_, int c_) { nM = M / BM; nN = N / BM; nwg = nM * nN; G = G_; c = c_; }
    __host__ __device__ bool next(int i, Unit& u) const {
        const long L = (long)i * G + c; if (L >= nwg) return false;
        int wgid = (int)L; { const int q = nwg / NXCD, r = nwg % NXCD, xcd = wgid % NXCD, off = wgid / NXCD; wgid = (xcd < r ? xcd * (q + 1) : r * (q + 1) + (xcd - r) * q) + off; }
        const int nig = WGM * nN, gid = wgid / nig, fm = gid * WGM, gsz = (nM - fm) < WGM ? (nM - fm) : WGM;
        u.pm = fm + ((wgid % nig) % gsz); u.pn = (wgid % nig) / gsz; return true;
    }
    __device__ __forceinline__ void a_ready(const Unit&) const {}
    __device__ __forceinline__ void done(const Unit&) const {}
};

__device__ __forceinline__ unsigned cvt_pk_bf16(float lo, float hi) { unsigned r; asm volatile("v_cvt_pk_bf16_f32 %0, %1, %2" : "=v"(r) : "v"(lo), "v"(hi)); return r; }
typedef float f32x2 __attribute__((ext_vector_type(2)));
__device__ __forceinline__ f32x2 gelu_pk(f32x2 v) {
    const f32x2 av = __builtin_elementwise_abs(v), d = av * 0.2316418882f + 1.0f;
    f32x2 t; t.x = __builtin_amdgcn_rcpf(d.x); t.y = __builtin_amdgcn_rcpf(d.y);
    f32x2 q = t * 0.5307027145f + (-0.7265760135f); q = q * t + 0.7107068705f; q = q * t + (-0.142248368f); q = q * t + 0.127414796f; q = q * t;
    const f32x2 s = (v * v) * (-0.72134752044f);
    f32x2 e; e.x = __builtin_amdgcn_exp2f(s.x); e.y = __builtin_amdgcn_exp2f(s.y);
    const f32x2 m = v * (q * e), r = v - m;
    f32x2 o; o.x = v.x < 0.f ? m.x : r.x; o.y = v.y < 0.f ? m.y : r.y; return o;
}

template <int ACT  > struct EpiBf16 {
    static constexpr bool PERM = true, AFTER_DRAIN = false; static_assert(ACT == 0 || ACT == 1, "EpiBf16: ACT is 0 (none) or 1 (gelu_pk)");
    bf16_t* O; int ldc; const float* bias; int split_cols; size_t split_stride; float scale0;
    __device__ __forceinline__ void operator()(const f32x4 (&acc)[2][2][4][2], const Unit& u, int wr, int wc, int fr, int fq) const {
        const int row0 = u.pm * BM + wr * 64 + fr; int colt = u.pn * BM; bf16_t* base = O;
        float sc = 1.f; if (split_cols) { const int t = colt / split_cols; base += (size_t)t * split_stride; colt -= t * split_cols; if (t == 0) sc = scale0; }
        const int col0 = colt + wc * 32 + 8 * fq, bcol0 = u.pn * BM + wc * 32 + 8 * fq;
        f32x4 bv[2][2];
#pragma unroll
        for (int bj = 0; bj < 2; ++bj)
#pragma unroll
            for (int n = 0; n < 2; ++n) bv[bj][n] = bias ? *(const f32x4*)(bias + bcol0 + bj * HALF + 4 * n) : (f32x4){0.f, 0.f, 0.f, 0.f};
#pragma unroll
        for (int ai = 0; ai < 2; ++ai)
#pragma unroll
            for (int m = 0; m < 4; ++m) { bf16_t* rowp = base + (size_t)(row0 + ai * HALF + m * 16) * ldc + col0;
#pragma unroll
                for (int bj = 0; bj < 2; ++bj) { f32x4 v0 = acc[ai][bj][m][0] + bv[bj][0], v1 = acc[ai][bj][m][1] + bv[bj][1];
                    if (ACT == 1) { f32x2 a = gelu_pk((f32x2){v0[0], v0[1]}), b = gelu_pk((f32x2){v0[2], v0[3]}), c = gelu_pk((f32x2){v1[0], v1[1]}), d = gelu_pk((f32x2){v1[2], v1[3]});
                        v0 = (f32x4){a.x, a.y, b.x, b.y}; v1 = (f32x4){c.x, c.y, d.x, d.y}; }
                    v0 = v0 * sc; v1 = v1 * sc; u32x4 w; w.x = cvt_pk_bf16(v0[0], v0[1]); w.y = cvt_pk_bf16(v0[2], v0[3]); w.z = cvt_pk_bf16(v1[0], v1[1]); w.w = cvt_pk_bf16(v1[2], v1[3]);
                    *(u32x4*)(rowp + bj * HALF) = w; } }
    }
};
template <class Epi, class Sched, bool ALIGN_EPI = false, bool SP2 = false>
__device__ __forceinline__ void gemm_phase(PG8_LAS unsigned char* lds, const Gemm g, const Sched& S, const Epi& E) {
    const int tid = opaque_tid(), wid = __builtin_amdgcn_readfirstlane(tid >> 6), lane = tid & 63, wr = wid >> 2, wc = wid & 3, fr = lane & 15, fq = lane >> 4;
    const int K = g.K, nt = K / BK;
    unsigned voffA[2], voffB[2];
#pragma unroll
    for (int i = 0; i < 2; ++i) { int R, C; stage_rc(tid * 16 + i * 8192, R, C); const int Rb = Epi::PERM ? ((R & ~31) + perm32(R & 31)) : R;
        voffA[i] = (unsigned)(R * K + C) * 2u; voffB[i] = (unsigned)(Rb * K + C) * 2u; }
    const size_t kstep = (size_t)(BK * 2);
    const size_t hstep = (size_t)HALF * K * 2;
    const size_t tstep = 2 * hstep;
    const unsigned ldsw = (unsigned)wid * 1024u;
    const int aoff = lds_byte(wr * 64 + fr, fq * 8), boff = lds_byte(wc * 32 + fr, fq * 8);
#define PG8_SA(b, h) (((b) * 2 + (h)) * HTB)
#define PG8_SB(b, h) ((4 + (b) * 2 + (h)) * HTB)
#define PG8_STAGE(bufoff, gbase, voff) do { _Pragma("unroll") for (int _i = 0; _i < 2; ++_i) \
        __builtin_amdgcn_global_load_lds((const unsigned*)((const char*)(gbase) + (voff)[_i]), (PG8_LAS unsigned*)(lds + (bufoff) + ldsw + _i * 8192), 16, 0, 0); } while (0)
#define PG8_LDA(dst, b, h) do { _Pragma("unroll") for (int m = 0; m < 4; ++m) _Pragma("unroll") for (int k = 0; k < 2; ++k) dst[m][k] = *(const PG8_LAS bf16x8*)(lds + PG8_SA(b, h) + aoff + m * 2048 + k * 1024); } while (0)
#define PG8_LDB(dst, b, h) do { _Pragma("unroll") for (int n = 0; n < 2; ++n) _Pragma("unroll") for (int k = 0; k < 2; ++k) dst[n][k] = *(const PG8_LAS bf16x8*)(lds + PG8_SB(b, h) + boff + n * 2048 + k * 1024); } while (0)
#define PG8_MMA(ai, bj, At, Bt) do { __builtin_amdgcn_s_setprio(1); _Pragma("unroll") for (int m = 0; m < 4; ++m) _Pragma("unroll") for (int n = 0; n < 2; ++n) _Pragma("unroll") for (int k = 0; k < 2; ++k) \
        acc[ai][bj][m][n] = __builtin_amdgcn_mfma_f32_16x16x32_bf16(Bt[n][k], At[m][k], acc[ai][bj][m][n], 0, 0, 0); __builtin_amdgcn_s_setprio(0); } while (0)
#define PG8_WAIT_V(n) asm volatile("s_waitcnt vmcnt(" #n ")" ::: "memory")
#define PG8_WAIT_L(n) asm volatile("s_waitcnt lgkmcnt(" #n ")" ::: "memory")
#define PG8_BAR __builtin_amdgcn_s_barrier()
#define PG8_SCHED __builtin_amdgcn_sched_barrier(0)
    Unit cur, nxt; int ui = 0;
    if (!S.next(0, cur)) return;
    f32x4 acc[2][2][4][2];
#pragma unroll
    for (int a = 0; a < 2; ++a)
#pragma unroll
        for (int b = 0; b < 2; ++b)
#pragma unroll
            for (int m = 0; m < 4; ++m)
#pragma unroll
                for (int n = 0; n < 2; ++n) acc[a][b][m][n] = (f32x4){0.f, 0.f, 0.f, 0.f};
    bf16x8 At[4][2], B0[2][2], B1[2][2];
    const char* cA = (const char*)g.A + (size_t)cur.pm * tstep; const char* cB = (const char*)g.Bt + (size_t)cur.pn * tstep;
    S.a_ready(cur);
    if constexpr (SP2) {
        PG8_STAGE(PG8_SB(0, 0), cB, voffB); PG8_STAGE(PG8_SB(0, 1), cB + hstep, voffB); PG8_STAGE(PG8_SA(0, 0), cA, voffA); PG8_STAGE(PG8_SA(0, 1), cA + hstep, voffA);
        if (wr == 1) PG8_BAR;
        PG8_WAIT_V(2); PG8_BAR;
        PG8_STAGE(PG8_SB(1, 0), cB + kstep, voffB); PG8_STAGE(PG8_SA(1, 0), cA + kstep, voffA); PG8_STAGE(PG8_SB(1, 1), cB + hstep + kstep, voffB);
        PG8_WAIT_V(6); PG8_BAR;
    } else {
        PG8_STAGE(PG8_SB(0, 0), cB, voffB); PG8_STAGE(PG8_SA(0, 0), cA, voffA); PG8_STAGE(PG8_SB(0, 1), cB + hstep, voffB); PG8_STAGE(PG8_SA(0, 1), cA + hstep, voffA);
        if (wr == 1) PG8_BAR;
        PG8_WAIT_V(4); PG8_BAR;
        PG8_STAGE(PG8_SB(1, 0), cB + kstep, voffB); PG8_STAGE(PG8_SA(1, 0), cA + kstep, voffA); PG8_STAGE(PG8_SB(1, 1), cB + hstep + kstep, voffB);
        PG8_WAIT_V(6); PG8_BAR;
    }
    for (;;) {
        const bool has_next = S.next(ui + 1, nxt);
        const char* nA = has_next ? (const char*)g.A + (size_t)nxt.pm * tstep : cA; const char* nB = has_next ? (const char*)g.Bt + (size_t)nxt.pn * tstep : cB;
        for (int t = 0; t < nt; t += 2) {
            const bool last = (t == nt - 2);
            const char* a1 = cA + (size_t)(t + 1) * kstep;
            const char* a2 = last ? nA : cA + (size_t)(t + 2) * kstep; const char* b2 = last ? nB : cB + (size_t)(t + 2) * kstep;
            const char* a3 = a2 + kstep; const char* b3 = b2 + kstep;
            if (last && has_next) S.a_ready(nxt);
            if constexpr (SP2) {
            PG8_LDB(B0, 0, 0); PG8_LDB(B1, 0, 1); PG8_SCHED; PG8_LDA(At, 0, 0); PG8_STAGE(PG8_SA(1, 1), a1 + hstep, voffA);
            PG8_WAIT_V(8); PG8_WAIT_L(0); PG8_BAR; PG8_MMA(0, 0, At, B0); PG8_MMA(0, 1, At, B1); PG8_BAR; PG8_SCHED;
            PG8_LDA(At, 0, 1); PG8_STAGE(PG8_SB(0, 0), b2, voffB); PG8_STAGE(PG8_SB(0, 1), b2 + hstep, voffB); PG8_STAGE(PG8_SA(0, 0), a2, voffA);
            PG8_WAIT_V(8); PG8_WAIT_L(0); PG8_BAR; PG8_MMA(1, 0, At, B0); PG8_MMA(1, 1, At, B1); PG8_BAR; PG8_SCHED;
            PG8_LDB(B0, 1, 0); PG8_LDB(B1, 1, 1); PG8_SCHED; PG8_LDA(At, 1, 0); PG8_STAGE(PG8_SA(0, 1), a2 + hstep, voffA);
            PG8_WAIT_V(8); PG8_WAIT_L(0); PG8_BAR; PG8_MMA(0, 0, At, B0); PG8_MMA(0, 1, At, B1); PG8_BAR; PG8_SCHED;
            PG8_LDA(At, 1, 1); PG8_STAGE(PG8_SB(1, 0), b3, voffB); PG8_STAGE(PG8_SB(1, 1), b3 + hstep, voffB); PG8_STAGE(PG8_SA(1, 0), a3, voffA);
            PG8_WAIT_V(8); PG8_WAIT_L(0); PG8_BAR; PG8_MMA(1, 0, At, B0); PG8_MMA(1, 1, At, B1); PG8_BAR; PG8_SCHED;
            } else {
            PG8_LDB(B0, 0, 0); PG8_SCHED; PG8_LDA(At, 0, 0); PG8_STAGE(PG8_SA(1, 1), a1 + hstep, voffA);
            PG8_WAIT_L(8); PG8_BAR; PG8_WAIT_L(0); PG8_MMA(0, 0, At, B0); PG8_BAR; PG8_SCHED;
            PG8_LDB(B1, 0, 1); PG8_STAGE(PG8_SB(0, 0), b2, voffB);
            PG8_BAR; PG8_WAIT_L(0); PG8_MMA(0, 1, At, B1); PG8_BAR;
            PG8_LDA(At, 0, 1); PG8_STAGE(PG8_SA(0, 0), a2, voffA);
            PG8_BAR; PG8_WAIT_L(0); PG8_MMA(1, 0, At, B0); PG8_BAR; PG8_SCHED;
            PG8_STAGE(PG8_SB(0, 1), b2 + hstep, voffB);
            PG8_WAIT_V(6); PG8_BAR; PG8_MMA(1, 1, At, B1); PG8_BAR;
            PG8_LDB(B0, 1, 0); PG8_SCHED; PG8_LDA(At, 1, 0); PG8_STAGE(PG8_SA(0, 1), a2 + hstep, voffA);
            PG8_WAIT_L(8); PG8_BAR; PG8_WAIT_L(0); PG8_MMA(0, 0, At, B0); PG8_BAR; PG8_SCHED;
            PG8_LDB(B1, 1, 1); PG8_STAGE(PG8_SB(1, 0), b3, voffB);
            PG8_BAR; PG8_WAIT_L(0); PG8_MMA(0, 1, At, B1); PG8_BAR;
            PG8_LDA(At, 1, 1); PG8_STAGE(PG8_SA(1, 0), a3, voffA);
            PG8_BAR; PG8_WAIT_L(0); PG8_MMA(1, 0, At, B0); PG8_BAR; PG8_SCHED;
            PG8_STAGE(PG8_SB(1, 1), b3 + hstep, voffB);
            PG8_WAIT_V(6); PG8_BAR; PG8_MMA(1, 1, At, B1); PG8_BAR;
            }
        }
        if constexpr (ALIGN_EPI) { if (wr == 0) PG8_BAR; }
        if constexpr (!Epi::AFTER_DRAIN) { E(acc, cur, wr, wc, fr, fq); S.done(cur); }
        if (!has_next) break;
#pragma unroll
        for (int a = 0; a < 2; ++a)
#pragma unroll
            for (int b = 0; b < 2; ++b)
#pragma unroll
                for (int m = 0; m < 4; ++m)
#pragma unroll
                    for (int n = 0; n < 2; ++n) acc[a][b][m][n] = (f32x4){0.f, 0.f, 0.f, 0.f};
        cur = nxt; cA = nA; cB = nB; ++ui;
        if constexpr (ALIGN_EPI) { if (wr == 1) PG8_BAR; }
    }
    PG8_WAIT_V(0);
    if constexpr (!ALIGN_EPI) { if (wr == 0) PG8_BAR; }
    PG8_BAR;
    if constexpr (Epi::AFTER_DRAIN) { E.fused(acc, cur, wr, wc, fr, fq, lds, wid, lane); S.done(cur); }
#undef PG8_SA
#undef PG8_SB
#undef PG8_STAGE
#undef PG8_LDA
#undef PG8_LDB
#undef PG8_MMA
#undef PG8_WAIT_V
#undef PG8_WAIT_L
#undef PG8_BAR
#undef PG8_SCHED
}
}
#ifndef PG8_SP2
#define PG8_SP2 true
#endif
#ifndef PG8_ALIGN
#define PG8_ALIGN true
#endif
#ifndef MK_N_LAUNCHES
#define MK_N_LAUNCHES 1
#endif

constexpr int NB = 8, SEQ = 4096, D = 1024, T = NB * SEQ, NPROJ = 4096, DMIX = 2048;
constexpr int NPH = 10;
constexpr float EPS = 1e-6f;
constexpr size_t MiB = 1u << 20;
constexpr size_t WS_WIN = 0, WS_WOUT = 16 * MiB, WS_GW = 24 * MiB, WS_PW = 25 * MiB, WS_MOD = 26 * MiB;
constexpr size_t WS_H = 32 * MiB, WS_YCAT = 96 * MiB, WS_PROJ = 224 * MiB, WS_Y = WS_PROJ, WS_U = WS_H, WS_END = 480 * MiB;
constexpr size_t WS_CTL = 28 * MiB, CTL_BYTES = 16384;
constexpr int LDS_BYTES = 147456, LDS_BST_OFF = 131072 + 64;

#define LAS __attribute__((address_space(3)))
typedef unsigned short bf16;
typedef float f32x4 __attribute__((ext_vector_type(4)));
typedef float f32x2 __attribute__((ext_vector_type(2)));
typedef unsigned u32x4 __attribute__((ext_vector_type(4)));
typedef unsigned u32x2 __attribute__((ext_vector_type(2)));
typedef short bf16x8 __attribute__((ext_vector_type(8)));

struct Args { const float* in[18]; float* out; unsigned char* ws; int ph_lo, ph_hi; };

__device__ __forceinline__ unsigned pk2(float lo, float hi) { return pg8::cvt_pk_bf16(lo, hi); }
__device__ __forceinline__ float bflo(unsigned w) { return u2f(w << 16); }
__device__ __forceinline__ float bfhi(unsigned w) { return u2f(w & 0xffff0000u); }
template <int CTRL> __device__ __forceinline__ float dpp_mov_(float v) { return i2f(__builtin_amdgcn_update_dpp(0, f2i(v), CTRL, 0xf, 0xf, true)); }
__device__ __forceinline__ float wave_sum(float v) {
    v += dpp_mov_<0xB1>(v);
    v += dpp_mov_<0x4E>(v);
    v += dpp_mov_<0x141>(v);
    v += dpp_mov_<0x140>(v);
    const float r0 = i2f(__builtin_amdgcn_readlane(f2i(v), 0)), r1 = i2f(__builtin_amdgcn_readlane(f2i(v), 16));
    const float r2 = i2f(__builtin_amdgcn_readlane(f2i(v), 32)), r3 = i2f(__builtin_amdgcn_readlane(f2i(v), 48));
    return (r0 + r1) + (r2 + r3);
}
__device__ __forceinline__ float sigmoidf_(float x) { return 1.0f / (1.0f + __expf(-x)); }
__device__ __forceinline__ float siluf_(float x) { return x / (1.0f + __expf(-x)); }

__device__ __forceinline__ void transpose_tile(const float* W, int K, int N, bf16* WT, LAS float* scr, int k0, int n0, int drow, int lane, float wscale = 1.0f) {
    {
        f32x4 v[8];
#pragma unroll
        for (int i = 0; i < 8; ++i) v[i] = *(const f32x4*)(W + (size_t)(k0 + (lane >> 3) + 8 * i) * N + n0 + (lane & 7) * 4);
#pragma unroll
        for (int i = 0; i < 8; ++i) { LAS float* d = scr + ((lane >> 3) + 8 * i) * 33 + (lane & 7) * 4; d[0] = v[i].x * wscale; d[1] = v[i].y * wscale; d[2] = v[i].z * wscale; d[3] = v[i].w * wscale; }
    }
    asm volatile("s_waitcnt lgkmcnt(0)" ::: "memory");
    const int c = lane & 7;
#pragma unroll
    for (int j = 0; j < 4; ++j) { const int n = (lane >> 3) + 8 * j; const LAS float* s = scr + (8 * c) * 33 + n;
        u32x4 o; o.x = pk2(s[0 * 33], s[1 * 33]); o.y = pk2(s[2 * 33], s[3 * 33]); o.z = pk2(s[4 * 33], s[5 * 33]); o.w = pk2(s[6 * 33], s[7 * 33]);
        *(u32x4*)(WT + (size_t)(drow + n) * K + k0 + 8 * c) = o; }
    asm volatile("s_waitcnt lgkmcnt(0)" ::: "memory");
}
__device__ __forceinline__ void transpose_item(const float* W, int K, int N, bf16* WT, LAS float* scr, int item, int lane) {
    const int nblk = N / 32, kb = item / nblk, nb = item % nblk;
    transpose_tile(W, K, N, WT, scr, 64 * kb, 32 * nb, 32 * nb, lane);
}

__device__ __forceinline__ void phase_prep(const Args& a, LAS unsigned char* lds) {
    const int tid = opaque_tid(), lane = tid & 63, wv = tid >> 6;
    const int G = gridDim.x;
    unsigned char* ws = a.ws;
    {
        LAS float* sc = (LAS float*)lds;
        LAS float* red = (LAS float*)(lds + 32768);
        const float* c = a.in[1]; const float* ada_w = a.in[2]; const float* ada_b = a.in[3];
        float* MOD = (float*)(ws + WS_MOD);
        if ((int)blockIdx.x < 192) {
            for (int i = tid; i < 8192; i += 512) sc[i] = siluf_(c[i]);
            sync_threads_();
            for (int unit = blockIdx.x; unit < 192; unit += G) {
                const int l = unit / 96, cb = (unit % 96) * 32, cl = tid & 31, ks = tid >> 5;
                const float* wp = ada_w + (size_t)l * 1024 * 3072 + (size_t)(ks * 64) * 3072 + cb + cl;
                float acc[8];
#pragma unroll
                for (int b = 0; b < 8; ++b) acc[b] = 0.f;
#pragma unroll 16
                for (int k = 0; k < 64; ++k) { const float w = wp[(size_t)k * 3072];
#pragma unroll
                    for (int b = 0; b < 8; ++b) acc[b] += sc[b * 1024 + ks * 64 + k] * w; }
#pragma unroll
                for (int b = 0; b < 8; ++b) red[(ks * 8 + b) * 32 + cl] = acc[b];
                sync_threads_();
                if (tid < 256) { const int b = tid >> 5; float s = 0.f;
#pragma unroll
                    for (int k2 = 0; k2 < 16; ++k2) s += red[(k2 * 8 + b) * 32 + cl];
                    MOD[(l * 8 + b) * 3072 + cb + cl] = s + ada_b[l * 3072 + cb + cl]; }
                sync_threads_();
            }
        }
        sync_threads_();
    }
    {
        LAS float* scr = (LAS float*)(lds + wv * 16384);
        const int gw = blockIdx.x * 8 + wv, NGW = G * 8;
        constexpr int I_IN = (1024 / 64) * (4096 / 32), I_OUT = (2048 / 64) * (1024 / 32);
        for (int it = gw; it < 2 * (I_IN + I_OUT); it += NGW) {
            int r = it;
            if (r < 2 * I_IN) { const int l = r / I_IN; r -= l * I_IN;
                transpose_item(a.in[5] + (size_t)l * 1024 * 4096, 1024, 4096, (bf16*)(ws + WS_WIN) + (size_t)l * 4096 * 1024, scr, r, lane); }
            else { r -= 2 * I_IN; const int l = r / I_OUT; r -= l * I_OUT;
                transpose_item(a.in[16] + (size_t)l * 2048 * 1024, 2048, 1024, (bf16*)(ws + WS_WOUT) + (size_t)l * 1024 * 2048, scr, r, lane); }
        }
    }
    {
        LAS float* scr = (LAS float*)(lds + wv * 16384);
        const int gw = blockIdx.x * 8 + wv, NGW = G * 8;
        bf16* GWp = (bf16*)(ws + WS_GW); bf16* PWp = (bf16*)(ws + WS_PW);
        for (int it = NGW - 1 - gw; it < 512; it += NGW) {
            if (it < 256) { const int lh = it >> 4, r = it & 15, gate = r >> 3, kb = (r >> 2) & 1, q = r & 3;
                transpose_tile((gate ? a.in[10] : a.in[8]) + (size_t)lh * 128 * 128, 128, 128, GWp + (size_t)lh * 4 * 64 * 128, scr, 64 * kb, 32 * q, q * 64 + gate * 32, lane, -1.4426950408889634f); }
            else { const int r = it - 256, lg = r >> 5, kb = (r >> 3) & 3, nb = r & 7;
                transpose_tile(a.in[13] + (size_t)lg * 256 * 256, 256, 256, PWp + (size_t)lg * 256 * 256, scr, 64 * kb, 32 * nb, 32 * nb, lane); }
        }
    }
}

constexpr int RPW = 4;
__device__ __forceinline__ void phase_h0(const Args& a) {
    const int tid = opaque_tid(), lane = tid & 63, wv = tid >> 6;
    const int gw = blockIdx.x * 8 + wv, NGW = gridDim.x * 8;
    const float* x = a.in[0]; const float* g = a.in[4]; const float* MOD = (const float*)(a.ws + WS_MOD);
    bf16* H = (bf16*)(a.ws + WS_H);
    const int WPB = NGW / NB, b = gw / WPB, wq = gw % WPB;
    const float* sh = MOD + (size_t)b * 3072; const float* scl = sh + 1024;
    f32x4 A1[4], SH[4];
#pragma unroll
    for (int j = 0; j < 4; ++j) { const int col = 4 * lane + 256 * j; A1[j] = *(const f32x4*)(g + col) * (*(const f32x4*)(scl + col) + 1.0f); SH[j] = *(const f32x4*)(sh + col); }
    for (int mr = wq * RPW; mr < SEQ; mr += WPB * RPW) {
        const int m0 = b * SEQ + mr;
        f32x4 v[RPW][4];
#pragma unroll
        for (int r = 0; r < RPW; ++r) { const f32x4* xr = (const f32x4*)(x + (size_t)(m0 + r) * D) + lane;
#pragma unroll
            for (int j = 0; j < 4; ++j) v[r][j] = __builtin_nontemporal_load(xr + 64 * j); }
#pragma unroll
        for (int r = 0; r < RPW; ++r) {
            float ss = 0.f;
#pragma unroll
            for (int j = 0; j < 4; ++j) ss += (v[r][j].x * v[r][j].x + v[r][j].y * v[r][j].y) + (v[r][j].z * v[r][j].z + v[r][j].w * v[r][j].w);
            const float rstd = 1.0f / __builtin_sqrtf(wave_sum(ss) * (1.0f / D) + EPS);
            u32x2* o = (u32x2*)(H + (size_t)(m0 + r) * D) + lane;
#pragma unroll
            for (int j = 0; j < 4; ++j) {
                const f32x4 rr = (v[r][j] * rstd) * A1[j] + SH[j];
                u32x2 w; w.x = pk2(rr.x, rr.y); w.y = pk2(rr.z, rr.w); o[64 * j] = w; }
        }
    }
}

__device__ __forceinline__ void phase_post(const Args& a, int l) {
    const int tid = opaque_tid(), lane = tid & 63, wv = tid >> 6;
    const int gw = blockIdx.x * 8 + wv, NGW = gridDim.x * 8;
    const float* xin = (l == 0) ? a.in[0] : a.out; float* out = a.out;
    const bf16* Y = (const bf16*)(a.ws + WS_Y); bf16* H = (bf16*)(a.ws + WS_H);
    const float* MOD = (const float*)(a.ws + WS_MOD);
    const float* gpost = a.in[17] + l * D; const float* gpre = a.in[4] + (l + 1) * D;
    const int WPB = NGW / NB, b = gw / WPB, wq = gw % WPB;
    const float* gate = MOD + (size_t)(l * 8 + b) * 3072 + 2048;
    const float* sh = MOD + (size_t)(8 + b) * 3072; const float* scl = sh + 1024;
    f32x4 GP[4], A1[4], SH[4];
#pragma unroll
    for (int j = 0; j < 4; ++j) { const int col = 4 * lane + 256 * j; GP[j] = *(const f32x4*)(gate + col) * *(const f32x4*)(gpost + col);
        if (l == 0) { A1[j] = *(const f32x4*)(gpre + col) * (*(const f32x4*)(scl + col) + 1.0f); SH[j] = *(const f32x4*)(sh + col); } }
    for (int mr = wq * RPW; mr < SEQ; mr += WPB * RPW) {
        const int m0 = b * SEQ + mr;
        f32x4 xv[RPW][4]; u32x2 yw[RPW][4];
#pragma unroll
        for (int r = 0; r < RPW; ++r) { const f32x4* xr = (const f32x4*)(xin + (size_t)(m0 + r) * D) + lane; const u32x2* yr = (const u32x2*)(Y + (size_t)(m0 + r) * D) + lane;
#pragma unroll
            for (int j = 0; j < 4; ++j) { xv[r][j] = xr[64 * j]; yw[r][j] = yr[64 * j]; } }
#pragma unroll
        for (int r = 0; r < RPW; ++r) {
            f32x4 yv[4]; float ss = 0.f;
#pragma unroll
            for (int j = 0; j < 4; ++j) { const u32x2 w = yw[r][j]; yv[j] = (f32x4){bflo(w.x), bfhi(w.x), bflo(w.y), bfhi(w.y)};
                ss += (yv[j].x * yv[j].x + yv[j].y * yv[j].y) + (yv[j].z * yv[j].z + yv[j].w * yv[j].w); }
            const float rstd = 1.0f / __builtin_sqrtf(wave_sum(ss) * (1.0f / D) + EPS);
            float ss2 = 0.f;
#pragma unroll
            for (int j = 0; j < 4; ++j) { const int col = 4 * lane + 256 * j;
                const f32x4 xn = xv[r][j] + (yv[j] * rstd) * GP[j];
                xv[r][j] = xn;
                if (l == 0) *((f32x4*)(out + (size_t)(m0 + r) * D + col)) = xn;
                else __builtin_nontemporal_store(xn, (f32x4*)(out + (size_t)(m0 + r) * D + col));
                ss2 += (xn.x * xn.x + xn.y * xn.y) + (xn.z * xn.z + xn.w * xn.w); }
            if (l == 0) {
                const float rstd2 = 1.0f / __builtin_sqrtf(wave_sum(ss2) * (1.0f / D) + EPS);
                u32x2* o = (u32x2*)(H + (size_t)(m0 + r) * D) + lane;
#pragma unroll
                for (int j = 0; j < 4; ++j) {
                    const f32x4 rr = (xv[r][j] * rstd2) * A1[j] + SH[j];
                    u32x2 w; w.x = pk2(rr.x, rr.y); w.y = pk2(rr.z, rr.w); o[64 * j] = w; }
            }
        }
    }
}
#define XB_TMO      128
#define XB_XCNT(j)  (256  + 64 * (j))
#define XB_XSUB(j)  (1280 + 64 * (j))
#define XB_XGEN(j)  (2304 + 64 * (j))
#define XB_TOP      3328
#define XB_TOPGEN   3392
#define XCD_BAR_WORDS 3456
#define XB_SPIN_CAP (1u << 18)

__device__ __forceinline__ unsigned xb_ld(unsigned* p)              { return __hip_atomic_load(p, __ATOMIC_RELAXED, __HIP_MEMORY_SCOPE_AGENT); }
__device__ __forceinline__ unsigned xb_add(unsigned* p, unsigned v) { return __hip_atomic_fetch_add(p, v, __ATOMIC_RELAXED, __HIP_MEMORY_SCOPE_AGENT); }
__device__ __forceinline__ unsigned xb_xcc_id() { return (unsigned)__builtin_amdgcn_s_getreg((3 << 11) | 20) & 0xFu; }
#define XB_SPIN(cond, bar) do { unsigned _sp = 0; while (cond) { __builtin_amdgcn_s_sleep(1); \
    if ((++_sp & 255u) == 0u) { if (xb_ld(&(bar)[XB_TMO])) break; if (_sp > XB_SPIN_CAP) { xb_add(&(bar)[XB_TMO], 1u); break; } } } } while (0)

struct XcdBarrier {
    unsigned* bar; unsigned x;
    volatile LAS unsigned* st;
};

__device__ __forceinline__ XcdBarrier xcd_barrier_post(unsigned* bar, volatile LAS unsigned* st) {
    XcdBarrier b; b.bar = bar; b.x = xb_xcc_id(); b.st = st;
    if (threadIdx.x == 0) (void)xb_add(&bar[XB_XCNT(b.x)], 1u);
    return b;
}
__device__ __forceinline__ void xcd_barrier_complete(unsigned* bar, unsigned x, unsigned& nloc, unsigned& nx) {
    const unsigned G = gridDim.x * gridDim.y * gridDim.z;
    unsigned sum, cnt, mine, sp = 0u;
    for (;;) {
        sum = 0u; cnt = 0u; mine = 0u;
#pragma unroll
        for (unsigned j = 0; j < 16; ++j) { const unsigned c = xb_ld(&bar[XB_XCNT(j)]); sum += c; cnt += (c > 0u) ? 1u : 0u; mine = (j == x) ? c : mine; }
        if (sum == G) break;
        __builtin_amdgcn_s_sleep(1);
        if ((++sp & 255u) == 0u) { if (xb_ld(&bar[XB_TMO])) break; if (sp > XB_SPIN_CAP) { xb_add(&bar[XB_TMO], 1u); break; } }
    }
    nloc = mine > 0u ? mine : 1u; nx = cnt > 0u ? cnt : 1u;
}

__device__ __forceinline__ void xcd_barrier(const XcdBarrier& b) {
    asm volatile("s_waitcnt vmcnt(0)" ::: "memory");
    sync_threads_();
    if (threadIdx.x == 0) {
        unsigned* bar = b.bar;
        __builtin_amdgcn_s_waitcnt(0);
        unsigned nloc = b.st[0], nx = b.st[1];
        if (nloc == 0u) { xcd_barrier_complete(bar, b.x, nloc, nx); b.st[0] = nloc; b.st[1] = nx; }
        const unsigned old = xb_add(&bar[XB_XSUB(b.x)], 1u);
        const unsigned gen = old / nloc;
        if (old + 1u == (gen + 1u) * nloc) {
            __builtin_amdgcn_fence(__ATOMIC_RELEASE, "agent");
            asm volatile("s_waitcnt vmcnt(0)" ::: "memory");
            const unsigned og = xb_add(&bar[XB_TOP], 1u);
            const unsigned tg = og / nx;
            if (og + 1u == (tg + 1u) * nx) xb_add(&bar[XB_TOPGEN], 1u);
            else XB_SPIN(xb_ld(&bar[XB_TOPGEN]) == tg, bar);
            __builtin_amdgcn_fence(__ATOMIC_ACQUIRE, "agent");
            xb_add(&bar[XB_XGEN(b.x)], 1u);
            asm volatile("s_waitcnt vmcnt(0)" ::: "memory");
        } else {
            XB_SPIN(xb_ld(&bar[XB_XGEN(b.x)]) == gen, bar);
            __builtin_amdgcn_fence(__ATOMIC_ACQUIRE, "agent");
            asm volatile("s_waitcnt vmcnt(0)" ::: "memory");
        }
    }
    sync_threads_();
}

#define LDS_BARRIER() do { asm volatile("s_waitcnt lgkmcnt(0)" ::: "memory"); __builtin_amdgcn_s_barrier(); asm volatile("" ::: "memory"); } while (0)
constexpr int XROW = 272;
constexpr int CROW = 132;
constexpr int R_XT = 0, R_UT = 35840, R_AT = 70656, R_VT = 87552, R_EP = 104448, R_CWT = 105472, R_GT = 108032, R_YT = 116736;
template <int D> __device__ __forceinline__ float dpp_row_shr(float old, float src) {
    return i2f(__builtin_amdgcn_update_dpp(f2i(old), f2i(src), 0x110 | D, 0xf, 0xf, false)); }
__device__ __forceinline__ float softplus_small_(float e) { return (e < 0.03f) ? e * (1.0f + e * (-0.5f + e * (0.33333334f + e * (-0.25f + e * 0.2f)))) : __builtin_logf(1.0f + e); }
__device__ __forceinline__ float fast_sigmoid(float x) { return __builtin_amdgcn_rcpf(1.0f + __builtin_amdgcn_exp2f(-1.4426950408889634f * x)); }
__device__ __forceinline__ void rnn_unit(const Args& a, int l, int u, LAS unsigned char* lds) {
    const int tid = opaque_tid(), lane = tid & 63, wv = tid >> 6, fr = lane & 15, fq = lane >> 4;
    const int xcd = u & 7, jj = u >> 3, q = jj & 3, bh = (jj >> 2) * 8 + xcd, b = bh >> 3, h = bh & 7;
    const bf16* PROJ = (const bf16*)(a.ws + WS_PROJ); bf16* YCAT = (bf16*)(a.ws + WS_YCAT);
    const bf16* xr_base = PROJ + (size_t)(b * SEQ) * NPROJ + h * 128;
    const bf16* gr_base = PROJ + (size_t)(b * SEQ) * NPROJ + 1024 + h * 128 + q * 32;
    bf16* y_base = YCAT + (size_t)(b * SEQ) * DMIX + h * 128 + q * 32;
    LAS unsigned char* XT = lds + R_XT; LAS unsigned char* UT = lds + R_UT;
    LAS float* AT = (LAS float*)(lds + R_AT); LAS float* VT = (LAS float*)(lds + R_VT);
    LAS unsigned char* GT = lds + R_GT; LAS unsigned char* YT = lds + R_YT;
    const int io_tk = tid >> 2, io_cq = tid & 3;
    const int ck = tid & 15, tg = tid >> 4;
    LAS float* CWT = (LAS float*)(lds + R_CWT);
    for (int i = tid; i < 640; i += 512) { const int r = i >> 7, c = i & 127;
        CWT[i] = (r < 4) ? a.in[6][(size_t)l * 4 * 1024 + r * 1024 + h * 128 + c] : a.in[7][(size_t)l * 1024 + h * 128 + c]; }
    bf16x8 Wf[4][4];
    {
        const bf16* gwp = (const bf16*)(a.ws + WS_GW) + (size_t)((l * 8 + h) * 4 + q) * 64 * 128;
#pragma unroll
        for (int nb = 0; nb < 4; ++nb)
#pragma unroll
            for (int kb = 0; kb < 4; ++kb) Wf[nb][kb] = *(const bf16x8*)(gwp + (nb * 16 + fr) * 128 + kb * 32 + fq * 8);
    }
    LAS float* EP = (LAS float*)(lds + R_EP);
    if (tid < 96) {
        const int r = tid >> 5, c = tid & 31, ch = h * 128 + q * 32 + c; float v;
        if (r == 0) v = -1.4426950408889634f * a.in[9][l * 1024 + ch];
        else if (r == 1) v = -1.4426950408889634f * a.in[11][l * 1024 + ch];
        else v = 8.0f * 1.4426950408889634f * softplus_small_(__builtin_expf(-a.in[12][l * 1024 + ch]));
        EP[r * 32 + c] = v;
    }
    u32x4 pf[4], pfh = (u32x4){0u, 0u, 0u, 0u};
#pragma unroll
    for (int i = 0; i < 4; ++i) { const int id = tid + 512 * i, row = id >> 4, cc = id & 15; pf[i] = *(const u32x4*)(xr_base + (size_t)row * NPROJ + cc * 8); }
    u32x4 gpf = *(const u32x4*)(gr_base + (size_t)io_tk * NPROJ + io_cq * 8);
    const int sc_ci = lane >> 4, sc_sg = lane & 15, sc_c = wv * 4 + sc_ci;
    float hcar = 0.f;
#pragma unroll
    for (int i = 0; i < 4; ++i) { const int id = tid + 512 * i, row = id >> 4, cc = id & 15; *(LAS u32x4*)(XT + (3 + row) * XROW + cc * 16) = pf[i]; }
    if (tid < 48) *(LAS u32x4*)(XT + (tid >> 4) * XROW + (tid & 15) * 16) = pfh;
    for (int tile = 0; tile < SEQ / 128; ++tile) {
        const int t0 = tile * 128;
        LDS_BARRIER();
        {
            const int t0n = (tile + 1 < SEQ / 128) ? t0 + 128 : t0;
#pragma unroll
            for (int i = 0; i < 4; ++i) { const int id = tid + 512 * i, row = id >> 4, cc = id & 15; pf[i] = *(const u32x4*)(xr_base + (size_t)(t0n + row) * NPROJ + cc * 8); }
            if (tid < 48) pfh = *(const u32x4*)(xr_base + (size_t)(t0n - 3 + (tid >> 4)) * NPROJ + (tid & 15) * 8);
        }
        {
            if (tile > 0) {
                unsigned short yv_[8];
#pragma unroll
                for (int e = 0; e < 8; ++e) yv_[e] = *(const LAS unsigned short*)(YT + (io_cq * 8 + e) * XROW + io_tk * 2);
                u32x4 w; w.x = yv_[0] | ((unsigned)yv_[1] << 16); w.y = yv_[2] | ((unsigned)yv_[3] << 16); w.z = yv_[4] | ((unsigned)yv_[5] << 16); w.w = yv_[6] | ((unsigned)yv_[7] << 16);
                *(u32x4*)(y_base + (size_t)(t0 - 128 + io_tk) * DMIX + io_cq * 8) = w;
            }
            const unsigned gwv[4] = {gpf.x, gpf.y, gpf.z, gpf.w};
#pragma unroll
            for (int e2 = 0; e2 < 4; ++e2) { *(LAS unsigned short*)(GT + (io_cq * 8 + 2 * e2) * XROW + io_tk * 2) = (unsigned short)(gwv[e2] & 0xffffu);
                *(LAS unsigned short*)(GT + (io_cq * 8 + 2 * e2 + 1) * XROW + io_tk * 2) = (unsigned short)(gwv[e2] >> 16); }
            const int t1 = (tile + 1 < SEQ / 128) ? t0 + 128 : t0;
            gpf = *(const u32x4*)(gr_base + (size_t)(t1 + io_tk) * NPROJ + io_cq * 8);
        }
        {
            f32x2 o[4][4], cw[4][4];
            {
                const f32x4 b0 = *(const LAS f32x4*)(CWT + 4 * 128 + ck * 8), b1 = *(const LAS f32x4*)(CWT + 4 * 128 + ck * 8 + 4);
#pragma unroll
                for (int i = 0; i < 4; ++i) { o[i][0] = (f32x2){b0.x, b0.y}; o[i][1] = (f32x2){b0.z, b0.w}; o[i][2] = (f32x2){b1.x, b1.y}; o[i][3] = (f32x2){b1.z, b1.w}; }
            }
#pragma unroll
            for (int k = 0; k < 4; ++k) { const f32x4 w0 = *(const LAS f32x4*)(CWT + k * 128 + ck * 8), w1 = *(const LAS f32x4*)(CWT + k * 128 + ck * 8 + 4);
                cw[k][0] = (f32x2){w0.x, w0.y}; cw[k][1] = (f32x2){w0.z, w0.w}; cw[k][2] = (f32x2){w1.x, w1.y}; cw[k][3] = (f32x2){w1.z, w1.w}; }
#pragma unroll
            for (int r = 0; r < 7; ++r) {
                const u32x4 w = *(const LAS u32x4*)(XT + (tg * 4 + r) * XROW + ck * 16);
                const f32x2 xv[4] = {(f32x2){bflo(w.x), bfhi(w.x)}, (f32x2){bflo(w.y), bfhi(w.y)}, (f32x2){bflo(w.z), bfhi(w.z)}, (f32x2){bflo(w.w), bfhi(w.w)}};
#pragma unroll
                for (int i = 0; i < 4; ++i) { const int k = r - i; if (k >= 0 && k < 4) {
#pragma unroll
                    for (int e = 0; e < 4; ++e) o[i][e] = __builtin_elementwise_fma(cw[k][e], xv[e], o[i][e]); } }
            }
#pragma unroll
            for (int i = 0; i < 4; ++i) { u32x4 w; w.x = pk2(o[i][0].x, o[i][0].y); w.y = pk2(o[i][1].x, o[i][1].y); w.z = pk2(o[i][2].x, o[i][2].y); w.w = pk2(o[i][3].x, o[i][3].y);
                *(LAS u32x4*)(UT + (tg * 4 + i) * XROW + ck * 16) = w; }
        }
        asm volatile("s_waitcnt lgkmcnt(0)" ::: "memory");
        {
            f32x4 acc[4];
#pragma unroll
            for (int nb = 0; nb < 4; ++nb) acc[nb] = (f32x4){0.f, 0.f, 0.f, 0.f};
#pragma unroll
            for (int kb = 0; kb < 4; ++kb) { const bf16x8 uf = *(const LAS bf16x8*)(UT + (wv * 16 + fr) * XROW + kb * 64 + fq * 16);
#pragma unroll
                for (int nb = 0; nb < 4; ++nb) acc[nb] = __builtin_amdgcn_mfma_f32_16x16x32_bf16(Wf[nb][kb], uf, acc[nb], 0, 0, 0); }
            const int tk = wv * 16 + fr;
#pragma unroll
            for (int nb2 = 0; nb2 < 2; ++nb2) {
                const int c0 = nb2 * 16 + 4 * fq;
                const u32x2 uw = *(const LAS u32x2*)(UT + tk * XROW + (q * 32 + c0) * 2);
                const f32x4 uu = (f32x4){bflo(uw.x), bfhi(uw.x), bflo(uw.y), bfhi(uw.y)};
                const f32x4 ra = acc[nb2] + *(const LAS f32x4*)(EP + c0), rx = acc[nb2 + 2] + *(const LAS f32x4*)(EP + 32 + c0), sp8 = *(const LAS f32x4*)(EP + 64 + c0);
#pragma unroll
                for (int e = 0; e < 4; ++e) { const float r = __builtin_amdgcn_rcpf(1.0f + __builtin_amdgcn_exp2f(ra[e])), ig = __builtin_amdgcn_rcpf(1.0f + __builtin_amdgcn_exp2f(rx[e]));
                    const float av = __builtin_amdgcn_exp2f(-r * sp8[e]);
                    const float m2 = __builtin_fmaxf(__builtin_fmaf(-av, av, 1.0f), 0.f);
                    AT[(c0 + e) * CROW + tk] = av; VT[(c0 + e) * CROW + tk] = __builtin_amdgcn_sqrtf(m2) * (ig * uu[e]); }
            }
        }
        LDS_BARRIER();
        {
            const f32x4 a0 = *(const LAS f32x4*)(AT + sc_c * CROW + sc_sg * 8), a1 = *(const LAS f32x4*)(AT + sc_c * CROW + sc_sg * 8 + 4);
            const f32x4 v0 = *(const LAS f32x4*)(VT + sc_c * CROW + sc_sg * 8), v1 = *(const LAS f32x4*)(VT + sc_c * CROW + sc_sg * 8 + 4);
            const float av[8] = {a0.x, a0.y, a0.z, a0.w, a1.x, a1.y, a1.z, a1.w}, vv[8] = {v0.x, v0.y, v0.z, v0.w, v1.x, v1.y, v1.z, v1.w};
            float hl[8], pp[8]; float hcur = 0.f, pcur = 1.f;
#pragma unroll
            for (int j = 0; j < 8; ++j) { hcur = __builtin_fmaf(av[j], hcur, vv[j]); pcur *= av[j]; hl[j] = hcur; pp[j] = pcur; }
            float P = pcur, H = hcur;
            { float Pp = dpp_row_shr<1>(1.f, P), Hp = dpp_row_shr<1>(0.f, H); H = __builtin_fmaf(P, Hp, H); P *= Pp;
              Pp = dpp_row_shr<2>(1.f, P); Hp = dpp_row_shr<2>(0.f, H); H = __builtin_fmaf(P, Hp, H); P *= Pp;
              Pp = dpp_row_shr<4>(1.f, P); Hp = dpp_row_shr<4>(0.f, H); H = __builtin_fmaf(P, Hp, H); P *= Pp;
              Pp = dpp_row_shr<8>(1.f, P); Hp = dpp_row_shr<8>(0.f, H); H = __builtin_fmaf(P, Hp, H); P *= Pp; }
            const float Pe = dpp_row_shr<1>(1.f, P), He = dpp_row_shr<1>(0.f, H);
            const float carry = __builtin_fmaf(Pe, hcar, He);
            const float hend = __builtin_fmaf(P, hcar, H);
            hcar = row_last_(hend);
            const u32x4 gq = *(const LAS u32x4*)(GT + sc_c * XROW + sc_sg * 16);
            const float gvv[8] = {bflo(gq.x), bfhi(gq.x), bflo(gq.y), bfhi(gq.y), bflo(gq.z), bfhi(gq.z), bflo(gq.w), bfhi(gq.w)};
            float yy[8];
#pragma unroll
            for (int j = 0; j < 8; ++j) { const float hv = __builtin_fmaf(pp[j], carry, hl[j]); yy[j] = hv * gvv[j] * fast_sigmoid(gvv[j]); }
            u32x4 yw_; yw_.x = pk2(yy[0], yy[1]); yw_.y = pk2(yy[2], yy[3]); yw_.z = pk2(yy[4], yy[5]); yw_.w = pk2(yy[6], yy[7]);
            *(LAS u32x4*)(YT + sc_c * XROW + sc_sg * 16) = yw_;
        }
#pragma unroll
        for (int i = 0; i < 4; ++i) { const int id = tid + 512 * i, row = id >> 4, cc = id & 15; *(LAS u32x4*)(XT + (3 + row) * XROW + cc * 16) = pf[i]; }
        if (tid < 48) *(LAS u32x4*)(XT + (tid >> 4) * XROW + (tid & 15) * 16) = pfh;
    }
    LDS_BARRIER();
    {
        unsigned short yv_[8];
#pragma unroll
        for (int e = 0; e < 8; ++e) yv_[e] = *(const LAS unsigned short*)(YT + (io_cq * 8 + e) * XROW + io_tk * 2);
        u32x4 w; w.x = yv_[0] | ((unsigned)yv_[1] << 16); w.y = yv_[2] | ((unsigned)yv_[3] << 16); w.z = yv_[4] | ((unsigned)yv_[5] << 16); w.w = yv_[6] | ((unsigned)yv_[7] << 16);
        *(u32x4*)(y_base + (size_t)(SEQ - 128 + io_tk) * DMIX + io_cq * 8) = w;
    }
    LDS_BARRIER();
}

constexpr int PROW = 528;
constexpr int R_XP = 0, R_PT = 42240;
__device__ __forceinline__ void pool_units(const Args& a, int l, int u, LAS unsigned char* lds) {
    const int tid = opaque_tid(), lane = tid & 63, wv = tid >> 6, fr = lane & 15, fq = lane >> 4;
    const int g = u & 3, bi = u >> 2, win = 2 << g;
    const bf16* PROJ = (const bf16*)(a.ws + WS_PROJ); bf16* YCAT = (bf16*)(a.ws + WS_YCAT);
    LAS unsigned char* XP = lds + R_XP; LAS unsigned char* PT = lds + R_PT;
    const bf16* pw = (const bf16*)(a.ws + WS_PW) + (size_t)(l * 4 + g) * 256 * 256;
    bf16x8 Wf[2][8];
#pragma unroll
    for (int nb = 0; nb < 2; ++nb)
#pragma unroll
        for (int kb = 0; kb < 8; ++kb) Wf[nb][kb] = *(const bf16x8*)(pw + (size_t)(wv * 32 + 8 * (fr >> 2) + 4 * nb + (fr & 3)) * 256 + kb * 32 + fq * 8);
    f32x4 pb[2], ps[2];
#pragma unroll
    for (int nb = 0; nb < 2; ++nb) { const int n = wv * 32 + 8 * fq + 4 * nb;
        pb[nb] = *(const f32x4*)(a.in[14] + (size_t)l * 1024 + g * 256 + n); ps[nb] = *(const f32x4*)(a.in[15] + (size_t)l * 1024 + g * 256 + n); }
    const int ck = tid & 31, tg = tid >> 5;
    u32x4 pf[5];
    {
        const int tile = bi * 8, b = tile >> 6, t0 = (tile & 63) * 64;
        const bf16* xp_base = PROJ + (size_t)(b * SEQ) * NPROJ + 2048 + g * 256;
#pragma unroll
        for (int i = 0; i < 5; ++i) { const int id = tid + 512 * i, row = id >> 5, cc = id & 31, t = t0 - 16 + row;
            const u32x4 v = *(const u32x4*)(xp_base + (size_t)(t < 0 ? 0 : t) * NPROJ + cc * 8); pf[i] = (t < 0) ? (u32x4){0u, 0u, 0u, 0u} : v; }
    }
#pragma unroll
    for (int i = 0; i < 5; ++i) { const int id = tid + 512 * i, row = id >> 5, cc = id & 31; *(LAS u32x4*)(XP + row * PROW + cc * 16) = pf[i]; }
    u32x4 gp[4];
    {
        const int tile = bi * 8, b = tile >> 6, t0 = (tile & 63) * 64;
        const bf16* gp_base0 = PROJ + (size_t)(b * SEQ) * NPROJ + 3072 + g * 256;
#pragma unroll
        for (int tb = 0; tb < 4; ++tb)
        { gp[tb] = *(const u32x4*)(gp_base0 + (size_t)(t0 + tb * 16 + fr) * NPROJ + wv * 32 + 8 * fq);
                asm volatile("" : "+v"(gp[tb])); }
    }
    for (int it = 0; it < 8; ++it) {
        const int tile = bi * 8 + it, b = tile >> 6, t0 = (tile & 63) * 64;
        bf16* y_base = YCAT + (size_t)(b * SEQ) * DMIX + 1024 + g * 256;
        LDS_BARRIER();
        {
            const int tile2 = bi * 8 + ((it + 1 < 8) ? it + 1 : it), b2 = tile2 >> 6, t02 = (tile2 & 63) * 64;
            const bf16* xp_base = PROJ + (size_t)(b2 * SEQ) * NPROJ + 2048 + g * 256;
#pragma unroll
            for (int i = 0; i < 5; ++i) { const int id = tid + 512 * i, row = id >> 5, cc = id & 31, t = t02 - 16 + row;
                const u32x4 v = *(const u32x4*)(xp_base + (size_t)(t < 0 ? 0 : t) * NPROJ + cc * 8); pf[i] = (t < 0) ? (u32x4){0u, 0u, 0u, 0u} : v; }
        }
        u32x4 gpn[4];
        {
            const int tile2 = bi * 8 + ((it + 1 < 8) ? it + 1 : it), b2 = tile2 >> 6, t02 = (tile2 & 63) * 64;
            const bf16* gp_base2 = PROJ + (size_t)(b2 * SEQ) * NPROJ + 3072 + g * 256;
#pragma unroll
            for (int tb = 0; tb < 4; ++tb)
                gpn[tb] = *(const u32x4*)(gp_base2 + (size_t)(t02 + tb * 16 + fr) * NPROJ + wv * 32 + 8 * fq);
        }
        {
            float s[8];
#pragma unroll
            for (int e = 0; e < 8; ++e) s[e] = 0.f;
            const int r0 = tg * 4 + 16;
            for (int r = r0 - win + 1; r < r0; ++r) { const u32x4 w = *(const LAS u32x4*)(XP + r * PROW + ck * 16);
                s[0] += bflo(w.x); s[1] += bfhi(w.x); s[2] += bflo(w.y); s[3] += bfhi(w.y); s[4] += bflo(w.z); s[5] += bfhi(w.z); s[6] += bflo(w.w); s[7] += bfhi(w.w); }
#pragma unroll
            for (int i = 0; i < 4; ++i) {
                const u32x4 w = *(const LAS u32x4*)(XP + (r0 + i) * PROW + ck * 16);
                const float xv[8] = {bflo(w.x), bfhi(w.x), bflo(w.y), bfhi(w.y), bflo(w.z), bfhi(w.z), bflo(w.w), bfhi(w.w)};
                const int t = t0 + tg * 4 + i; const float inv = __builtin_amdgcn_rcpf((float)((t + 1 < win) ? (t + 1) : win));
                float p[8];
#pragma unroll
                for (int e = 0; e < 8; ++e) { s[e] += xv[e]; p[e] = __builtin_fmaf(s[e], inv, -xv[e]); }
                u32x4 o; o.x = pk2(p[0], p[1]); o.y = pk2(p[2], p[3]); o.z = pk2(p[4], p[5]); o.w = pk2(p[6], p[7]);
                *(LAS u32x4*)(PT + (tg * 4 + i) * PROW + ck * 16) = o;
                const u32x4 wo = *(const LAS u32x4*)(XP + (r0 + i - win + 1) * PROW + ck * 16);
                s[0] -= bflo(wo.x); s[1] -= bfhi(wo.x); s[2] -= bflo(wo.y); s[3] -= bfhi(wo.y); s[4] -= bflo(wo.z); s[5] -= bfhi(wo.z); s[6] -= bflo(wo.w); s[7] -= bfhi(wo.w);
            }
        }
        LDS_BARRIER();
#pragma unroll
        for (int tb = 0; tb < 4; ++tb) {
            f32x4 acc[2] = {(f32x4){0.f, 0.f, 0.f, 0.f}, (f32x4){0.f, 0.f, 0.f, 0.f}};
#pragma unroll
            for (int kb = 0; kb < 8; ++kb) { const bf16x8 pfm = *(const LAS bf16x8*)(PT + (tb * 16 + fr) * PROW + kb * 64 + fq * 16);
#pragma unroll
                for (int nb = 0; nb < 2; ++nb) acc[nb] = __builtin_amdgcn_mfma_f32_16x16x32_bf16(Wf[nb][kb], pfm, acc[nb], 0, 0, 0); }
            const int t = t0 + tb * 16 + fr;
            u32x4 o;
#pragma unroll
            for (int nb = 0; nb < 2; ++nb) {
                const unsigned g0 = nb ? gp[tb].z : gp[tb].x, g1 = nb ? gp[tb].w : gp[tb].y;
                const f32x4 gv = (f32x4){bflo(g0), bfhi(g0), bflo(g1), bfhi(g1)};
                f32x4 r = (acc[nb] + pb[nb]) * ps[nb];
#pragma unroll
                for (int e = 0; e < 4; ++e) r[e] *= gv[e] * fast_sigmoid(gv[e]);
                if (nb == 0) { o.x = pk2(r.x, r.y); o.y = pk2(r.z, r.w); } else { o.z = pk2(r.x, r.y); o.w = pk2(r.z, r.w); } }
            *(u32x4*)(y_base + (size_t)t * DMIX + wv * 32 + 8 * fq) = o;
        }
#pragma unroll
        for (int i = 0; i < 5; ++i) { const int id = tid + 512 * i, row = id >> 5, cc = id & 31; *(LAS u32x4*)(XP + row * PROW + cc * 16) = pf[i]; }
#pragma unroll
        for (int tb = 0; tb < 4; ++tb)
            gp[tb] = gpn[tb];
    }
    LDS_BARRIER();
}

__device__ __forceinline__ void phase_mixer(const Args& a, int l, LAS unsigned char* lds) {
#ifndef MK_MIX
#define MK_MIX 3
#endif
#ifndef MK_DBL_RNN
#define MK_DBL_RNN 0
#endif
#ifndef MK_DBL_POOL
#define MK_DBL_POOL 0
#endif
    for (int rep = 0; rep < 1 + ((l == 0) ? MK_DBL_RNN : 0); ++rep) for (int u = blockIdx.x; u < 256; u += gridDim.x) rnn_unit(a, l, u, lds);
    for (int rep = 0; rep < 1 + ((l == 0) ? MK_DBL_POOL : 0); ++rep) for (int u = blockIdx.x; u < 256; u += gridDim.x) pool_units(a, l, u, lds);
}
#ifndef MK_DBL_PH
#define MK_DBL_PH -1
#endif
#ifndef MK_MASK
#define MK_MASK 63
#endif
__global__ void __launch_bounds__(512, 2) mk_fwd(Args a) {
    extern __shared__ __attribute__((aligned(16))) unsigned char lds_raw[];
    LAS unsigned char* lds = (LAS unsigned char*)lds_raw;
    cg::grid_group grid = cg::this_grid();
    volatile LAS unsigned* bst = (volatile LAS unsigned*)(lds + LDS_BST_OFF);
    if (threadIdx.x < 4) bst[threadIdx.x] = 0u;
    sync_threads_();
    XcdBarrier xbar = xcd_barrier_post((unsigned*)(a.ws + WS_CTL), bst);
#define GRID_BAR() do { if (a.ph_hi - a.ph_lo > 64) grid.sync(); else xcd_barrier(xbar); } while (0)
    for (int ph = a.ph_lo; ph < a.ph_hi; ++ph) {
#if MK_DBL_PH >= 0
      for (int rep = 0; rep < ((ph == MK_DBL_PH) ? 2 : 1); ++rep) {
        if (rep) GRID_BAR();
#endif
        if (ph == 0) { if (MK_MASK & 1) phase_prep(a, lds); }
        else if (ph == 1) { if (MK_MASK & 2) phase_h0(a); }
        else {
            const int l = (ph - 2) >> 2, sub = (ph - 2) & 3;
            if (sub == 0) { if (MK_MASK & 4) {
                pg8::Gemm g{(const pg8::bf16_t*)(a.ws + WS_H), (const pg8::bf16_t*)(a.ws + WS_WIN) + (size_t)l * NPROJ * D, T, NPROJ, D};
                pg8::StaticOrder S; S.init(T, NPROJ, gridDim.x, (int)blockIdx.x);
                pg8::EpiBf16<0> E{(pg8::bf16_t*)(a.ws + WS_PROJ), NPROJ, nullptr, 0, 0, 1.f};
                pg8::gemm_phase<pg8::EpiBf16<0>, pg8::StaticOrder, PG8_ALIGN, PG8_SP2>(lds, g, S, E); }
            } else if (sub == 1) {
                if (MK_MASK & 8) phase_mixer(a, l, lds);
            } else if (sub == 2) { if (MK_MASK & 16) {
                pg8::Gemm g{(const pg8::bf16_t*)(a.ws + WS_YCAT), (const pg8::bf16_t*)(a.ws + WS_WOUT) + (size_t)l * D * DMIX, T, D, DMIX};
                pg8::StaticOrder S; S.init(T, D, gridDim.x, (int)blockIdx.x);
                pg8::EpiBf16<0> E{(pg8::bf16_t*)(a.ws + WS_Y), D, nullptr, 0, 0, 1.f};
                pg8::gemm_phase<pg8::EpiBf16<0>, pg8::StaticOrder, PG8_ALIGN, PG8_SP2>(lds, g, S, E); }
            } else {
                if (MK_MASK & 32) phase_post(a, l);
            }
        }
#if MK_DBL_PH >= 0
      }
#endif
        if (ph + 1 < a.ph_hi) GRID_BAR();
    }
}

#if defined(__HIP_DEVICE_COMPILE__)
#pragma clang attribute pop
#endif

extern "C" void kernel_launch(void* const* d_in, const int* in_sizes, int n_in, void* d_out, int out_size, void* d_ws, size_t ws_size, hipStream_t stream) {
    static int grid = 0;
    if (grid == 0) {
        if (n_in != 18 || in_sizes[0] != T * D || out_size != T * D || ws_size < WS_END) {
            fprintf(stderr, "kernel_launch: unexpected shapes (n_in %d, in0 %d, out %d, ws %zu); nothing launched\n", n_in, n_in > 0 ? in_sizes[0] : -1, out_size, ws_size); grid = -1; return; }
        int dev = 0, cus = 0, per_cu = 0;
        if (hipGetDevice(&dev) != hipSuccess || hipDeviceGetAttribute(&cus, hipDeviceAttributeMultiprocessorCount, dev) != hipSuccess) { grid = -1; return; }
        if (hipFuncSetAttribute((const void*)mk_fwd, hipFuncAttributeMaxDynamicSharedMemorySize, LDS_BYTES) != hipSuccess) { fprintf(stderr, "kernel_launch: hipFuncSetAttribute failed\n"); grid = -1; return; }
        if (hipOccupancyMaxActiveBlocksPerMultiprocessor(&per_cu, (const void*)mk_fwd, 512, LDS_BYTES) != hipSuccess || per_cu < 1) { fprintf(stderr, "kernel_launch: occupancy query says %d blocks per CU\n", per_cu); per_cu = 1; }
        (void)hipGetLastError();
        grid = cus;
    }
    if (grid < 0) return;
    Args a{};
    for (int i = 0; i < 18; ++i) a.in[i] = (const float*)d_in[i];
    a.out = (float*)d_out; a.ws = (unsigned char*)d_ws;
    if (hipMemsetAsync((char*)d_ws + WS_CTL, 0, CTL_BYTES, stream) != hipSuccess) { fprintf(stderr, "kernel_launch: memset of the barrier words failed\n"); return; }
#if MK_N_LAUNCHES == 1
    a.ph_lo = 0; a.ph_hi = NPH;
    void* args[] = {&a};
    const hipError_t e = hipLaunchCooperativeKernel((const void*)mk_fwd, dim3(grid), dim3(512), args, LDS_BYTES, stream);
    if (e != hipSuccess) fprintf(stderr, "kernel_launch: cooperative launch failed: %s (grid %d)\n", hipGetErrorString(e), grid);
#else
    for (int ph = 0; ph < NPH; ++ph) {
        a.ph_lo = ph; a.ph_hi = ph + 1;
        hipLaunchKernelGGL(mk_fwd, dim3(grid), dim3(512), LDS_BYTES, stream, a);
    }
#endif
}
```

```cpp
#include <hip/hip_runtime.h>
#include <hip/hip_cooperative_groups.h>
#include <cstdio>
#include <cstdint>
namespace cg = cooperative_groups;
__device__ __forceinline__ int opaque_tid() { int t = threadIdx.x; asm volatile("" : "+v"(t)); return t; }
#if defined(__HIP_DEVICE_COMPILE__)
#pragma clang attribute push (__attribute__((target("no-packed-fp32-ops"))), apply_to = function)
#endif
__device__ __forceinline__ float u2f(unsigned x) { return __builtin_bit_cast(float, x); }
__device__ __forceinline__ float i2f(int x) { return __builtin_bit_cast(float, x); }
__device__ __forceinline__ int f2i(float x) { return __builtin_bit_cast(int, x); }
__device__ __forceinline__ int lane_id_() { return (int)__builtin_amdgcn_mbcnt_hi(~0u, __builtin_amdgcn_mbcnt_lo(~0u, 0u)); }
__device__ __forceinline__ float shfl_xor_(float v, int o) { return i2f(__builtin_amdgcn_ds_bpermute((lane_id_() ^ o) << 2, f2i(v))); }
__device__ __forceinline__ float row_last_(float v) { return i2f(__builtin_amdgcn_ds_bpermute((lane_id_() | 15) << 2, f2i(v))); }
__device__ __forceinline__ void sync_threads_() { __builtin_amdgcn_fence(__ATOMIC_RELEASE, "workgroup"); __builtin_amdgcn_s_barrier(); __builtin_amdgcn_fence(__ATOMIC_ACQUIRE, "workgroup"); }
namespace pg8 {
#define PG8_LAS __attribute__((address_space(3)))
typedef unsigned short bf16_t;
typedef short bf16x8 __attribute__((ext_vector_type(8)));
typedef float f32x4 __attribute__((ext_vector_type(4)));
typedef unsigned u32x4 __attribute__((ext_vector_type(4)));
constexpr int BM = 256, BK = 64, HALF = 128, HTB = HALF * BK * 2  , STAGE_BYTES = 8 * HTB, NXCD = 8, WGM = 8;

__host__ __device__ __forceinline__ int lds_byte(int r, int c) { const int st = (r >> 4) * 2 + (c >> 5), rr = r & 15, cc = c & 31, ob = rr * 64 + cc * 2; return st * 1024 + (ob ^ (((ob >> 9) & 1) << 5)); }
__host__ __device__ __forceinline__ void stage_rc(int b, int& R, int& C) { const int st = b / 1024, sb = b % 1024, swz = sb ^ (((sb >> 9) & 1) << 5); R = (st >> 1) * 16 + swz / 64; C = (st & 1) * 32 + (swz % 64) / 2; }
__host__ __device__ __forceinline__ int perm32(int rho) { const int n = rho >> 4, i = rho & 15; return 8 * (i >> 2) + 4 * n + (i & 3); }

struct Unit { int pm, pn; };
struct Gemm { const bf16_t* A; const bf16_t* Bt; int M, N, K; };

struct StaticOrder {
    int nM, nN, nwg, G, c;
    __host__ __device__ void init(int M, int N, int G_, int c_) { nM = M / BM; nN = N / BM; nwg = nM * nN; G = G_; c = c_; }
    __host__ __device__ bool next(int i, Unit& u) const {
        const long L = (long)i * G + c; if (L >= nwg) return false;
        int wgid = (int)L; { const int q = nwg / NXCD, r = nwg % NXCD, xcd = wgid % NXCD, off = wgid / NXCD; wgid = (xcd < r ? xcd * (q + 1) : r * (q + 1) + (xcd - r) * q) + off; }
        const int nig = WGM * nN, gid = wgid / nig, fm = gid * WGM, gsz = (nM - fm) < WGM ? (nM - fm) : WGM;
        u.pm = fm + ((wgid % nig) % gsz); u.pn = (wgid % nig) / gsz; return true;
    }
    __device__ __forceinline__ void a_ready(const Unit&) const {}
    __device__ __forceinline__ void done(const Unit&) const {}
};

__device__ __forceinline__ unsigned cvt_pk_bf16(float lo, float hi) { unsigned r; asm volatile("v_cvt_pk_bf16_f32 %0, %1, %2" : "=v"(r) : "v"(lo), "v"(hi)); return r; }
typedef float f32x2 __attribute__((ext_vector_type(2)));
__device__ __forceinline__ f32x2 gelu_pk(f32x2 v) {
    const f32x2 av = __builtin_elementwise_abs(v), d = av * 0.2316418882f + 1.0f;
    f32x2 t; t.x = __builtin_amdgcn_rcpf(d.x); t.y = __builtin_amdgcn_rcpf(d.y);
    f32x2 q = t * 0.5307027145f + (-0.7265760135f); q = q * t + 0.7107068705f; q = q * t + (-0.142248368f); q = q * t + 0.127414796f; q = q * t;
    const f32x2 s = (v * v) * (-0.72134752044f);
    f32x2 e; e.x = __builtin_amdgcn_exp2f(s.x); e.y = __builtin_amdgcn_exp2f(s.y);
    const f32x2 m = v * (q * e), r = v - m;
    f32x2 o; o.x = v.x < 0.f ? m.x : r.x; o.y = v.y < 0.f ? m.y : r.y; return o;
}

template <int ACT  > struct EpiBf16 {
    static constexpr bool PERM = true, AFTER_DRAIN = false; static_assert(ACT == 0 || ACT == 1, "EpiBf16: ACT is 0 (none) or 1 (gelu_pk)");
    bf16_t* O; int ldc; const float* bias; int split_cols; size_t split_stride; float scale0;
    __device__ __forceinline__ void operator()(const f32x4 (&acc)[2][2][4][2], const Unit& u, int wr, int wc, int fr, int fq) const {
        const int row0 = u.pm * BM + wr * 64 + fr; int colt = u.pn * BM; bf16_t* base = O;
        float sc = 1.f; if (split_cols) { const int t = colt / split_cols; base += (size_t)t * split_stride; colt -= t * split_cols; if (t == 0) sc = scale0; }
        const int col0 = colt + wc * 32 + 8 * fq, bcol0 = u.pn * BM + wc * 32 + 8 * fq;
        f32x4 bv[2][2];
#pragma unroll
        for (int bj = 0; bj < 2; ++bj)
#pragma unroll
            for (int n = 0; n < 2; ++n) bv[bj][n] = bias ? *(const f32x4*)(bias + bcol0 + bj * HALF + 4 * n) : (f32x4){0.f, 0.f, 0.f, 0.f};
#pragma unroll
        for (int ai = 0; ai < 2; ++ai)
#pragma unroll
            for (int m = 0; m < 4; ++m) { bf16_t* rowp = base + (size_t)(row0 + ai * HALF + m * 16) * ldc + col0;
#pragma unroll
                for (int bj = 0; bj < 2; ++bj) { f32x4 v0 = acc[ai][bj][m][0] + bv[bj][0], v1 = acc[ai][bj][m][1] + bv[bj][1];
                    if (ACT == 1) { f32x2 a = gelu_pk((f32x2){v0[0], v0[1]}), b = gelu_pk((f32x2){v0[2], v0[3]}), c = gelu_pk((f32x2){v1[0], v1[1]}), d = gelu_pk((f32x2){v1[2], v1[3]});
                        v0 = (f32x4){a.x, a.y, b.x, b.y}; v1 = (f32x4){c.x, c.y, d.x, d.y}; }
                    v0 = v0 * sc; v1 = v1 * sc; u32x4 w; w.x = cvt_pk_bf16(v0[0], v0[1]); w.y = cvt_pk_bf16(v0[2], v0[3]); w.z = cvt_pk_bf16(v1[0], v1[1]); w.w = cvt_pk_bf16(v1[2], v1[3]);
                    *(u32x4*)(rowp + bj * HALF) = w; } }
    }
};
template <class Epi, class Sched, bool ALIGN_EPI = false, bool SP2 = false>
__device__ __forceinline__ void gemm_phase(PG8_LAS unsigned char* lds, const Gemm g, const Sched& S, const Epi& E) {
    const int tid = opaque_tid(), wid = __builtin_amdgcn_readfirstlane(tid >> 6), lane = tid & 63, wr = wid >> 2, wc = wid & 3, fr = lane & 15, fq = lane >> 4;
    const int K = g.K, nt = K / BK;
    unsigned voffA[2], voffB[2];
#pragma unroll
    for (int i = 0; i < 2; ++i) { int R, C; stage_rc(tid * 16 + i * 8192, R, C); const int Rb = Epi::PERM ? ((R & ~31) + perm32(R & 31)) : R;
        voffA[i] = (unsigned)(R * K + C) * 2u; voffB[i] = (unsigned)(Rb * K + C) * 2u; }
    const size_t kstep = (size_t)(BK * 2);
    const size_t hstep = (size_t)HALF * K * 2;
    const size_t tstep = 2 * hstep;
    const unsigned ldsw = (unsigned)wid * 1024u;
    const int aoff = lds_byte(wr * 64 + fr, fq * 8), boff = lds_byte(wc * 32 + fr, fq * 8);
#define PG8_SA(b, h) (((b) * 2 + (h)) * HTB)
#define PG8_SB(b, h) ((4 + (b) * 2 + (h)) * HTB)
#define PG8_STAGE(bufoff, gbase, voff) do { _Pragma("unroll") for (int _i = 0; _i < 2; ++_i) \
        __builtin_amdgcn_global_load_lds((const unsigned*)((const char*)(gbase) + (voff)[_i]), (PG8_LAS unsigned*)(lds + (bufoff) + ldsw + _i * 8192), 16, 0, 0); } while (0)
#define PG8_LDA(dst, b, h) do { _Pragma("unroll") for (int m = 0; m < 4; ++m) _Pragma("unroll") for (int k = 0; k < 2; ++k) dst[m][k] = *(const PG8_LAS bf16x8*)(lds + PG8_SA(b, h) + aoff + m * 2048 + k * 1024); } while (0)
#define PG8_LDB(dst, b, h) do { _Pragma("unroll") for (int n = 0; n < 2; ++n) _Pragma("unroll") for (int k = 0; k < 2; ++k) dst[n][k] = *(const PG8_LAS bf16x8*)(lds + PG8_SB(b, h) + boff + n * 2048 + k * 1024); } while (0)
#define PG8_MMA(ai, bj, At, Bt) do { __builtin_amdgcn_s_setprio(1); _Pragma("unroll") for (int m = 0; m < 4; ++m) _Pragma("unroll") for (int n = 0; n < 2; ++n) _Pragma("unroll") for (int k = 0; k < 2; ++k) \
        acc[ai][bj][m][n] = __builtin_amdgcn_mfma_f32_16x16x32_bf16(Bt[n][k], At[m][k], acc[ai][bj][m][n], 0, 0, 0); __builtin_amdgcn_s_setprio(0); } while (0)
#define PG8_WAIT_V(n) asm volatile("s_waitcnt vmcnt(" #n ")" ::: "memory")
#define PG8_WAIT_L(n) asm volatile("s_waitcnt lgkmcnt(" #n ")" ::: "memory")
#define PG8_BAR __builtin_amdgcn_s_barrier()
#define PG8_SCHED __builtin_amdgcn_sched_barrier(0)
    Unit cur, nxt; int ui = 0;
    if (!S.next(0, cur)) return;
    f32x4 acc[2][2][4][2];
#pragma unroll
    for (int a = 0; a < 2; ++a)
#pragma unroll
        for (int b = 0; b < 2; ++b)
#pragma unroll
            for (int m = 0; m < 4; ++m)
#pragma unroll
                for (int n = 0; n < 2; ++n) acc[a][b][m][n] = (f32x4){0.f, 0.f, 0.f, 0.f};
    bf16x8 At[4][2], B0[2][2], B1[2][2];
    const char* cA = (const char*)g.A + (size_t)cur.pm * tstep; const char* cB = (const char*)g.Bt + (size_t)cur.pn * tstep;
    S.a_ready(cur);
    if constexpr (SP2) {
        PG8_STAGE(PG8_SB(0, 0), cB, voffB); PG8_STAGE(PG8_SB(0, 1), cB + hstep, voffB); PG8_STAGE(PG8_SA(0, 0), cA, voffA); PG8_STAGE(PG8_SA(0, 1), cA + hstep, voffA);
        if (wr == 1) PG8_BAR;
        PG8_WAIT_V(2); PG8_BAR;
        PG8_STAGE(PG8_SB(1, 0), cB + kstep, voffB); PG8_STAGE(PG8_SA(1, 0), cA + kstep, voffA); PG8_STAGE(PG8_SB(1, 1), cB + hstep + kstep, voffB);
        PG8_WAIT_V(6); PG8_BAR;
    } else {
        PG8_STAGE(PG8_SB(0, 0), cB, voffB); PG8_STAGE(PG8_SA(0, 0), cA, voffA); PG8_STAGE(PG8_SB(0, 1), cB + hstep, voffB); PG8_STAGE(PG8_SA(0, 1), cA + hstep, voffA);
        if (wr == 1) PG8_BAR;
        PG8_WAIT_V(4); PG8_BAR;
        PG8_STAGE(PG8_SB(1, 0), cB + kstep, voffB); PG8_STAGE(PG8_SA(1, 0), cA + kstep, voffA); PG8_STAGE(PG8_SB(1, 1), cB + hstep + kstep, voffB);
        PG8_WAIT_V(6); PG8_BAR;
    }
    for (;;) {
        const bool has_next = S.next(ui + 1, nxt);
        const char* nA = has_next ? (const char*)g.A + (size_t)nxt.pm * tstep : cA; const char* nB = has_next ? (const char*)g.Bt + (size_t)nxt.pn * tstep : cB;
        for (int t = 0; t < nt; t += 2) {
            const bool last = (t == nt - 2);
            const char* a1 = cA + (size_t)(t + 1) * kstep;
            const char* a2 = last ? nA : cA + (size_t)(t + 2) * kstep; const char* b2 = last ? nB : cB + (size_t)(t + 2) * kstep;
            const char* a3 = a2 + kstep; const char* b3 = b2 + kstep;
            if (last && has_next) S.a_ready(nxt);
            if constexpr (SP2) {
            PG8_LDB(B0, 0, 0); PG8_LDB(B1, 0, 1); PG8_SCHED; PG8_LDA(At, 0, 0); PG8_STAGE(PG8_SA(1, 1), a1 + hstep, voffA);
            PG8_WAIT_V(8); PG8_WAIT_L(0); PG8_BAR; PG8_MMA(0, 0, At, B0); PG8_MMA(0, 1, At, B1); PG8_BAR; PG8_SCHED;
            PG8_LDA(At, 0, 1); PG8_STAGE(PG8_SB(0, 0), b2, voffB); PG8_STAGE(PG8_SB(0, 1), b2 + hstep, voffB); PG8_STAGE(PG8_SA(0, 0), a2, voffA);
            PG8_WAIT_V(8); PG8_WAIT_L(0); PG8_BAR; PG8_MMA(1, 0, At, B0); PG8_MMA(1, 1, At, B1); PG8_BAR; PG8_SCHED;
            PG8_LDB(B0, 1, 0); PG8_LDB(B1, 1, 1); PG8_SCHED; PG8_LDA(At, 1, 0); PG8_STAGE(PG8_SA(0, 1), a2 + hstep, voffA);
            PG8_WAIT_V(8); PG8_WAIT_L(0); PG8_BAR; PG8_MMA(0, 0, At, B0); PG8_MMA(0, 1, At, B1); PG8_BAR; PG8_SCHED;
            PG8_LDA(At, 1, 1); PG8_STAGE(PG8_SB(1, 0), b3, voffB); PG8_STAGE(PG8_SB(1, 1), b3 + hstep, voffB); PG8_STAGE(PG8_SA(1, 0), a3, voffA);
            PG8_WAIT_V(8); PG8_WAIT_L(0); PG8_BAR; PG8_MMA(1, 0, At, B0); PG8_MMA(1, 1, At, B1); PG8_BAR; PG8_SCHED;
            } else {
            PG8_LDB(B0, 0, 0); PG8_SCHED; PG8_LDA(At, 0, 0); PG8_STAGE(PG8_SA(1, 1), a1 + hstep, voffA);
            PG8_WAIT_L(8); PG8_BAR; PG8_WAIT_L(0); PG8_MMA(0, 0, At, B0); PG8_BAR; PG8_SCHED;
            PG8_LDB(B1, 0, 1); PG8_STAGE(PG8_SB(0, 0), b2, voffB);
            PG8_BAR; PG8_WAIT_L(0); PG8_MMA(0, 1, At, B1); PG8_BAR;
            PG8_LDA(At, 0, 1); PG8_STAGE(PG8_SA(0, 0), a2, voffA);
            PG8_BAR; PG8_WAIT_L(0); PG8_MMA(1, 0, At, B0); PG8_BAR; PG8_SCHED;
            PG8_STAGE(PG8_SB(0, 1), b2 + hstep, voffB);
            PG8_WAIT_V(6); PG8_BAR; PG8_MMA(1, 1, At, B1); PG8_BAR;
            PG8_LDB(B0, 1, 0); PG8_SCHED; PG8_LDA(At, 1, 0); PG8_STAGE(PG8_SA(0, 1), a2 + hstep, voffA);
            PG8_WAIT_L(8); PG8_BAR; PG8_WAIT_L(0); PG8_MMA(0, 0, At, B0); PG8_BAR; PG8_SCHED;
            PG8_LDB(B1, 1, 1); PG8_STAGE(PG8_SB(1, 0), b3, voffB);
            PG8_BAR; PG8_WAIT_L(0); PG8_MMA(0, 1, At, B1); PG8_BAR;
            PG8_LDA(At, 1, 1); PG8_STAGE(PG8_SA(1, 0), a3, voffA);
            PG8_BAR; PG8_WAIT_L(0); PG8_MMA(1, 0, At, B0); PG8_BAR; PG8_SCHED;
            PG8_STAGE(PG8_SB(1, 1), b3 + hstep, voffB);
            PG8_WAIT_V(6); PG8_BAR; PG8_MMA(1, 1, At, B1); PG8_BAR;
            }
        }
        if constexpr (ALIGN_EPI) { if (wr == 0) PG8_BAR; }
        if constexpr (!Epi::AFTER_DRAIN) { E(acc, cur, wr, wc, fr, fq); S.done(cur); }
        if (!has_next) break;
#pragma unroll
        for (int a = 0; a < 2; ++a)
#pragma unroll
            for (int b = 0; b < 2; ++b)
#pragma unroll
                for (int m = 0; m < 4; ++m)
#pragma unroll
                    for (int n = 0; n < 2; ++n) acc[a][b][m][n] = (f32x4){0.f, 0.f, 0.f, 0.f};
        cur = nxt; cA = nA; cB = nB; ++ui;
        if constexpr (ALIGN_EPI) { if (wr == 1) PG8_BAR; }
    }
    PG8_WAIT_V(0);
    if constexpr (!ALIGN_EPI) { if (wr == 0) PG8_BAR; }
    PG8_BAR;
    if constexpr (Epi::AFTER_DRAIN) { E.fused(acc, cur, wr, wc, fr, fq, lds, wid, lane); S.done(cur); }
#undef PG8_SA
#undef PG8_SB
#undef PG8_STAGE
#undef PG8_LDA
#undef PG8_LDB
#undef PG8_MMA
#undef PG8_WAIT_V
#undef PG8_WAIT_L
#undef PG8_BAR
#undef PG8_SCHED
}
}
#ifndef PG8_SP2
#define PG8_SP2 true
#endif
#ifndef PG8_ALIGN
#define PG8_ALIGN true
#endif
#ifndef MK_N_LAUNCHES
#define MK_N_LAUNCHES 1
#endif

constexpr int NB = 8, SEQ = 4096, D = 1024, T = NB * SEQ, NPROJ = 4096, DMIX = 2048;
constexpr int NPH = 10;
constexpr float EPS = 1e-6f;
constexpr size_t MiB = 1u << 20;
constexpr size_t WS_WIN = 0, WS_WOUT = 16 * MiB, WS_GW = 24 * MiB, WS_PW = 25 * MiB, WS_MOD = 26 * MiB;
constexpr size_t WS_H = 32 * MiB, WS_YCAT = 96 * MiB, WS_PROJ = 224 * MiB, WS_Y = WS_PROJ, WS_U = WS_H, WS_END = 480 * MiB;
constexpr size_t WS_CTL = 28 * MiB, CTL_BYTES = 16384;
constexpr int LDS_BYTES = 147456, LDS_BST_OFF = 131072 + 64;

#define LAS __attribute__((address_space(3)))
typedef unsigned short bf16;
typedef float f32x4 __attribute__((ext_vector_type(4)));
typedef float f32x2 __attribute__((ext_vector_type(2)));
typedef unsigned u32x4 __attribute__((ext_vector_type(4)));
typedef unsigned u32x2 __attribute__((ext_vector_type(2)));
typedef short bf16x8 __attribute__((ext_vector_type(8)));

struct Args { const float* in[18]; float* out; unsigned char* ws; int ph_lo, ph_hi; };

__device__ __forceinline__ unsigned pk2(float lo, float hi) { return pg8::cvt_pk_bf16(lo, hi); }
__device__ __forceinline__ float bflo(unsigned w) { return u2f(w << 16); }
__device__ __forceinline__ float bfhi(unsigned w) { return u2f(w & 0xffff0000u); }
template <int CTRL> __device__ __forceinline__ float dpp_mov_(float v) { return i2f(__builtin_amdgcn_update_dpp(0, f2i(v), CTRL, 0xf, 0xf, true)); }
__device__ __forceinline__ float wave_sum(float v) {
    v += dpp_mov_<0xB1>(v);
    v += dpp_mov_<0x4E>(v);
    v += dpp_mov_<0x141>(v);
    v += dpp_mov_<0x140>(v);
    const float r0 = i2f(__builtin_amdgcn_readlane(f2i(v), 0)), r1 = i2f(__builtin_amdgcn_readlane(f2i(v), 16));
    const float r2 = i2f(__builtin_amdgcn_readlane(f2i(v), 32)), r3 = i2f(__builtin_amdgcn_readlane(f2i(v), 48));
    return (r0 + r1) + (r2 + r3);
}
__device__ __forceinline__ float sigmoidf_(float x) { return 1.0f / (1.0f + __expf(-x)); }
__device__ __forceinline__ float siluf_(float x) { return x / (1.0f + __expf(-x)); }

__device__ __forceinline__ void transpose_tile(const float* W, int K, int N, bf16* WT, LAS float* scr, int k0, int n0, int drow, int lane, float wscale = 1.0f) {
    {
        f32x4 v[8];
#pragma unroll
        for (int i = 0; i < 8; ++i) v[i] = *(const f32x4*)(W + (size_t)(k0 + (lane >> 3) + 8 * i) * N + n0 + (lane & 7) * 4);
#pragma unroll
        for (int i = 0; i < 8; ++i) { LAS float* d = scr + ((lane >> 3) + 8 * i) * 33 + (lane & 7) * 4; d[0] = v[i].x * wscale; d[1] = v[i].y * wscale; d[2] = v[i].z * wscale; d[3] = v[i].w * wscale; }
    }
    asm volatile("s_waitcnt lgkmcnt(0)" ::: "memory");
    const int c = lane & 7;
#pragma unroll
    for (int j = 0; j < 4; ++j) { const int n = (lane >> 3) + 8 * j; const LAS float* s = scr + (8 * c) * 33 + n;
        u32x4 o; o.x = pk2(s[0 * 33], s[1 * 33]); o.y = pk2(s[2 * 33], s[3 * 33]); o.z = pk2(s[4 * 33], s[5 * 33]); o.w = pk2(s[6 * 33], s[7 * 33]);
        *(u32x4*)(WT + (size_t)(drow + n) * K + k0 + 8 * c) = o; }
    asm volatile("s_waitcnt lgkmcnt(0)" ::: "memory");
}
__device__ __forceinline__ void transpose_item(const float* W, int K, int N, bf16* WT, LAS float* scr, int item, int lane) {
    const int nblk = N / 32, kb = item / nblk, nb = item % nblk;
    transpose_tile(W, K, N, WT, scr, 64 * kb, 32 * nb, 32 * nb, lane);
}

__device__ __forceinline__ void phase_prep(const Args& a, LAS unsigned char* lds) {
    const int tid = opaque_tid(), lane = tid & 63, wv = tid >> 6;
    const int G = gridDim.x;
    unsigned char* ws = a.ws;
    {
        LAS float* sc = (LAS float*)lds;
        LAS float* red = (LAS float*)(lds + 32768);
        const float* c = a.in[1]; const float* ada_w = a.in[2]; const float* ada_b = a.in[3];
        float* MOD = (float*)(ws + WS_MOD);
        if ((int)blockIdx.x < 192) {
            for (int i = tid; i < 8192; i += 512) sc[i] = siluf_(c[i]);
            sync_threads_();
            for (int unit = blockIdx.x; unit < 192; unit += G) {
                const int l = unit / 96, cb = (unit % 96) * 32, cl = tid & 31, ks = tid >> 5;
                const float* wp = ada_w + (size_t)l * 1024 * 3072 + (size_t)(ks * 64) * 3072 + cb + cl;
                float acc[8];
#pragma unroll
                for (int b = 0; b < 8; ++b) acc[b] = 0.f;
#pragma unroll 16
                for (int k = 0; k < 64; ++k) { const float w = wp[(size_t)k * 3072];
#pragma unroll
                    for (int b = 0; b < 8; ++b) acc[b] += sc[b * 1024 + ks * 64 + k] * w; }
#pragma unroll
                for (int b = 0; b < 8; ++b) red[(ks * 8 + b) * 32 + cl] = acc[b];
                sync_threads_();
                if (tid < 256) { const int b = tid >> 5; float s = 0.f;
#pragma unroll
                    for (int k2 = 0; k2 < 16; ++k2) s += red[(k2 * 8 + b) * 32 + cl];
                    MOD[(l * 8 + b) * 3072 + cb + cl] = s + ada_b[l * 3072 + cb + cl]; }
                sync_threads_();
            }
        }
        sync_threads_();
    }
    {
        LAS float* scr = (LAS float*)(lds + wv * 16384);
        const int gw = blockIdx.x * 8 + wv, NGW = G * 8;
        constexpr int I_IN = (1024 / 64) * (4096 / 32), I_OUT = (2048 / 64) * (1024 / 32);
        for (int it = gw; it < 2 * (I_IN + I_OUT); it += NGW) {
            int r = it;
            if (r < 2 * I_IN) { const int l = r / I_IN; r -= l * I_IN;
                transpose_item(a.in[5] + (size_t)l * 1024 * 4096, 1024, 4096, (bf16*)(ws + WS_WIN) + (size_t)l * 4096 * 1024, scr, r, lane); }
            else { r -= 2 * I_IN; const int l = r / I_OUT; r -= l * I_OUT;
                transpose_item(a.in[16] + (size_t)l * 2048 * 1024, 2048, 1024, (bf16*)(ws + WS_WOUT) + (size_t)l * 1024 * 2048, scr, r, lane); }
        }
    }
    {
        LAS float* scr = (LAS float*)(lds + wv * 16384);
        const int gw = blockIdx.x * 8 + wv, NGW = G * 8;
        bf16* GWp = (bf16*)(ws + WS_GW); bf16* PWp = (bf16*)(ws + WS_PW);
        for (int it = NGW - 1 - gw; it < 512; it += NGW) {
            if (it < 256) { const int lh = it >> 4, r = it & 15, gate = r >> 3, kb = (r >> 2) & 1, q = r & 3;
                transpose_tile((gate ? a.in[10] : a.in[8]) + (size_t)lh * 128 * 128, 128, 128, GWp + (size_t)lh * 4 * 64 * 128, scr, 64 * kb, 32 * q, q * 64 + gate * 32, lane, -1.4426950408889634f); }
            else { const int r = it - 256, lg = r >> 5, kb = (r >> 3) & 3, nb = r & 7;
                transpose_tile(a.in[13] + (size_t)lg * 256 * 256, 256, 256, PWp + (size_t)lg * 256 * 256, scr, 64 * kb, 32 * nb, 32 * nb, lane); }
        }
    }
}

constexpr int RPW = 4;
__device__ __forceinline__ void phase_h0(const Args& a) {
    const int tid = opaque_tid(), lane = tid & 63, wv = tid >> 6;
    const int gw = blockIdx.x * 8 + wv, NGW = gridDim.x * 8;
    const float* x = a.in[0]; const float* g = a.in[4]; const float* MOD = (const float*)(a.ws + WS_MOD);
    bf16* H = (bf16*)(a.ws + WS_H);
    const int WPB = NGW / NB, b = gw / WPB, wq = gw % WPB;
    const float* sh = MOD + (size_t)b * 3072; const float* scl = sh + 1024;
    f32x4 A1[4], SH[4];
#pragma unroll
    for (int j = 0; j < 4; ++j) { const int col = 4 * lane + 256 * j; A1[j] = *(const f32x4*)(g + col) * (*(const f32x4*)(scl + col) + 1.0f); SH[j] = *(const f32x4*)(sh + col); }
    for (int mr = wq * RPW; mr < SEQ; mr += WPB * RPW) {
        const int m0 = b * SEQ + mr;
        f32x4 v[RPW][4];
#pragma unroll
        for (int r = 0; r < RPW; ++r) { const f32x4* xr = (const f32x4*)(x + (size_t)(m0 + r) * D) + lane;
#pragma unroll
            for (int j = 0; j < 4; ++j) v[r][j] = __builtin_nontemporal_load(xr + 64 * j); }
#pragma unroll
        for (int r = 0; r < RPW; ++r) {
            float ss = 0.f;
#pragma unroll
            for (int j = 0; j < 4; ++j) ss += (v[r][j].x * v[r][j].x + v[r][j].y * v[r][j].y) + (v[r][j].z * v[r][j].z + v[r][j].w * v[r][j].w);
            const float rstd = 1.0f / __builtin_sqrtf(wave_sum(ss) * (1.0f / D) + EPS);
            u32x2* o = (u32x2*)(H + (size_t)(m0 + r) * D) + lane;
#pragma unroll
            for (int j = 0; j < 4; ++j) {
                const f32x4 rr = (v[r][j] * rstd) * A1[j] + SH[j];
                u32x2 w; w.x = pk2(rr.x, rr.y); w.y = pk2(rr.z, rr.w); o[64 * j] = w; }
        }
    }
}

__device__ __forceinline__ void phase_post(const Args& a, int l) {
    const int tid = opaque_tid(), lane = tid & 63, wv = tid >> 6;
    const int gw = blockIdx.x * 8 + wv, NGW = gridDim.x * 8;
    const float* xin = (l == 0) ? a.in[0] : a.out; float* out = a.out;
    const bf16* Y = (const bf16*)(a.ws + WS_Y); bf16* H = (bf16*)(a.ws + WS_H);
    const float* MOD = (const float*)(a.ws + WS_MOD);
    const float* gpost = a.in[17] + l * D; const float* gpre = a.in[4] + (l + 1) * D;
    const int WPB = NGW / NB, b = gw / WPB, wq = gw % WPB;
    const float* gate = MOD + (size_t)(l * 8 + b) * 3072 + 2048;
    const float* sh = MOD + (size_t)(8 + b) * 3072; const float* scl = sh + 1024;
    f32x4 GP[4], A1[4], SH[4];
#pragma unroll
    for (int j = 0; j < 4; ++j) { const int col = 4 * lane + 256 * j; GP[j] = *(const f32x4*)(gate + col) * *(const f32x4*)(gpost + col);
        if (l == 0) { A1[j] = *(const f32x4*)(gpre + col) * (*(const f32x4*)(scl + col) + 1.0f); SH[j] = *(const f32x4*)(sh + col); } }
    for (int mr = wq * RPW; mr < SEQ; mr += WPB * RPW) {
        const int m0 = b * SEQ + mr;
        f32x4 xv[RPW][4]; u32x2 yw[RPW][4];
#pragma unroll
        for (int r = 0; r < RPW; ++r) { const f32x4* xr = (const f32x4*)(xin + (size_t)(m0 + r) * D) + lane; const u32x2* yr = (const u32x2*)(Y + (size_t)(m0 + r) * D) + lane;
#pragma unroll
            for (int j = 0; j < 4; ++j) { xv[r][j] = xr[64 * j]; yw[r][j] = yr[64 * j]; } }
#pragma unroll
        for (int r = 0; r < RPW; ++r) {
            f32x4 yv[4]; float ss = 0.f;
#pragma unroll
            for (int j = 0; j < 4; ++j) { const u32x2 w = yw[r][j]; yv[j] = (f32x4){bflo(w.x), bfhi(w.x), bflo(w.y), bfhi(w.y)};
                ss += (yv[j].x * yv[j].x + yv[j].y * yv[j].y) + (yv[j].z * yv[j].z + yv[j].w * yv[j].w); }
            const float rstd = 1.0f / __builtin_sqrtf(wave_sum(ss) * (1.0f / D) + EPS);
            float ss2 = 0.f;
#pragma unroll
            for (int j = 0; j < 4; ++j) { const int col = 4 * lane + 256 * j;
                const f32x4 xn = xv[r][j] + (yv[j] * rstd) * GP[j];
                xv[r][j] = xn;
                if (l == 0) *((f32x4*)(out + (size_t)(m0 + r) * D + col)) = xn;
                else __builtin_nontemporal_store(xn, (f32x4*)(out + (size_t)(m0 + r) * D + col));
                ss2 += (xn.x * xn.x + xn.y * xn.y) + (xn.z * xn.z + xn.w * xn.w); }
            if (l == 0) {
                const float rstd2 = 1.0f / __builtin_sqrtf(wave_sum(ss2) * (1.0f / D) + EPS);
                u32x2* o = (u32x2*)(H + (size_t)(m0 + r) * D) + lane;
#pragma unroll
                for (int j = 0; j < 4; ++j) {
                    const f32x4 rr = (xv[r][j] * rstd2) * A1[j] + SH[j];
                    u32x2 w; w.x = pk2(rr.x, rr.y); w.y = pk2(rr.z, rr.w); o[64 * j] = w; }
            }
        }
    }
}
#define XB_TMO      128
#define XB_XCNT(j)  (256  + 64 * (j))
#define XB_XSUB(j)  (1280 + 64 * (j))
#define XB_XGEN(j)  (2304 + 64 * (j))
#define XB_TOP      3328
#define XB_TOPGEN   3392
#define XCD_BAR_WORDS 3456
#define XB_SPIN_CAP (1u << 18)

__device__ __forceinline__ unsigned xb_ld(unsigned* p)              { return __hip_atomic_load(p, __ATOMIC_RELAXED, __HIP_MEMORY_SCOPE_AGENT); }
__device__ __forceinline__ unsigned xb_add(unsigned* p, unsigned v) { return __hip_atomic_fetch_add(p, v, __ATOMIC_RELAXED, __HIP_MEMORY_SCOPE_AGENT); }
__device__ __forceinline__ unsigned xb_xcc_id() { return (unsigned)__builtin_amdgcn_s_getreg((3 << 11) | 20) & 0xFu; }
#define XB_SPIN(cond, bar) do { unsigned _sp = 0; while (cond) { __builtin_amdgcn_s_sleep(1); \
    if ((++_sp & 255u) == 0u) { if (xb_ld(&(bar)[XB_TMO])) break; if (_sp > XB_SPIN_CAP) { xb_add(&(bar)[XB_TMO], 1u); break; } } } } while (0)

struct XcdBarrier {
    unsigned* bar; unsigned x;
    volatile LAS unsigned* st;
};

__device__ __forceinline__ XcdBarrier xcd_barrier_post(unsigned* bar, volatile LAS unsigned* st) {
    XcdBarrier b; b.bar = bar; b.x = xb_xcc_id(); b.st = st;
    if (threadIdx.x == 0) (void)xb_add(&bar[XB_XCNT(b.x)], 1u);
    return b;
}
__device__ __forceinline__ void xcd_barrier_complete(unsigned* bar, unsigned x, unsigned& nloc, unsigned& nx) {
    const unsigned G = gridDim.x * gridDim.y * gridDim.z;
    unsigned sum, cnt, mine, sp = 0u;
    for (;;) {
        sum = 0u; cnt = 0u; mine = 0u;
#pragma unroll
        for (unsigned j = 0; j < 16; ++j) { const unsigned c = xb_ld(&bar[XB_XCNT(j)]); sum += c; cnt += (c > 0u) ? 1u : 0u; mine = (j == x) ? c : mine; }
        if (sum == G) break;
        __builtin_amdgcn_s_sleep(1);
        if ((++sp & 255u) == 0u) { if (xb_ld(&bar[XB_TMO])) break; if (sp > XB_SPIN_CAP) { xb_add(&bar[XB_TMO], 1u); break; } }
    }
    nloc = mine > 0u ? mine : 1u; nx = cnt > 0u ? cnt : 1u;
}

__device__ __forceinline__ void xcd_barrier(const XcdBarrier& b) {
    asm volatile("s_waitcnt vmcnt(0)" ::: "memory");
    sync_threads_();
    if (threadIdx.x == 0) {
        unsigned* bar = b.bar;
        __builtin_amdgcn_s_waitcnt(0);
        unsigned nloc = b.st[0], nx = b.st[1];
        if (nloc == 0u) { xcd_barrier_complete(bar, b.x, nloc, nx); b.st[0] = nloc; b.st[1] = nx; }
        const unsigned old = xb_add(&bar[XB_XSUB(b.x)], 1u);
        const unsigned gen = old / nloc;
        if (old + 1u == (gen + 1u) * nloc) {
            __builtin_amdgcn_fence(__ATOMIC_RELEASE, "agent");
            asm volatile("s_waitcnt vmcnt(0)" ::: "memory");
            const unsigned og = xb_add(&bar[XB_TOP], 1u);
            const unsigned tg = og / nx;
            if (og + 1u == (tg + 1u) * nx) xb_add(&bar[XB_TOPGEN], 1u);
            else XB_SPIN(xb_ld(&bar[XB_TOPGEN]) == tg, bar);
            __builtin_amdgcn_fence(__ATOMIC_ACQUIRE, "agent");
            xb_add(&bar[XB_XGEN(b.x)], 1u);
            asm volatile("s_waitcnt vmcnt(0)" ::: "memory");
        } else {
            XB_SPIN(xb_ld(&bar[XB_XGEN(b.x)]) == gen, bar);
            __builtin_amdgcn_fence(__ATOMIC_ACQUIRE, "agent");
            asm volatile("s_waitcnt vmcnt(0)" ::: "memory");
        }
    }
    sync_threads_();
}

#define LDS_BARRIER() do { asm volatile("s_waitcnt lgkmcnt(0)" ::: "memory"); __builtin_amdgcn_s_barrier(); asm volatile("" ::: "memory"); } while (0)
constexpr int XROW = 272;
constexpr int CROW = 132;
constexpr int R_XT = 0, R_UT = 35840, R_AT = 70656, R_VT = 87552, R_EP = 104448, R_CWT = 105472, R_GT = 108032, R_YT = 116736;
template <int D> __device__ __forceinline__ float dpp_row_shr(float old, float src) {
    return i2f(__builtin_amdgcn_update_dpp(f2i(old), f2i(src), 0x110 | D, 0xf, 0xf, false)); }
__device__ __forceinline__ float softplus_small_(float e) { return (e < 0.03f) ? e * (1.0f + e * (-0.5f + e * (0.33333334f + e * (-0.25f + e * 0.2f)))) : __builtin_logf(1.0f + e); }
__device__ __forceinline__ float fast_sigmoid(float x) { return __builtin_amdgcn_rcpf(1.0f + __builtin_amdgcn_exp2f(-1.4426950408889634f * x)); }
__device__ __forceinline__ void rnn_unit(const Args& a, int l, int u, LAS unsigned char* lds) {
    const int tid = opaque_tid(), lane = tid & 63, wv = tid >> 6, fr = lane & 15, fq = lane >> 4;
    const int xcd = u & 7, jj = u >> 3, q = jj & 3, bh = (jj >> 2) * 8 + xcd, b = bh >> 3, h = bh & 7;
    const bf16* PROJ = (const bf16*)(a.ws + WS_PROJ); bf16* YCAT = (bf16*)(a.ws + WS_YCAT);
    const bf16* xr_base = PROJ + (size_t)(b * SEQ) * NPROJ + h * 128;
    const bf16* gr_base = PROJ + (size_t)(b * SEQ) * NPROJ + 1024 + h * 128 + q * 32;
    bf16* y_base = YCAT + (size_t)(b * SEQ) * DMIX + h * 128 + q * 32;
    LAS unsigned char* XT = lds + R_XT; LAS unsigned char* UT = lds + R_UT;
    LAS float* AT = (LAS float*)(lds + R_AT); LAS float* VT = (LAS float*)(lds + R_VT);
    LAS unsigned char* GT = lds + R_GT; LAS unsigned char* YT = lds + R_YT;
    const int io_tk = tid >> 2, io_cq = tid & 3;
    const int ck = tid & 15, tg = tid >> 4;
    LAS float* CWT = (LAS float*)(lds + R_CWT);
    for (int i = tid; i < 640; i += 512) { const int r = i >> 7, c = i & 127;
        CWT[i] = (r < 4) ? a.in[6][(size_t)l * 4 * 1024 + r * 1024 + h * 128 + c] : a.in[7][(size_t)l * 1024 + h * 128 + c]; }
    bf16x8 Wf[4][4];
    {
        const bf16* gwp = (const bf16*)(a.ws + WS_GW) + (size_t)((l * 8 + h) * 4 + q) * 64 * 128;
#pragma unroll
        for (int nb = 0; nb < 4; ++nb)
#pragma unroll
            for (int kb = 0; kb < 4; ++kb) Wf[nb][kb] = *(const bf16x8*)(gwp + (nb * 16 + fr) * 128 + kb * 32 + fq * 8);
    }
    LAS float* EP = (LAS float*)(lds + R_EP);
    if (tid < 96) {
        const int r = tid >> 5, c = tid & 31, ch = h * 128 + q * 32 + c; float v;
        if (r == 0) v = -1.4426950408889634f * a.in[9][l * 1024 + ch];
        else if (r == 1) v = -1.4426950408889634f * a.in[11][l * 1024 + ch];
        else v = 8.0f * 1.4426950408889634f * softplus_small_(__builtin_expf(-a.in[12][l * 1024 + ch]));
        EP[r * 32 + c] = v;
    }
    u32x4 pf[4], pfh = (u32x4){0u, 0u, 0u, 0u};
#pragma unroll
    for (int i = 0; i < 4; ++i) { const int id = tid + 512 * i, row = id >> 4, cc = id & 15; pf[i] = *(const u32x4*)(xr_base + (size_t)row * NPROJ + cc * 8); }
    u32x4 gpf = *(const u32x4*)(gr_base + (size_t)io_tk * NPROJ + io_cq * 8);
    const int sc_ci = lane >> 4, sc_sg = lane & 15, sc_c = wv * 4 + sc_ci;
    float hcar = 0.f;
#pragma unroll
    for (int i = 0; i < 4; ++i) { const int id = tid + 512 * i, row = id >> 4, cc = id & 15; *(LAS u32x4*)(XT + (3 + row) * XROW + cc * 16) = pf[i]; }
    if (tid < 48) *(LAS u32x4*)(XT + (tid >> 4) * XROW + (tid & 15) * 16) = pfh;
    for (int tile = 0; tile < SEQ / 128; ++tile) {
        const int t0 = tile * 128;
        LDS_BARRIER();
        {
            const int t0n = (tile + 1 < SEQ / 128) ? t0 + 128 : t0;
#pragma unroll
            for (int i = 0; i < 4; ++i) { const int id = tid + 512 * i, row = id >> 4, cc = id & 15; pf[i] = *(const u32x4*)(xr_base + (size_t)(t0n + row) * NPROJ + cc * 8); }
            if (tid < 48) pfh = *(const u32x4*)(xr_base + (size_t)(t0n - 3 + (tid >> 4)) * NPROJ + (tid & 15) * 8);
        }
        {
            {
                unsigned short yv_[8];
#pragma unroll
                for (int e = 0; e < 8; ++e) yv_[e] = *(const LAS unsigned short*)(YT + (io_cq * 8 + e) * XROW + io_tk * 2);
                u32x4 w; w.x = yv_[0] | ((unsigned)yv_[1] << 16); w.y = yv_[2] | ((unsigned)yv_[3] << 16); w.z = yv_[4] | ((unsigned)yv_[5] << 16); w.w = yv_[6] | ((unsigned)yv_[7] << 16);
                *(u32x4*)(y_base + (size_t)((tile > 0 ? t0 - 128 : 0) + io_tk) * DMIX + io_cq * 8) = w;
            }
            const unsigned gwv[4] = {gpf.x, gpf.y, gpf.z, gpf.w};
#pragma unroll
            for (int e2 = 0; e2 < 4; ++e2) { *(LAS unsigned short*)(GT + (io_cq * 8 + 2 * e2) * XROW + io_tk * 2) = (unsigned short)(gwv[e2] & 0xffffu);
                *(LAS unsigned short*)(GT + (io_cq * 8 + 2 * e2 + 1) * XROW + io_tk * 2) = (unsigned short)(gwv[e2] >> 16); }
            const int t1 = (tile + 1 < SEQ / 128) ? t0 + 128 : t0;
            gpf = *(const u32x4*)(gr_base + (size_t)(t1 + io_tk) * NPROJ + io_cq * 8);
        }
        {
            f32x2 o[4][4], cw[4][4];
            {
                const f32x4 b0 = *(const LAS f32x4*)(CWT + 4 * 128 + ck * 8), b1 = *(const LAS f32x4*)(CWT + 4 * 128 + ck * 8 + 4);
#pragma unroll
                for (int i = 0; i < 4; ++i) { o[i][0] = (f32x2){b0.x, b0.y}; o[i][1] = (f32x2){b0.z, b0.w}; o[i][2] = (f32x2){b1.x, b1.y}; o[i][3] = (f32x2){b1.z, b1.w}; }
            }
#pragma unroll
            for (int k = 0; k < 4; ++k) { const f32x4 w0 = *(const LAS f32x4*)(CWT + k * 128 + ck * 8), w1 = *(const LAS f32x4*)(CWT + k * 128 + ck * 8 + 4);
                cw[k][0] = (f32x2){w0.x, w0.y}; cw[k][1] = (f32x2){w0.z, w0.w}; cw[k][2] = (f32x2){w1.x, w1.y}; cw[k][3] = (f32x2){w1.z, w1.w}; }
#pragma unroll
            for (int r = 0; r < 7; ++r) {
                const u32x4 w = *(const LAS u32x4*)(XT + (tg * 4 + r) * XROW + ck * 16);
                const f32x2 xv[4] = {(f32x2){bflo(w.x), bfhi(w.x)}, (f32x2){bflo(w.y), bfhi(w.y)}, (f32x2){bflo(w.z), bfhi(w.z)}, (f32x2){bflo(w.w), bfhi(w.w)}};
#pragma unroll
                for (int i = 0; i < 4; ++i) { const int k = r - i; if (k >= 0 && k < 4) {
#pragma unroll
                    for (int e = 0; e < 4; ++e) o[i][e] = __builtin_elementwise_fma(cw[k][e], xv[e], o[i][e]); } }
            }
#pragma unroll
            for (int i = 0; i < 4; ++i) { u32x4 w; w.x = pk2(o[i][0].x, o[i][0].y); w.y = pk2(o[i][1].x, o[i][1].y); w.z = pk2(o[i][2].x, o[i][2].y); w.w = pk2(o[i][3].x, o[i][3].y);
                *(LAS u32x4*)(UT + (tg * 4 + i) * XROW + ck * 16) = w; }
        }
        asm volatile("s_waitcnt lgkmcnt(0)" ::: "memory");
        {
            f32x4 acc[4];
#pragma unroll
            for (int nb = 0; nb < 4; ++nb) acc[nb] = (f32x4){0.f, 0.f, 0.f, 0.f};
#pragma unroll
            for (int kb = 0; kb < 4; ++kb) { const bf16x8 uf = *(const LAS bf16x8*)(UT + (wv * 16 + fr) * XROW + kb * 64 + fq * 16);
#pragma unroll
                for (int nb = 0; nb < 4; ++nb) acc[nb] = __builtin_amdgcn_mfma_f32_16x16x32_bf16(Wf[nb][kb], uf, acc[nb], 0, 0, 0); }
            const int tk = wv * 16 + fr;
#pragma unroll
            for (int nb2 = 0; nb2 < 2; ++nb2) {
                const int c0 = nb2 * 16 + 4 * fq;
                const u32x2 uw = *(const LAS u32x2*)(UT + tk * XROW + (q * 32 + c0) * 2);
                const f32x4 uu = (f32x4){bflo(uw.x), bfhi(uw.x), bflo(uw.y), bfhi(uw.y)};
                const f32x4 ra = acc[nb2] + *(const LAS f32x4*)(EP + c0), rx = acc[nb2 + 2] + *(const LAS f32x4*)(EP + 32 + c0), sp8 = *(const LAS f32x4*)(EP + 64 + c0);
#pragma unroll
                for (int e = 0; e < 4; ++e) { const float r = __builtin_amdgcn_rcpf(1.0f + __builtin_amdgcn_exp2f(ra[e])), ig = __builtin_amdgcn_rcpf(1.0f + __builtin_amdgcn_exp2f(rx[e]));
                    const float av = __builtin_amdgcn_exp2f(-r * sp8[e]);
                    const float m2 = __builtin_fmaxf(__builtin_fmaf(-av, av, 1.0f), 0.f);
                    AT[(c0 + e) * CROW + tk] = av; VT[(c0 + e) * CROW + tk] = __builtin_amdgcn_sqrtf(m2) * (ig * uu[e]); }
            }
        }
        LDS_BARRIER();
        {
            const f32x4 a0 = *(const LAS f32x4*)(AT + sc_c * CROW + sc_sg * 8), a1 = *(const LAS f32x4*)(AT + sc_c * CROW + sc_sg * 8 + 4);
            const f32x4 v0 = *(const LAS f32x4*)(VT + sc_c * CROW + sc_sg * 8), v1 = *(const LAS f32x4*)(VT + sc_c * CROW + sc_sg * 8 + 4);
            const float av[8] = {a0.x, a0.y, a0.z, a0.w, a1.x, a1.y, a1.z, a1.w}, vv[8] = {v0.x, v0.y, v0.z, v0.w, v1.x, v1.y, v1.z, v1.w};
            float hl[8], pp[8]; float hcur = 0.f, pcur = 1.f;
#pragma unroll
            for (int j = 0; j < 8; ++j) { hcur = __builtin_fmaf(av[j], hcur, vv[j]); pcur *= av[j]; hl[j] = hcur; pp[j] = pcur; }
            float P = pcur, H = hcur;
            { float Pp = dpp_row_shr<1>(1.f, P), Hp = dpp_row_shr<1>(0.f, H); H = __builtin_fmaf(P, Hp, H); P *= Pp;
              Pp = dpp_row_shr<2>(1.f, P); Hp = dpp_row_shr<2>(0.f, H); H = __builtin_fmaf(P, Hp, H); P *= Pp;
              Pp = dpp_row_shr<4>(1.f, P); Hp = dpp_row_shr<4>(0.f, H); H = __builtin_fmaf(P, Hp, H); P *= Pp;
              Pp = dpp_row_shr<8>(1.f, P); Hp = dpp_row_shr<8>(0.f, H); H = __builtin_fmaf(P, Hp, H); P *= Pp; }
            const float Pe = dpp_row_shr<1>(1.f, P), He = dpp_row_shr<1>(0.f, H);
            const float carry = __builtin_fmaf(Pe, hcar, He);
            const float hend = __builtin_fmaf(P, hcar, H);
            hcar = row_last_(hend);
            const u32x4 gq = *(const LAS u32x4*)(GT + sc_c * XROW + sc_sg * 16);
            const float gvv[8] = {bflo(gq.x), bfhi(gq.x), bflo(gq.y), bfhi(gq.y), bflo(gq.z), bfhi(gq.z), bflo(gq.w), bfhi(gq.w)};
            float yy[8];
#pragma unroll
            for (int j = 0; j < 8; ++j) { const float hv = __builtin_fmaf(pp[j], carry, hl[j]); yy[j] = hv * gvv[j] * fast_sigmoid(gvv[j]); }
            u32x4 yw_; yw_.x = pk2(yy[0], yy[1]); yw_.y = pk2(yy[2], yy[3]); yw_.z = pk2(yy[4], yy[5]); yw_.w = pk2(yy[6], yy[7]);
            *(LAS u32x4*)(YT + sc_c * XROW + sc_sg * 16) = yw_;
        }
#pragma unroll
        for (int i = 0; i < 4; ++i) { const int id = tid + 512 * i, row = id >> 4, cc = id & 15; *(LAS u32x4*)(XT + (3 + row) * XROW + cc * 16) = pf[i]; }
        if (tid < 48) *(LAS u32x4*)(XT + (tid >> 4) * XROW + (tid & 15) * 16) = pfh;
    }
    LDS_BARRIER();
    {
        unsigned short yv_[8];
#pragma unroll
        for (int e = 0; e < 8; ++e) yv_[e] = *(const LAS unsigned short*)(YT + (io_cq * 8 + e) * XROW + io_tk * 2);
        u32x4 w; w.x = yv_[0] | ((unsigned)yv_[1] << 16); w.y = yv_[2] | ((unsigned)yv_[3] << 16); w.z = yv_[4] | ((unsigned)yv_[5] << 16); w.w = yv_[6] | ((unsigned)yv_[7] << 16);
        *(u32x4*)(y_base + (size_t)(SEQ - 128 + io_tk) * DMIX + io_cq * 8) = w;
    }
    LDS_BARRIER();
}

constexpr int PROW = 528;
constexpr int R_XP = 0, R_PT = 42240;
__device__ __forceinline__ void pool_units(const Args& a, int l, int u, LAS unsigned char* lds) {
    const int tid = opaque_tid(), lane = tid & 63, wv = tid >> 6, fr = lane & 15, fq = lane >> 4;
    const int g = u & 3, bi = u >> 2, win = 2 << g;
    const bf16* PROJ = (const bf16*)(a.ws + WS_PROJ); bf16* YCAT = (bf16*)(a.ws + WS_YCAT);
    LAS unsigned char* XP = lds + R_XP; LAS unsigned char* PT = lds + R_PT;
    const bf16* pw = (const bf16*)(a.ws + WS_PW) + (size_t)(l * 4 + g) * 256 * 256;
    bf16x8 Wf[2][8];
#pragma unroll
    for (int nb = 0; nb < 2; ++nb)
#pragma unroll
        for (int kb = 0; kb < 8; ++kb) Wf[nb][kb] = *(const bf16x8*)(pw + (size_t)(wv * 32 + 8 * (fr >> 2) + 4 * nb + (fr & 3)) * 256 + kb * 32 + fq * 8);
    f32x4 pb[2], ps[2];
#pragma unroll
    for (int nb = 0; nb < 2; ++nb) { const int n = wv * 32 + 8 * fq + 4 * nb;
        pb[nb] = *(const f32x4*)(a.in[14] + (size_t)l * 1024 + g * 256 + n); ps[nb] = *(const f32x4*)(a.in[15] + (size_t)l * 1024 + g * 256 + n); }
    const int ck = tid & 31, tg = tid >> 5;
    u32x4 pf[5];
    {
        const int tile = bi * 8, b = tile >> 6, t0 = (tile & 63) * 64;
        const bf16* xp_base = PROJ + (size_t)(b * SEQ) * NPROJ + 2048 + g * 256;
#pragma unroll
        for (int i = 0; i < 5; ++i) { const int id = tid + 512 * i, row = id >> 5, cc = id & 31, t = t0 - 16 + row;
            const u32x4 v = *(const u32x4*)(xp_base + (size_t)(t < 0 ? 0 : t) * NPROJ + cc * 8); pf[i] = (t < 0) ? (u32x4){0u, 0u, 0u, 0u} : v; }
    }
#pragma unroll
    for (int i = 0; i < 5; ++i) { const int id = tid + 512 * i, row = id >> 5, cc = id & 31; *(LAS u32x4*)(XP + row * PROW + cc * 16) = pf[i]; }
    u32x4 gp[4];
    {
        const int tile = bi * 8, b = tile >> 6, t0 = (tile & 63) * 64;
        const bf16* gp_base0 = PROJ + (size_t)(b * SEQ) * NPROJ + 3072 + g * 256;
#pragma unroll
        for (int tb = 0; tb < 4; ++tb)
        { gp[tb] = *(const u32x4*)(gp_base0 + (size_t)(t0 + tb * 16 + fr) * NPROJ + wv * 32 + 8 * fq);
                asm volatile("" : "+v"(gp[tb])); }
    }
    for (int it = 0; it < 8; ++it) {
        const int tile = bi * 8 + it, b = tile >> 6, t0 = (tile & 63) * 64;
        bf16* y_base = YCAT + (size_t)(b * SEQ) * DMIX + 1024 + g * 256;
        LDS_BARRIER();
        {
            const int tile2 = bi * 8 + ((it + 1 < 8) ? it + 1 : it), b2 = tile2 >> 6, t02 = (tile2 & 63) * 64;
            const bf16* xp_base = PROJ + (size_t)(b2 * SEQ) * NPROJ + 2048 + g * 256;
#pragma unroll
            for (int i = 0; i < 5; ++i) { const int id = tid + 512 * i, row = id >> 5, cc = id & 31, t = t02 - 16 + row;
                const u32x4 v = *(const u32x4*)(xp_base + (size_t)(t < 0 ? 0 : t) * NPROJ + cc * 8); pf[i] = (t < 0) ? (u32x4){0u, 0u, 0u, 0u} : v; }
        }
        u32x4 gpn[4];
        {
            const int tile2 = bi * 8 + ((it + 1 < 8) ? it + 1 : it), b2 = tile2 >> 6, t02 = (tile2 & 63) * 64;
            const bf16* gp_base2 = PROJ + (size_t)(b2 * SEQ) * NPROJ + 3072 + g * 256;
#pragma unroll
            for (int tb = 0; tb < 4; ++tb)
                gpn[tb] = *(const u32x4*)(gp_base2 + (size_t)(t02 + tb * 16 + fr) * NPROJ + wv * 32 + 8 * fq);
        }
        {
            float s[8];
#pragma unroll
            for (int e = 0; e < 8; ++e) s[e] = 0.f;
            const int r0 = tg * 4 + 16;
            for (int r = r0 - win + 1; r < r0; ++r) { const u32x4 w = *(const LAS u32x4*)(XP + r * PROW + ck * 16);
                s[0] += bflo(w.x); s[1] += bfhi(w.x); s[2] += bflo(w.y); s[3] += bfhi(w.y); s[4] += bflo(w.z); s[5] += bfhi(w.z); s[6] += bflo(w.w); s[7] += bfhi(w.w); }
#pragma unroll
            for (int i = 0; i < 4; ++i) {
                const u32x4 w = *(const LAS u32x4*)(XP + (r0 + i) * PROW + ck * 16);
                const float xv[8] = {bflo(w.x), bfhi(w.x), bflo(w.y), bfhi(w.y), bflo(w.z), bfhi(w.z), bflo(w.w), bfhi(w.w)};
                const int t = t0 + tg * 4 + i; const float inv = __builtin_amdgcn_rcpf((float)((t + 1 < win) ? (t + 1) : win));
                float p[8];
#pragma unroll
                for (int e = 0; e < 8; ++e) { s[e] += xv[e]; p[e] = __builtin_fmaf(s[e], inv, -xv[e]); }
                u32x4 o; o.x = pk2(p[0], p[1]); o.y = pk2(p[2], p[3]); o.z = pk2(p[4], p[5]); o.w = pk2(p[6], p[7]);
                *(LAS u32x4*)(PT + (tg * 4 + i) * PROW + ck * 16) = o;
                const u32x4 wo = *(const LAS u32x4*)(XP + (r0 + i - win + 1) * PROW + ck * 16);
                s[0] -= bflo(wo.x); s[1] -= bfhi(wo.x); s[2] -= bflo(wo.y); s[3] -= bfhi(wo.y); s[4] -= bflo(wo.z); s[5] -= bfhi(wo.z); s[6] -= bflo(wo.w); s[7] -= bfhi(wo.w);
            }
        }
        LDS_BARRIER();
#pragma unroll
        for (int tb = 0; tb < 4; ++tb) {
            f32x4 acc[2] = {(f32x4){0.f, 0.f, 0.f, 0.f}, (f32x4){0.f, 0.f, 0.f, 0.f}};
#pragma unroll
            for (int kb = 0; kb < 8; ++kb) { const bf16x8 pfm = *(const LAS bf16x8*)(PT + (tb * 16 + fr) * PROW + kb * 64 + fq * 16);
#pragma unroll
                for (int nb = 0; nb < 2; ++nb) acc[nb] = __builtin_amdgcn_mfma_f32_16x16x32_bf16(Wf[nb][kb], pfm, acc[nb], 0, 0, 0); }
            const int t = t0 + tb * 16 + fr;
            u32x4 o;
#pragma unroll
            for (int nb = 0; nb < 2; ++nb) {
                const unsigned g0 = nb ? gp[tb].z : gp[tb].x, g1 = nb ? gp[tb].w : gp[tb].y;
                const f32x4 gv = (f32x4){bflo(g0), bfhi(g0), bflo(g1), bfhi(g1)};
                f32x4 r = (acc[nb] + pb[nb]) * ps[nb];
#pragma unroll
                for (int e = 0; e < 4; ++e) r[e] *= gv[e] * fast_sigmoid(gv[e]);
                if (nb == 0) { o.x = pk2(r.x, r.y); o.y = pk2(r.z, r.w); } else { o.z = pk2(r.x, r.y); o.w = pk2(r.z, r.w); } }
            *(u32x4*)(y_base + (size_t)t * DMIX + wv * 32 + 8 * fq) = o;
        }
#pragma unroll
        for (int i = 0; i < 5; ++i) { const int id = tid + 512 * i, row = id >> 5, cc = id & 31; *(LAS u32x4*)(XP + row * PROW + cc * 16) = pf[i]; }
#pragma unroll
        for (int tb = 0; tb < 4; ++tb)
            gp[tb] = gpn[tb];
    }
    LDS_BARRIER();
}

__device__ __forceinline__ void phase_mixer(const Args& a, int l, LAS unsigned char* lds) {
#ifndef MK_MIX
#define MK_MIX 3
#endif
#ifndef MK_DBL_RNN
#define MK_DBL_RNN 0
#endif
#ifndef MK_DBL_POOL
#define MK_DBL_POOL 0
#endif
    for (int rep = 0; rep < 1 + ((l == 0) ? MK_DBL_RNN : 0); ++rep) for (int u = blockIdx.x; u < 256; u += gridDim.x) rnn_unit(a, l, u, lds);
    for (int rep = 0; rep < 1 + ((l == 0) ? MK_DBL_POOL : 0); ++rep) for (int u = blockIdx.x; u < 256; u += gridDim.x) pool_units(a, l, u, lds);
}
#ifndef MK_DBL_PH
#define MK_DBL_PH -1
#endif
#ifndef MK_MASK
#define MK_MASK 63
#endif
__global__ void __launch_bounds__(512, 2) mk_fwd(Args a) {
    extern __shared__ __attribute__((aligned(16))) unsigned char lds_raw[];
    LAS unsigned char* lds = (LAS unsigned char*)lds_raw;
    cg::grid_group grid = cg::this_grid();
    volatile LAS unsigned* bst = (volatile LAS unsigned*)(lds + LDS_BST_OFF);
    if (threadIdx.x < 4) bst[threadIdx.x] = 0u;
    sync_threads_();
    XcdBarrier xbar = xcd_barrier_post((unsigned*)(a.ws + WS_CTL), bst);
#define GRID_BAR() do { if (a.ph_hi - a.ph_lo > 64) grid.sync(); else xcd_barrier(xbar); } while (0)
    for (int ph = a.ph_lo; ph < a.ph_hi; ++ph) {
#if MK_DBL_PH >= 0
      for (int rep = 0; rep < ((ph == MK_DBL_PH) ? 2 : 1); ++rep) {
        if (rep) GRID_BAR();
#endif
        if (ph == 0) { if (MK_MASK & 1) phase_prep(a, lds); }
        else if (ph == 1) { if (MK_MASK & 2) phase_h0(a); }
        else {
            const int l = (ph - 2) >> 2, sub = (ph - 2) & 3;
            if (sub == 0) { if (MK_MASK & 4) {
                pg8::Gemm g{(const pg8::bf16_t*)(a.ws + WS_H), (const pg8::bf16_t*)(a.ws + WS_WIN) + (size_t)l * NPROJ * D, T, NPROJ, D};
                pg8::StaticOrder S; S.init(T, NPROJ, gridDim.x, (int)blockIdx.x);
                pg8::EpiBf16<0> E{(pg8::bf16_t*)(a.ws + WS_PROJ), NPROJ, nullptr, 0, 0, 1.f};
                pg8::gemm_phase<pg8::EpiBf16<0>, pg8::StaticOrder, PG8_ALIGN, PG8_SP2>(lds, g, S, E); }
            } else if (sub == 1) {
                if (MK_MASK & 8) phase_mixer(a, l, lds);
            } else if (sub == 2) { if (MK_MASK & 16) {
                pg8::Gemm g{(const pg8::bf16_t*)(a.ws + WS_YCAT), (const pg8::bf16_t*)(a.ws + WS_WOUT) + (size_t)l * D * DMIX, T, D, DMIX};
                pg8::StaticOrder S; S.init(T, D, gridDim.x, (int)blockIdx.x);
                pg8::EpiBf16<0> E{(pg8::bf16_t*)(a.ws + WS_Y), D, nullptr, 0, 0, 1.f};
                pg8::gemm_phase<pg8::EpiBf16<0>, pg8::StaticOrder, PG8_ALIGN, PG8_SP2>(lds, g, S, E); }
            } else {
                if (MK_MASK & 32) phase_post(a, l);
            }
        }
#if MK_DBL_PH >= 0
      }
#endif
        if (ph + 1 < a.ph_hi) GRID_BAR();
    }
}

#if defined(__HIP_DEVICE_COMPILE__)
#pragma clang attribute pop
#endif

extern "C" void kernel_launch(void* const* d_in, const int* in_sizes, int n_in, void* d_out, int out_size, void* d_ws, size_t ws_size, hipStream_t stream) {
    static int grid = 0;
    if (grid == 0) {
        if (n_in != 18 || in_sizes[0] != T * D || out_size != T * D || ws_size < WS_END) {
            fprintf(stderr, "kernel_launch: unexpected shapes (n_in %d, in0 %d, out %d, ws %zu); nothing launched\n", n_in, n_in > 0 ? in_sizes[0] : -1, out_size, ws_size); grid = -1; return; }
        int dev = 0, cus = 0, per_cu = 0;
        if (hipGetDevice(&dev) != hipSuccess || hipDeviceGetAttribute(&cus, hipDeviceAttributeMultiprocessorCount, dev) != hipSuccess) { grid = -1; return; }
        if (hipFuncSetAttribute((const void*)mk_fwd, hipFuncAttributeMaxDynamicSharedMemorySize, LDS_BYTES) != hipSuccess) { fprintf(stderr, "kernel_launch: hipFuncSetAttribute failed\n"); grid = -1; return; }
        if (hipOccupancyMaxActiveBlocksPerMultiprocessor(&per_cu, (const void*)mk_fwd, 512, LDS_BYTES) != hipSuccess || per_cu < 1) { fprintf(stderr, "kernel_launch: occupancy query says %d blocks per CU\n", per_cu); per_cu = 1; }
        (void)hipGetLastError();
        grid = cus;
    }
    if (grid < 0) return;
    Args a{};
    for (int i = 0; i < 18; ++i) a.in[i] = (const float*)d_in[i];
    a.out = (float*)d_out; a.ws = (unsigned char*)d_ws;
    if (hipMemsetAsync((char*)d_ws + WS_CTL, 0, CTL_BYTES, stream) != hipSuccess) { fprintf(stderr, "kernel_launch: memset of the barrier words failed\n"); return; }
#if MK_N_LAUNCHES == 1
    a.ph_lo = 0; a.ph_hi = NPH;
    void* args[] = {&a};
    const hipError_t e = hipLaunchCooperativeKernel((const void*)mk_fwd, dim3(grid), dim3(512), args, LDS_BYTES, stream);
    if (e != hipSuccess) fprintf(stderr, "kernel_launch: cooperative launch failed: %s (grid %d)\n", hipGetErrorString(e), grid);
#else
    for (int ph = 0; ph < NPH; ++ph) {
        a.ph_lo = ph; a.ph_hi = ph + 1;
        hipLaunchKernelGGL(mk_fwd, dim3(grid), dim3(512), LDS_BYTES, stream, a);
    }
#endif
}
```

```cpp
#include <hip/hip_runtime.h>
#include <hip/hip_cooperative_groups.h>
#include <cstdio>
#include <cstdint>
namespace cg = cooperative_groups;
__device__ __forceinline__ int opaque_tid() { int t = threadIdx.x; asm volatile("" : "+v"(t)); return t; }
#if defined(__HIP_DEVICE_COMPILE__)
#pragma clang attribute push (__attribute__((target("no-packed-fp32-ops"))), apply_to = function)
#endif
__device__ __forceinline__ float u2f(unsigned x) { return __builtin_bit_cast(float, x); }
__device__ __forceinline__ float i2f(int x) { return __builtin_bit_cast(float, x); }
__device__ __forceinline__ int f2i(float x) { return __builtin_bit_cast(int, x); }
__device__ __forceinline__ int lane_id_() { return (int)__builtin_amdgcn_mbcnt_hi(~0u, __builtin_amdgcn_mbcnt_lo(~0u, 0u)); }
__device__ __forceinline__ float shfl_xor_(float v, int o) { return i2f(__builtin_amdgcn_ds_bpermute((lane_id_() ^ o) << 2, f2i(v))); }
__device__ __forceinline__ float row_last_(float v) { return i2f(__builtin_amdgcn_ds_bpermute((lane_id_() | 15) << 2, f2i(v))); }
__device__ __forceinline__ void sync_threads_() { __builtin_amdgcn_fence(__ATOMIC_RELEASE, "workgroup"); __builtin_amdgcn_s_barrier(); __builtin_amdgcn_fence(__ATOMIC_ACQUIRE, "workgroup"); }
namespace pg8 {
#define PG8_LAS __attribute__((address_space(3)))
typedef unsigned short bf16_t;
typedef short bf16x8 __attribute__((ext_vector_type(8)));
typedef float f32x4 __attribute__((ext_vector_type(4)));
typedef unsigned u32x4 __attribute__((ext_vector_type(4)));
constexpr int BM = 256, BK = 64, HALF = 128, HTB = HALF * BK * 2  , STAGE_BYTES = 8 * HTB, NXCD = 8, WGM = 8;

__host__ __device__ __forceinline__ int lds_byte(int r, int c) { const int st = (r >> 4) * 2 + (c >> 5), rr = r & 15, cc = c & 31, ob = rr * 64 + cc * 2; return st * 1024 + (ob ^ (((ob >> 9) & 1) << 5)); }
__host__ __device__ __forceinline__ void stage_rc(int b, int& R, int& C) { const int st = b / 1024, sb = b % 1024, swz = sb ^ (((sb >> 9) & 1) << 5); R = (st >> 1) * 16 + swz / 64; C = (st & 1) * 32 + (swz % 64) / 2; }
__host__ __device__ __forceinline__ int perm32(int rho) { const int n = rho >> 4, i = rho & 15; return 8 * (i >> 2) + 4 * n + (i & 3); }

struct Unit { int pm, pn; };
struct Gemm { const bf16_t* A; const bf16_t* Bt; int M, N, K; };

struct StaticOrder {
    int nM, nN, nwg, G, c;
    __host__ __device__ void init(int M, int N, int G_, int c_) { nM = M / BM; nN = N / BM; nwg = nM * nN; G = G_; c = c_; }
    __host__ __device__ bool next(int i, Unit& u) const {
        const long L = (long)i * G + c; if (L >= nwg) return false;
        int wgid = (int)L; { const int q = nwg / NXCD, r = nwg % NXCD, xcd = wgid % NXCD, off = wgid / NXCD; wgid = (xcd < r ? xcd * (q + 1) : r * (q + 1) + (xcd - r) * q) + off; }
        const int nig = WGM * nN, gid = wgid / nig, fm = gid * WGM, gsz = (nM - fm) < WGM ? (nM - fm) : WGM;
        u.pm = fm + ((wgid % nig) % gsz); u.pn = (wgid % nig) / gsz; return true;
    }
    __device__ __forceinline__ void a_ready(const Unit&) const {}
    __device__ __forceinline__ void done(const Unit&) const {}
};

__device__ __forceinline__ unsigned cvt_pk_bf16(float lo, float hi) { unsigned r; asm volatile("v_cvt_pk_bf16_f32 %0, %1, %2" : "=v"(r) : "v"(lo), "v"(hi)); return r; }
typedef float f32x2 __attribute__((ext_vector_type(2)));
__device__ __forceinline__ f32x2 gelu_pk(f32x2 v) {
    const f32x2 av = __builtin_elementwise_abs(v), d = av * 0.2316418882f + 1.0f;
    f32x2 t; t.x = __builtin_amdgcn_rcpf(d.x); t.y = __builtin_amdgcn_rcpf(d.y);
    f32x2 q = t * 0.5307027145f + (-0.7265760135f); q = q * t + 0.7107068705f; q = q * t + (-0.142248368f); q = q * t + 0.127414796f; q = q * t;
    const f32x2 s = (v * v) * (-0.72134752044f);
    f32x2 e; e.x = __builtin_amdgcn_exp2f(s.x); e.y = __builtin_amdgcn_exp2f(s.y);
    const f32x2 m = v * (q * e), r = v - m;
    f32x2 o; o.x = v.x < 0.f ? m.x : r.x; o.y = v.y < 0.f ? m.y : r.y; return o;
}

template <int ACT  > struct EpiBf16 {
    static constexpr bool PERM = true, AFTER_DRAIN = false; static_assert(ACT == 0 || ACT == 1, "EpiBf16: ACT is 0 (none) or 1 (gelu_pk)");
    bf16_t* O; int ldc; const float* bias; int split_cols; size_t split_stride; float scale0;
    __device__ __forceinline__ void operator()(const f32x4 (&acc)[2][2][4][2], const Unit& u, int wr, int wc, int fr, int fq) const {
        const int row0 = u.pm * BM + wr * 64 + fr; int colt = u.pn * BM; bf16_t* base = O;
        float sc = 1.f; if (split_cols) { const int t = colt / split_cols; base += (size_t)t * split_stride; colt -= t * split_cols; if (t == 0) sc = scale0; }
        const int col0 = colt + wc * 32 + 8 * fq, bcol0 = u.pn * BM + wc * 32 + 8 * fq;
        f32x4 bv[2][2];
#pragma unroll
        for (int bj = 0; bj < 2; ++bj)
#pragma unroll
            for (int n = 0; n < 2; ++n) bv[bj][n] = bias ? *(const f32x4*)(bias + bcol0 + bj * HALF + 4 * n) : (f32x4){0.f, 0.f, 0.f, 0.f};
#pragma unroll
        for (int ai = 0; ai < 2; ++ai)
#pragma unroll
            for (int m = 0; m < 4; ++m) { bf16_t* rowp = base + (size_t)(row0 + ai * HALF + m * 16) * ldc + col0;
#pragma unroll
                for (int bj = 0; bj < 2; ++bj) { f32x4 v0 = acc[ai][bj][m][0] + bv[bj][0], v1 = acc[ai][bj][m][1] + bv[bj][1];
                    if (ACT == 1) { f32x2 a = gelu_pk((f32x2){v0[0], v0[1]}), b = gelu_pk((f32x2){v0[2], v0[3]}), c = gelu_pk((f32x2){v1[0], v1[1]}), d = gelu_pk((f32x2){v1[2], v1[3]});
                        v0 = (f32x4){a.x, a.y, b.x, b.y}; v1 = (f32x4){c.x, c.y, d.x, d.y}; }
                    v0 = v0 * sc; v1 = v1 * sc; u32x4 w; w.x = cvt_pk_bf16(v0[0], v0[1]); w.y = cvt_pk_bf16(v0[2], v0[3]); w.z = cvt_pk_bf16(v1[0], v1[1]); w.w = cvt_pk_bf16(v1[2], v1[3]);
                    *(u32x4*)(rowp + bj * HALF) = w; } }
    }
};
template <class Epi, class Sched, bool ALIGN_EPI = false, bool SP2 = false>
__device__ __forceinline__ void gemm_phase(PG8_LAS unsigned char* lds, const Gemm g, const Sched& S, const Epi& E) {
    const int tid = opaque_tid(), wid = __builtin_amdgcn_readfirstlane(tid >> 6), lane = tid & 63, wr = wid >> 2, wc = wid & 3, fr = lane & 15, fq = lane >> 4;
    const int K = g.K, nt = K / BK;
    unsigned voffA[2], voffB[2];
#pragma unroll
    for (int i = 0; i < 2; ++i) { int R, C; stage_rc(tid * 16 + i * 8192, R, C); const int Rb = Epi::PERM ? ((R & ~31) + perm32(R & 31)) : R;
        voffA[i] = (unsigned)(R * K + C) * 2u; voffB[i] = (unsigned)(Rb * K + C) * 2u; }
    const size_t kstep = (size_t)(BK * 2);
    const size_t hstep = (size_t)HALF * K * 2;
    const size_t tstep = 2 * hstep;
    const unsigned ldsw = (unsigned)wid * 1024u;
    const int aoff = lds_byte(wr * 64 + fr, fq * 8), boff = lds_byte(wc * 32 + fr, fq * 8);
#define PG8_SA(b, h) (((b) * 2 + (h)) * HTB)
#define PG8_SB(b, h) ((4 + (b) * 2 + (h)) * HTB)
#define PG8_STAGE(bufoff, gbase, voff) do { _Pragma("unroll") for (int _i = 0; _i < 2; ++_i) \
        __builtin_amdgcn_global_load_lds((const unsigned*)((const char*)(gbase) + (voff)[_i]), (PG8_LAS unsigned*)(lds + (bufoff) + ldsw + _i * 8192), 16, 0, 0); } while (0)
#define PG8_LDA(dst, b, h) do { _Pragma("unroll") for (int m = 0; m < 4; ++m) _Pragma("unroll") for (int k = 0; k < 2; ++k) dst[m][k] = *(const PG8_LAS bf16x8*)(lds + PG8_SA(b, h) + aoff + m * 2048 + k * 1024); } while (0)
#define PG8_LDB(dst, b, h) do { _Pragma("unroll") for (int n = 0; n < 2; ++n) _Pragma("unroll") for (int k = 0; k < 2; ++k) dst[n][k] = *(const PG8_LAS bf16x8*)(lds + PG8_SB(b, h) + boff + n * 2048 + k * 1024); } while (0)
#define PG8_MMA(ai, bj, At, Bt) do { __builtin_amdgcn_s_setprio(1); _Pragma("unroll") for (int m = 0; m < 4; ++m) _Pragma("unroll") for (int n = 0; n < 2; ++n) _Pragma("unroll") for (int k = 0; k < 2; ++k) \
        acc[ai][bj][m][n] = __builtin_amdgcn_mfma_f32_16x16x32_bf16(Bt[n][k], At[m][k], acc[ai][bj][m][n], 0, 0, 0); __builtin_amdgcn_s_setprio(0); } while (0)
#define PG8_WAIT_V(n) asm volatile("s_waitcnt vmcnt(" #n ")" ::: "memory")
#define PG8_WAIT_L(n) asm volatile("s_waitcnt lgkmcnt(" #n ")" ::: "memory")
#define PG8_BAR __builtin_amdgcn_s_barrier()
#define PG8_SCHED __builtin_amdgcn_sched_barrier(0)
    Unit cur, nxt; int ui = 0;
    if (!S.next(0, cur)) return;
    f32x4 acc[2][2][4][2];
#pragma unroll
    for (int a = 0; a < 2; ++a)
#pragma unroll
        for (int b = 0; b < 2; ++b)
#pragma unroll
            for (int m = 0; m < 4; ++m)
#pragma unroll
                for (int n = 0; n < 2; ++n) acc[a][b][m][n] = (f32x4){0.f, 0.f, 0.f, 0.f};
    bf16x8 At[4][2], B0[2][2], B1[2][2];
    const char* cA = (const char*)g.A + (size_t)cur.pm * tstep; const char* cB = (const char*)g.Bt + (size_t)cur.pn * tstep;
    S.a_ready(cur);
    if constexpr (SP2) {
        PG8_STAGE(PG8_SB(0, 0), cB, voffB); PG8_STAGE(PG8_SB(0, 1), cB + hstep, voffB); PG8_STAGE(PG8_SA(0, 0), cA, voffA); PG8_STAGE(PG8_SA(0, 1), cA + hstep, voffA);
        if (wr == 1) PG8_BAR;
        PG8_WAIT_V(2); PG8_BAR;
        PG8_STAGE(PG8_SB(1, 0), cB + kstep, voffB); PG8_STAGE(PG8_SA(1, 0), cA + kstep, voffA); PG8_STAGE(PG8_SB(1, 1), cB + hstep + kstep, voffB);
        PG8_WAIT_V(6); PG8_BAR;
    } else {
        PG8_STAGE(PG8_SB(0, 0), cB, voffB); PG8_STAGE(PG8_SA(0, 0), cA, voffA); PG8_STAGE(PG8_SB(0, 1), cB + hstep, voffB); PG8_STAGE(PG8_SA(0, 1), cA + hstep, voffA);
        if (wr == 1) PG8_BAR;
        PG8_WAIT_V(4); PG8_BAR;
        PG8_STAGE(PG8_SB(1, 0), cB + kstep, voffB); PG8_STAGE(PG8_SA(1, 0), cA + kstep, voffA); PG8_STAGE(PG8_SB(1, 1), cB + hstep + kstep, voffB);
        PG8_WAIT_V(6); PG8_BAR;
    }
    for (;;) {
        const bool has_next = S.next(ui + 1, nxt);
        const char* nA = has_next ? (const char*)g.A + (size_t)nxt.pm * tstep : cA; const char* nB = has_next ? (const char*)g.Bt + (size_t)nxt.pn * tstep : cB;
        for (int t = 0; t < nt; t += 2) {
            const bool last = (t == nt - 2);
            const char* a1 = cA + (size_t)(t + 1) * kstep;
            const char* a2 = last ? nA : cA + (size_t)(t + 2) * kstep; const char* b2 = last ? nB : cB + (size_t)(t + 2) * kstep;
            const char* a3 = a2 + kstep; const char* b3 = b2 + kstep;
            if (last && has_next) S.a_ready(nxt);
            if constexpr (SP2) {
            PG8_LDB(B0, 0, 0); PG8_LDB(B1, 0, 1); PG8_SCHED; PG8_LDA(At, 0, 0); PG8_STAGE(PG8_SA(1, 1), a1 + hstep, voffA);
            PG8_WAIT_V(8); PG8_WAIT_L(0); PG8_BAR; PG8_MMA(0, 0, At, B0); PG8_MMA(0, 1, At, B1); PG8_BAR; PG8_SCHED;
            PG8_LDA(At, 0, 1); PG8_STAGE(PG8_SB(0, 0), b2, voffB); PG8_STAGE(PG8_SB(0, 1), b2 + hstep, voffB); PG8_STAGE(PG8_SA(0, 0), a2, voffA);
            PG8_WAIT_V(8); PG8_WAIT_L(0); PG8_BAR; PG8_MMA(1, 0, At, B0); PG8_MMA(1, 1, At, B1); PG8_BAR; PG8_SCHED;
            PG8_LDB(B0, 1, 0); PG8_LDB(B1, 1, 1); PG8_SCHED; PG8_LDA(At, 1, 0); PG8_STAGE(PG8_SA(0, 1), a2 + hstep, voffA);
            PG8_WAIT_V(8); PG8_WAIT_L(0); PG8_BAR; PG8_MMA(0, 0, At, B0); PG8_MMA(0, 1, At, B1); PG8_BAR; PG8_SCHED;
            PG8_LDA(At, 1, 1); PG8_STAGE(PG8_SB(1, 0), b3, voffB); PG8_STAGE(PG8_SB(1, 1), b3 + hstep, voffB); PG8_STAGE(PG8_SA(1, 0), a3, voffA);
            PG8_WAIT_V(8); PG8_WAIT_L(0); PG8_BAR; PG8_MMA(1, 0, At, B0); PG8_MMA(1, 1, At, B1); PG8_BAR; PG8_SCHED;
            } else {
            PG8_LDB(B0, 0, 0); PG8_SCHED; PG8_LDA(At, 0, 0); PG8_STAGE(PG8_SA(1, 1), a1 + hstep, voffA);
            PG8_WAIT_L(8); PG8_BAR; PG8_WAIT_L(0); PG8_MMA(0, 0, At, B0); PG8_BAR; PG8_SCHED;
            PG8_LDB(B1, 0, 1); PG8_STAGE(PG8_SB(0, 0), b2, voffB);
            PG8_BAR; PG8_WAIT_L(0); PG8_MMA(0, 1, At, B1); PG8_BAR;
            PG8_LDA(At, 0, 1); PG8_STAGE(PG8_SA(0, 0), a2, voffA);
            PG8_BAR; PG8_WAIT_L(0); PG8_MMA(1, 0, At, B0); PG8_BAR; PG8_SCHED;
            PG8_STAGE(PG8_SB(0, 1), b2 + hstep, voffB);
            PG8_WAIT_V(6); PG8_BAR; PG8_MMA(1, 1, At, B1); PG8_BAR;
            PG8_LDB(B0, 1, 0); PG8_SCHED; PG8_LDA(At, 1, 0); PG8_STAGE(PG8_SA(0, 1), a2 + hstep, voffA);
            PG8_WAIT_L(8); PG8_BAR; PG8_WAIT_L(0); PG8_MMA(0, 0, At, B0); PG8_BAR; PG8_SCHED;
            PG8_LDB(B1, 1, 1); PG8_STAGE(PG8_SB(1, 0), b3, voffB);
            PG8_BAR; PG8_WAIT_L(0); PG8_MMA(0, 1, At, B1); PG8_BAR;
            PG8_LDA(At, 1, 1); PG8_STAGE(PG8_SA(1, 0), a3, voffA);
            PG8_BAR; PG8_WAIT_L(0); PG8_MMA(1, 0, At, B0); PG8_BAR; PG8_SCHED;
            PG8_STAGE(PG8_SB(1, 1), b3 + hstep, voffB);
            PG8_WAIT_V(6); PG8_BAR; PG8_MMA(1, 1, At, B1); PG8_BAR;
            }
        }
        if constexpr (ALIGN_EPI) { if (wr == 0) PG8_BAR; }
        if constexpr (!Epi::AFTER_DRAIN) { E(acc, cur, wr, wc, fr, fq); S.done(cur); }
        if (!has_next) break;
#pragma unroll
        for (int a = 0; a < 2; ++a)
#pragma unroll
            for (int b = 0; b < 2; ++b)
#pragma unroll
                for (int m = 0; m < 4; ++m)
#pragma unroll
                    for (int n = 0; n < 2; ++n) acc[a][b][m][n] = (f32x4){0.f, 0.f, 0.f, 0.f};
        cur = nxt; cA = nA; cB = nB; ++ui;
        if constexpr (ALIGN_EPI) { if (wr == 1) PG8_BAR; }
    }
    PG8_WAIT_V(0);
    if constexpr (!ALIGN_EPI) { if (wr == 0) PG8_BAR; }
    PG8_BAR;
    if constexpr (Epi::AFTER_DRAIN) { E.fused(acc, cur, wr, wc, fr, fq, lds, wid, lane); S.done(cur); }
#undef PG8_SA
#undef PG8_SB
#undef PG8_STAGE
#undef PG8_LDA
#undef PG8_LDB
#undef PG8_MMA
#undef PG8_WAIT_V
#undef PG8_WAIT_L
#undef PG8_BAR
#undef PG8_SCHED
}
}
#ifndef PG8_SP2
#define PG8_SP2 true
#endif
#ifndef PG8_ALIGN
#define PG8_ALIGN true
#endif
#ifndef MK_N_LAUNCHES
#define MK_N_LAUNCHES 1
#endif

constexpr int NB = 8, SEQ = 4096, D = 1024, T = NB * SEQ, NPROJ = 4096, DMIX = 2048;
constexpr int NPH = 10;
constexpr float EPS = 1e-6f;
constexpr size_t MiB = 1u << 20;
constexpr size_t WS_WIN = 0, WS_WOUT = 16 * MiB, WS_GW = 24 * MiB, WS_PW = 25 * MiB, WS_MOD = 26 * MiB;
constexpr size_t WS_H = 32 * MiB, WS_YCAT = 96 * MiB, WS_PROJ = 224 * MiB, WS_Y = WS_PROJ, WS_U = WS_H, WS_END = 480 * MiB;
constexpr size_t WS_CTL = 28 * MiB, CTL_BYTES = 16384;
constexpr int LDS_BYTES = 147456, LDS_BST_OFF = 131072 + 64;

#define LAS __attribute__((address_space(3)))
typedef unsigned short bf16;
typedef float f32x4 __attribute__((ext_vector_type(4)));
typedef float f32x2 __attribute__((ext_vector_type(2)));
typedef unsigned u32x4 __attribute__((ext_vector_type(4)));
typedef unsigned u32x2 __attribute__((ext_vector_type(2)));
typedef short bf16x8 __attribute__((ext_vector_type(8)));

struct Args { const float* in[18]; float* out; unsigned char* ws; int ph_lo, ph_hi; };

__device__ __forceinline__ unsigned pk2(float lo, float hi) { return pg8::cvt_pk_bf16(lo, hi); }
__device__ __forceinline__ float bflo(unsigned w) { return u2f(w << 16); }
__device__ __forceinline__ float bfhi(unsigned w) { return u2f(w & 0xffff0000u); }
template <int CTRL> __device__ __forceinline__ float dpp_mov_(float v) { return i2f(__builtin_amdgcn_update_dpp(0, f2i(v), CTRL, 0xf, 0xf, true)); }
__device__ __forceinline__ float wave_sum(float v) {
    v += dpp_mov_<0xB1>(v);
    v += dpp_mov_<0x4E>(v);
    v += dpp_mov_<0x141>(v);
    v += dpp_mov_<0x140>(v);
    const float r0 = i2f(__builtin_amdgcn_readlane(f2i(v), 0)), r1 = i2f(__builtin_amdgcn_readlane(f2i(v), 16));
    const float r2 = i2f(__builtin_amdgcn_readlane(f2i(v), 32)), r3 = i2f(__builtin_amdgcn_readlane(f2i(v), 48));
    return (r0 + r1) + (r2 + r3);
}
__device__ __forceinline__ float sigmoidf_(float x) { return 1.0f / (1.0f + __expf(-x)); }
__device__ __forceinline__ float siluf_(float x) { return x / (1.0f + __expf(-x)); }

__device__ __forceinline__ void transpose_tile(const float* W, int K, int N, bf16* WT, LAS float* scr, int k0, int n0, int drow, int lane, float wscale = 1.0f) {
    {
        f32x4 v[8];
#pragma unroll
        for (int i = 0; i < 8; ++i) v[i] = *(const f32x4*)(W + (size_t)(k0 + (lane >> 3) + 8 * i) * N + n0 + (lane & 7) * 4);
#pragma unroll
        for (int i = 0; i < 8; ++i) { LAS float* d = scr + ((lane >> 3) + 8 * i) * 33 + (lane & 7) * 4; d[0] = v[i].x * wscale; d[1] = v[i].y * wscale; d[2] = v[i].z * wscale; d[3] = v[i].w * wscale; }
    }
    asm volatile("s_waitcnt lgkmcnt(0)" ::: "memory");
    const int c = lane & 7;
#pragma unroll
    for (int j = 0; j < 4; ++j) { const int n = (lane >> 3) + 8 * j; const LAS float* s = scr + (8 * c) * 33 + n;
        u32x4 o; o.x = pk2(s[0 * 33], s[1 * 33]); o.y = pk2(s[2 * 33], s[3 * 33]); o.z = pk2(s[4 * 33], s[5 * 33]); o.w = pk2(s[6 * 33], s[7 * 33]);
        *(u32x4*)(WT + (size_t)(drow + n) * K + k0 + 8 * c) = o; }
    asm volatile("s_waitcnt lgkmcnt(0)" ::: "memory");
}
__device__ __forceinline__ void transpose_item(const float* W, int K, int N, bf16* WT, LAS float* scr, int item, int lane) {
    const int nblk = N / 32, kb = item / nblk, nb = item % nblk;
    transpose_tile(W, K, N, WT, scr, 64 * kb, 32 * nb, 32 * nb, lane);
}

__device__ __forceinline__ void phase_prep(const Args& a, LAS unsigned char* lds) {
    const int tid = opaque_tid(), lane = tid & 63, wv = tid >> 6;
    const int G = gridDim.x;
    unsigned char* ws = a.ws;
    {
        LAS float* sc = (LAS float*)lds;
        LAS float* red = (LAS float*)(lds + 32768);
        const float* c = a.in[1]; const float* ada_w = a.in[2]; const float* ada_b = a.in[3];
        float* MOD = (float*)(ws + WS_MOD);
        if ((int)blockIdx.x < 192) {
            for (int i = tid; i < 8192; i += 512) sc[i] = siluf_(c[i]);
            sync_threads_();
            for (int unit = blockIdx.x; unit < 192; unit += G) {
                const int l = unit / 96, cb = (unit % 96) * 32, cl = tid & 31, ks = tid >> 5;
                const float* wp = ada_w + (size_t)l * 1024 * 3072 + (size_t)(ks * 64) * 3072 + cb + cl;
                float acc[8];
#pragma unroll
                for (int b = 0; b < 8; ++b) acc[b] = 0.f;
#pragma unroll 16
                for (int k = 0; k < 64; ++k) { const float w = wp[(size_t)k * 3072];
#pragma unroll
                    for (int b = 0; b < 8; ++b) acc[b] += sc[b * 1024 + ks * 64 + k] * w; }
#pragma unroll
                for (int b = 0; b < 8; ++b) red[(ks * 8 + b) * 32 + cl] = acc[b];
                sync_threads_();
                if (tid < 256) { const int b = tid >> 5; float s = 0.f;
#pragma unroll
                    for (int k2 = 0; k2 < 16; ++k2) s += red[(k2 * 8 + b) * 32 + cl];
                    MOD[(l * 8 + b) * 3072 + cb + cl] = s + ada_b[l * 3072 + cb + cl]; }
                sync_threads_();
            }
        }
        sync_threads_();
    }
    {
        LAS float* scr = (LAS float*)(lds + wv * 16384);
        const int gw = blockIdx.x * 8 + wv, NGW = G * 8;
        constexpr int I_IN = (1024 / 64) * (4096 / 32), I_OUT = (2048 / 64) * (1024 / 32);
        for (int it = gw; it < 2 * (I_IN + I_OUT); it += NGW) {
            int r = it;
            if (r < 2 * I_IN) { const int l = r / I_IN; r -= l * I_IN;
                transpose_item(a.in[5] + (size_t)l * 1024 * 4096, 1024, 4096, (bf16*)(ws + WS_WIN) + (size_t)l * 4096 * 1024, scr, r, lane); }
            else { r -= 2 * I_IN; const int l = r / I_OUT; r -= l * I_OUT;
                transpose_item(a.in[16] + (size_t)l * 2048 * 1024, 2048, 1024, (bf16*)(ws + WS_WOUT) + (size_t)l * 1024 * 2048, scr, r, lane); }
        }
    }
    {
        LAS float* scr = (LAS float*)(lds + wv * 16384);
        const int gw = blockIdx.x * 8 + wv, NGW = G * 8;
        bf16* GWp = (bf16*)(ws + WS_GW); bf16* PWp = (bf16*)(ws + WS_PW);
        for (int it = NGW - 1 - gw; it < 512; it += NGW) {
            if (it < 256) { const int lh = it >> 4, r = it & 15, gate = r >> 3, kb = (r >> 2) & 1, q = r & 3;
                transpose_tile((gate ? a.in[10] : a.in[8]) + (size_t)lh * 128 * 128, 128, 128, GWp + (size_t)lh * 4 * 64 * 128, scr, 64 * kb, 32 * q, q * 64 + gate * 32, lane, -1.4426950408889634f); }
            else { const int r = it - 256, lg = r >> 5, kb = (r >> 3) & 3, nb = r & 7;
                transpose_tile(a.in[13] + (size_t)lg * 256 * 256, 256, 256, PWp + (size_t)lg * 256 * 256, scr, 64 * kb, 32 * nb, 32 * nb, lane); }
        }
    }
}

constexpr int RPW = 4;
__device__ __forceinline__ void phase_h0(const Args& a) {
    const int tid = opaque_tid(), lane = tid & 63, wv = tid >> 6;
    const int gw = blockIdx.x * 8 + wv, NGW = gridDim.x * 8;
    const float* x = a.in[0]; const float* g = a.in[4]; const float* MOD = (const float*)(a.ws + WS_MOD);
    bf16* H = (bf16*)(a.ws + WS_H);
    const int WPB = NGW / NB, b = gw / WPB, wq = gw % WPB;
    const float* sh = MOD + (size_t)b * 3072; const float* scl = sh + 1024;
    f32x4 A1[4], SH[4];
#pragma unroll
    for (int j = 0; j < 4; ++j) { const int col = 4 * lane + 256 * j; A1[j] = *(const f32x4*)(g + col) * (*(const f32x4*)(scl + col) + 1.0f); SH[j] = *(const f32x4*)(sh + col); }
    for (int mr = wq * RPW; mr < SEQ; mr += WPB * RPW) {
        const int m0 = b * SEQ + mr;
        f32x4 v[RPW][4];
#pragma unroll
        for (int r = 0; r < RPW; ++r) { const f32x4* xr = (const f32x4*)(x + (size_t)(m0 + r) * D) + lane;
#pragma unroll
            for (int j = 0; j < 4; ++j) v[r][j] = __builtin_nontemporal_load(xr + 64 * j); }
#pragma unroll
        for (int r = 0; r < RPW; ++r) {
            float ss = 0.f;
#pragma unroll
            for (int j = 0; j < 4; ++j) ss += (v[r][j].x * v[r][j].x + v[r][j].y * v[r][j].y) + (v[r][j].z * v[r][j].z + v[r][j].w * v[r][j].w);
            const float rstd = 1.0f / __builtin_sqrtf(wave_sum(ss) * (1.0f / D) + EPS);
            u32x2* o = (u32x2*)(H + (size_t)(m0 + r) * D) + lane;
#pragma unroll
            for (int j = 0; j < 4; ++j) {
                const f32x4 rr = (v[r][j] * rstd) * A1[j] + SH[j];
                u32x2 w; w.x = pk2(rr.x, rr.y); w.y = pk2(rr.z, rr.w); o[64 * j] = w; }
        }
    }
}

template <int l> __device__ __forceinline__ void phase_post(const Args& a) {
    const int tid = opaque_tid(), lane = tid & 63, wv = tid >> 6;
    const int gw = blockIdx.x * 8 + wv, NGW = gridDim.x * 8;
    const float* xin = (l == 0) ? a.in[0] : a.out; float* out = a.out;
    const bf16* Y = (const bf16*)(a.ws + WS_Y); bf16* H = (bf16*)(a.ws + WS_H);
    const float* MOD = (const float*)(a.ws + WS_MOD);
    const float* gpost = a.in[17] + l * D; const float* gpre = a.in[4] + (l + 1) * D;
    const int WPB = NGW / NB, b = gw / WPB, wq = gw % WPB;
    const float* gate = MOD + (size_t)(l * 8 + b) * 3072 + 2048;
    const float* sh = MOD + (size_t)(8 + b) * 3072; const float* scl = sh + 1024;
    f32x4 GP[4], A1[4], SH[4];
#pragma unroll
    for (int j = 0; j < 4; ++j) { const int col = 4 * lane + 256 * j; GP[j] = *(const f32x4*)(gate + col) * *(const f32x4*)(gpost + col);
        if (l == 0) { A1[j] = *(const f32x4*)(gpre + col) * (*(const f32x4*)(scl + col) + 1.0f); SH[j] = *(const f32x4*)(sh + col); } }
    for (int mr = wq * RPW; mr < SEQ; mr += WPB * RPW) {
        const int m0 = b * SEQ + mr;
        f32x4 xv[RPW][4]; u32x2 yw[RPW][4];
#pragma unroll
        for (int r = 0; r < RPW; ++r) { const f32x4* xr = (const f32x4*)(xin + (size_t)(m0 + r) * D) + lane; const u32x2* yr = (const u32x2*)(Y + (size_t)(m0 + r) * D) + lane;
#pragma unroll
            for (int j = 0; j < 4; ++j) { xv[r][j] = xr[64 * j]; yw[r][j] = yr[64 * j]; } }
#pragma unroll
        for (int r = 0; r < RPW; ++r) {
            f32x4 yv[4]; float ss = 0.f;
#pragma unroll
            for (int j = 0; j < 4; ++j) { const u32x2 w = yw[r][j]; yv[j] = (f32x4){bflo(w.x), bfhi(w.x), bflo(w.y), bfhi(w.y)};
                ss += (yv[j].x * yv[j].x + yv[j].y * yv[j].y) + (yv[j].z * yv[j].z + yv[j].w * yv[j].w); }
            const float rstd = 1.0f / __builtin_sqrtf(wave_sum(ss) * (1.0f / D) + EPS);
            float ss2 = 0.f;
#pragma unroll
            for (int j = 0; j < 4; ++j) { const int col = 4 * lane + 256 * j;
                const f32x4 xn = xv[r][j] + (yv[j] * rstd) * GP[j];
                xv[r][j] = xn;
                if (l == 0) *((f32x4*)(out + (size_t)(m0 + r) * D + col)) = xn;
                else __builtin_nontemporal_store(xn, (f32x4*)(out + (size_t)(m0 + r) * D + col));
                ss2 += (xn.x * xn.x + xn.y * xn.y) + (xn.z * xn.z + xn.w * xn.w); }
            if (l == 0) {
                const float rstd2 = 1.0f / __builtin_sqrtf(wave_sum(ss2) * (1.0f / D) + EPS);
                u32x2* o = (u32x2*)(H + (size_t)(m0 + r) * D) + lane;
#pragma unroll
                for (int j = 0; j < 4; ++j) {
                    const f32x4 rr = (xv[r][j] * rstd2) * A1[j] + SH[j];
                    u32x2 w; w.x = pk2(rr.x, rr.y); w.y = pk2(rr.z, rr.w); o[64 * j] = w; }
            }
        }
    }
}
#define XB_TMO      128
#define XB_XCNT(j)  (256  + 64 * (j))
#define XB_XSUB(j)  (1280 + 64 * (j))
#define XB_XGEN(j)  (2304 + 64 * (j))
#define XB_TOP      3328
#define XB_TOPGEN   3392
#define XCD_BAR_WORDS 3456
#define XB_SPIN_CAP (1u << 18)

__device__ __forceinline__ unsigned xb_ld(unsigned* p)              { return __hip_atomic_load(p, __ATOMIC_RELAXED, __HIP_MEMORY_SCOPE_AGENT); }
__device__ __forceinline__ unsigned xb_add(unsigned* p, unsigned v) { return __hip_atomic_fetch_add(p, v, __ATOMIC_RELAXED, __HIP_MEMORY_SCOPE_AGENT); }
__device__ __forceinline__ unsigned xb_xcc_id() { return (unsigned)__builtin_amdgcn_s_getreg((3 << 11) | 20) & 0xFu; }
#define XB_SPIN(cond, bar) do { unsigned _sp = 0; while (cond) { __builtin_amdgcn_s_sleep(1); \
    if ((++_sp & 255u) == 0u) { if (xb_ld(&(bar)[XB_TMO])) break; if (_sp > XB_SPIN_CAP) { xb_add(&(bar)[XB_TMO], 1u); break; } } } } while (0)

struct XcdBarrier {
    unsigned* bar; unsigned x;
    volatile LAS unsigned* st;
};

__device__ __forceinline__ XcdBarrier xcd_barrier_post(unsigned* bar, volatile LAS unsigned* st) {
    XcdBarrier b; b.bar = bar; b.x = xb_xcc_id(); b.st = st;
    if (threadIdx.x == 0) (void)xb_add(&bar[XB_XCNT(b.x)], 1u);
    return b;
}
__device__ __forceinline__ void xcd_barrier_complete(unsigned* bar, unsigned x, unsigned& nloc, unsigned& nx) {
    const unsigned G = gridDim.x * gridDim.y * gridDim.z;
    unsigned sum, cnt, mine, sp = 0u;
    for (;;) {
        sum = 0u; cnt = 0u; mine = 0u;
#pragma unroll
        for (unsigned j = 0; j < 16; ++j) { const unsigned c = xb_ld(&bar[XB_XCNT(j)]); sum += c; cnt += (c > 0u) ? 1u : 0u; mine = (j == x) ? c : mine; }
        if (sum == G) break;
        __builtin_amdgcn_s_sleep(1);
        if ((++sp & 255u) == 0u) { if (xb_ld(&bar[XB_TMO])) break; if (sp > XB_SPIN_CAP) { xb_add(&bar[XB_TMO], 1u); break; } }
    }
    nloc = mine > 0u ? mine : 1u; nx = cnt > 0u ? cnt : 1u;
}

__device__ __forceinline__ void xcd_barrier(const XcdBarrier& b) {
    asm volatile("s_waitcnt vmcnt(0)" ::: "memory");
    sync_threads_();
    if (threadIdx.x == 0) {
        unsigned* bar = b.bar;
        __builtin_amdgcn_s_waitcnt(0);
        unsigned nloc = b.st[0], nx = b.st[1];
        if (nloc == 0u) { xcd_barrier_complete(bar, b.x, nloc, nx); b.st[0] = nloc; b.st[1] = nx; }
        const unsigned old = xb_add(&bar[XB_XSUB(b.x)], 1u);
        const unsigned gen = old / nloc;
        if (old + 1u == (gen + 1u) * nloc) {
            __builtin_amdgcn_fence(__ATOMIC_RELEASE, "agent");
            asm volatile("s_waitcnt vmcnt(0)" ::: "memory");
            const unsigned og = xb_add(&bar[XB_TOP], 1u);
            const unsigned tg = og / nx;
            if (og + 1u == (tg + 1u) * nx) xb_add(&bar[XB_TOPGEN], 1u);
            else XB_SPIN(xb_ld(&bar[XB_TOPGEN]) == tg, bar);
            __builtin_amdgcn_fence(__ATOMIC_ACQUIRE, "agent");
            xb_add(&bar[XB_XGEN(b.x)], 1u);
            asm volatile("s_waitcnt vmcnt(0)" ::: "memory");
        } else {
            XB_SPIN(xb_ld(&bar[XB_XGEN(b.x)]) == gen, bar);
            __builtin_amdgcn_fence(__ATOMIC_ACQUIRE, "agent");
            asm volatile("s_waitcnt vmcnt(0)" ::: "memory");
        }
    }
    sync_threads_();
}

#define LDS_BARRIER() do { asm volatile("s_waitcnt lgkmcnt(0)" ::: "memory"); __builtin_amdgcn_s_barrier(); asm volatile("" ::: "memory"); } while (0)
constexpr int XROW = 272;
constexpr int CROW = 132;
constexpr int R_XT = 0, R_UT = 35840, R_AT = 70656, R_VT = 87552, R_EP = 104448, R_CWT = 105472, R_GT = 108032, R_YT = 116736;
template <int D> __device__ __forceinline__ float dpp_row_shr(float old, float src) {
    return i2f(__builtin_amdgcn_update_dpp(f2i(old), f2i(src), 0x110 | D, 0xf, 0xf, false)); }
__device__ __forceinline__ float softplus_small_(float e) { return (e < 0.03f) ? e * (1.0f + e * (-0.5f + e * (0.33333334f + e * (-0.25f + e * 0.2f)))) : __builtin_logf(1.0f + e); }
__device__ __forceinline__ float fast_sigmoid(float x) { return __builtin_amdgcn_rcpf(1.0f + __builtin_amdgcn_exp2f(-1.4426950408889634f * x)); }
__device__ __forceinline__ void rnn_unit(const Args& a, int l, int u, LAS unsigned char* lds) {
    const int tid = opaque_tid(), lane = tid & 63, wv = tid >> 6, fr = lane & 15, fq = lane >> 4;
    const int xcd = u & 7, jj = u >> 3, q = jj & 3, bh = (jj >> 2) * 8 + xcd, b = bh >> 3, h = bh & 7;
    const bf16* PROJ = (const bf16*)(a.ws + WS_PROJ); bf16* YCAT = (bf16*)(a.ws + WS_YCAT);
    const bf16* xr_base = PROJ + (size_t)(b * SEQ) * NPROJ + h * 128;
    const bf16* gr_base = PROJ + (size_t)(b * SEQ) * NPROJ + 1024 + h * 128 + q * 32;
    bf16* y_base = YCAT + (size_t)(b * SEQ) * DMIX + h * 128 + q * 32;
    LAS unsigned char* XT = lds + R_XT; LAS unsigned char* UT = lds + R_UT;
    LAS float* AT = (LAS float*)(lds + R_AT); LAS float* VT = (LAS float*)(lds + R_VT);
    LAS unsigned char* GT = lds + R_GT; LAS unsigned char* YT = lds + R_YT;
    const int io_tk = tid >> 2, io_cq = tid & 3;
    const int ck = tid & 15, tg = tid >> 4;
    LAS float* CWT = (LAS float*)(lds + R_CWT);
    for (int i = tid; i < 640; i += 512) { const int r = i >> 7, c = i & 127;
        CWT[i] = (r < 4) ? a.in[6][(size_t)l * 4 * 1024 + r * 1024 + h * 128 + c] : a.in[7][(size_t)l * 1024 + h * 128 + c]; }
    bf16x8 Wf[4][4];
    {
        const bf16* gwp = (const bf16*)(a.ws + WS_GW) + (size_t)((l * 8 + h) * 4 + q) * 64 * 128;
#pragma unroll
        for (int nb = 0; nb < 4; ++nb)
#pragma unroll
            for (int kb = 0; kb < 4; ++kb) Wf[nb][kb] = *(const bf16x8*)(gwp + (nb * 16 + fr) * 128 + kb * 32 + fq * 8);
    }
    LAS float* EP = (LAS float*)(lds + R_EP);
    if (tid < 96) {
        const int r = tid >> 5, c = tid & 31, ch = h * 128 + q * 32 + c; float v;
        if (r == 0) v = -1.4426950408889634f * a.in[9][l * 1024 + ch];
        else if (r == 1) v = -1.4426950408889634f * a.in[11][l * 1024 + ch];
        else v = 8.0f * 1.4426950408889634f * softplus_small_(__builtin_expf(-a.in[12][l * 1024 + ch]));
        EP[r * 32 + c] = v;
    }
    u32x4 pf[4], pfh = (u32x4){0u, 0u, 0u, 0u};
#pragma unroll
    for (int i = 0; i < 4; ++i) { const int id = tid + 512 * i, row = id >> 4, cc = id & 15; pf[i] = *(const u32x4*)(xr_base + (size_t)row * NPROJ + cc * 8); }
    u32x4 gpf = *(const u32x4*)(gr_base + (size_t)io_tk * NPROJ + io_cq * 8);
    const int sc_ci = lane >> 4, sc_sg = lane & 15, sc_c = wv * 4 + sc_ci;
    float hcar = 0.f;
#pragma unroll
    for (int i = 0; i < 4; ++i) { const int id = tid + 512 * i, row = id >> 4, cc = id & 15; *(LAS u32x4*)(XT + (3 + row) * XROW + cc * 16) = pf[i]; }
    if (tid < 48) *(LAS u32x4*)(XT + (tid >> 4) * XROW + (tid & 15) * 16) = pfh;
    for (int tile = 0; tile < SEQ / 128; ++tile) {
        const int t0 = tile * 128;
        LDS_BARRIER();
        {
            const int t0n = (tile + 1 < SEQ / 128) ? t0 + 128 : t0;
#pragma unroll
            for (int i = 0; i < 4; ++i) { const int id = tid + 512 * i, row = id >> 4, cc = id & 15; pf[i] = *(const u32x4*)(xr_base + (size_t)(t0n + row) * NPROJ + cc * 8); }
            if (tid < 48) pfh = *(const u32x4*)(xr_base + (size_t)(t0n - 3 + (tid >> 4)) * NPROJ + (tid & 15) * 8);
        }
        {
            {
                unsigned short yv_[8];
#pragma unroll
                for (int e = 0; e < 8; ++e) yv_[e] = *(const LAS unsigned short*)(YT + (io_cq * 8 + e) * XROW + io_tk * 2);
                u32x4 w; w.x = yv_[0] | ((unsigned)yv_[1] << 16); w.y = yv_[2] | ((unsigned)yv_[3] << 16); w.z = yv_[4] | ((unsigned)yv_[5] << 16); w.w = yv_[6] | ((unsigned)yv_[7] << 16);
                *(u32x4*)(y_base + (size_t)((tile > 0 ? t0 - 128 : 0) + io_tk) * DMIX + io_cq * 8) = w;
            }
            const unsigned gwv[4] = {gpf.x, gpf.y, gpf.z, gpf.w};
#pragma unroll
            for (int e2 = 0; e2 < 4; ++e2) { *(LAS unsigned short*)(GT + (io_cq * 8 + 2 * e2) * XROW + io_tk * 2) = (unsigned short)(gwv[e2] & 0xffffu);
                *(LAS unsigned short*)(GT + (io_cq * 8 + 2 * e2 + 1) * XROW + io_tk * 2) = (unsigned short)(gwv[e2] >> 16); }
            const int t1 = (tile + 1 < SEQ / 128) ? t0 + 128 : t0;
            gpf = *(const u32x4*)(gr_base + (size_t)(t1 + io_tk) * NPROJ + io_cq * 8);
        }
        {
            f32x2 o[4][4], cw[4][4];
            {
                const f32x4 b0 = *(const LAS f32x4*)(CWT + 4 * 128 + ck * 8), b1 = *(const LAS f32x4*)(CWT + 4 * 128 + ck * 8 + 4);
#pragma unroll
                for (int i = 0; i < 4; ++i) { o[i][0] = (f32x2){b0.x, b0.y}; o[i][1] = (f32x2){b0.z, b0.w}; o[i][2] = (f32x2){b1.x, b1.y}; o[i][3] = (f32x2){b1.z, b1.w}; }
            }
#pragma unroll
            for (int k = 0; k < 4; ++k) { const f32x4 w0 = *(const LAS f32x4*)(CWT + k * 128 + ck * 8), w1 = *(const LAS f32x4*)(CWT + k * 128 + ck * 8 + 4);
                cw[k][0] = (f32x2){w0.x, w0.y}; cw[k][1] = (f32x2){w0.z, w0.w}; cw[k][2] = (f32x2){w1.x, w1.y}; cw[k][3] = (f32x2){w1.z, w1.w}; }
#pragma unroll
            for (int r = 0; r < 7; ++r) {
                const u32x4 w = *(const LAS u32x4*)(XT + (tg * 4 + r) * XROW + ck * 16);
                const f32x2 xv[4] = {(f32x2){bflo(w.x), bfhi(w.x)}, (f32x2){bflo(w.y), bfhi(w.y)}, (f32x2){bflo(w.z), bfhi(w.z)}, (f32x2){bflo(w.w), bfhi(w.w)}};
#pragma unroll
                for (int i = 0; i < 4; ++i) { const int k = r - i; if (k >= 0 && k < 4) {
#pragma unroll
                    for (int e = 0; e < 4; ++e) o[i][e] = __builtin_elementwise_fma(cw[k][e], xv[e], o[i][e]); } }
            }
#pragma unroll
            for (int i = 0; i < 4; ++i) { u32x4 w; w.x = pk2(o[i][0].x, o[i][0].y); w.y = pk2(o[i][1].x, o[i][1].y); w.z = pk2(o[i][2].x, o[i][2].y); w.w = pk2(o[i][3].x, o[i][3].y);
                *(LAS u32x4*)(UT + (tg * 4 + i) * XROW + ck * 16) = w; }
        }
        asm volatile("s_waitcnt lgkmcnt(0)" ::: "memory");
        {
            f32x4 acc[4];
#pragma unroll
            for (int nb = 0; nb < 4; ++nb) acc[nb] = (f32x4){0.f, 0.f, 0.f, 0.f};
#pragma unroll
            for (int kb = 0; kb < 4; ++kb) { const bf16x8 uf = *(const LAS bf16x8*)(UT + (wv * 16 + fr) * XROW + kb * 64 + fq * 16);
#pragma unroll
                for (int nb = 0; nb < 4; ++nb) acc[nb] = __builtin_amdgcn_mfma_f32_16x16x32_bf16(Wf[nb][kb], uf, acc[nb], 0, 0, 0); }
            const int tk = wv * 16 + fr;
#pragma unroll
            for (int nb2 = 0; nb2 < 2; ++nb2) {
                const int c0 = nb2 * 16 + 4 * fq;
                const u32x2 uw = *(const LAS u32x2*)(UT + tk * XROW + (q * 32 + c0) * 2);
                const f32x4 uu = (f32x4){bflo(uw.x), bfhi(uw.x), bflo(uw.y), bfhi(uw.y)};
                const f32x4 ra = acc[nb2] + *(const LAS f32x4*)(EP + c0), rx = acc[nb2 + 2] + *(const LAS f32x4*)(EP + 32 + c0), sp8 = *(const LAS f32x4*)(EP + 64 + c0);
#pragma unroll
                for (int e = 0; e < 4; ++e) { const float r = __builtin_amdgcn_rcpf(1.0f + __builtin_amdgcn_exp2f(ra[e])), ig = __builtin_amdgcn_rcpf(1.0f + __builtin_amdgcn_exp2f(rx[e]));
                    const float av = __builtin_amdgcn_exp2f(-r * sp8[e]);
                    const float m2 = __builtin_fmaxf(__builtin_fmaf(-av, av, 1.0f), 0.f);
                    AT[(c0 + e) * CROW + tk] = av; VT[(c0 + e) * CROW + tk] = __builtin_amdgcn_sqrtf(m2) * (ig * uu[e]); }
            }
        }
        LDS_BARRIER();
        {
            const f32x4 a0 = *(const LAS f32x4*)(AT + sc_c * CROW + sc_sg * 8), a1 = *(const LAS f32x4*)(AT + sc_c * CROW + sc_sg * 8 + 4);
            const f32x4 v0 = *(const LAS f32x4*)(VT + sc_c * CROW + sc_sg * 8), v1 = *(const LAS f32x4*)(VT + sc_c * CROW + sc_sg * 8 + 4);
            const float av[8] = {a0.x, a0.y, a0.z, a0.w, a1.x, a1.y, a1.z, a1.w}, vv[8] = {v0.x, v0.y, v0.z, v0.w, v1.x, v1.y, v1.z, v1.w};
            float hl[8], pp[8]; float hcur = 0.f, pcur = 1.f;
#pragma unroll
            for (int j = 0; j < 8; ++j) { hcur = __builtin_fmaf(av[j], hcur, vv[j]); pcur *= av[j]; hl[j] = hcur; pp[j] = pcur; }
            float P = pcur, H = hcur;
            { float Pp = dpp_row_shr<1>(1.f, P), Hp = dpp_row_shr<1>(0.f, H); H = __builtin_fmaf(P, Hp, H); P *= Pp;
              Pp = dpp_row_shr<2>(1.f, P); Hp = dpp_row_shr<2>(0.f, H); H = __builtin_fmaf(P, Hp, H); P *= Pp;
              Pp = dpp_row_shr<4>(1.f, P); Hp = dpp_row_shr<4>(0.f, H); H = __builtin_fmaf(P, Hp, H); P *= Pp;
              Pp = dpp_row_shr<8>(1.f, P); Hp = dpp_row_shr<8>(0.f, H); H = __builtin_fmaf(P, Hp, H); P *= Pp; }
            const float Pe = dpp_row_shr<1>(1.f, P), He = dpp_row_shr<1>(0.f, H);
            const float carry = __builtin_fmaf(Pe, hcar, He);
            const float hend = __builtin_fmaf(P, hcar, H);
            hcar = row_last_(hend);
            const u32x4 gq = *(const LAS u32x4*)(GT + sc_c * XROW + sc_sg * 16);
            const float gvv[8] = {bflo(gq.x), bfhi(gq.x), bflo(gq.y), bfhi(gq.y), bflo(gq.z), bfhi(gq.z), bflo(gq.w), bfhi(gq.w)};
            float yy[8];
#pragma unroll
            for (int j = 0; j < 8; ++j) { const float hv = __builtin_fmaf(pp[j], carry, hl[j]); yy[j] = hv * gvv[j] * fast_sigmoid(gvv[j]); }
            u32x4 yw_; yw_.x = pk2(yy[0], yy[1]); yw_.y = pk2(yy[2], yy[3]); yw_.z = pk2(yy[4], yy[5]); yw_.w = pk2(yy[6], yy[7]);
            *(LAS u32x4*)(YT + sc_c * XROW + sc_sg * 16) = yw_;
        }
#pragma unroll
        for (int i = 0; i < 4; ++i) { const int id = tid + 512 * i, row = id >> 4, cc = id & 15; *(LAS u32x4*)(XT + (3 + row) * XROW + cc * 16) = pf[i]; }
        if (tid < 48) *(LAS u32x4*)(XT + (tid >> 4) * XROW + (tid & 15) * 16) = pfh;
    }
    LDS_BARRIER();
    {
        unsigned short yv_[8];
#pragma unroll
        for (int e = 0; e < 8; ++e) yv_[e] = *(const LAS unsigned short*)(YT + (io_cq * 8 + e) * XROW + io_tk * 2);
        u32x4 w; w.x = yv_[0] | ((unsigned)yv_[1] << 16); w.y = yv_[2] | ((unsigned)yv_[3] << 16); w.z = yv_[4] | ((unsigned)yv_[5] << 16); w.w = yv_[6] | ((unsigned)yv_[7] << 16);
        *(u32x4*)(y_base + (size_t)(SEQ - 128 + io_tk) * DMIX + io_cq * 8) = w;
    }
    LDS_BARRIER();
}

constexpr int PROW = 528;
constexpr int R_XP = 0, R_PT = 42240;
template <int g> __device__ __forceinline__ void pool_units(const Args& a, int l, int u, LAS unsigned char* lds) {
    const int tid = opaque_tid(), lane = tid & 63, wv = tid >> 6, fr = lane & 15, fq = lane >> 4;
    const int bi = u >> 2; constexpr int win = 2 << g;
    const bf16* PROJ = (const bf16*)(a.ws + WS_PROJ); bf16* YCAT = (bf16*)(a.ws + WS_YCAT);
    LAS unsigned char* XP = lds + R_XP; LAS unsigned char* PT = lds + R_PT;
    const bf16* pw = (const bf16*)(a.ws + WS_PW) + (size_t)(l * 4 + g) * 256 * 256;
    bf16x8 Wf[2][8];
#pragma unroll
    for (int nb = 0; nb < 2; ++nb)
#pragma unroll
        for (int kb = 0; kb < 8; ++kb) Wf[nb][kb] = *(const bf16x8*)(pw + (size_t)(wv * 32 + 8 * (fr >> 2) + 4 * nb + (fr & 3)) * 256 + kb * 32 + fq * 8);
    f32x4 pb[2], ps[2];
#pragma unroll
    for (int nb = 0; nb < 2; ++nb) { const int n = wv * 32 + 8 * fq + 4 * nb;
        pb[nb] = *(const f32x4*)(a.in[14] + (size_t)l * 1024 + g * 256 + n); ps[nb] = *(const f32x4*)(a.in[15] + (size_t)l * 1024 + g * 256 + n); }
    const int ck = tid & 31, tg = tid >> 5;
    u32x4 pf[5];
    {
        const int tile = bi * 8, b = tile >> 6, t0 = (tile & 63) * 64;
        const bf16* xp_base = PROJ + (size_t)(b * SEQ) * NPROJ + 2048 + g * 256;
#pragma unroll
        for (int i = 0; i < 5; ++i) { const int id = tid + 512 * i, row = id >> 5, cc = id & 31, t = t0 - 16 + row;
            const u32x4 v = *(const u32x4*)(xp_base + (size_t)(t < 0 ? 0 : t) * NPROJ + cc * 8); pf[i] = (t < 0) ? (u32x4){0u, 0u, 0u, 0u} : v; }
    }
#pragma unroll
    for (int i = 0; i < 5; ++i) { const int id = tid + 512 * i, row = id >> 5, cc = id & 31; *(LAS u32x4*)(XP + row * PROW + cc * 16) = pf[i]; }
    u32x4 gp[4];
    {
        const int tile = bi * 8, b = tile >> 6, t0 = (tile & 63) * 64;
        const bf16* gp_base0 = PROJ + (size_t)(b * SEQ) * NPROJ + 3072 + g * 256;
#pragma unroll
        for (int tb = 0; tb < 4; ++tb)
        { gp[tb] = *(const u32x4*)(gp_base0 + (size_t)(t0 + tb * 16 + fr) * NPROJ + wv * 32 + 8 * fq);
                asm volatile("" : "+v"(gp[tb])); }
    }
    for (int it = 0; it < 8; ++it) {
        const int tile = bi * 8 + it, b = tile >> 6, t0 = (tile & 63) * 64;
        bf16* y_base = YCAT + (size_t)(b * SEQ) * DMIX + 1024 + g * 256;
        LDS_BARRIER();
        {
            const int tile2 = bi * 8 + ((it + 1 < 8) ? it + 1 : it), b2 = tile2 >> 6, t02 = (tile2 & 63) * 64;
            const bf16* xp_base = PROJ + (size_t)(b2 * SEQ) * NPROJ + 2048 + g * 256;
#pragma unroll
            for (int i = 0; i < 5; ++i) { const int id = tid + 512 * i, row = id >> 5, cc = id & 31, t = t02 - 16 + row;
                const u32x4 v = *(const u32x4*)(xp_base + (size_t)(t < 0 ? 0 : t) * NPROJ + cc * 8); pf[i] = (t < 0) ? (u32x4){0u, 0u, 0u, 0u} : v; }
        }
        u32x4 gpn[4];
        {
            const int tile2 = bi * 8 + ((it + 1 < 8) ? it + 1 : it), b2 = tile2 >> 6, t02 = (tile2 & 63) * 64;
            const bf16* gp_base2 = PROJ + (size_t)(b2 * SEQ) * NPROJ + 3072 + g * 256;
#pragma unroll
            for (int tb = 0; tb < 4; ++tb)
                gpn[tb] = *(const u32x4*)(gp_base2 + (size_t)(t02 + tb * 16 + fr) * NPROJ + wv * 32 + 8 * fq);
        }
        {
            float s[8];
#pragma unroll
            for (int e = 0; e < 8; ++e) s[e] = 0.f;
            const int r0 = tg * 4 + 16;
#pragma unroll
            for (int r = r0 - win + 1; r < r0; ++r) { const u32x4 w = *(const LAS u32x4*)(XP + r * PROW + ck * 16);
                s[0] += bflo(w.x); s[1] += bfhi(w.x); s[2] += bflo(w.y); s[3] += bfhi(w.y); s[4] += bflo(w.z); s[5] += bfhi(w.z); s[6] += bflo(w.w); s[7] += bfhi(w.w); }
#pragma unroll
            for (int i = 0; i < 4; ++i) {
                const u32x4 w = *(const LAS u32x4*)(XP + (r0 + i) * PROW + ck * 16);
                const float xv[8] = {bflo(w.x), bfhi(w.x), bflo(w.y), bfhi(w.y), bflo(w.z), bfhi(w.z), bflo(w.w), bfhi(w.w)};
                const int t = t0 + tg * 4 + i; const float inv = __builtin_amdgcn_rcpf((float)((t + 1 < win) ? (t + 1) : win));
                float p[8];
#pragma unroll
                for (int e = 0; e < 8; ++e) { s[e] += xv[e]; p[e] = __builtin_fmaf(s[e], inv, -xv[e]); }
                u32x4 o; o.x = pk2(p[0], p[1]); o.y = pk2(p[2], p[3]); o.z = pk2(p[4], p[5]); o.w = pk2(p[6], p[7]);
                *(LAS u32x4*)(PT + (tg * 4 + i) * PROW + ck * 16) = o;
                const u32x4 wo = *(const LAS u32x4*)(XP + (r0 + i - win + 1) * PROW + ck * 16);
                s[0] -= bflo(wo.x); s[1] -= bfhi(wo.x); s[2] -= bflo(wo.y); s[3] -= bfhi(wo.y); s[4] -= bflo(wo.z); s[5] -= bfhi(wo.z); s[6] -= bflo(wo.w); s[7] -= bfhi(wo.w);
            }
        }
        LDS_BARRIER();
#pragma unroll
        for (int tb = 0; tb < 4; ++tb) {
            f32x4 acc[2] = {(f32x4){0.f, 0.f, 0.f, 0.f}, (f32x4){0.f, 0.f, 0.f, 0.f}};
#pragma unroll
            for (int kb = 0; kb < 8; ++kb) { const bf16x8 pfm = *(const LAS bf16x8*)(PT + (tb * 16 + fr) * PROW + kb * 64 + fq * 16);
#pragma unroll
                for (int nb = 0; nb < 2; ++nb) acc[nb] = __builtin_amdgcn_mfma_f32_16x16x32_bf16(Wf[nb][kb], pfm, acc[nb], 0, 0, 0); }
            const int t = t0 + tb * 16 + fr;
            u32x4 o;
#pragma unroll
            for (int nb = 0; nb < 2; ++nb) {
                const unsigned g0 = nb ? gp[tb].z : gp[tb].x, g1 = nb ? gp[tb].w : gp[tb].y;
                const f32x4 gv = (f32x4){bflo(g0), bfhi(g0), bflo(g1), bfhi(g1)};
                f32x4 r = (acc[nb] + pb[nb]) * ps[nb];
#pragma unroll
                for (int e = 0; e < 4; ++e) r[e] *= gv[e] * fast_sigmoid(gv[e]);
                if (nb == 0) { o.x = pk2(r.x, r.y); o.y = pk2(r.z, r.w); } else { o.z = pk2(r.x, r.y); o.w = pk2(r.z, r.w); } }
            *(u32x4*)(y_base + (size_t)t * DMIX + wv * 32 + 8 * fq) = o;
        }
#pragma unroll
        for (int i = 0; i < 5; ++i) { const int id = tid + 512 * i, row = id >> 5, cc = id & 31; *(LAS u32x4*)(XP + row * PROW + cc * 16) = pf[i]; }
#pragma unroll
        for (int tb = 0; tb < 4; ++tb)
            gp[tb] = gpn[tb];
    }
    LDS_BARRIER();
}

__device__ __forceinline__ void phase_mixer(const Args& a, int l, LAS unsigned char* lds) {
#ifndef MK_MIX
#define MK_MIX 3
#endif
#ifndef MK_DBL_RNN
#define MK_DBL_RNN 0
#endif
#ifndef MK_DBL_POOL
#define MK_DBL_POOL 0
#endif
    for (int rep = 0; rep < 1 + ((l == 0) ? MK_DBL_RNN : 0); ++rep) for (int u = blockIdx.x; u < 256; u += gridDim.x) rnn_unit(a, l, u, lds);
    for (int rep = 0; rep < 1 + ((l == 0) ? MK_DBL_POOL : 0); ++rep) for (int u = blockIdx.x; u < 256; u += gridDim.x) { const int g_ = u & 3; if (g_ == 0) pool_units<0>(a, l, u, lds); else if (g_ == 1) pool_units<1>(a, l, u, lds); else if (g_ == 2) pool_units<2>(a, l, u, lds); else pool_units<3>(a, l, u, lds); }
}
#ifndef MK_DBL_PH
#define MK_DBL_PH -1
#endif
#ifndef MK_MASK
#define MK_MASK 63
#endif
__global__ void __launch_bounds__(512, 2) mk_fwd(Args a) {
    extern __shared__ __attribute__((aligned(16))) unsigned char lds_raw[];
    LAS unsigned char* lds = (LAS unsigned char*)lds_raw;
    cg::grid_group grid = cg::this_grid();
    volatile LAS unsigned* bst = (volatile LAS unsigned*)(lds + LDS_BST_OFF);
    if (threadIdx.x < 4) bst[threadIdx.x] = 0u;
    sync_threads_();
    XcdBarrier xbar = xcd_barrier_post((unsigned*)(a.ws + WS_CTL), bst);
#define GRID_BAR() do { if (a.ph_hi - a.ph_lo > 64) grid.sync(); else xcd_barrier(xbar); } while (0)
    for (int ph = a.ph_lo; ph < a.ph_hi; ++ph) {
#if MK_DBL_PH >= 0
      for (int rep = 0; rep < ((ph == MK_DBL_PH) ? 2 : 1); ++rep) {
        if (rep) GRID_BAR();
#endif
        if (ph == 0) { if (MK_MASK & 1) phase_prep(a, lds); }
        else if (ph == 1) { if (MK_MASK & 2) phase_h0(a); }
        else {
            const int l = (ph - 2) >> 2, sub = (ph - 2) & 3;
            if (sub == 0) { if (MK_MASK & 4) {
                pg8::Gemm g{(const pg8::bf16_t*)(a.ws + WS_H), (const pg8::bf16_t*)(a.ws + WS_WIN) + (size_t)l * NPROJ * D, T, NPROJ, D};
                pg8::StaticOrder S; S.init(T, NPROJ, gridDim.x, (int)blockIdx.x);
                pg8::EpiBf16<0> E{(pg8::bf16_t*)(a.ws + WS_PROJ), NPROJ, nullptr, 0, 0, 1.f};
                pg8::gemm_phase<pg8::EpiBf16<0>, pg8::StaticOrder, PG8_ALIGN, PG8_SP2>(lds, g, S, E); }
            } else if (sub == 1) {
                if (MK_MASK & 8) phase_mixer(a, l, lds);
            } else if (sub == 2) { if (MK_MASK & 16) {
                pg8::Gemm g{(const pg8::bf16_t*)(a.ws + WS_YCAT), (const pg8::bf16_t*)(a.ws + WS_WOUT) + (size_t)l * D * DMIX, T, D, DMIX};
                pg8::StaticOrder S; S.init(T, D, gridDim.x, (int)blockIdx.x);
                pg8::EpiBf16<0> E{(pg8::bf16_t*)(a.ws + WS_Y), D, nullptr, 0, 0, 1.f};
                pg8::gemm_phase<pg8::EpiBf16<0>, pg8::StaticOrder, PG8_ALIGN, PG8_SP2>(lds, g, S, E); }
            } else {
                if (MK_MASK & 32) { if (l == 0) phase_post<0>(a); else phase_post<1>(a); }
            }
        }
#if MK_DBL_PH >= 0
      }
#endif
        if (ph + 1 < a.ph_hi) GRID_BAR();
    }
}

#if defined(__HIP_DEVICE_COMPILE__)
#pragma clang attribute pop
#endif

extern "C" void kernel_launch(void* const* d_in, const int* in_sizes, int n_in, void* d_out, int out_size, void* d_ws, size_t ws_size, hipStream_t stream) {
    static int grid = 0;
    if (grid == 0) {
        if (n_in != 18 || in_sizes[0] != T * D || out_size != T * D || ws_size < WS_END) {
            fprintf(stderr, "kernel_launch: unexpected shapes (n_in %d, in0 %d, out %d, ws %zu); nothing launched\n", n_in, n_in > 0 ? in_sizes[0] : -1, out_size, ws_size); grid = -1; return; }
        int dev = 0, cus = 0, per_cu = 0;
        if (hipGetDevice(&dev) != hipSuccess || hipDeviceGetAttribute(&cus, hipDeviceAttributeMultiprocessorCount, dev) != hipSuccess) { grid = -1; return; }
        if (hipFuncSetAttribute((const void*)mk_fwd, hipFuncAttributeMaxDynamicSharedMemorySize, LDS_BYTES) != hipSuccess) { fprintf(stderr, "kernel_launch: hipFuncSetAttribute failed\n"); grid = -1; return; }
        if (hipOccupancyMaxActiveBlocksPerMultiprocessor(&per_cu, (const void*)mk_fwd, 512, LDS_BYTES) != hipSuccess || per_cu < 1) { fprintf(stderr, "kernel_launch: occupancy query says %d blocks per CU\n", per_cu); per_cu = 1; }
        (void)hipGetLastError();
        grid = cus;
    }
    if (grid < 0) return;
    Args a{};
    for (int i = 0; i < 18; ++i) a.in[i] = (const float*)d_in[i];
    a.out = (float*)d_out; a.ws = (unsigned char*)d_ws;
    if (hipMemsetAsync((char*)d_ws + WS_CTL, 0, CTL_BYTES, stream) != hipSuccess) { fprintf(stderr, "kernel_launch: memset of the barrier words failed\n"); return; }
#if MK_N_LAUNCHES == 1
    a.ph_lo = 0; a.ph_hi = NPH;
    void* args[] = {&a};
    const hipError_t e = hipLaunchCooperativeKernel((const void*)mk_fwd, dim3(grid), dim3(512), args, LDS_BYTES, stream);
    if (e != hipSuccess) fprintf(stderr, "kernel_launch: cooperative launch failed: %s (grid %d)\n", hipGetErrorString(e), grid);
#else
    for (int ph = 0; ph < NPH; ++ph) {
        a.ph_lo = ph; a.ph_hi = ph + 1;
        hipLaunchKernelGGL(mk_fwd, dim3(grid), dim3(512), LDS_BYTES, stream, a);
    }
#endif
}
```

```cpp
#include <hip/hip_runtime.h>
#include <hip/hip_cooperative_groups.h>
#include <cstdio>
#include <cstdint>
namespace cg = cooperative_groups;
__device__ __forceinline__ int opaque_tid() { int t = threadIdx.x; asm volatile("" : "+v"(t)); return t; }
#if defined(__HIP_DEVICE_COMPILE__)
#pragma clang attribute push (__attribute__((target("no-packed-fp32-ops"))), apply_to = function)
#endif
__device__ __forceinline__ float u2f(unsigned x) { return __builtin_bit_cast(float, x); }
__device__ __forceinline__ float i2f(int x) { return __builtin_bit_cast(float, x); }
__device__ __forceinline__ int f2i(float x) { return __builtin_bit_cast(int, x); }
__device__ __forceinline__ int lane_id_() { return (int)__builtin_amdgcn_mbcnt_hi(~0u, __builtin_amdgcn_mbcnt_lo(~0u, 0u)); }
__device__ __forceinline__ float shfl_xor_(float v, int o) { return i2f(__builtin_amdgcn_ds_bpermute((lane_id_() ^ o) << 2, f2i(v))); }
__device__ __forceinline__ float row_last_(float v) { return i2f(__builtin_amdgcn_ds_bpermute((lane_id_() | 15) << 2, f2i(v))); }
__device__ __forceinline__ void sync_threads_() { __builtin_amdgcn_fence(__ATOMIC_RELEASE, "workgroup"); __builtin_amdgcn_s_barrier(); __builtin_amdgcn_fence(__ATOMIC_ACQUIRE, "workgroup"); }
namespace pg8 {
#define PG8_LAS __attribute__((address_space(3)))
typedef unsigned short bf16_t;
typedef short bf16x8 __attribute__((ext_vector_type(8)));
typedef float f32x4 __attribute__((ext_vector_type(4)));
typedef unsigned u32x4 __attribute__((ext_vector_type(4)));
constexpr int BM = 256, BK = 64, HALF = 128, HTB = HALF * BK * 2  , STAGE_BYTES = 8 * HTB, NXCD = 8, WGM = 8;

__host__ __device__ __forceinline__ int lds_byte(int r, int c) { const int st = (r >> 4) * 2 + (c >> 5), rr = r & 15, cc = c & 31, ob = rr * 64 + cc * 2; return st * 1024 + (ob ^ (((ob >> 9) & 1) << 5)); }
__host__ __device__ __forceinline__ void stage_rc(int b, int& R, int& C) { const int st = b / 1024, sb = b % 1024, swz = sb ^ (((sb >> 9) & 1) << 5); R = (st >> 1) * 16 + swz / 64; C = (st & 1) * 32 + (swz % 64) / 2; }
__host__ __device__ __forceinline__ int perm32(int rho) { const int n = rho >> 4, i = rho & 15; return 8 * (i >> 2) + 4 * n + (i & 3); }

struct Unit { int pm, pn; };
struct Gemm { const bf16_t* A; const bf16_t* Bt; int M, N, K; };

struct StaticOrder {
    int nM, nN, nwg, G, c;
    __host__ __device__ void init(int M, int N, int G_, int c_) { nM = M / BM; nN = N / BM; nwg = nM * nN; G = G_; c = c_; }
    __host__ __device__ bool next(int i, Unit& u) const {
        const long L = (long)i * G + c; if (L >= nwg) return false;
        int wgid = (int)L; { const int q = nwg / NXCD, r = nwg % NXCD, xcd = wgid % NXCD, off = wgid / NXCD; wgid = (xcd < r ? xcd * (q + 1) : r * (q + 1) + (xcd - r) * q) + off; }
        const int nig = WGM * nN, gid = wgid / nig, fm = gid * WGM, gsz = (nM - fm) < WGM ? (nM - fm) : WGM;
        u.pm = fm + ((wgid % nig) % gsz); u.pn = (wgid % nig) / gsz; return true;
    }
    __device__ __forceinline__ void a_ready(const Unit&) const {}
    __device__ __forceinline__ void done(const Unit&) const {}
};

__device__ __forceinline__ unsigned cvt_pk_bf16(float lo, float hi) { unsigned r; asm volatile("v_cvt_pk_bf16_f32 %0, %1, %2" : "=v"(r) : "v"(lo), "v"(hi)); return r; }
typedef float f32x2 __attribute__((ext_vector_type(2)));
__device__ __forceinline__ f32x2 gelu_pk(f32x2 v) {
    const f32x2 av = __builtin_elementwise_abs(v), d = av * 0.2316418882f + 1.0f;
    f32x2 t; t.x = __builtin_amdgcn_rcpf(d.x); t.y = __builtin_amdgcn_rcpf(d.y);
    f32x2 q = t * 0.5307027145f + (-0.7265760135f); q = q * t + 0.7107068705f; q = q * t + (-0.142248368f); q = q * t + 0.127414796f; q = q * t;
    const f32x2 s = (v * v) * (-0.72134752044f);
    f32x2 e; e.x = __builtin_amdgcn_exp2f(s.x); e.y = __builtin_amdgcn_exp2f(s.y);
    const f32x2 m = v * (q * e), r = v - m;
    f32x2 o; o.x = v.x < 0.f ? m.x : r.x; o.y = v.y < 0.f ? m.y : r.y; return o;
}

template <int ACT  > struct EpiBf16 {
    static constexpr bool PERM = true, AFTER_DRAIN = false; static_assert(ACT == 0 || ACT == 1, "EpiBf16: ACT is 0 (none) or 1 (gelu_pk)");
    bf16_t* O; int ldc; const float* bias; int split_cols; size_t split_stride; float scale0;
    __device__ __forceinline__ void operator()(const f32x4 (&acc)[2][2][4][2], const Unit& u, int wr, int wc, int fr, int fq) const {
        const int row0 = u.pm * BM + wr * 64 + fr; int colt = u.pn * BM; bf16_t* base = O;
        float sc = 1.f; if (split_cols) { const int t = colt / split_cols; base += (size_t)t * split_stride; colt -= t * split_cols; if (t == 0) sc = scale0; }
        const int col0 = colt + wc * 32 + 8 * fq, bcol0 = u.pn * BM + wc * 32 + 8 * fq;
        f32x4 bv[2][2];
#pragma unroll
        for (int bj = 0; bj < 2; ++bj)
#pragma unroll
            for (int n = 0; n < 2; ++n) bv[bj][n] = bias ? *(const f32x4*)(bias + bcol0 + bj * HALF + 4 * n) : (f32x4){0.f, 0.f, 0.f, 0.f};
#pragma unroll
        for (int ai = 0; ai < 2; ++ai)
#pragma unroll
            for (int m = 0; m < 4; ++m) { bf16_t* rowp = base + (size_t)(row0 + ai * HALF + m * 16) * ldc + col0;
#pragma unroll
                for (int bj = 0; bj < 2; ++bj) { f32x4 v0 = acc[ai][bj][m][0] + bv[bj][0], v1 = acc[ai][bj][m][1] + bv[bj][1];
                    if (ACT == 1) { f32x2 a = gelu_pk((f32x2){v0[0], v0[1]}), b = gelu_pk((f32x2){v0[2], v0[3]}), c = gelu_pk((f32x2){v1[0], v1[1]}), d = gelu_pk((f32x2){v1[2], v1[3]});
                        v0 = (f32x4){a.x, a.y, b.x, b.y}; v1 = (f32x4){c.x, c.y, d.x, d.y}; }
                    v0 = v0 * sc; v1 = v1 * sc; u32x4 w; w.x = cvt_pk_bf16(v0[0], v0[1]); w.y = cvt_pk_bf16(v0[2], v0[3]); w.z = cvt_pk_bf16(v1[0], v1[1]); w.w = cvt_pk_bf16(v1[2], v1[3]);
                    *(u32x4*)(rowp + bj * HALF) = w; } }
    }
};
template <class Epi, class Sched, bool ALIGN_EPI = false, bool SP2 = false>
__device__ __forceinline__ void gemm_phase(PG8_LAS unsigned char* lds, const Gemm g, const Sched& S, const Epi& E) {
    const int tid = opaque_tid(), wid = __builtin_amdgcn_readfirstlane(tid >> 6), lane = tid & 63, wr = wid >> 2, wc = wid & 3, fr = lane & 15, fq = lane >> 4;
    const int K = g.K, nt = K / BK;
    unsigned voffA[2], voffB[2];
#pragma unroll
    for (int i = 0; i < 2; ++i) { int R, C; stage_rc(tid * 16 + i * 8192, R, C); const int Rb = Epi::PERM ? ((R & ~31) + perm32(R & 31)) : R;
        voffA[i] = (unsigned)(R * K + C) * 2u; voffB[i] = (unsigned)(Rb * K + C) * 2u; }
    const size_t kstep = (size_t)(BK * 2);
    const size_t hstep = (size_t)HALF * K * 2;
    const size_t tstep = 2 * hstep;
    const unsigned ldsw = (unsigned)wid * 1024u;
    const int aoff = lds_byte(wr * 64 + fr, fq * 8), boff = lds_byte(wc * 32 + fr, fq * 8);
#define PG8_SA(b, h) (((b) * 2 + (h)) * HTB)
#define PG8_SB(b, h) ((4 + (b) * 2 + (h)) * HTB)
#define PG8_STAGE(bufoff, gbase, voff) do { _Pragma("unroll") for (int _i = 0; _i < 2; ++_i) \
        __builtin_amdgcn_global_load_lds((const unsigned*)((const char*)(gbase) + (voff)[_i]), (PG8_LAS unsigned*)(lds + (bufoff) + ldsw + _i * 8192), 16, 0, 0); } while (0)
#define PG8_LDA(dst, b, h) do { _Pragma("unroll") for (int m = 0; m < 4; ++m) _Pragma("unroll") for (int k = 0; k < 2; ++k) dst[m][k] = *(const PG8_LAS bf16x8*)(lds + PG8_SA(b, h) + aoff + m * 2048 + k * 1024); } while (0)
#define PG8_LDB(dst, b, h) do { _Pragma("unroll") for (int n = 0; n < 2; ++n) _Pragma("unroll") for (int k = 0; k < 2; ++k) dst[n][k] = *(const PG8_LAS bf16x8*)(lds + PG8_SB(b, h) + boff + n * 2048 + k * 1024); } while (0)
#define PG8_MMA(ai, bj, At, Bt) do { __builtin_amdgcn_s_setprio(1); _Pragma("unroll") for (int m = 0; m < 4; ++m) _Pragma("unroll") for (int n = 0; n < 2; ++n) _Pragma("unroll") for (int k = 0; k < 2; ++k) \
        acc[ai][bj][m][n] = __builtin_amdgcn_mfma_f32_16x16x32_bf16(Bt[n][k], At[m][k], acc[ai][bj][m][n], 0, 0, 0); __builtin_amdgcn_s_setprio(0); } while (0)
#define PG8_WAIT_V(n) asm volatile("s_waitcnt vmcnt(" #n ")" ::: "memory")
#define PG8_WAIT_L(n) asm volatile("s_waitcnt lgkmcnt(" #n ")" ::: "memory")
#define PG8_BAR __builtin_amdgcn_s_barrier()
#define PG8_SCHED __builtin_amdgcn_sched_barrier(0)
    Unit cur, nxt; int ui = 0;
    if (!S.next(0, cur)) return;
    f32x4 acc[2][2][4][2];
#pragma unroll
    for (int a = 0; a < 2; ++a)
#pragma unroll
        for (int b = 0; b < 2; ++b)
#pragma unroll
            for (int m = 0; m < 4; ++m)
#pragma unroll
                for (int n = 0; n < 2; ++n) acc[a][b][m][n] = (f32x4){0.f, 0.f, 0.f, 0.f};
    bf16x8 At[4][2], B0[2][2], B1[2][2];
    const char* cA = (const char*)g.A + (size_t)cur.pm * tstep; const char* cB = (const char*)g.Bt + (size_t)cur.pn * tstep;
    S.a_ready(cur);
    if constexpr (SP2) {
        PG8_STAGE(PG8_SB(0, 0), cB, voffB); PG8_STAGE(PG8_SB(0, 1), cB + hstep, voffB); PG8_STAGE(PG8_SA(0, 0), cA, voffA); PG8_STAGE(PG8_SA(0, 1), cA + hstep, voffA);
        if (wr == 1) PG8_BAR;
        PG8_WAIT_V(2); PG8_BAR;
        PG8_STAGE(PG8_SB(1, 0), cB + kstep, voffB); PG8_STAGE(PG8_SA(1, 0), cA + kstep, voffA); PG8_STAGE(PG8_SB(1, 1), cB + hstep + kstep, voffB);
        PG8_WAIT_V(6); PG8_BAR;
    } else {
        PG8_STAGE(PG8_SB(0, 0), cB, voffB); PG8_STAGE(PG8_SA(0, 0), cA, voffA); PG8_STAGE(PG8_SB(0, 1), cB + hstep, voffB); PG8_STAGE(PG8_SA(0, 1), cA + hstep, voffA);
        if (wr == 1) PG8_BAR;
        PG8_WAIT_V(4); PG8_BAR;
        PG8_STAGE(PG8_SB(1, 0), cB + kstep, voffB); PG8_STAGE(PG8_SA(1, 0), cA + kstep, voffA); PG8_STAGE(PG8_SB(1, 1), cB + hstep + kstep, voffB);
        PG8_WAIT_V(6); PG8_BAR;
    }
    for (;;) {
        const bool has_next = S.next(ui + 1, nxt);
        const char* nA = has_next ? (const char*)g.A + (size_t)nxt.pm * tstep : cA; const char* nB = has_next ? (const char*)g.Bt + (size_t)nxt.pn * tstep : cB;
        for (int t = 0; t < nt; t += 2) {
            const bool last = (t == nt - 2);
            const char* a1 = cA + (size_t)(t + 1) * kstep;
            const char* a2 = last ? nA : cA + (size_t)(t + 2) * kstep; const char* b2 = last ? nB : cB + (size_t)(t + 2) * kstep;
            const char* a3 = a2 + kstep; const char* b3 = b2 + kstep;
            if (last && has_next) S.a_ready(nxt);
            if constexpr (SP2) {
            PG8_LDB(B0, 0, 0); PG8_LDB(B1, 0, 1); PG8_SCHED; PG8_LDA(At, 0, 0); PG8_STAGE(PG8_SA(1, 1), a1 + hstep, voffA);
            PG8_WAIT_V(8); PG8_WAIT_L(0); PG8_BAR; PG8_MMA(0, 0, At, B0); PG8_MMA(0, 1, At, B1); PG8_BAR; PG8_SCHED;
            PG8_LDA(At, 0, 1); PG8_STAGE(PG8_SB(0, 0), b2, voffB); PG8_STAGE(PG8_SB(0, 1), b2 + hstep, voffB); PG8_STAGE(PG8_SA(0, 0), a2, voffA);
            PG8_WAIT_V(8); PG8_WAIT_L(0); PG8_BAR; PG8_MMA(1, 0, At, B0); PG8_MMA(1, 1, At, B1); PG8_BAR; PG8_SCHED;
            PG8_LDB(B0, 1, 0); PG8_LDB(B1, 1, 1); PG8_SCHED; PG8_LDA(At, 1, 0); PG8_STAGE(PG8_SA(0, 1), a2 + hstep, voffA);
            PG8_WAIT_V(8); PG8_WAIT_L(0); PG8_BAR; PG8_MMA(0, 0, At, B0); PG8_MMA(0, 1, At, B1); PG8_BAR; PG8_SCHED;
            PG8_LDA(At, 1, 1); PG8_STAGE(PG8_SB(1, 0), b3, voffB); PG8_STAGE(PG8_SB(1, 1), b3 + hstep, voffB); PG8_STAGE(PG8_SA(1, 0), a3, voffA);
            PG8_WAIT_V(8); PG8_WAIT_L(0); PG8_BAR; PG8_MMA(1, 0, At, B0); PG8_MMA(1, 1, At, B1); PG8_BAR; PG8_SCHED;
            } else {
            PG8_LDB(B0, 0, 0); PG8_SCHED; PG8_LDA(At, 0, 0); PG8_STAGE(PG8_SA(1, 1), a1 + hstep, voffA);
            PG8_WAIT_L(8); PG8_BAR; PG8_WAIT_L(0); PG8_MMA(0, 0, At, B0); PG8_BAR; PG8_SCHED;
            PG8_LDB(B1, 0, 1); PG8_STAGE(PG8_SB(0, 0), b2, voffB);
            PG8_BAR; PG8_WAIT_L(0); PG8_MMA(0, 1, At, B1); PG8_BAR;
            PG8_LDA(At, 0, 1); PG8_STAGE(PG8_SA(0, 0), a2, voffA);
            PG8_BAR; PG8_WAIT_L(0); PG8_MMA(1, 0, At, B0); PG8_BAR; PG8_SCHED;
            PG8_STAGE(PG8_SB(0, 1), b2 + hstep, voffB);
            PG8_WAIT_V(6); PG8_BAR; PG8_MMA(1, 1, At, B1); PG8_BAR;
            PG8_LDB(B0, 1, 0); PG8_SCHED; PG8_LDA(At, 1, 0); PG8_STAGE(PG8_SA(0, 1), a2 + hstep, voffA);
            PG8_WAIT_L(8); PG8_BAR; PG8_WAIT_L(0); PG8_MMA(0, 0, At, B0); PG8_BAR; PG8_SCHED;
            PG8_LDB(B1, 1, 1); PG8_STAGE(PG8_SB(1, 0), b3, voffB);
            PG8_BAR; PG8_WAIT_L(0); PG8_MMA(0, 1, At, B1); PG8_BAR;
            PG8_LDA(At, 1, 1); PG8_STAGE(PG8_SA(1, 0), a3, voffA);
            PG8_BAR; PG8_WAIT_L(0); PG8_MMA(1, 0, At, B0); PG8_BAR; PG8_SCHED;
            PG8_STAGE(PG8_SB(1, 1), b3 + hstep, voffB);
            PG8_WAIT_V(6); PG8_BAR; PG8_MMA(1, 1, At, B1); PG8_BAR;
            }
        }
        if constexpr (ALIGN_EPI) { if (wr == 0) PG8_BAR; }
        if constexpr (!Epi::AFTER_DRAIN) { E(acc, cur, wr, wc, fr, fq); S.done(cur); }
        if (!has_next) break;
#pragma unroll
        for (int a = 0; a < 2; ++a)
#pragma unroll
            for (int b = 0; b < 2; ++b)
#pragma unroll
                for (int m = 0; m < 4; ++m)
#pragma unroll
                    for (int n = 0; n < 2; ++n) acc[a][b][m][n] = (f32x4){0.f, 0.f, 0.f, 0.f};
        cur = nxt; cA = nA; cB = nB; ++ui;
        if constexpr (ALIGN_EPI) { if (wr == 1) PG8_BAR; }
    }
    PG8_WAIT_V(0);
    if constexpr (!ALIGN_EPI) { if (wr == 0) PG8_BAR; }
    PG8_BAR;
    if constexpr (Epi::AFTER_DRAIN) { E.fused(acc, cur, wr, wc, fr, fq, lds, wid, lane); S.done(cur); }
#undef PG8_SA
#undef PG8_SB
#undef PG8_STAGE
#undef PG8_LDA
#undef PG8_LDB
#undef PG8_MMA
#undef PG8_WAIT_V
#undef PG8_WAIT_L
#undef PG8_BAR
#undef PG8_SCHED
}
}
#ifndef PG8_SP2
#define PG8_SP2 true
#endif
#ifndef PG8_ALIGN
#define PG8_ALIGN true
#endif
#ifndef MK_N_LAUNCHES
#define MK_N_LAUNCHES 1
#endif

constexpr int NB = 8, SEQ = 4096, D = 1024, T = NB * SEQ, NPROJ = 4096, DMIX = 2048;
constexpr int PSTR = 1024; constexpr size_t PSEG = (size_t)T * 1024;
constexpr int NPH = 10;
constexpr float EPS = 1e-6f;
constexpr size_t MiB = 1u << 20;
constexpr size_t WS_WIN = 0, WS_WOUT = 16 * MiB, WS_GW = 24 * MiB, WS_PW = 25 * MiB, WS_MOD = 26 * MiB;
constexpr size_t WS_H = 32 * MiB, WS_YCAT = 96 * MiB, WS_PROJ = 224 * MiB, WS_Y = WS_PROJ, WS_U = WS_H, WS_END = 480 * MiB;
constexpr size_t WS_CTL = 28 * MiB, CTL_BYTES = 16384;
constexpr int LDS_BYTES = 147456, LDS_BST_OFF = 131072 + 64;

#define LAS __attribute__((address_space(3)))
typedef unsigned short bf16;
typedef float f32x4 __attribute__((ext_vector_type(4)));
typedef float f32x2 __attribute__((ext_vector_type(2)));
typedef unsigned u32x4 __attribute__((ext_vector_type(4)));
typedef unsigned u32x2 __attribute__((ext_vector_type(2)));
typedef short bf16x8 __attribute__((ext_vector_type(8)));

struct Args { const float* in[18]; float* out; unsigned char* ws; int ph_lo, ph_hi; };

__device__ __forceinline__ unsigned pk2(float lo, float hi) { return pg8::cvt_pk_bf16(lo, hi); }
__device__ __forceinline__ float bflo(unsigned w) { return u2f(w << 16); }
__device__ __forceinline__ float bfhi(unsigned w) { return u2f(w & 0xffff0000u); }
template <int CTRL> __device__ __forceinline__ float dpp_mov_(float v) { return i2f(__builtin_amdgcn_update_dpp(0, f2i(v), CTRL, 0xf, 0xf, true)); }
__device__ __forceinline__ float wave_sum(float v) {
    v += dpp_mov_<0xB1>(v);
    v += dpp_mov_<0x4E>(v);
    v += dpp_mov_<0x141>(v);
    v += dpp_mov_<0x140>(v);
    const float r0 = i2f(__builtin_amdgcn_readlane(f2i(v), 0)), r1 = i2f(__builtin_amdgcn_readlane(f2i(v), 16));
    const float r2 = i2f(__builtin_amdgcn_readlane(f2i(v), 32)), r3 = i2f(__builtin_amdgcn_readlane(f2i(v), 48));
    return (r0 + r1) + (r2 + r3);
}
__device__ __forceinline__ float sigmoidf_(float x) { return 1.0f / (1.0f + __expf(-x)); }
__device__ __forceinline__ float siluf_(float x) { return x / (1.0f + __expf(-x)); }

__device__ __forceinline__ void transpose_tile(const float* W, int K, int N, bf16* WT, LAS float* scr, int k0, int n0, int drow, int lane, float wscale = 1.0f) {
    {
        f32x4 v[8];
#pragma unroll
        for (int i = 0; i < 8; ++i) v[i] = *(const f32x4*)(W + (size_t)(k0 + (lane >> 3) + 8 * i) * N + n0 + (lane & 7) * 4);
#pragma unroll
        for (int i = 0; i < 8; ++i) { LAS float* d = scr + ((lane >> 3) + 8 * i) * 33 + (lane & 7) * 4; d[0] = v[i].x * wscale; d[1] = v[i].y * wscale; d[2] = v[i].z * wscale; d[3] = v[i].w * wscale; }
    }
    asm volatile("s_waitcnt lgkmcnt(0)" ::: "memory");
    const int c = lane & 7;
#pragma unroll
    for (int j = 0; j < 4; ++j) { const int n = (lane >> 3) + 8 * j; const LAS float* s = scr + (8 * c) * 33 + n;
        u32x4 o; o.x = pk2(s[0 * 33], s[1 * 33]); o.y = pk2(s[2 * 33], s[3 * 33]); o.z = pk2(s[4 * 33], s[5 * 33]); o.w = pk2(s[6 * 33], s[7 * 33]);
        *(u32x4*)(WT + (size_t)(drow + n) * K + k0 + 8 * c) = o; }
    asm volatile("s_waitcnt lgkmcnt(0)" ::: "memory");
}
__device__ __forceinline__ void transpose_item(const float* W, int K, int N, bf16* WT, LAS float* scr, int item, int lane) {
    const int nblk = N / 32, kb = item / nblk, nb = item % nblk;
    transpose_tile(W, K, N, WT, scr, 64 * kb, 32 * nb, 32 * nb, lane);
}

__device__ __forceinline__ void phase_prep(const Args& a, LAS unsigned char* lds) {
    const int tid = opaque_tid(), lane = tid & 63, wv = tid >> 6;
    const int G = gridDim.x;
    unsigned char* ws = a.ws;
    {
        LAS float* sc = (LAS float*)lds;
        LAS float* red = (LAS float*)(lds + 32768);
        const float* c = a.in[1]; const float* ada_w = a.in[2]; const float* ada_b = a.in[3];
        float* MOD = (float*)(ws + WS_MOD);
        if ((int)blockIdx.x < 192) {
            for (int i = tid; i < 8192; i += 512) sc[i] = siluf_(c[i]);
            sync_threads_();
            for (int unit = blockIdx.x; unit < 192; unit += G) {
                const int l = unit / 96, cb = (unit % 96) * 32, cl = tid & 31, ks = tid >> 5;
                const float* wp = ada_w + (size_t)l * 1024 * 3072 + (size_t)(ks * 64) * 3072 + cb + cl;
                float acc[8];
#pragma unroll
                for (int b = 0; b < 8; ++b) acc[b] = 0.f;
#pragma unroll 16
                for (int k = 0; k < 64; ++k) { const float w = wp[(size_t)k * 3072];
#pragma unroll
                    for (int b = 0; b < 8; ++b) acc[b] += sc[b * 1024 + ks * 64 + k] * w; }
#pragma unroll
                for (int b = 0; b < 8; ++b) red[(ks * 8 + b) * 32 + cl] = acc[b];
                sync_threads_();
                if (tid < 256) { const int b = tid >> 5; float s = 0.f;
#pragma unroll
                    for (int k2 = 0; k2 < 16; ++k2) s += red[(k2 * 8 + b) * 32 + cl];
                    MOD[(l * 8 + b) * 3072 + cb + cl] = s + ada_b[l * 3072 + cb + cl]; }
                sync_threads_();
            }
        }
        sync_threads_();
    }
    {
        LAS float* scr = (LAS float*)(lds + wv * 16384);
        const int gw = blockIdx.x * 8 + wv, NGW = G * 8;
        constexpr int I_IN = (1024 / 64) * (4096 / 32), I_OUT = (2048 / 64) * (1024 / 32);
        for (int it = gw; it < 2 * (I_IN + I_OUT); it += NGW) {
            int r = it;
            if (r < 2 * I_IN) { const int l = r / I_IN; r -= l * I_IN;
                transpose_item(a.in[5] + (size_t)l * 1024 * 4096, 1024, 4096, (bf16*)(ws + WS_WIN) + (size_t)l * 4096 * 1024, scr, r, lane); }
            else { r -= 2 * I_IN; const int l = r / I_OUT; r -= l * I_OUT;
                transpose_item(a.in[16] + (size_t)l * 2048 * 1024, 2048, 1024, (bf16*)(ws + WS_WOUT) + (size_t)l * 1024 * 2048, scr, r, lane); }
        }
    }
    {
        LAS float* scr = (LAS float*)(lds + wv * 16384);
        const int gw = blockIdx.x * 8 + wv, NGW = G * 8;
        bf16* GWp = (bf16*)(ws + WS_GW); bf16* PWp = (bf16*)(ws + WS_PW);
        for (int it = NGW - 1 - gw; it < 512; it += NGW) {
            if (it < 256) { const int lh = it >> 4, r = it & 15, gate = r >> 3, kb = (r >> 2) & 1, q = r & 3;
                transpose_tile((gate ? a.in[10] : a.in[8]) + (size_t)lh * 128 * 128, 128, 128, GWp + (size_t)lh * 4 * 64 * 128, scr, 64 * kb, 32 * q, q * 64 + gate * 32, lane, -1.4426950408889634f); }
            else { const int r = it - 256, lg = r >> 5, kb = (r >> 3) & 3, nb = r & 7;
                transpose_tile(a.in[13] + (size_t)lg * 256 * 256, 256, 256, PWp + (size_t)lg * 256 * 256, scr, 64 * kb, 32 * nb, 32 * nb, lane); }
        }
    }
}

constexpr int RPW = 4;
__device__ __forceinline__ void phase_h0(const Args& a) {
    const int tid = opaque_tid(), lane = tid & 63, wv = tid >> 6;
    const int gw = blockIdx.x * 8 + wv, NGW = gridDim.x * 8;
    const float* x = a.in[0]; const float* g = a.in[4]; const float* MOD = (const float*)(a.ws + WS_MOD);
    bf16* H = (bf16*)(a.ws + WS_H);
    const int WPB = NGW / NB, b = gw / WPB, wq = gw % WPB;
    const float* sh = MOD + (size_t)b * 3072; const float* scl = sh + 1024;
    f32x4 A1[4], SH[4];
#pragma unroll
    for (int j = 0; j < 4; ++j) { const int col = 4 * lane + 256 * j; A1[j] = *(const f32x4*)(g + col) * (*(const f32x4*)(scl + col) + 1.0f); SH[j] = *(const f32x4*)(sh + col); }
    for (int mr = wq * RPW; mr < SEQ; mr += WPB * RPW) {
        const int m0 = b * SEQ + mr;
        f32x4 v[RPW][4];
#pragma unroll
        for (int r = 0; r < RPW; ++r) { const f32x4* xr = (const f32x4*)(x + (size_t)(m0 + r) * D) + lane;
#pragma unroll
            for (int j = 0; j < 4; ++j) v[r][j] = __builtin_nontemporal_load(xr + 64 * j); }
#pragma unroll
        for (int r = 0; r < RPW; ++r) {
            float ss = 0.f;
#pragma unroll
            for (int j = 0; j < 4; ++j) ss += (v[r][j].x * v[r][j].x + v[r][j].y * v[r][j].y) + (v[r][j].z * v[r][j].z + v[r][j].w * v[r][j].w);
            const float rstd = 1.0f / __builtin_sqrtf(wave_sum(ss) * (1.0f / D) + EPS);
            u32x2* o = (u32x2*)(H + (size_t)(m0 + r) * D) + lane;
#pragma unroll
            for (int j = 0; j < 4; ++j) {
                const f32x4 rr = (v[r][j] * rstd) * A1[j] + SH[j];
                u32x2 w; w.x = pk2(rr.x, rr.y); w.y = pk2(rr.z, rr.w); o[64 * j] = w; }
        }
    }
}

template <int l> __device__ __forceinline__ void phase_post(const Args& a) {
    const int tid = opaque_tid(), lane = tid & 63, wv = tid >> 6;
    const int gw = blockIdx.x * 8 + wv, NGW = gridDim.x * 8;
    const float* xin = (l == 0) ? a.in[0] : a.out; float* out = a.out;
    const bf16* Y = (const bf16*)(a.ws + WS_Y); bf16* H = (bf16*)(a.ws + WS_H);
    const float* MOD = (const float*)(a.ws + WS_MOD);
    const float* gpost = a.in[17] + l * D; const float* gpre = a.in[4] + (l + 1) * D;
    const int WPB = NGW / NB, b = gw / WPB, wq = gw % WPB;
    const float* gate = MOD + (size_t)(l * 8 + b) * 3072 + 2048;
    const float* sh = MOD + (size_t)(8 + b) * 3072; const float* scl = sh + 1024;
    f32x4 GP[4], A1[4], SH[4];
#pragma unroll
    for (int j = 0; j < 4; ++j) { const int col = 4 * lane + 256 * j; GP[j] = *(const f32x4*)(gate + col) * *(const f32x4*)(gpost + col);
        if (l == 0) { A1[j] = *(const f32x4*)(gpre + col) * (*(const f32x4*)(scl + col) + 1.0f); SH[j] = *(const f32x4*)(sh + col); } }
    for (int mr = wq * RPW; mr < SEQ; mr += WPB * RPW) {
        const int m0 = b * SEQ + mr;
        f32x4 xv[RPW][4]; u32x2 yw[RPW][4];
#pragma unroll
        for (int r = 0; r < RPW; ++r) { const f32x4* xr = (const f32x4*)(xin + (size_t)(m0 + r) * D) + lane; const u32x2* yr = (const u32x2*)(Y + (size_t)(m0 + r) * D) + lane;
#pragma unroll
            for (int j = 0; j < 4; ++j) { xv[r][j] = xr[64 * j]; yw[r][j] = yr[64 * j]; } }
#pragma unroll
        for (int r = 0; r < RPW; ++r) {
            f32x4 yv[4]; float ss = 0.f;
#pragma unroll
            for (int j = 0; j < 4; ++j) { const u32x2 w = yw[r][j]; yv[j] = (f32x4){bflo(w.x), bfhi(w.x), bflo(w.y), bfhi(w.y)};
                ss += (yv[j].x * yv[j].x + yv[j].y * yv[j].y) + (yv[j].z * yv[j].z + yv[j].w * yv[j].w); }
            const float rstd = 1.0f / __builtin_sqrtf(wave_sum(ss) * (1.0f / D) + EPS);
            float ss2 = 0.f;
#pragma unroll
            for (int j = 0; j < 4; ++j) { const int col = 4 * lane + 256 * j;
                const f32x4 xn = xv[r][j] + (yv[j] * rstd) * GP[j];
                xv[r][j] = xn;
                if (l == 0) *((f32x4*)(out + (size_t)(m0 + r) * D + col)) = xn;
                else __builtin_nontemporal_store(xn, (f32x4*)(out + (size_t)(m0 + r) * D + col));
                ss2 += (xn.x * xn.x + xn.y * xn.y) + (xn.z * xn.z + xn.w * xn.w); }
            if (l == 0) {
                const float rstd2 = 1.0f / __builtin_sqrtf(wave_sum(ss2) * (1.0f / D) + EPS);
                u32x2* o = (u32x2*)(H + (size_t)(m0 + r) * D) + lane;
#pragma unroll
                for (int j = 0; j < 4; ++j) {
                    const f32x4 rr = (xv[r][j] * rstd2) * A1[j] + SH[j];
                    u32x2 w; w.x = pk2(rr.x, rr.y); w.y = pk2(rr.z, rr.w); o[64 * j] = w; }
            }
        }
    }
}
#define XB_TMO      128
#define XB_XCNT(j)  (256  + 64 * (j))
#define XB_XSUB(j)  (1280 + 64 * (j))
#define XB_XGEN(j)  (2304 + 64 * (j))
#define XB_TOP      3328
#define XB_TOPGEN   3392
#define XCD_BAR_WORDS 3456
#define XB_SPIN_CAP (1u << 18)

__device__ __forceinline__ unsigned xb_ld(unsigned* p)              { return __hip_atomic_load(p, __ATOMIC_RELAXED, __HIP_MEMORY_SCOPE_AGENT); }
__device__ __forceinline__ unsigned xb_add(unsigned* p, unsigned v) { return __hip_atomic_fetch_add(p, v, __ATOMIC_RELAXED, __HIP_MEMORY_SCOPE_AGENT); }
__device__ __forceinline__ unsigned xb_xcc_id() { return (unsigned)__builtin_amdgcn_s_getreg((3 << 11) | 20) & 0xFu; }
#define XB_SPIN(cond, bar) do { unsigned _sp = 0; while (cond) { __builtin_amdgcn_s_sleep(1); \
    if ((++_sp & 255u) == 0u) { if (xb_ld(&(bar)[XB_TMO])) break; if (_sp > XB_SPIN_CAP) { xb_add(&(bar)[XB_TMO], 1u); break; } } } } while (0)

struct XcdBarrier {
    unsigned* bar; unsigned x;
    volatile LAS unsigned* st;
};

__device__ __forceinline__ XcdBarrier xcd_barrier_post(unsigned* bar, volatile LAS unsigned* st) {
    XcdBarrier b; b.bar = bar; b.x = xb_xcc_id(); b.st = st;
    if (threadIdx.x == 0) (void)xb_add(&bar[XB_XCNT(b.x)], 1u);
    return b;
}
__device__ __forceinline__ void xcd_barrier_complete(unsigned* bar, unsigned x, unsigned& nloc, unsigned& nx) {
    const unsigned G = gridDim.x * gridDim.y * gridDim.z;
    unsigned sum, cnt, mine, sp = 0u;
    for (;;) {
        sum = 0u; cnt = 0u; mine = 0u;
#pragma unroll
        for (unsigned j = 0; j < 16; ++j) { const unsigned c = xb_ld(&bar[XB_XCNT(j)]); sum += c; cnt += (c > 0u) ? 1u : 0u; mine = (j == x) ? c : mine; }
        if (sum == G) break;
        __builtin_amdgcn_s_sleep(1);
        if ((++sp & 255u) == 0u) { if (xb_ld(&bar[XB_TMO])) break; if (sp > XB_SPIN_CAP) { xb_add(&bar[XB_TMO], 1u); break; } }
    }
    nloc = mine > 0u ? mine : 1u; nx = cnt > 0u ? cnt : 1u;
}

__device__ __forceinline__ void xcd_barrier(const XcdBarrier& b) {
    asm volatile("s_waitcnt vmcnt(0)" ::: "memory");
    sync_threads_();
    if (threadIdx.x == 0) {
        unsigned* bar = b.bar;
        __builtin_amdgcn_s_waitcnt(0);
        unsigned nloc = b.st[0], nx = b.st[1];
        if (nloc == 0u) { xcd_barrier_complete(bar, b.x, nloc, nx); b.st[0] = nloc; b.st[1] = nx; }
        const unsigned old = xb_add(&bar[XB_XSUB(b.x)], 1u);
        const unsigned gen = old / nloc;
        if (old + 1u == (gen + 1u) * nloc) {
            __builtin_amdgcn_fence(__ATOMIC_RELEASE, "agent");
            asm volatile("s_waitcnt vmcnt(0)" ::: "memory");
            const unsigned og = xb_add(&bar[XB_TOP], 1u);
            const unsigned tg = og / nx;
            if (og + 1u == (tg + 1u) * nx) xb_add(&bar[XB_TOPGEN], 1u);
            else XB_SPIN(xb_ld(&bar[XB_TOPGEN]) == tg, bar);
            __builtin_amdgcn_fence(__ATOMIC_ACQUIRE, "agent");
            xb_add(&bar[XB_XGEN(b.x)], 1u);
            asm volatile("s_waitcnt vmcnt(0)" ::: "memory");
        } else {
            XB_SPIN(xb_ld(&bar[XB_XGEN(b.x)]) == gen, bar);
            __builtin_amdgcn_fence(__ATOMIC_ACQUIRE, "agent");
            asm volatile("s_waitcnt vmcnt(0)" ::: "memory");
        }
    }
    sync_threads_();
}

#define LDS_BARRIER() do { asm volatile("s_waitcnt lgkmcnt(0)" ::: "memory"); __builtin_amdgcn_s_barrier(); asm volatile("" ::: "memory"); } while (0)
constexpr int XROW = 272;
constexpr int CROW = 132;
constexpr int R_XT = 0, R_UT = 35840, R_AT = 70656, R_VT = 87552, R_EP = 104448, R_CWT = 105472, R_GT = 108032, R_YT = 116736;
template <int D> __device__ __forceinline__ float dpp_row_shr(float old, float src) {
    return i2f(__builtin_amdgcn_update_dpp(f2i(old), f2i(src), 0x110 | D, 0xf, 0xf, false)); }
__device__ __forceinline__ float softplus_small_(float e) { return (e < 0.03f) ? e * (1.0f + e * (-0.5f + e * (0.33333334f + e * (-0.25f + e * 0.2f)))) : __builtin_logf(1.0f + e); }
__device__ __forceinline__ float fast_sigmoid(float x) { return __builtin_amdgcn_rcpf(1.0f + __builtin_amdgcn_exp2f(-1.4426950408889634f * x)); }
__device__ __forceinline__ void rnn_unit(const Args& a, int l, int u, LAS unsigned char* lds) {
    const int tid = opaque_tid(), lane = tid & 63, wv = tid >> 6, fr = lane & 15, fq = lane >> 4;
    const int xcd = u & 7, jj = u >> 3, q = jj & 3, bh = (jj >> 2) * 8 + xcd, b = bh >> 3, h = bh & 7;
    const bf16* PROJ = (const bf16*)(a.ws + WS_PROJ); bf16* YCAT = (bf16*)(a.ws + WS_YCAT);
    const bf16* xr_base = PROJ + 0 * PSEG + (size_t)(b * SEQ) * PSTR + h * 128;
    const bf16* gr_base = PROJ + 1 * PSEG + (size_t)(b * SEQ) * PSTR + h * 128 + q * 32;
    bf16* y_base = YCAT + (size_t)(b * SEQ) * DMIX + h * 128 + q * 32;
    LAS unsigned char* XT = lds + R_XT; LAS unsigned char* UT = lds + R_UT;
    LAS float* AT = (LAS float*)(lds + R_AT); LAS float* VT = (LAS float*)(lds + R_VT);
    LAS unsigned char* GT = lds + R_GT; LAS unsigned char* YT = lds + R_YT;
    const int io_tk = tid >> 2, io_cq = tid & 3;
    const int ck = tid & 15, tg = tid >> 4;
    LAS float* CWT = (LAS float*)(lds + R_CWT);
    for (int i = tid; i < 640; i += 512) { const int r = i >> 7, c = i & 127;
        CWT[i] = (r < 4) ? a.in[6][(size_t)l * 4 * 1024 + r * 1024 + h * 128 + c] : a.in[7][(size_t)l * 1024 + h * 128 + c]; }
    bf16x8 Wf[4][4];
    {
        const bf16* gwp = (const bf16*)(a.ws + WS_GW) + (size_t)((l * 8 + h) * 4 + q) * 64 * 128;
#pragma unroll
        for (int nb = 0; nb < 4; ++nb)
#pragma unroll
            for (int kb = 0; kb < 4; ++kb) Wf[nb][kb] = *(const bf16x8*)(gwp + (nb * 16 + fr) * 128 + kb * 32 + fq * 8);
    }
    LAS float* EP = (LAS float*)(lds + R_EP);
    if (tid < 96) {
        const int r = tid >> 5, c = tid & 31, ch = h * 128 + q * 32 + c; float v;
        if (r == 0) v = -1.4426950408889634f * a.in[9][l * 1024 + ch];
        else if (r == 1) v = -1.4426950408889634f * a.in[11][l * 1024 + ch];
        else v = 8.0f * 1.4426950408889634f * softplus_small_(__builtin_expf(-a.in[12][l * 1024 + ch]));
        EP[r * 32 + c] = v;
    }
    u32x4 pf[4], pfh = (u32x4){0u, 0u, 0u, 0u};
#pragma unroll
    for (int i = 0; i < 4; ++i) { const int id = tid + 512 * i, row = id >> 4, cc = id & 15; pf[i] = *(const u32x4*)(xr_base + (size_t)row * PSTR + cc * 8); }
    u32x4 gpf = *(const u32x4*)(gr_base + (size_t)io_tk * PSTR + io_cq * 8);
    const int sc_ci = lane >> 4, sc_sg = lane & 15, sc_c = wv * 4 + sc_ci;
    float hcar = 0.f;
#pragma unroll
    for (int i = 0; i < 4; ++i) { const int id = tid + 512 * i, row = id >> 4, cc = id & 15; *(LAS u32x4*)(XT + (3 + row) * XROW + cc * 16) = pf[i]; }
    if (tid < 48) *(LAS u32x4*)(XT + (tid >> 4) * XROW + (tid & 15) * 16) = pfh;
    for (int tile = 0; tile < SEQ / 128; ++tile) {
        const int t0 = tile * 128;
        LDS_BARRIER();
        {
            const int t0n = (tile + 1 < SEQ / 128) ? t0 + 128 : t0;
#pragma unroll
            for (int i = 0; i < 4; ++i) { const int id = tid + 512 * i, row = id >> 4, cc = id & 15; pf[i] = *(const u32x4*)(xr_base + (size_t)(t0n + row) * PSTR + cc * 8); }
            if (tid < 48) pfh = *(const u32x4*)(xr_base + (size_t)(t0n - 3 + (tid >> 4)) * PSTR + (tid & 15) * 8);
        }
        {
            {
                unsigned short yv_[8];
#pragma unroll
                for (int e = 0; e < 8; ++e) yv_[e] = *(const LAS unsigned short*)(YT + (io_cq * 8 + e) * XROW + io_tk * 2);
                u32x4 w; w.x = yv_[0] | ((unsigned)yv_[1] << 16); w.y = yv_[2] | ((unsigned)yv_[3] << 16); w.z = yv_[4] | ((unsigned)yv_[5] << 16); w.w = yv_[6] | ((unsigned)yv_[7] << 16);
                *(u32x4*)(y_base + (size_t)((tile > 0 ? t0 - 128 : 0) + io_tk) * DMIX + io_cq * 8) = w;
            }
            const unsigned gwv[4] = {gpf.x, gpf.y, gpf.z, gpf.w};
#pragma unroll
            for (int e2 = 0; e2 < 4; ++e2) { *(LAS unsigned short*)(GT + (io_cq * 8 + 2 * e2) * XROW + io_tk * 2) = (unsigned short)(gwv[e2] & 0xffffu);
                *(LAS unsigned short*)(GT + (io_cq * 8 + 2 * e2 + 1) * XROW + io_tk * 2) = (unsigned short)(gwv[e2] >> 16); }
            const int t1 = (tile + 1 < SEQ / 128) ? t0 + 128 : t0;
            gpf = *(const u32x4*)(gr_base + (size_t)(t1 + io_tk) * PSTR + io_cq * 8);
        }
        {
            f32x2 o[4][4], cw[4][4];
            {
                const f32x4 b0 = *(const LAS f32x4*)(CWT + 4 * 128 + ck * 8), b1 = *(const LAS f32x4*)(CWT + 4 * 128 + ck * 8 + 4);
#pragma unroll
                for (int i = 0; i < 4; ++i) { o[i][0] = (f32x2){b0.x, b0.y}; o[i][1] = (f32x2){b0.z, b0.w}; o[i][2] = (f32x2){b1.x, b1.y}; o[i][3] = (f32x2){b1.z, b1.w}; }
            }
#pragma unroll
            for (int k = 0; k < 4; ++k) { const f32x4 w0 = *(const LAS f32x4*)(CWT + k * 128 + ck * 8), w1 = *(const LAS f32x4*)(CWT + k * 128 + ck * 8 + 4);
                cw[k][0] = (f32x2){w0.x, w0.y}; cw[k][1] = (f32x2){w0.z, w0.w}; cw[k][2] = (f32x2){w1.x, w1.y}; cw[k][3] = (f32x2){w1.z, w1.w}; }
#pragma unroll
            for (int r = 0; r < 7; ++r) {
                const u32x4 w = *(const LAS u32x4*)(XT + (tg * 4 + r) * XROW + ck * 16);
                const f32x2 xv[4] = {(f32x2){bflo(w.x), bfhi(w.x)}, (f32x2){bflo(w.y), bfhi(w.y)}, (f32x2){bflo(w.z), bfhi(w.z)}, (f32x2){bflo(w.w), bfhi(w.w)}};
#pragma unroll
                for (int i = 0; i < 4; ++i) { const int k = r - i; if (k >= 0 && k < 4) {
#pragma unroll
                    for (int e = 0; e < 4; ++e) o[i][e] = __builtin_elementwise_fma(cw[k][e], xv[e], o[i][e]); } }
            }
#pragma unroll
            for (int i = 0; i < 4; ++i) { u32x4 w; w.x = pk2(o[i][0].x, o[i][0].y); w.y = pk2(o[i][1].x, o[i][1].y); w.z = pk2(o[i][2].x, o[i][2].y); w.w = pk2(o[i][3].x, o[i][3].y);
                *(LAS u32x4*)(UT + (tg * 4 + i) * XROW + ck * 16) = w; }
        }
        asm volatile("s_waitcnt lgkmcnt(0)" ::: "memory");
        {
            f32x4 acc[4];
#pragma unroll
            for (int nb = 0; nb < 4; ++nb) acc[nb] = (f32x4){0.f, 0.f, 0.f, 0.f};
#pragma unroll
            for (int kb = 0; kb < 4; ++kb) { const bf16x8 uf = *(const LAS bf16x8*)(UT + (wv * 16 + fr) * XROW + kb * 64 + fq * 16);
#pragma unroll
                for (int nb = 0; nb < 4; ++nb) acc[nb] = __builtin_amdgcn_mfma_f32_16x16x32_bf16(Wf[nb][kb], uf, acc[nb], 0, 0, 0); }
            const int tk = wv * 16 + fr;
#pragma unroll
            for (int nb2 = 0; nb2 < 2; ++nb2) {
                const int c0 = nb2 * 16 + 4 * fq;
                const u32x2 uw = *(const LAS u32x2*)(UT + tk * XROW + (q * 32 + c0) * 2);
                const f32x4 uu = (f32x4){bflo(uw.x), bfhi(uw.x), bflo(uw.y), bfhi(uw.y)};
                const f32x4 ra = acc[nb2] + *(const LAS f32x4*)(EP + c0), rx = acc[nb2 + 2] + *(const LAS f32x4*)(EP + 32 + c0), sp8 = *(const LAS f32x4*)(EP + 64 + c0);
#pragma unroll
                for (int e = 0; e < 4; ++e) { const float r = __builtin_amdgcn_rcpf(1.0f + __builtin_amdgcn_exp2f(ra[e])), ig = __builtin_amdgcn_rcpf(1.0f + __builtin_amdgcn_exp2f(rx[e]));
                    const float av = __builtin_amdgcn_exp2f(-r * sp8[e]);
                    const float m2 = __builtin_fmaxf(__builtin_fmaf(-av, av, 1.0f), 0.f);
                    *(LAS f32x2*)(AT + ((c0 + e) * CROW + tk) * 2) = (f32x2){av, __builtin_amdgcn_sqrtf(m2) * (ig * uu[e])}; }
            }
        }
        LDS_BARRIER();
        {
            const LAS f32x4* avp = (const LAS f32x4*)(AT + (sc_c * CROW + sc_sg * 8) * 2);
            const f32x4 q0 = avp[0], q1 = avp[1], q2 = avp[2], q3 = avp[3];
            const float av[8] = {q0.x, q0.z, q1.x, q1.z, q2.x, q2.z, q3.x, q3.z}, vv[8] = {q0.y, q0.w, q1.y, q1.w, q2.y, q2.w, q3.y, q3.w};
            float hl[8], pp[8]; float hcur = 0.f, pcur = 1.f;
#pragma unroll
            for (int j = 0; j < 8; ++j) { hcur = __builtin_fmaf(av[j], hcur, vv[j]); pcur *= av[j]; hl[j] = hcur; pp[j] = pcur; }
            float P = pcur, H = hcur;
            { float Pp = dpp_row_shr<1>(1.f, P), Hp = dpp_row_shr<1>(0.f, H); H = __builtin_fmaf(P, Hp, H); P *= Pp;
              Pp = dpp_row_shr<2>(1.f, P); Hp = dpp_row_shr<2>(0.f, H); H = __builtin_fmaf(P, Hp, H); P *= Pp;
              Pp = dpp_row_shr<4>(1.f, P); Hp = dpp_row_shr<4>(0.f, H); H = __builtin_fmaf(P, Hp, H); P *= Pp;
              Pp = dpp_row_shr<8>(1.f, P); Hp = dpp_row_shr<8>(0.f, H); H = __builtin_fmaf(P, Hp, H); P *= Pp; }
            const float Pe = dpp_row_shr<1>(1.f, P), He = dpp_row_shr<1>(0.f, H);
            const float carry = __builtin_fmaf(Pe, hcar, He);
            const float hend = __builtin_fmaf(P, hcar, H);
            hcar = row_last_(hend);
            const u32x4 gq = *(const LAS u32x4*)(GT + sc_c * XROW + sc_sg * 16);
            const float gvv[8] = {bflo(gq.x), bfhi(gq.x), bflo(gq.y), bfhi(gq.y), bflo(gq.z), bfhi(gq.z), bflo(gq.w), bfhi(gq.w)};
            float yy[8];
#pragma unroll
            for (int j = 0; j < 8; ++j) { const float hv = __builtin_fmaf(pp[j], carry, hl[j]); yy[j] = hv * gvv[j] * fast_sigmoid(gvv[j]); }
            u32x4 yw_; yw_.x = pk2(yy[0], yy[1]); yw_.y = pk2(yy[2], yy[3]); yw_.z = pk2(yy[4], yy[5]); yw_.w = pk2(yy[6], yy[7]);
            *(LAS u32x4*)(YT + sc_c * XROW + sc_sg * 16) = yw_;
        }
#pragma unroll
        for (int i = 0; i < 4; ++i) { const int id = tid + 512 * i, row = id >> 4, cc = id & 15; *(LAS u32x4*)(XT + (3 + row) * XROW + cc * 16) = pf[i]; }
        if (tid < 48) *(LAS u32x4*)(XT + (tid >> 4) * XROW + (tid & 15) * 16) = pfh;
    }
    LDS_BARRIER();
    {
        unsigned short yv_[8];
#pragma unroll
        for (int e = 0; e < 8; ++e) yv_[e] = *(const LAS unsigned short*)(YT + (io_cq * 8 + e) * XROW + io_tk * 2);
        u32x4 w; w.x = yv_[0] | ((unsigned)yv_[1] << 16); w.y = yv_[2] | ((unsigned)yv_[3] << 16); w.z = yv_[4] | ((unsigned)yv_[5] << 16); w.w = yv_[6] | ((unsigned)yv_[7] << 16);
        *(u32x4*)(y_base + (size_t)(SEQ - 128 + io_tk) * DMIX + io_cq * 8) = w;
    }
    LDS_BARRIER();
}

constexpr int PROW = 528;
constexpr int R_XP = 0, R_PT = 42240;
template <int g> __device__ __forceinline__ void pool_units(const Args& a, int l, int u, LAS unsigned char* lds) {
    const int tid = opaque_tid(), lane = tid & 63, wv = tid >> 6, fr = lane & 15, fq = lane >> 4;
    const int bi = u >> 2; constexpr int win = 2 << g;
    const bf16* PROJ = (const bf16*)(a.ws + WS_PROJ); bf16* YCAT = (bf16*)(a.ws + WS_YCAT);
    LAS unsigned char* XP = lds + R_XP; LAS unsigned char* PT = lds + R_PT;
    const bf16* pw = (const bf16*)(a.ws + WS_PW) + (size_t)(l * 4 + g) * 256 * 256;
    bf16x8 Wf[2][8];
#pragma unroll
    for (int nb = 0; nb < 2; ++nb)
#pragma unroll
        for (int kb = 0; kb < 8; ++kb) Wf[nb][kb] = *(const bf16x8*)(pw + (size_t)(wv * 32 + 8 * (fr >> 2) + 4 * nb + (fr & 3)) * 256 + kb * 32 + fq * 8);
    f32x4 pb[2], ps[2];
#pragma unroll
    for (int nb = 0; nb < 2; ++nb) { const int n = wv * 32 + 8 * fq + 4 * nb;
        pb[nb] = *(const f32x4*)(a.in[14] + (size_t)l * 1024 + g * 256 + n); ps[nb] = *(const f32x4*)(a.in[15] + (size_t)l * 1024 + g * 256 + n); }
    const int ck = tid & 31, tg = tid >> 5;
    u32x4 pf[4], hal;
    const int hr = tid >> 5, hc = tid & 31;
    {
        const int tile = bi * 8, b = tile >> 6, t0 = (tile & 63) * 64;
        const bf16* xp_base = PROJ + 2 * PSEG + (size_t)(b * SEQ) * PSTR + g * 256;
#pragma unroll
        for (int i = 0; i < 4; ++i) { const int id = tid + 512 * i, row = id >> 5, cc = id & 31; pf[i] = *(const u32x4*)(xp_base + (size_t)(t0 + row) * PSTR + cc * 8); }
        const int th = t0 - 16 + hr;
        const u32x4 hv = *(const u32x4*)(xp_base + (size_t)(th < 0 ? 0 : th) * PSTR + hc * 8); hal = (th < 0) ? (u32x4){0u, 0u, 0u, 0u} : hv;
    }
#pragma unroll
    for (int i = 0; i < 4; ++i) { const int id = tid + 512 * i, row = id >> 5, cc = id & 31; *(LAS u32x4*)(XP + (16 + row) * PROW + cc * 16) = pf[i]; }
    *(LAS u32x4*)(XP + hr * PROW + hc * 16) = hal;
    u32x4 gp[4];
    {
        const int tile = bi * 8, b = tile >> 6, t0 = (tile & 63) * 64;
        const bf16* gp_base0 = PROJ + 3 * PSEG + (size_t)(b * SEQ) * PSTR + g * 256;
#pragma unroll
        for (int tb = 0; tb < 4; ++tb)
        { gp[tb] = *(const u32x4*)(gp_base0 + (size_t)(t0 + tb * 16 + fr) * PSTR + wv * 32 + 8 * fq);
                asm volatile("" : "+v"(gp[tb])); }
    }
    for (int it = 0; it < 8; ++it) {
        const int tile = bi * 8 + it, b = tile >> 6, t0 = (tile & 63) * 64;
        bf16* y_base = YCAT + (size_t)(b * SEQ) * DMIX + 1024 + g * 256;
        LDS_BARRIER();
        {
            const int tile2 = bi * 8 + ((it + 1 < 8) ? it + 1 : it), b2 = tile2 >> 6, t02 = (tile2 & 63) * 64;
            const bf16* xp_base = PROJ + 2 * PSEG + (size_t)(b2 * SEQ) * PSTR + g * 256;
#pragma unroll
            for (int i = 0; i < 4; ++i) { const int id = tid + 512 * i, row = id >> 5, cc = id & 31; pf[i] = *(const u32x4*)(xp_base + (size_t)(t02 + row) * PSTR + cc * 8); }
        }
        hal = *(const LAS u32x4*)(XP + (64 + hr) * PROW + hc * 16);
        u32x4 gpn[4];
        {
            const int tile2 = bi * 8 + ((it + 1 < 8) ? it + 1 : it), b2 = tile2 >> 6, t02 = (tile2 & 63) * 64;
            const bf16* gp_base2 = PROJ + 3 * PSEG + (size_t)(b2 * SEQ) * PSTR + g * 256;
#pragma unroll
            for (int tb = 0; tb < 4; ++tb)
                gpn[tb] = *(const u32x4*)(gp_base2 + (size_t)(t02 + tb * 16 + fr) * PSTR + wv * 32 + 8 * fq);
        }
        {
            float s[8];
#pragma unroll
            for (int e = 0; e < 8; ++e) s[e] = 0.f;
            const int r0 = tg * 4 + 16;
#pragma unroll
            for (int r = r0 - win + 1; r < r0; ++r) { const u32x4 w = *(const LAS u32x4*)(XP + r * PROW + ck * 16);
                s[0] += bflo(w.x); s[1] += bfhi(w.x); s[2] += bflo(w.y); s[3] += bfhi(w.y); s[4] += bflo(w.z); s[5] += bfhi(w.z); s[6] += bflo(w.w); s[7] += bfhi(w.w); }
#pragma unroll
            for (int i = 0; i < 4; ++i) {
                const u32x4 w = *(const LAS u32x4*)(XP + (r0 + i) * PROW + ck * 16);
                const float xv[8] = {bflo(w.x), bfhi(w.x), bflo(w.y), bfhi(w.y), bflo(w.z), bfhi(w.z), bflo(w.w), bfhi(w.w)};
                const int t = t0 + tg * 4 + i; const float inv = __builtin_amdgcn_rcpf((float)((t + 1 < win) ? (t + 1) : win));
                float p[8];
#pragma unroll
                for (int e = 0; e < 8; ++e) { s[e] += xv[e]; p[e] = __builtin_fmaf(s[e], inv, -xv[e]); }
                u32x4 o; o.x = pk2(p[0], p[1]); o.y = pk2(p[2], p[3]); o.z = pk2(p[4], p[5]); o.w = pk2(p[6], p[7]);
                *(LAS u32x4*)(PT + (tg * 4 + i) * PROW + ck * 16) = o;
                const u32x4 wo = *(const LAS u32x4*)(XP + (r0 + i - win + 1) * PROW + ck * 16);
                s[0] -= bflo(wo.x); s[1] -= bfhi(wo.x); s[2] -= bflo(wo.y); s[3] -= bfhi(wo.y); s[4] -= bflo(wo.z); s[5] -= bfhi(wo.z); s[6] -= bflo(wo.w); s[7] -= bfhi(wo.w);
            }
        }
        LDS_BARRIER();
#pragma unroll
        for (int tb = 0; tb < 4; ++tb) {
            f32x4 acc[2] = {(f32x4){0.f, 0.f, 0.f, 0.f}, (f32x4){0.f, 0.f, 0.f, 0.f}};
#pragma unroll
            for (int kb = 0; kb < 8; ++kb) { const bf16x8 pfm = *(const LAS bf16x8*)(PT + (tb * 16 + fr) * PROW + kb * 64 + fq * 16);
#pragma unroll
                for (int nb = 0; nb < 2; ++nb) acc[nb] = __builtin_amdgcn_mfma_f32_16x16x32_bf16(Wf[nb][kb], pfm, acc[nb], 0, 0, 0); }
            const int t = t0 + tb * 16 + fr;
            u32x4 o;
#pragma unroll
            for (int nb = 0; nb < 2; ++nb) {
                const unsigned g0 = nb ? gp[tb].z : gp[tb].x, g1 = nb ? gp[tb].w : gp[tb].y;
                const f32x4 gv = (f32x4){bflo(g0), bfhi(g0), bflo(g1), bfhi(g1)};
                f32x4 r = (acc[nb] + pb[nb]) * ps[nb];
#pragma unroll
                for (int e = 0; e < 4; ++e) r[e] *= gv[e] * fast_sigmoid(gv[e]);
                if (nb == 0) { o.x = pk2(r.x, r.y); o.y = pk2(r.z, r.w); } else { o.z = pk2(r.x, r.y); o.w = pk2(r.z, r.w); } }
            *(u32x4*)(y_base + (size_t)t * DMIX + wv * 32 + 8 * fq) = o;
        }
#pragma unroll
        for (int i = 0; i < 4; ++i) { const int id = tid + 512 * i, row = id >> 5, cc = id & 31; *(LAS u32x4*)(XP + (16 + row) * PROW + cc * 16) = pf[i]; }
        *(LAS u32x4*)(XP + hr * PROW + hc * 16) = hal;
#pragma unroll
        for (int tb = 0; tb < 4; ++tb)
            gp[tb] = gpn[tb];
    }
    LDS_BARRIER();
}

__device__ __forceinline__ void phase_mixer(const Args& a, int l, LAS unsigned char* lds) {
#ifndef MK_MIX
#define MK_MIX 3
#endif
#ifndef MK_DBL_RNN
#define MK_DBL_RNN 0
#endif
#ifndef MK_DBL_POOL
#define MK_DBL_POOL 0
#endif
    for (int rep = 0; rep < 1 + ((l == 0) ? MK_DBL_RNN : 0); ++rep) for (int u = blockIdx.x; u < 256; u += gridDim.x) rnn_unit(a, l, u, lds);
    for (int rep = 0; rep < 1 + ((l == 0) ? MK_DBL_POOL : 0); ++rep) for (int u = blockIdx.x; u < 256; u += gridDim.x) { const int g_ = u & 3; if (g_ == 0) pool_units<0>(a, l, u, lds); else if (g_ == 1) pool_units<1>(a, l, u, lds); else if (g_ == 2) pool_units<2>(a, l, u, lds); else pool_units<3>(a, l, u, lds); }
}
#ifndef MK_DBL_PH
#define MK_DBL_PH -1
#endif
#ifndef MK_MASK
#define MK_MASK 63
#endif
__global__ void __launch_bounds__(512, 2) mk_fwd(Args a) {
    extern __shared__ __attribute__((aligned(16))) unsigned char lds_raw[];
    LAS unsigned char* lds = (LAS unsigned char*)lds_raw;
    cg::grid_group grid = cg::this_grid();
    volatile LAS unsigned* bst = (volatile LAS unsigned*)(lds + LDS_BST_OFF);
    if (threadIdx.x < 4) bst[threadIdx.x] = 0u;
    sync_threads_();
    XcdBarrier xbar = xcd_barrier_post((unsigned*)(a.ws + WS_CTL), bst);
#define GRID_BAR() do { if (a.ph_hi - a.ph_lo > 64) grid.sync(); else xcd_barrier(xbar); } while (0)
    for (int ph = a.ph_lo; ph < a.ph_hi; ++ph) {
#if MK_DBL_PH >= 0
      for (int rep = 0; rep < ((ph == MK_DBL_PH) ? 2 : 1); ++rep) {
        if (rep) GRID_BAR();
#endif
        if (ph == 0) { if (MK_MASK & 1) phase_prep(a, lds); }
        else if (ph == 1) { if (MK_MASK & 2) phase_h0(a); }
        else {
            const int l = (ph - 2) >> 2, sub = (ph - 2) & 3;
            if (sub == 0) { if (MK_MASK & 4) {
                pg8::Gemm g{(const pg8::bf16_t*)(a.ws + WS_H), (const pg8::bf16_t*)(a.ws + WS_WIN) + (size_t)l * NPROJ * D, T, NPROJ, D};
                pg8::StaticOrder S; S.init(T, NPROJ, gridDim.x, (int)blockIdx.x);
                pg8::EpiBf16<0> E{(pg8::bf16_t*)(a.ws + WS_PROJ), PSTR, nullptr, 1024, PSEG, 1.f};
                pg8::gemm_phase<pg8::EpiBf16<0>, pg8::StaticOrder, PG8_ALIGN, PG8_SP2>(lds, g, S, E); }
            } else if (sub == 1) {
                if (MK_MASK & 8) phase_mixer(a, l, lds);
            } else if (sub == 2) { if (MK_MASK & 16) {
                pg8::Gemm g{(const pg8::bf16_t*)(a.ws + WS_YCAT), (const pg8::bf16_t*)(a.ws + WS_WOUT) + (size_t)l * D * DMIX, T, D, DMIX};
                pg8::StaticOrder S; S.init(T, D, gridDim.x, (int)blockIdx.x);
                pg8::EpiBf16<0> E{(pg8::bf16_t*)(a.ws + WS_Y), D, nullptr, 0, 0, 1.f};
                pg8::gemm_phase<pg8::EpiBf16<0>, pg8::StaticOrder, PG8_ALIGN, PG8_SP2>(lds, g, S, E); }
            } else {
                if (MK_MASK & 32) { if (l == 0) phase_post<0>(a); else phase_post<1>(a); }
            }
        }
#if MK_DBL_PH >= 0
      }
#endif
        if (ph + 1 < a.ph_hi) GRID_BAR();
    }
}

#if defined(__HIP_DEVICE_COMPILE__)
#pragma clang attribute pop
#endif

extern "C" void kernel_launch(void* const* d_in, const int* in_sizes, int n_in, void* d_out, int out_size, void* d_ws, size_t ws_size, hipStream_t stream) {
    static int grid = 0;
    if (grid == 0) {
        if (n_in != 18 || in_sizes[0] != T * D || out_size != T * D || ws_size < WS_END) {
            fprintf(stderr, "kernel_launch: unexpected shapes (n_in %d, in0 %d, out %d, ws %zu); nothing launched\n", n_in, n_in > 0 ? in_sizes[0] : -1, out_size, ws_size); grid = -1; return; }
        int dev = 0, cus = 0, per_cu = 0;
        if (hipGetDevice(&dev) != hipSuccess || hipDeviceGetAttribute(&cus, hipDeviceAttributeMultiprocessorCount, dev) != hipSuccess) { grid = -1; return; }
        if (hipFuncSetAttribute((const void*)mk_fwd, hipFuncAttributeMaxDynamicSharedMemorySize, LDS_BYTES) != hipSuccess) { fprintf(stderr, "kernel_launch: hipFuncSetAttribute failed\n"); grid = -1; return; }
        if (hipOccupancyMaxActiveBlocksPerMultiprocessor(&per_cu, (const void*)mk_fwd, 512, LDS_BYTES) != hipSuccess || per_cu < 1) { fprintf(stderr, "kernel_launch: occupancy query says %d blocks per CU\n", per_cu); per_cu = 1; }
        (void)hipGetLastError();
        grid = cus;
    }
    if (grid < 0) return;
    Args a{};
    for (int i = 0; i < 18; ++i) a.in[i] = (const float*)d_in[i];
    a.out = (float*)d_out; a.ws = (unsigned char*)d_ws;
    if (hipMemsetAsync((char*)d_ws + WS_CTL, 0, CTL_BYTES, stream) != hipSuccess) { fprintf(stderr, "kernel_launch: memset of the barrier words failed\n"); return; }
#if MK_N_LAUNCHES == 1
    a.ph_lo = 0; a.ph_hi = NPH;
    void* args[] = {&a};
    const hipError_t e = hipLaunchCooperativeKernel((const void*)mk_fwd, dim3(grid), dim3(512), args, LDS_BYTES, stream);
    if (e != hipSuccess) fprintf(stderr, "kernel_launch: cooperative launch failed: %s (grid %d)\n", hipGetErrorString(e), grid);
#else
    for (int ph = 0; ph < NPH; ++ph) {
        a.ph_lo = ph; a.ph_hi = ph + 1;
        hipLaunchKernelGGL(mk_fwd, dim3(grid), dim3(512), LDS_BYTES, stream, a);
    }
#endif
}
```

```cpp
#include <hip/hip_runtime.h>
#include <hip/hip_cooperative_groups.h>
#include <cstdio>
#include <cstdint>
namespace cg = cooperative_groups;
__device__ __forceinline__ int opaque_tid() { int t = threadIdx.x; asm volatile("" : "+v"(t)); return t; }
#if defined(__HIP_DEVICE_COMPILE__)
#pragma clang attribute push (__attribute__((target("no-packed-fp32-ops"))), apply_to = function)
#endif
__device__ __forceinline__ float u2f(unsigned x) { return __builtin_bit_cast(float, x); }
__device__ __forceinline__ float i2f(int x) { return __builtin_bit_cast(float, x); }
__device__ __forceinline__ int f2i(float x) { return __builtin_bit_cast(int, x); }
__device__ __forceinline__ int lane_id_() { return (int)__builtin_amdgcn_mbcnt_hi(~0u, __builtin_amdgcn_mbcnt_lo(~0u, 0u)); }
__device__ __forceinline__ float shfl_xor_(float v, int o) { return i2f(__builtin_amdgcn_ds_bpermute((lane_id_() ^ o) << 2, f2i(v))); }
__device__ __forceinline__ float row_last_(float v) { return i2f(__builtin_amdgcn_ds_bpermute((lane_id_() | 15) << 2, f2i(v))); }
__device__ __forceinline__ void sync_threads_() { __builtin_amdgcn_fence(__ATOMIC_RELEASE, "workgroup"); __builtin_amdgcn_s_barrier(); __builtin_amdgcn_fence(__ATOMIC_ACQUIRE, "workgroup"); }
namespace pg8 {
#define PG8_LAS __attribute__((address_space(3)))
typedef unsigned short bf16_t;
typedef short bf16x8 __attribute__((ext_vector_type(8)));
typedef float f32x4 __attribute__((ext_vector_type(4)));
typedef unsigned u32x4 __attribute__((ext_vector_type(4)));
constexpr int BM = 256, BK = 64, HALF = 128, HTB = HALF * BK * 2  , STAGE_BYTES = 8 * HTB, NXCD = 8, WGM = 8;

__host__ __device__ __forceinline__ int lds_byte(int r, int c) { const int st = (r >> 4) * 2 + (c >> 5), rr = r & 15, cc = c & 31, ob = rr * 64 + cc * 2; return st * 1024 + (ob ^ (((ob >> 9) & 1) << 5)); }
__host__ __device__ __forceinline__ void stage_rc(int b, int& R, int& C) { const int st = b / 1024, sb = b % 1024, swz = sb ^ (((sb >> 9) & 1) << 5); R = (st >> 1) * 16 + swz / 64; C = (st & 1) * 32 + (swz % 64) / 2; }
__host__ __device__ __forceinline__ int perm32(int rho) { const int n = rho >> 4, i = rho & 15; return 8 * (i >> 2) + 4 * n + (i & 3); }

struct Unit { int pm, pn; };
struct Gemm { const bf16_t* A; const bf16_t* Bt; int M, N, K; };

struct StaticOrder {
    int nM, nN, nwg, G, c;
    __host__ __device__ void init(int M, int N, int G_, int c_) { nM = M / BM; nN = N / BM; nwg = nM * nN; G = G_; c = c_; }
    __host__ __device__ bool next(int i, Unit& u) const {
        const long L = (long)i * G + c; if (L >= nwg) return false;
        int wgid = (int)L; { const int q = nwg / NXCD, r = nwg % NXCD, xcd = wgid % NXCD, off = wgid / NXCD; wgid = (xcd < r ? xcd * (q + 1) : r * (q + 1) + (xcd - r) * q) + off; }
        const int nig = WGM * nN, gid = wgid / nig, fm = gid * WGM, gsz = (nM - fm) < WGM ? (nM - fm) : WGM;
        u.pm = fm + ((wgid % nig) % gsz); u.pn = (wgid % nig) / gsz; return true;
    }
    __device__ __forceinline__ void a_ready(const Unit&) const {}
    __device__ __forceinline__ void done(const Unit&) const {}
};

__device__ __forceinline__ unsigned cvt_pk_bf16(float lo, float hi) { unsigned r; asm volatile("v_cvt_pk_bf16_f32 %0, %1, %2" : "=v"(r) : "v"(lo), "v"(hi)); return r; }
typedef float f32x2 __attribute__((ext_vector_type(2)));
__device__ __forceinline__ f32x2 gelu_pk(f32x2 v) {
    const f32x2 av = __builtin_elementwise_abs(v), d = av * 0.2316418882f + 1.0f;
    f32x2 t; t.x = __builtin_amdgcn_rcpf(d.x); t.y = __builtin_amdgcn_rcpf(d.y);
    f32x2 q = t * 0.5307027145f + (-0.7265760135f); q = q * t + 0.7107068705f; q = q * t + (-0.142248368f); q = q * t + 0.127414796f; q = q * t;
    const f32x2 s = (v * v) * (-0.72134752044f);
    f32x2 e; e.x = __builtin_amdgcn_exp2f(s.x); e.y = __builtin_amdgcn_exp2f(s.y);
    const f32x2 m = v * (q * e), r = v - m;
    f32x2 o; o.x = v.x < 0.f ? m.x : r.x; o.y = v.y < 0.f ? m.y : r.y; return o;
}

template <int ACT  > struct EpiBf16 {
    static constexpr bool PERM = true, AFTER_DRAIN = false; static_assert(ACT == 0 || ACT == 1, "EpiBf16: ACT is 0 (none) or 1 (gelu_pk)");
    bf16_t* O; int ldc; const float* bias; int split_cols; size_t split_stride; float scale0;
    __device__ __forceinline__ void operator()(const f32x4 (&acc)[2][2][4][2], const Unit& u, int wr, int wc, int fr, int fq) const {
        const int row0 = u.pm * BM + wr * 64 + fr; int colt = u.pn * BM; bf16_t* base = O;
        float sc = 1.f; if (split_cols) { const int t = colt / split_cols; base += (size_t)t * split_stride; colt -= t * split_cols; if (t == 0) sc = scale0; }
        const int col0 = colt + wc * 32 + 8 * fq, bcol0 = u.pn * BM + wc * 32 + 8 * fq;
        f32x4 bv[2][2];
#pragma unroll
        for (int bj = 0; bj < 2; ++bj)
#pragma unroll
            for (int n = 0; n < 2; ++n) bv[bj][n] = bias ? *(const f32x4*)(bias + bcol0 + bj * HALF + 4 * n) : (f32x4){0.f, 0.f, 0.f, 0.f};
#pragma unroll
        for (int ai = 0; ai < 2; ++ai)
#pragma unroll
            for (int m = 0; m < 4; ++m) { bf16_t* rowp = base + (size_t)(row0 + ai * HALF + m * 16) * ldc + col0;
#pragma unroll
                for (int bj = 0; bj < 2; ++bj) { f32x4 v0 = acc[ai][bj][m][0] + bv[bj][0], v1 = acc[ai][bj][m][1] + bv[bj][1];
                    if (ACT == 1) { f32x2 a = gelu_pk((f32x2){v0[0], v0[1]}), b = gelu_pk((f32x2){v0[2], v0[3]}), c = gelu_pk((f32x2){v1[0], v1[1]}), d = gelu_pk((f32x2){v1[2], v1[3]});
                        v0 = (f32x4){a.x, a.y, b.x, b.y}; v1 = (f32x4){c.x, c.y, d.x, d.y}; }
                    v0 = v0 * sc; v1 = v1 * sc; u32x4 w; w.x = cvt_pk_bf16(v0[0], v0[1]); w.y = cvt_pk_bf16(v0[2], v0[3]); w.z = cvt_pk_bf16(v1[0], v1[1]); w.w = cvt_pk_bf16(v1[2], v1[3]);
                    *(u32x4*)(rowp + bj * HALF) = w; } }
    }
};
template <class Epi, class Sched, bool ALIGN_EPI = false, bool SP2 = false>
__device__ __forceinline__ void gemm_phase(PG8_LAS unsigned char* lds, const Gemm g, const Sched& S, const Epi& E) {
    const int tid = opaque_tid(), wid = __builtin_amdgcn_readfirstlane(tid >> 6), lane = tid & 63, wr = wid >> 2, wc = wid & 3, fr = lane & 15, fq = lane >> 4;
    const int K = g.K, nt = K / BK;
    unsigned voffA[2], voffB[2];
#pragma unroll
    for (int i = 0; i < 2; ++i) { int R, C; stage_rc(tid * 16 + i * 8192, R, C); const int Rb = Epi::PERM ? ((R & ~31) + perm32(R & 31)) : R;
        voffA[i] = (unsigned)(R * K + C) * 2u; voffB[i] = (unsigned)(Rb * K + C) * 2u; }
    const size_t kstep = (size_t)(BK * 2);
    const size_t hstep = (size_t)HALF * K * 2;
    const size_t tstep = 2 * hstep;
    const unsigned ldsw = (unsigned)wid * 1024u;
    const int aoff = lds_byte(wr * 64 + fr, fq * 8), boff = lds_byte(wc * 32 + fr, fq * 8);
#define PG8_SA(b, h) (((b) * 2 + (h)) * HTB)
#define PG8_SB(b, h) ((4 + (b) * 2 + (h)) * HTB)
#define PG8_STAGE(bufoff, gbase, voff) do { _Pragma("unroll") for (int _i = 0; _i < 2; ++_i) \
        __builtin_amdgcn_global_load_lds((const unsigned*)((const char*)(gbase) + (voff)[_i]), (PG8_LAS unsigned*)(lds + (bufoff) + ldsw + _i * 8192), 16, 0, 0); } while (0)
#define PG8_LDA(dst, b, h) do { _Pragma("unroll") for (int m = 0; m < 4; ++m) _Pragma("unroll") for (int k = 0; k < 2; ++k) dst[m][k] = *(const PG8_LAS bf16x8*)(lds + PG8_SA(b, h) + aoff + m * 2048 + k * 1024); } while (0)
#define PG8_LDB(dst, b, h) do { _Pragma("unroll") for (int n = 0; n < 2; ++n) _Pragma("unroll") for (int k = 0; k < 2; ++k) dst[n][k] = *(const PG8_LAS bf16x8*)(lds + PG8_SB(b, h) + boff + n * 2048 + k * 1024); } while (0)
#define PG8_MMA(ai, bj, At, Bt) do { __builtin_amdgcn_s_setprio(1); _Pragma("unroll") for (int m = 0; m < 4; ++m) _Pragma("unroll") for (int n = 0; n < 2; ++n) _Pragma("unroll") for (int k = 0; k < 2; ++k) \
        acc[ai][bj][m][n] = __builtin_amdgcn_mfma_f32_16x16x32_bf16(Bt[n][k], At[m][k], acc[ai][bj][m][n], 0, 0, 0); __builtin_amdgcn_s_setprio(0); } while (0)
#define PG8_WAIT_V(n) asm volatile("s_waitcnt vmcnt(" #n ")" ::: "memory")
#define PG8_WAIT_L(n) asm volatile("s_waitcnt lgkmcnt(" #n ")" ::: "memory")
#define PG8_BAR __builtin_amdgcn_s_barrier()
#define PG8_SCHED __builtin_amdgcn_sched_barrier(0)
    Unit cur, nxt; int ui = 0;
    if (!S.next(0, cur)) return;
    f32x4 acc[2][2][4][2];
#pragma unroll
    for (int a = 0; a < 2; ++a)
#pragma unroll
        for (int b = 0; b < 2; ++b)
#pragma unroll
            for (int m = 0; m < 4; ++m)
#pragma unroll
                for (int n = 0; n < 2; ++n) acc[a][b][m][n] = (f32x4){0.f, 0.f, 0.f, 0.f};
    bf16x8 At[4][2], B0[2][2], B1[2][2];
    const char* cA = (const char*)g.A + (size_t)cur.pm * tstep; const char* cB = (const char*)g.Bt + (size_t)cur.pn * tstep;
    S.a_ready(cur);
    if constexpr (SP2) {
        PG8_STAGE(PG8_SB(0, 0), cB, voffB); PG8_STAGE(PG8_SB(0, 1), cB + hstep, voffB); PG8_STAGE(PG8_SA(0, 0), cA, voffA); PG8_STAGE(PG8_SA(0, 1), cA + hstep, voffA);
        if (wr == 1) PG8_BAR;
        PG8_WAIT_V(2); PG8_BAR;
        PG8_STAGE(PG8_SB(1, 0), cB + kstep, voffB); PG8_STAGE(PG8_SA(1, 0), cA + kstep, voffA); PG8_STAGE(PG8_SB(1, 1), cB + hstep + kstep, voffB);
        PG8_WAIT_V(6); PG8_BAR;
    } else {
        PG8_STAGE(PG8_SB(0, 0), cB, voffB); PG8_STAGE(PG8_SA(0, 0), cA, voffA); PG8_STAGE(PG8_SB(0, 1), cB + hstep, voffB); PG8_STAGE(PG8_SA(0, 1), cA + hstep, voffA);
        if (wr == 1) PG8_BAR;
        PG8_WAIT_V(4); PG8_BAR;
        PG8_STAGE(PG8_SB(1, 0), cB + kstep, voffB); PG8_STAGE(PG8_SA(1, 0), cA + kstep, voffA); PG8_STAGE(PG8_SB(1, 1), cB + hstep + kstep, voffB);
        PG8_WAIT_V(6); PG8_BAR;
    }
    for (;;) {
        const bool has_next = S.next(ui + 1, nxt);
        const char* nA = has_next ? (const char*)g.A + (size_t)nxt.pm * tstep : cA; const char* nB = has_next ? (const char*)g.Bt + (size_t)nxt.pn * tstep : cB;
        for (int t = 0; t < nt; t += 2) {
            const bool last = (t == nt - 2);
            const char* a1 = cA + (size_t)(t + 1) * kstep;
            const char* a2 = last ? nA : cA + (size_t)(t + 2) * kstep; const char* b2 = last ? nB : cB + (size_t)(t + 2) * kstep;
            const char* a3 = a2 + kstep; const char* b3 = b2 + kstep;
            if (last && has_next) S.a_ready(nxt);
            if constexpr (SP2) {
            PG8_LDB(B0, 0, 0); PG8_LDB(B1, 0, 1); PG8_SCHED; PG8_LDA(At, 0, 0); PG8_STAGE(PG8_SA(1, 1), a1 + hstep, voffA);
            PG8_WAIT_V(8); PG8_WAIT_L(0); PG8_BAR; PG8_MMA(0, 0, At, B0); PG8_MMA(0, 1, At, B1); PG8_BAR; PG8_SCHED;
            PG8_LDA(At, 0, 1); PG8_STAGE(PG8_SB(0, 0), b2, voffB); PG8_STAGE(PG8_SB(0, 1), b2 + hstep, voffB); PG8_STAGE(PG8_SA(0, 0), a2, voffA);
            PG8_WAIT_V(8); PG8_WAIT_L(0); PG8_BAR; PG8_MMA(1, 0, At, B0); PG8_MMA(1, 1, At, B1); PG8_BAR; PG8_SCHED;
            PG8_LDB(B0, 1, 0); PG8_LDB(B1, 1, 1); PG8_SCHED; PG8_LDA(At, 1, 0); PG8_STAGE(PG8_SA(0, 1), a2 + hstep, voffA);
            PG8_WAIT_V(8); PG8_WAIT_L(0); PG8_BAR; PG8_MMA(0, 0, At, B0); PG8_MMA(0, 1, At, B1); PG8_BAR; PG8_SCHED;
            PG8_LDA(At, 1, 1); PG8_STAGE(PG8_SB(1, 0), b3, voffB); PG8_STAGE(PG8_SB(1, 1), b3 + hstep, voffB); PG8_STAGE(PG8_SA(1, 0), a3, voffA);
            PG8_WAIT_V(8); PG8_WAIT_L(0); PG8_BAR; PG8_MMA(1, 0, At, B0); PG8_MMA(1, 1, At, B1); PG8_BAR; PG8_SCHED;
            } else {
            PG8_LDB(B0, 0, 0); PG8_SCHED; PG8_LDA(At, 0, 0); PG8_STAGE(PG8_SA(1, 1), a1 + hstep, voffA);
            PG8_WAIT_L(8); PG8_BAR; PG8_WAIT_L(0); PG8_MMA(0, 0, At, B0); PG8_BAR; PG8_SCHED;
            PG8_LDB(B1, 0, 1); PG8_STAGE(PG8_SB(0, 0), b2, voffB);
            PG8_BAR; PG8_WAIT_L(0); PG8_MMA(0, 1, At, B1); PG8_BAR;
            PG8_LDA(At, 0, 1); PG8_STAGE(PG8_SA(0, 0), a2, voffA);
            PG8_BAR; PG8_WAIT_L(0); PG8_MMA(1, 0, At, B0); PG8_BAR; PG8_SCHED;
            PG8_STAGE(PG8_SB(0, 1), b2 + hstep, voffB);
            PG8_WAIT_V(6); PG8_BAR; PG8_MMA(1, 1, At, B1); PG8_BAR;
            PG8_LDB(B0, 1, 0); PG8_SCHED; PG8_LDA(At, 1, 0); PG8_STAGE(PG8_SA(0, 1), a2 + hstep, voffA);
            PG8_WAIT_L(8); PG8_BAR; PG8_WAIT_L(0); PG8_MMA(0, 0, At, B0); PG8_BAR; PG8_SCHED;
            PG8_LDB(B1, 1, 1); PG8_STAGE(PG8_SB(1, 0), b3, voffB);
            PG8_BAR; PG8_WAIT_L(0); PG8_MMA(0, 1, At, B1); PG8_BAR;
            PG8_LDA(At, 1, 1); PG8_STAGE(PG8_SA(1, 0), a3, voffA);
            PG8_BAR; PG8_WAIT_L(0); PG8_MMA(1, 0, At, B0); PG8_BAR; PG8_SCHED;
            PG8_STAGE(PG8_SB(1, 1), b3 + hstep, voffB);
            PG8_WAIT_V(6); PG8_BAR; PG8_MMA(1, 1, At, B1); PG8_BAR;
            }
        }
        if constexpr (ALIGN_EPI) { if (wr == 0) PG8_BAR; }
        if constexpr (!Epi::AFTER_DRAIN) { E(acc, cur, wr, wc, fr, fq); S.done(cur); }
        if (!has_next) break;
#pragma unroll
        for (int a = 0; a < 2; ++a)
#pragma unroll
            for (int b = 0; b < 2; ++b)
#pragma unroll
                for (int m = 0; m < 4; ++m)
#pragma unroll
                    for (int n = 0; n < 2; ++n) acc[a][b][m][n] = (f32x4){0.f, 0.f, 0.f, 0.f};
        cur = nxt; cA = nA; cB = nB; ++ui;
        if constexpr (ALIGN_EPI) { if (wr == 1) PG8_BAR; }
    }
    PG8_WAIT_V(0);
    if constexpr (!ALIGN_EPI) { if (wr == 0) PG8_BAR; }
    PG8_BAR;
    if constexpr (Epi::AFTER_DRAIN) { E.fused(acc, cur, wr, wc, fr, fq, lds, wid, lane); S.done(cur); }
#undef PG8_SA
#undef PG8_SB
#undef PG8_STAGE
#undef PG8_LDA
#undef PG8_LDB
#undef PG8_MMA
#undef PG8_WAIT_V
#undef PG8_WAIT_L
#undef PG8_BAR
#undef PG8_SCHED
}
}
#ifndef PG8_SP2
#define PG8_SP2 true
#endif
#ifndef PG8_ALIGN
#define PG8_ALIGN true
#endif
#ifndef MK_N_LAUNCHES
#define MK_N_LAUNCHES 1
#endif

constexpr int NB = 8, SEQ = 4096, D = 1024, T = NB * SEQ, NPROJ = 4096, DMIX = 2048;
constexpr int PSTR = 1024; constexpr size_t PSEG = (size_t)T * 1024;
constexpr int NPH = 10;
constexpr float EPS = 1e-6f;
constexpr size_t MiB = 1u << 20;
constexpr size_t WS_WIN = 0, WS_WOUT = 16 * MiB, WS_GW = 24 * MiB, WS_PW = 25 * MiB, WS_MOD = 26 * MiB;
constexpr size_t WS_H = 32 * MiB, WS_YCAT = 96 * MiB, WS_PROJ = 224 * MiB, WS_Y = WS_PROJ, WS_U = WS_H, WS_END = 480 * MiB;
constexpr size_t WS_CTL = 28 * MiB, CTL_BYTES = 16384;
constexpr int LDS_BYTES = 147456, LDS_BST_OFF = 147456 - 64;

#define LAS __attribute__((address_space(3)))
typedef unsigned short bf16;
typedef float f32x4 __attribute__((ext_vector_type(4)));
typedef float f32x2 __attribute__((ext_vector_type(2)));
typedef unsigned u32x4 __attribute__((ext_vector_type(4)));
typedef unsigned u32x2 __attribute__((ext_vector_type(2)));
typedef short bf16x8 __attribute__((ext_vector_type(8)));

struct Args { const float* in[18]; float* out; unsigned char* ws; int ph_lo, ph_hi; };

__device__ __forceinline__ unsigned pk2(float lo, float hi) { return pg8::cvt_pk_bf16(lo, hi); }
__device__ __forceinline__ float bflo(unsigned w) { return u2f(w << 16); }
__device__ __forceinline__ float bfhi(unsigned w) { return u2f(w & 0xffff0000u); }
template <int CTRL> __device__ __forceinline__ float dpp_mov_(float v) { return i2f(__builtin_amdgcn_update_dpp(0, f2i(v), CTRL, 0xf, 0xf, true)); }
__device__ __forceinline__ float wave_sum(float v) {
    v += dpp_mov_<0xB1>(v);
    v += dpp_mov_<0x4E>(v);
    v += dpp_mov_<0x141>(v);
    v += dpp_mov_<0x140>(v);
    const float r0 = i2f(__builtin_amdgcn_readlane(f2i(v), 0)), r1 = i2f(__builtin_amdgcn_readlane(f2i(v), 16));
    const float r2 = i2f(__builtin_amdgcn_readlane(f2i(v), 32)), r3 = i2f(__builtin_amdgcn_readlane(f2i(v), 48));
    return (r0 + r1) + (r2 + r3);
}
__device__ __forceinline__ float sigmoidf_(float x) { return 1.0f / (1.0f + __expf(-x)); }
__device__ __forceinline__ float siluf_(float x) { return x / (1.0f + __expf(-x)); }

__device__ __forceinline__ void transpose_tile(const float* W, int K, int N, bf16* WT, LAS float* scr, int k0, int n0, int drow, int lane, float wscale = 1.0f) {
    {
        f32x4 v[8];
#pragma unroll
        for (int i = 0; i < 8; ++i) v[i] = *(const f32x4*)(W + (size_t)(k0 + (lane >> 3) + 8 * i) * N + n0 + (lane & 7) * 4);
#pragma unroll
        for (int i = 0; i < 8; ++i) { LAS float* d = scr + ((lane >> 3) + 8 * i) * 33 + (lane & 7) * 4; d[0] = v[i].x * wscale; d[1] = v[i].y * wscale; d[2] = v[i].z * wscale; d[3] = v[i].w * wscale; }
    }
    asm volatile("s_waitcnt lgkmcnt(0)" ::: "memory");
    const int c = lane & 7;
#pragma unroll
    for (int j = 0; j < 4; ++j) { const int n = (lane >> 3) + 8 * j; const LAS float* s = scr + (8 * c) * 33 + n;
        u32x4 o; o.x = pk2(s[0 * 33], s[1 * 33]); o.y = pk2(s[2 * 33], s[3 * 33]); o.z = pk2(s[4 * 33], s[5 * 33]); o.w = pk2(s[6 * 33], s[7 * 33]);
        *(u32x4*)(WT + (size_t)(drow + n) * K + k0 + 8 * c) = o; }
    asm volatile("s_waitcnt lgkmcnt(0)" ::: "memory");
}
__device__ __forceinline__ void transpose_item(const float* W, int K, int N, bf16* WT, LAS float* scr, int item, int lane) {
    const int nblk = N / 32, kb = item / nblk, nb = item % nblk;
    transpose_tile(W, K, N, WT, scr, 64 * kb, 32 * nb, 32 * nb, lane);
}

__device__ __forceinline__ void phase_prep(const Args& a, LAS unsigned char* lds) {
    const int tid = opaque_tid(), lane = tid & 63, wv = tid >> 6;
    const int G = gridDim.x;
    unsigned char* ws = a.ws;
    {
        LAS float* sc = (LAS float*)lds;
        LAS float* red = (LAS float*)(lds + 32768);
        const float* c = a.in[1]; const float* ada_w = a.in[2]; const float* ada_b = a.in[3];
        float* MOD = (float*)(ws + WS_MOD);
        if ((int)blockIdx.x < 192) {
            for (int i = tid; i < 8192; i += 512) sc[i] = siluf_(c[i]);
            sync_threads_();
            for (int unit = blockIdx.x; unit < 192; unit += G) {
                const int l = unit / 96, cb = (unit % 96) * 32, cl = tid & 31, ks = tid >> 5;
                const float* wp = ada_w + (size_t)l * 1024 * 3072 + (size_t)(ks * 64) * 3072 + cb + cl;
                float acc[8];
#pragma unroll
                for (int b = 0; b < 8; ++b) acc[b] = 0.f;
#pragma unroll 16
                for (int k = 0; k < 64; ++k) { const float w = wp[(size_t)k * 3072];
#pragma unroll
                    for (int b = 0; b < 8; ++b) acc[b] += sc[b * 1024 + ks * 64 + k] * w; }
#pragma unroll
                for (int b = 0; b < 8; ++b) red[(ks * 8 + b) * 32 + cl] = acc[b];
                sync_threads_();
                if (tid < 256) { const int b = tid >> 5; float s = 0.f;
#pragma unroll
                    for (int k2 = 0; k2 < 16; ++k2) s += red[(k2 * 8 + b) * 32 + cl];
                    MOD[(l * 8 + b) * 3072 + cb + cl] = s + ada_b[l * 3072 + cb + cl]; }
                sync_threads_();
            }
        }
        sync_threads_();
    }
    {
        LAS float* scr = (LAS float*)(lds + wv * 16384);
        const int gw = blockIdx.x * 8 + wv, NGW = G * 8;
        constexpr int I_IN = (1024 / 64) * (4096 / 32), I_OUT = (2048 / 64) * (1024 / 32);
        for (int it = gw; it < 2 * (I_IN + I_OUT); it += NGW) {
            int r = it;
            if (r < 2 * I_IN) { const int l = r / I_IN; r -= l * I_IN;
                transpose_item(a.in[5] + (size_t)l * 1024 * 4096, 1024, 4096, (bf16*)(ws + WS_WIN) + (size_t)l * 4096 * 1024, scr, r, lane); }
            else { r -= 2 * I_IN; const int l = r / I_OUT; r -= l * I_OUT;
                transpose_item(a.in[16] + (size_t)l * 2048 * 1024, 2048, 1024, (bf16*)(ws + WS_WOUT) + (size_t)l * 1024 * 2048, scr, r, lane); }
        }
    }
    {
        LAS float* scr = (LAS float*)(lds + wv * 16384);
        const int gw = blockIdx.x * 8 + wv, NGW = G * 8;
        bf16* GWp = (bf16*)(ws + WS_GW); bf16* PWp = (bf16*)(ws + WS_PW);
        for (int it = NGW - 1 - gw; it < 512; it += NGW) {
            if (it < 256) { const int lh = it >> 4, r = it & 15, gate = r >> 3, kb = (r >> 2) & 1, q = r & 3;
                transpose_tile((gate ? a.in[10] : a.in[8]) + (size_t)lh * 128 * 128, 128, 128, GWp + (size_t)lh * 4 * 64 * 128, scr, 64 * kb, 32 * q, q * 64 + gate * 32, lane, -1.4426950408889634f); }
            else { const int r = it - 256, lg = r >> 5, kb = (r >> 3) & 3, nb = r & 7;
                transpose_tile(a.in[13] + (size_t)lg * 256 * 256, 256, 256, PWp + (size_t)lg * 256 * 256, scr, 64 * kb, 32 * nb, 32 * nb, lane); }
        }
    }
}

constexpr int RPW = 4;
__device__ __forceinline__ void phase_h0(const Args& a) {
    const int tid = opaque_tid(), lane = tid & 63, wv = tid >> 6;
    const int gw = blockIdx.x * 8 + wv, NGW = gridDim.x * 8;
    const float* x = a.in[0]; const float* g = a.in[4]; const float* MOD = (const float*)(a.ws + WS_MOD);
    bf16* H = (bf16*)(a.ws + WS_H);
    const int WPB = NGW / NB, b = gw / WPB, wq = gw % WPB;
    const float* sh = MOD + (size_t)b * 3072; const float* scl = sh + 1024;
    f32x4 A1[4], SH[4];
#pragma unroll
    for (int j = 0; j < 4; ++j) { const int col = 4 * lane + 256 * j; A1[j] = *(const f32x4*)(g + col) * (*(const f32x4*)(scl + col) + 1.0f); SH[j] = *(const f32x4*)(sh + col); }
    for (int mr = wq * RPW; mr < SEQ; mr += WPB * RPW) {
        const int m0 = b * SEQ + mr;
        f32x4 v[RPW][4];
#pragma unroll
        for (int r = 0; r < RPW; ++r) { const f32x4* xr = (const f32x4*)(x + (size_t)(m0 + r) * D) + lane;
#pragma unroll
            for (int j = 0; j < 4; ++j) v[r][j] = __builtin_nontemporal_load(xr + 64 * j); }
#pragma unroll
        for (int r = 0; r < RPW; ++r) {
            float ss = 0.f;
#pragma unroll
            for (int j = 0; j < 4; ++j) ss += (v[r][j].x * v[r][j].x + v[r][j].y * v[r][j].y) + (v[r][j].z * v[r][j].z + v[r][j].w * v[r][j].w);
            const float rstd = 1.0f / __builtin_sqrtf(wave_sum(ss) * (1.0f / D) + EPS);
            u32x2* o = (u32x2*)(H + (size_t)(m0 + r) * D) + lane;
#pragma unroll
            for (int j = 0; j < 4; ++j) {
                const f32x4 rr = (v[r][j] * rstd) * A1[j] + SH[j];
                u32x2 w; w.x = pk2(rr.x, rr.y); w.y = pk2(rr.z, rr.w); o[64 * j] = w; }
        }
    }
}

template <int l> __device__ __forceinline__ void phase_post(const Args& a) {
    const int tid = opaque_tid(), lane = tid & 63, wv = tid >> 6;
    const int gw = blockIdx.x * 8 + wv, NGW = gridDim.x * 8;
    const float* xin = (l == 0) ? a.in[0] : a.out; float* out = a.out;
    const bf16* Y = (const bf16*)(a.ws + WS_Y); bf16* H = (bf16*)(a.ws + WS_H);
    const float* MOD = (const float*)(a.ws + WS_MOD);
    const float* gpost = a.in[17] + l * D; const float* gpre = a.in[4] + (l + 1) * D;
    const int WPB = NGW / NB, b = gw / WPB, wq = gw % WPB;
    const float* gate = MOD + (size_t)(l * 8 + b) * 3072 + 2048;
    const float* sh = MOD + (size_t)(8 + b) * 3072; const float* scl = sh + 1024;
    f32x4 GP[4], A1[4], SH[4];
#pragma unroll
    for (int j = 0; j < 4; ++j) { const int col = 4 * lane + 256 * j; GP[j] = *(const f32x4*)(gate + col) * *(const f32x4*)(gpost + col);
        if (l == 0) { A1[j] = *(const f32x4*)(gpre + col) * (*(const f32x4*)(scl + col) + 1.0f); SH[j] = *(const f32x4*)(sh + col); } }
    for (int mr = wq * RPW; mr < SEQ; mr += WPB * RPW) {
        const int m0 = b * SEQ + mr;
        f32x4 xv[RPW][4]; u32x2 yw[RPW][4];
#pragma unroll
        for (int r = 0; r < RPW; ++r) { const f32x4* xr = (const f32x4*)(xin + (size_t)(m0 + r) * D) + lane; const u32x2* yr = (const u32x2*)(Y + (size_t)(m0 + r) * D) + lane;
#pragma unroll
            for (int j = 0; j < 4; ++j) { xv[r][j] = xr[64 * j]; yw[r][j] = yr[64 * j]; } }
#pragma unroll
        for (int r = 0; r < RPW; ++r) {
            f32x4 yv[4]; float ss = 0.f;
#pragma unroll
            for (int j = 0; j < 4; ++j) { const u32x2 w = yw[r][j]; yv[j] = (f32x4){bflo(w.x), bfhi(w.x), bflo(w.y), bfhi(w.y)};
                ss += (yv[j].x * yv[j].x + yv[j].y * yv[j].y) + (yv[j].z * yv[j].z + yv[j].w * yv[j].w); }
            const float rstd = 1.0f / __builtin_sqrtf(wave_sum(ss) * (1.0f / D) + EPS);
            float ss2 = 0.f;
#pragma unroll
            for (int j = 0; j < 4; ++j) { const int col = 4 * lane + 256 * j;
                const f32x4 xn = xv[r][j] + (yv[j] * rstd) * GP[j];
                xv[r][j] = xn;
                if (l == 0) *((f32x4*)(out + (size_t)(m0 + r) * D + col)) = xn;
                else __builtin_nontemporal_store(xn, (f32x4*)(out + (size_t)(m0 + r) * D + col));
                ss2 += (xn.x * xn.x + xn.y * xn.y) + (xn.z * xn.z + xn.w * xn.w); }
            if (l == 0) {
                const float rstd2 = 1.0f / __builtin_sqrtf(wave_sum(ss2) * (1.0f / D) + EPS);
                u32x2* o = (u32x2*)(H + (size_t)(m0 + r) * D) + lane;
#pragma unroll
                for (int j = 0; j < 4; ++j) {
                    const f32x4 rr = (xv[r][j] * rstd2) * A1[j] + SH[j];
                    u32x2 w; w.x = pk2(rr.x, rr.y); w.y = pk2(rr.z, rr.w); o[64 * j] = w; }
            }
        }
    }
}
#define XB_TMO      128
#define XB_XCNT(j)  (256  + 64 * (j))
#define XB_XSUB(j)  (1280 + 64 * (j))
#define XB_XGEN(j)  (2304 + 64 * (j))
#define XB_TOP      3328
#define XB_TOPGEN   3392
#define XCD_BAR_WORDS 3456
#define XB_SPIN_CAP (1u << 18)

__device__ __forceinline__ unsigned xb_ld(unsigned* p)              { return __hip_atomic_load(p, __ATOMIC_RELAXED, __HIP_MEMORY_SCOPE_AGENT); }
__device__ __forceinline__ unsigned xb_add(unsigned* p, unsigned v) { return __hip_atomic_fetch_add(p, v, __ATOMIC_RELAXED, __HIP_MEMORY_SCOPE_AGENT); }
__device__ __forceinline__ unsigned xb_xcc_id() { return (unsigned)__builtin_amdgcn_s_getreg((3 << 11) | 20) & 0xFu; }
#define XB_SPIN(cond, bar) do { unsigned _sp = 0; while (cond) { __builtin_amdgcn_s_sleep(1); \
    if ((++_sp & 255u) == 0u) { if (xb_ld(&(bar)[XB_TMO])) break; if (_sp > XB_SPIN_CAP) { xb_add(&(bar)[XB_TMO], 1u); break; } } } } while (0)

struct XcdBarrier {
    unsigned* bar; unsigned x;
    volatile LAS unsigned* st;
};

__device__ __forceinline__ XcdBarrier xcd_barrier_post(unsigned* bar, volatile LAS unsigned* st) {
    XcdBarrier b; b.bar = bar; b.x = xb_xcc_id(); b.st = st;
    if (threadIdx.x == 0) (void)xb_add(&bar[XB_XCNT(b.x)], 1u);
    return b;
}
__device__ __forceinline__ void xcd_barrier_complete(unsigned* bar, unsigned x, unsigned& nloc, unsigned& nx) {
    const unsigned G = gridDim.x * gridDim.y * gridDim.z;
    unsigned sum, cnt, mine, sp = 0u;
    for (;;) {
        sum = 0u; cnt = 0u; mine = 0u;
#pragma unroll
        for (unsigned j = 0; j < 16; ++j) { const unsigned c = xb_ld(&bar[XB_XCNT(j)]); sum += c; cnt += (c > 0u) ? 1u : 0u; mine = (j == x) ? c : mine; }
        if (sum == G) break;
        __builtin_amdgcn_s_sleep(1);
        if ((++sp & 255u) == 0u) { if (xb_ld(&bar[XB_TMO])) break; if (sp > XB_SPIN_CAP) { xb_add(&bar[XB_TMO], 1u); break; } }
    }
    nloc = mine > 0u ? mine : 1u; nx = cnt > 0u ? cnt : 1u;
}

__device__ __forceinline__ void xcd_barrier(const XcdBarrier& b) {
    asm volatile("s_waitcnt vmcnt(0)" ::: "memory");
    sync_threads_();
    if (threadIdx.x == 0) {
        unsigned* bar = b.bar;
        __builtin_amdgcn_s_waitcnt(0);
        unsigned nloc = b.st[0], nx = b.st[1];
        if (nloc == 0u) { xcd_barrier_complete(bar, b.x, nloc, nx); b.st[0] = nloc; b.st[1] = nx; }
        const unsigned old = xb_add(&bar[XB_XSUB(b.x)], 1u);
        const unsigned gen = old / nloc;
        if (old + 1u == (gen + 1u) * nloc) {
            __builtin_amdgcn_fence(__ATOMIC_RELEASE, "agent");
            asm volatile("s_waitcnt vmcnt(0)" ::: "memory");
            const unsigned og = xb_add(&bar[XB_TOP], 1u);
            const unsigned tg = og / nx;
            if (og + 1u == (tg + 1u) * nx) xb_add(&bar[XB_TOPGEN], 1u);
            else XB_SPIN(xb_ld(&bar[XB_TOPGEN]) == tg, bar);
            __builtin_amdgcn_fence(__ATOMIC_ACQUIRE, "agent");
            xb_add(&bar[XB_XGEN(b.x)], 1u);
            asm volatile("s_waitcnt vmcnt(0)" ::: "memory");
        } else {
            XB_SPIN(xb_ld(&bar[XB_XGEN(b.x)]) == gen, bar);
            __builtin_amdgcn_fence(__ATOMIC_ACQUIRE, "agent");
            asm volatile("s_waitcnt vmcnt(0)" ::: "memory");
        }
    }
    sync_threads_();
}

#define LDS_BARRIER() do { asm volatile("s_waitcnt lgkmcnt(0)" ::: "memory"); __builtin_amdgcn_s_barrier(); asm volatile("" ::: "memory"); } while (0)
constexpr int XROW = 272;
constexpr int CROW = 132;
constexpr int R_XT = 0, R_UT = 35840, R_AT = 70656, R_VT = 87552, R_EP = 104448, R_CWT = 105472, R_GT = 108032, R_YT = 116736, R_AW = 125440;
constexpr int R_DUMMY_ = 0;
template <int D> __device__ __forceinline__ float dpp_row_shr(float old, float src) {
    return i2f(__builtin_amdgcn_update_dpp(f2i(old), f2i(src), 0x110 | D, 0xf, 0xf, false)); }
__device__ __forceinline__ float softplus_small_(float e) { return (e < 0.03f) ? e * (1.0f + e * (-0.5f + e * (0.33333334f + e * (-0.25f + e * 0.2f)))) : __builtin_logf(1.0f + e); }
typedef __bf16 bf16x2_t_ __attribute__((ext_vector_type(2)));
__device__ __forceinline__ unsigned cvtpk_s(float lo, float hi) { const f32x2 v = {lo, hi}; const bf16x2_t_ b = __builtin_convertvector(v, bf16x2_t_); return __builtin_bit_cast(unsigned, b); }
__device__ __forceinline__ float fast_sigmoid(float x) { return __builtin_amdgcn_rcpf(1.0f + __builtin_amdgcn_exp2f(-1.4426950408889634f * x)); }
__device__ __forceinline__ void rnn_unit(const Args& a, int l, int u, LAS unsigned char* lds) {
    const int tid = opaque_tid(), lane = tid & 63, wv = tid >> 6, fr = lane & 15, fq = lane >> 4;
    const int xcd = u & 7, jj = u >> 3, q = jj & 3, bh = (jj >> 2) * 8 + xcd, b = bh >> 3, h = bh & 7;
    const bf16* PROJ = (const bf16*)(a.ws + WS_PROJ); bf16* YCAT = (bf16*)(a.ws + WS_YCAT);
    const bf16* xr_base = PROJ + 0 * PSEG + (size_t)(b * SEQ) * PSTR + h * 128;
    const bf16* gr_base = PROJ + 1 * PSEG + (size_t)(b * SEQ) * PSTR + h * 128 + q * 32;
    bf16* y_base = YCAT + (size_t)(b * SEQ) * DMIX + h * 128 + q * 32;
    LAS unsigned char* XT = lds + R_XT; LAS unsigned char* UT = lds + R_UT;
    LAS float* AT = (LAS float*)(lds + R_AT); LAS float* VT = (LAS float*)(lds + R_VT);
    LAS unsigned char* GT = lds + R_GT; LAS unsigned char* YT = lds + R_YT;
    const int io_tk = tid >> 2, io_cq = tid & 3;
    LAS float* CB = (LAS float*)(lds + R_CWT);
    if (tid < 128) CB[tid] = a.in[7][(size_t)l * 1024 + h * 128 + tid];
    {
        LAS unsigned char* AW = lds + R_AW;
#pragma unroll
        for (int rep = 0; rep < 2; ++rep) { const int id = tid + 512 * rep, ln = id & 63, hh = (id >> 6) & 1, cb = id >> 7, i = ln & 15, tap = ln >> 4;
            u32x4 v = (u32x4){0u, 0u, 0u, 0u};
            if ((i >> 3) == hh) { const unsigned wb = pk2(a.in[6][(size_t)l * 4 * 1024 + tap * 1024 + h * 128 + cb * 16 + i], 0.f) & 0xffffu;
                const unsigned wsh = (i & 1) ? (wb << 16) : wb; const int d = (i & 7) >> 1;
                v.x = (d == 0) ? wsh : 0u; v.y = (d == 1) ? wsh : 0u; v.z = (d == 2) ? wsh : 0u; v.w = (d == 3) ? wsh : 0u; }
            *(LAS u32x4*)(AW + id * 16) = v; }
    }
    LDS_BARRIER();
    bf16x8 Wf[4][4];
    {
        const bf16* gwp = (const bf16*)(a.ws + WS_GW) + (size_t)((l * 8 + h) * 4 + q) * 64 * 128;
#pragma unroll
        for (int nb = 0; nb < 4; ++nb)
#pragma unroll
            for (int kb = 0; kb < 4; ++kb) Wf[nb][kb] = *(const bf16x8*)(gwp + (nb * 16 + fr) * 128 + kb * 32 + fq * 8);
    }
    LAS float* EP = (LAS float*)(lds + R_EP);
    if (tid < 96) {
        const int r = tid >> 5, c = tid & 31, ch = h * 128 + q * 32 + c; float v;
        if (r == 0) v = -1.4426950408889634f * a.in[9][l * 1024 + ch];
        else if (r == 1) v = -1.4426950408889634f * a.in[11][l * 1024 + ch];
        else v = 8.0f * 1.4426950408889634f * softplus_small_(__builtin_expf(-a.in[12][l * 1024 + ch]));
        EP[r * 32 + c] = v;
    }
    u32x4 pf[4], pfh = (u32x4){0u, 0u, 0u, 0u};
#pragma unroll
    for (int i = 0; i < 4; ++i) { const int id = tid + 512 * i, row = id >> 4, cc = id & 15; pf[i] = *(const u32x4*)(xr_base + (size_t)row * PSTR + cc * 8); }
    u32x4 gpf = *(const u32x4*)(gr_base + (size_t)io_tk * PSTR + io_cq * 8);
    const int sc_ci = lane >> 4, sc_sg = lane & 15, sc_c = wv * 4 + sc_ci;
    float hcar = 0.f;
#pragma unroll
    for (int i = 0; i < 4; ++i) { const int id = tid + 512 * i, row = id >> 4, cc = id & 15; *(LAS u32x4*)(XT + (3 + row) * XROW + cc * 16) = pf[i]; }
    if (tid < 48) *(LAS u32x4*)(XT + (tid >> 4) * XROW + (tid & 15) * 16) = pfh;
    for (int tile = 0; tile < SEQ / 128; ++tile) {
        const int t0 = tile * 128;
        LDS_BARRIER();
        {
            const int t0n = (tile + 1 < SEQ / 128) ? t0 + 128 : t0;
#pragma unroll
            for (int i = 0; i < 4; ++i) { const int id = tid + 512 * i, row = id >> 4, cc = id & 15; pf[i] = *(const u32x4*)(xr_base + (size_t)(t0n + row) * PSTR + cc * 8); }
            if (tid < 48) pfh = *(const u32x4*)(xr_base + (size_t)(t0n - 3 + (tid >> 4)) * PSTR + (tid & 15) * 8);
        }
        {
            {
                unsigned short yv_[8];
#pragma unroll
                for (int e = 0; e < 8; ++e) yv_[e] = *(const LAS unsigned short*)(YT + (io_cq * 8 + e) * XROW + io_tk * 2);
                u32x4 w; w.x = yv_[0] | ((unsigned)yv_[1] << 16); w.y = yv_[2] | ((unsigned)yv_[3] << 16); w.z = yv_[4] | ((unsigned)yv_[5] << 16); w.w = yv_[6] | ((unsigned)yv_[7] << 16);
                *(u32x4*)(y_base + (size_t)((tile > 0 ? t0 - 128 : 0) + io_tk) * DMIX + io_cq * 8) = w;
            }
            const unsigned gwv[4] = {gpf.x, gpf.y, gpf.z, gpf.w};
#pragma unroll
            for (int e2 = 0; e2 < 4; ++e2) { *(LAS unsigned short*)(GT + (io_cq * 8 + 2 * e2) * XROW + io_tk * 2) = (unsigned short)(gwv[e2] & 0xffffu);
                *(LAS unsigned short*)(GT + (io_cq * 8 + 2 * e2 + 1) * XROW + io_tk * 2) = (unsigned short)(gwv[e2] >> 16); }
            const int t1 = (tile + 1 < SEQ / 128) ? t0 + 128 : t0;
            gpf = *(const u32x4*)(gr_base + (size_t)(t1 + io_tk) * PSTR + io_cq * 8);
        }
        {
            const LAS unsigned char* AW = lds + R_AW;
#pragma unroll
            for (int g4 = 0; g4 < 2; ++g4) {
                f32x4 acc[4]; bf16x8 xb[4][2], aw[4][2];
#pragma unroll
                for (int c = 0; c < 4; ++c) { const int cb = g4 * 4 + c;
                    acc[c] = *(const LAS f32x4*)(CB + cb * 16 + 4 * fq);
#pragma unroll
                    for (int hh = 0; hh < 2; ++hh) {
                        xb[c][hh] = *(const LAS bf16x8*)(XT + (wv * 16 + fr + fq) * XROW + (cb * 2 + hh) * 16);
                        aw[c][hh] = *(const LAS bf16x8*)(AW + ((cb * 2 + hh) * 64 + lane) * 16); } }
#pragma unroll
                for (int hh = 0; hh < 2; ++hh)
#pragma unroll
                    for (int c = 0; c < 4; ++c) acc[c] = __builtin_amdgcn_mfma_f32_16x16x32_bf16(aw[c][hh], xb[c][hh], acc[c], 0, 0, 0);
#pragma unroll
                for (int c = 0; c < 4; ++c) { const int cb = g4 * 4 + c;
                    u32x2 o; o.x = cvtpk_s(acc[c][0], acc[c][1]); o.y = cvtpk_s(acc[c][2], acc[c][3]);
                    *(LAS u32x2*)(UT + (wv * 16 + fr) * XROW + (cb * 16 + 4 * fq) * 2) = o; }
            }
        }
        asm volatile("s_waitcnt lgkmcnt(0)" ::: "memory");
        {
            f32x4 acc[4];
#pragma unroll
            for (int nb = 0; nb < 4; ++nb) acc[nb] = (f32x4){0.f, 0.f, 0.f, 0.f};
#pragma unroll
            for (int kb = 0; kb < 4; ++kb) { const bf16x8 uf = *(const LAS bf16x8*)(UT + (wv * 16 + fr) * XROW + kb * 64 + fq * 16);
#pragma unroll
                for (int nb = 0; nb < 4; ++nb) acc[nb] = __builtin_amdgcn_mfma_f32_16x16x32_bf16(Wf[nb][kb], uf, acc[nb], 0, 0, 0); }
            const int tk = wv * 16 + fr;
#pragma unroll
            for (int nb2 = 0; nb2 < 2; ++nb2) {
                const int c0 = nb2 * 16 + 4 * fq;
                const u32x2 uw = *(const LAS u32x2*)(UT + tk * XROW + (q * 32 + c0) * 2);
                const f32x4 uu = (f32x4){bflo(uw.x), bfhi(uw.x), bflo(uw.y), bfhi(uw.y)};
                const f32x4 ra = acc[nb2] + *(const LAS f32x4*)(EP + c0), rx = acc[nb2 + 2] + *(const LAS f32x4*)(EP + 32 + c0), sp8 = *(const LAS f32x4*)(EP + 64 + c0);
#pragma unroll
                for (int e = 0; e < 4; ++e) { const float r = __builtin_amdgcn_rcpf(1.0f + __builtin_amdgcn_exp2f(ra[e])), ig = __builtin_amdgcn_rcpf(1.0f + __builtin_amdgcn_exp2f(rx[e]));
                    const float av = __builtin_amdgcn_exp2f(-r * sp8[e]);
                    const float m2 = __builtin_fmaxf(__builtin_fmaf(-av, av, 1.0f), 0.f);
                    *(LAS f32x2*)(AT + ((c0 + e) * CROW + tk) * 2) = (f32x2){av, __builtin_amdgcn_sqrtf(m2) * (ig * uu[e])}; }
            }
        }
        LDS_BARRIER();
        {
            const LAS f32x4* avp = (const LAS f32x4*)(AT + (sc_c * CROW + sc_sg * 8) * 2);
            const f32x4 q0 = avp[0], q1 = avp[1], q2 = avp[2], q3 = avp[3];
            const float av[8] = {q0.x, q0.z, q1.x, q1.z, q2.x, q2.z, q3.x, q3.z}, vv[8] = {q0.y, q0.w, q1.y, q1.w, q2.y, q2.w, q3.y, q3.w};
            float hl[8], pp[8]; float hcur = 0.f, pcur = 1.f;
#pragma unroll
            for (int j = 0; j < 8; ++j) { hcur = __builtin_fmaf(av[j], hcur, vv[j]); pcur *= av[j]; hl[j] = hcur; pp[j] = pcur; }
            float P = pcur, H = hcur;
            { float Pp = dpp_row_shr<1>(1.f, P), Hp = dpp_row_shr<1>(0.f, H); H = __builtin_fmaf(P, Hp, H); P *= Pp;
              Pp = dpp_row_shr<2>(1.f, P); Hp = dpp_row_shr<2>(0.f, H); H = __builtin_fmaf(P, Hp, H); P *= Pp;
              Pp = dpp_row_shr<4>(1.f, P); Hp = dpp_row_shr<4>(0.f, H); H = __builtin_fmaf(P, Hp, H); P *= Pp;
              Pp = dpp_row_shr<8>(1.f, P); Hp = dpp_row_shr<8>(0.f, H); H = __builtin_fmaf(P, Hp, H); P *= Pp; }
            const float Pe = dpp_row_shr<1>(1.f, P), He = dpp_row_shr<1>(0.f, H);
            const float carry = __builtin_fmaf(Pe, hcar, He);
            const float hend = __builtin_fmaf(P, hcar, H);
            hcar = row_last_(hend);
            const u32x4 gq = *(const LAS u32x4*)(GT + sc_c * XROW + sc_sg * 16);
            const float gvv[8] = {bflo(gq.x), bfhi(gq.x), bflo(gq.y), bfhi(gq.y), bflo(gq.z), bfhi(gq.z), bflo(gq.w), bfhi(gq.w)};
            float yy[8];
#pragma unroll
            for (int j = 0; j < 8; ++j) { const float hv = __builtin_fmaf(pp[j], carry, hl[j]); yy[j] = hv * gvv[j] * fast_sigmoid(gvv[j]); }
            u32x4 yw_; yw_.x = pk2(yy[0], yy[1]); yw_.y = pk2(yy[2], yy[3]); yw_.z = pk2(yy[4], yy[5]); yw_.w = pk2(yy[6], yy[7]);
            *(LAS u32x4*)(YT + sc_c * XROW + sc_sg * 16) = yw_;
        }
#pragma unroll
        for (int i = 0; i < 4; ++i) { const int id = tid + 512 * i, row = id >> 4, cc = id & 15; *(LAS u32x4*)(XT + (3 + row) * XROW + cc * 16) = pf[i]; }
        if (tid < 48) *(LAS u32x4*)(XT + (tid >> 4) * XROW + (tid & 15) * 16) = pfh;
    }
    LDS_BARRIER();
    {
        unsigned short yv_[8];
#pragma unroll
        for (int e = 0; e < 8; ++e) yv_[e] = *(const LAS unsigned short*)(YT + (io_cq * 8 + e) * XROW + io_tk * 2);
        u32x4 w; w.x = yv_[0] | ((unsigned)yv_[1] << 16); w.y = yv_[2] | ((unsigned)yv_[3] << 16); w.z = yv_[4] | ((unsigned)yv_[5] << 16); w.w = yv_[6] | ((unsigned)yv_[7] << 16);
        *(u32x4*)(y_base + (size_t)(SEQ - 128 + io_tk) * DMIX + io_cq * 8) = w;
    }
    LDS_BARRIER();
}

constexpr int PROW = 528;
constexpr int R_XP = 0, R_PT = 42240;
template <int g> __device__ __forceinline__ void pool_units(const Args& a, int l, int u, LAS unsigned char* lds) {
    const int tid = opaque_tid(), lane = tid & 63, wv = tid >> 6, fr = lane & 15, fq = lane >> 4;
    const int bi = u >> 2; constexpr int win = 2 << g;
    const bf16* PROJ = (const bf16*)(a.ws + WS_PROJ); bf16* YCAT = (bf16*)(a.ws + WS_YCAT);
    LAS unsigned char* XP = lds + R_XP; LAS unsigned char* PT = lds + R_PT;
    const bf16* pw = (const bf16*)(a.ws + WS_PW) + (size_t)(l * 4 + g) * 256 * 256;
    bf16x8 Wf[2][8];
#pragma unroll
    for (int nb = 0; nb < 2; ++nb)
#pragma unroll
        for (int kb = 0; kb < 8; ++kb) Wf[nb][kb] = *(const bf16x8*)(pw + (size_t)(wv * 32 + 8 * (fr >> 2) + 4 * nb + (fr & 3)) * 256 + kb * 32 + fq * 8);
    f32x4 pb[2], ps[2];
#pragma unroll
    for (int nb = 0; nb < 2; ++nb) { const int n = wv * 32 + 8 * fq + 4 * nb;
        pb[nb] = *(const f32x4*)(a.in[14] + (size_t)l * 1024 + g * 256 + n); ps[nb] = *(const f32x4*)(a.in[15] + (size_t)l * 1024 + g * 256 + n); }
    const int ck = tid & 31, tg = tid >> 5;
    u32x4 pf[4], hal;
    const int hr = tid >> 5, hc = tid & 31;
    {
        const int tile = bi * 8, b = tile >> 6, t0 = (tile & 63) * 64;
        const bf16* xp_base = PROJ + 2 * PSEG + (size_t)(b * SEQ) * PSTR + g * 256;
#pragma unroll
        for (int i = 0; i < 4; ++i) { const int id = tid + 512 * i, row = id >> 5, cc = id & 31; pf[i] = *(const u32x4*)(xp_base + (size_t)(t0 + row) * PSTR + cc * 8); }
        const int th = t0 - 16 + hr;
        const u32x4 hv = *(const u32x4*)(xp_base + (size_t)(th < 0 ? 0 : th) * PSTR + hc * 8); hal = (th < 0) ? (u32x4){0u, 0u, 0u, 0u} : hv;
    }
#pragma unroll
    for (int i = 0; i < 4; ++i) { const int id = tid + 512 * i, row = id >> 5, cc = id & 31; *(LAS u32x4*)(XP + (16 + row) * PROW + cc * 16) = pf[i]; }
    *(LAS u32x4*)(XP + hr * PROW + hc * 16) = hal;
    u32x4 gp[4];
    {
        const int tile = bi * 8, b = tile >> 6, t0 = (tile & 63) * 64;
        const bf16* gp_base0 = PROJ + 3 * PSEG + (size_t)(b * SEQ) * PSTR + g * 256;
#pragma unroll
        for (int tb = 0; tb < 4; ++tb)
        { gp[tb] = *(const u32x4*)(gp_base0 + (size_t)(t0 + tb * 16 + fr) * PSTR + wv * 32 + 8 * fq);
                asm volatile("" : "+v"(gp[tb])); }
    }
    for (int it = 0; it < 8; ++it) {
        const int tile = bi * 8 + it, b = tile >> 6, t0 = (tile & 63) * 64;
        bf16* y_base = YCAT + (size_t)(b * SEQ) * DMIX + 1024 + g * 256;
        LDS_BARRIER();
        {
            const int tile2 = bi * 8 + ((it + 1 < 8) ? it + 1 : it), b2 = tile2 >> 6, t02 = (tile2 & 63) * 64;
            const bf16* xp_base = PROJ + 2 * PSEG + (size_t)(b2 * SEQ) * PSTR + g * 256;
#pragma unroll
            for (int i = 0; i < 4; ++i) { const int id = tid + 512 * i, row = id >> 5, cc = id & 31; pf[i] = *(const u32x4*)(xp_base + (size_t)(t02 + row) * PSTR + cc * 8); }
        }
        hal = *(const LAS u32x4*)(XP + (64 + hr) * PROW + hc * 16);
        u32x4 gpn[4];
        {
            const int tile2 = bi * 8 + ((it + 1 < 8) ? it + 1 : it), b2 = tile2 >> 6, t02 = (tile2 & 63) * 64;
            const bf16* gp_base2 = PROJ + 3 * PSEG + (size_t)(b2 * SEQ) * PSTR + g * 256;
#pragma unroll
            for (int tb = 0; tb < 4; ++tb)
                gpn[tb] = *(const u32x4*)(gp_base2 + (size_t)(t02 + tb * 16 + fr) * PSTR + wv * 32 + 8 * fq);
        }
        {
            float s[8];
#pragma unroll
            for (int e = 0; e < 8; ++e) s[e] = 0.f;
            const int r0 = tg * 4 + 16;
#pragma unroll
            for (int r = r0 - win + 1; r < r0; ++r) { const u32x4 w = *(const LAS u32x4*)(XP + r * PROW + ck * 16);
                s[0] += bflo(w.x); s[1] += bfhi(w.x); s[2] += bflo(w.y); s[3] += bfhi(w.y); s[4] += bflo(w.z); s[5] += bfhi(w.z); s[6] += bflo(w.w); s[7] += bfhi(w.w); }
#pragma unroll
            for (int i = 0; i < 4; ++i) {
                const u32x4 w = *(const LAS u32x4*)(XP + (r0 + i) * PROW + ck * 16);
                const float xv[8] = {bflo(w.x), bfhi(w.x), bflo(w.y), bfhi(w.y), bflo(w.z), bfhi(w.z), bflo(w.w), bfhi(w.w)};
                const int t = t0 + tg * 4 + i; const float inv = __builtin_amdgcn_rcpf((float)((t + 1 < win) ? (t + 1) : win));
                float p[8];
#pragma unroll
                for (int e = 0; e < 8; ++e) { s[e] += xv[e]; p[e] = __builtin_fmaf(s[e], inv, -xv[e]); }
                u32x4 o; o.x = pk2(p[0], p[1]); o.y = pk2(p[2], p[3]); o.z = pk2(p[4], p[5]); o.w = pk2(p[6], p[7]);
                *(LAS u32x4*)(PT + (tg * 4 + i) * PROW + ck * 16) = o;
                const u32x4 wo = *(const LAS u32x4*)(XP + (r0 + i - win + 1) * PROW + ck * 16);
                s[0] -= bflo(wo.x); s[1] -= bfhi(wo.x); s[2] -= bflo(wo.y); s[3] -= bfhi(wo.y); s[4] -= bflo(wo.z); s[5] -= bfhi(wo.z); s[6] -= bflo(wo.w); s[7] -= bfhi(wo.w);
            }
        }
        LDS_BARRIER();
#pragma unroll
        for (int tb = 0; tb < 4; ++tb) {
            f32x4 acc[2] = {(f32x4){0.f, 0.f, 0.f, 0.f}, (f32x4){0.f, 0.f, 0.f, 0.f}};
#pragma unroll
            for (int kb = 0; kb < 8; ++kb) { const bf16x8 pfm = *(const LAS bf16x8*)(PT + (tb * 16 + fr) * PROW + kb * 64 + fq * 16);
#pragma unroll
                for (int nb = 0; nb < 2; ++nb) acc[nb] = __builtin_amdgcn_mfma_f32_16x16x32_bf16(Wf[nb][kb], pfm, acc[nb], 0, 0, 0); }
            const int t = t0 + tb * 16 + fr;
            u32x4 o;
#pragma unroll
            for (int nb = 0; nb < 2; ++nb) {
                const unsigned g0 = nb ? gp[tb].z : gp[tb].x, g1 = nb ? gp[tb].w : gp[tb].y;
                const f32x4 gv = (f32x4){bflo(g0), bfhi(g0), bflo(g1), bfhi(g1)};
                f32x4 r = (acc[nb] + pb[nb]) * ps[nb];
#pragma unroll
                for (int e = 0; e < 4; ++e) r[e] *= gv[e] * fast_sigmoid(gv[e]);
                if (nb == 0) { o.x = pk2(r.x, r.y); o.y = pk2(r.z, r.w); } else { o.z = pk2(r.x, r.y); o.w = pk2(r.z, r.w); } }
            *(u32x4*)(y_base + (size_t)t * DMIX + wv * 32 + 8 * fq) = o;
        }
#pragma unroll
        for (int i = 0; i < 4; ++i) { const int id = tid + 512 * i, row = id >> 5, cc = id & 31; *(LAS u32x4*)(XP + (16 + row) * PROW + cc * 16) = pf[i]; }
        *(LAS u32x4*)(XP + hr * PROW + hc * 16) = hal;
#pragma unroll
        for (int tb = 0; tb < 4; ++tb)
            gp[tb] = gpn[tb];
    }
    LDS_BARRIER();
}

__device__ __forceinline__ void phase_mixer(const Args& a, int l, LAS unsigned char* lds) {
#ifndef MK_MIX
#define MK_MIX 3
#endif
#ifndef MK_DBL_RNN
#define MK_DBL_RNN 0
#endif
#ifndef MK_DBL_POOL
#define MK_DBL_POOL 0
#endif
    for (int rep = 0; rep < 1 + ((l == 0) ? MK_DBL_RNN : 0); ++rep) for (int u = blockIdx.x; u < 256; u += gridDim.x) rnn_unit(a, l, u, lds);
    for (int rep = 0; rep < 1 + ((l == 0) ? MK_DBL_POOL : 0); ++rep) for (int u = blockIdx.x; u < 256; u += gridDim.x) { const int g_ = u & 3; if (g_ == 0) pool_units<0>(a, l, u, lds); else if (g_ == 1) pool_units<1>(a, l, u, lds); else if (g_ == 2) pool_units<2>(a, l, u, lds); else pool_units<3>(a, l, u, lds); }
}
#ifndef MK_DBL_PH
#define MK_DBL_PH -1
#endif
#ifndef MK_MASK
#define MK_MASK 63
#endif
__global__ void __launch_bounds__(512, 2) mk_fwd(Args a) {
    extern __shared__ __attribute__((aligned(16))) unsigned char lds_raw[];
    LAS unsigned char* lds = (LAS unsigned char*)lds_raw;
    cg::grid_group grid = cg::this_grid();
    volatile LAS unsigned* bst = (volatile LAS unsigned*)(lds + LDS_BST_OFF);
    if (threadIdx.x < 4) bst[threadIdx.x] = 0u;
    sync_threads_();
    XcdBarrier xbar = xcd_barrier_post((unsigned*)(a.ws + WS_CTL), bst);
#define GRID_BAR() do { if (a.ph_hi - a.ph_lo > 64) grid.sync(); else xcd_barrier(xbar); } while (0)
    for (int ph = a.ph_lo; ph < a.ph_hi; ++ph) {
#if MK_DBL_PH >= 0
      for (int rep = 0; rep < ((ph == MK_DBL_PH) ? 2 : 1); ++rep) {
        if (rep) GRID_BAR();
#endif
        if (ph == 0) { if (MK_MASK & 1) phase_prep(a, lds); }
        else if (ph == 1) { if (MK_MASK & 2) phase_h0(a); }
        else {
            const int l = (ph - 2) >> 2, sub = (ph - 2) & 3;
            if (sub == 0) { if (MK_MASK & 4) {
                pg8::Gemm g{(const pg8::bf16_t*)(a.ws + WS_H), (const pg8::bf16_t*)(a.ws + WS_WIN) + (size_t)l * NPROJ * D, T, NPROJ, D};
                pg8::StaticOrder S; S.init(T, NPROJ, gridDim.x, (int)blockIdx.x);
                pg8::EpiBf16<0> E{(pg8::bf16_t*)(a.ws + WS_PROJ), PSTR, nullptr, 1024, PSEG, 1.f};
                pg8::gemm_phase<pg8::EpiBf16<0>, pg8::StaticOrder, PG8_ALIGN, PG8_SP2>(lds, g, S, E); }
            } else if (sub == 1) {
                if (MK_MASK & 8) phase_mixer(a, l, lds);
            } else if (sub == 2) { if (MK_MASK & 16) {
                pg8::Gemm g{(const pg8::bf16_t*)(a.ws + WS_YCAT), (const pg8::bf16_t*)(a.ws + WS_WOUT) + (size_t)l * D * DMIX, T, D, DMIX};
                pg8::StaticOrder S; S.init(T, D, gridDim.x, (int)blockIdx.x);
                pg8::EpiBf16<0> E{(pg8::bf16_t*)(a.ws + WS_Y), D, nullptr, 0, 0, 1.f};
                pg8::gemm_phase<pg8::EpiBf16<0>, pg8::StaticOrder, PG8_ALIGN, PG8_SP2>(lds, g, S, E); }
            } else {
                if (MK_MASK & 32) { if (l == 0) phase_post<0>(a); else phase_post<1>(a); }
            }
        }
#if MK_DBL_PH >= 0
      }
#endif
        if (ph + 1 < a.ph_hi) GRID_BAR();
    }
}

#if defined(__HIP_DEVICE_COMPILE__)
#pragma clang attribute pop
#endif

extern "C" void kernel_launch(void* const* d_in, const int* in_sizes, int n_in, void* d_out, int out_size, void* d_ws, size_t ws_size, hipStream_t stream) {
    static int grid = 0;
    if (grid == 0) {
        if (n_in != 18 || in_sizes[0] != T * D || out_size != T * D || ws_size < WS_END) {
            fprintf(stderr, "kernel_launch: unexpected shapes (n_in %d, in0 %d, out %d, ws %zu); nothing launched\n", n_in, n_in > 0 ? in_sizes[0] : -1, out_size, ws_size); grid = -1; return; }
        int dev = 0, cus = 0, per_cu = 0;
        if (hipGetDevice(&dev) != hipSuccess || hipDeviceGetAttribute(&cus, hipDeviceAttributeMultiprocessorCount, dev) != hipSuccess) { grid = -1; return; }
        if (hipFuncSetAttribute((const void*)mk_fwd, hipFuncAttributeMaxDynamicSharedMemorySize, LDS_BYTES) != hipSuccess) { fprintf(stderr, "kernel_launch: hipFuncSetAttribute failed\n"); grid = -1; return; }
        if (hipOccupancyMaxActiveBlocksPerMultiprocessor(&per_cu, (const void*)mk_fwd, 512, LDS_BYTES) != hipSuccess || per_cu < 1) { fprintf(stderr, "kernel_launch: occupancy query says %d blocks per CU\n", per_cu); per_cu = 1; }
        (void)hipGetLastError();
        grid = cus;
    }
    if (grid < 0) return;
    Args a{};
    for (int i = 0; i < 18; ++i) a.in[i] = (const float*)d_in[i];
    a.out = (float*)d_out; a.ws = (unsigned char*)d_ws;
    if (hipMemsetAsync((char*)d_ws + WS_CTL, 0, CTL_BYTES, stream) != hipSuccess) { fprintf(stderr, "kernel_launch: memset of the barrier words failed\n"); return; }
#if MK_N_LAUNCHES == 1
    a.ph_lo = 0; a.ph_hi = NPH;
    void* args[] = {&a};
    const hipError_t e = hipLaunchCooperativeKernel((const void*)mk_fwd, dim3(grid), dim3(512), args, LDS_BYTES, stream);
    if (e != hipSuccess) fprintf(stderr, "kernel_launch: cooperative launch failed: %s (grid %d)\n", hipGetErrorString(e), grid);
#else
    for (int ph = 0; ph < NPH; ++ph) {
        a.ph_lo = ph; a.ph_hi = ph + 1;
        hipLaunchKernelGGL(mk_fwd, dim3(grid), dim3(512), LDS_BYTES, stream, a);
    }
#endif
}
```

```cpp
#include <hip/hip_runtime.h>
#include <hip/hip_cooperative_groups.h>
#include <cstdio>
#include <cstdint>
namespace cg = cooperative_groups;
__device__ __forceinline__ int opaque_tid() { int t = threadIdx.x; asm volatile("" : "+v"(t)); return t; }
#if defined(__HIP_DEVICE_COMPILE__)
#pragma clang attribute push (__attribute__((target("no-packed-fp32-ops"))), apply_to = function)
#endif
__device__ __forceinline__ float u2f(unsigned x) { return __builtin_bit_cast(float, x); }
__device__ __forceinline__ float i2f(int x) { return __builtin_bit_cast(float, x); }
__device__ __forceinline__ int f2i(float x) { return __builtin_bit_cast(int, x); }
__device__ __forceinline__ int lane_id_() { return (int)__builtin_amdgcn_mbcnt_hi(~0u, __builtin_amdgcn_mbcnt_lo(~0u, 0u)); }
__device__ __forceinline__ float shfl_xor_(float v, int o) { return i2f(__builtin_amdgcn_ds_bpermute((lane_id_() ^ o) << 2, f2i(v))); }
__device__ __forceinline__ float row_last_(float v) { return i2f(__builtin_amdgcn_ds_bpermute((lane_id_() | 15) << 2, f2i(v))); }
__device__ __forceinline__ void sync_threads_() { __builtin_amdgcn_fence(__ATOMIC_RELEASE, "workgroup"); __builtin_amdgcn_s_barrier(); __builtin_amdgcn_fence(__ATOMIC_ACQUIRE, "workgroup"); }
namespace pg8 {
#define PG8_LAS __attribute__((address_space(3)))
typedef unsigned short bf16_t;
typedef short bf16x8 __attribute__((ext_vector_type(8)));
typedef float f32x4 __attribute__((ext_vector_type(4)));
typedef unsigned u32x4 __attribute__((ext_vector_type(4)));
constexpr int BM = 256, BK = 64, HALF = 128, HTB = HALF * BK * 2  , STAGE_BYTES = 8 * HTB, NXCD = 8, WGM = 8;

__host__ __device__ __forceinline__ int lds_byte(int r, int c) { const int st = (r >> 4) * 2 + (c >> 5), rr = r & 15, cc = c & 31, ob = rr * 64 + cc * 2; return st * 1024 + (ob ^ (((ob >> 9) & 1) << 5)); }
__host__ __device__ __forceinline__ void stage_rc(int b, int& R, int& C) { const int st = b / 1024, sb = b % 1024, swz = sb ^ (((sb >> 9) & 1) << 5); R = (st >> 1) * 16 + swz / 64; C = (st & 1) * 32 + (swz % 64) / 2; }
__host__ __device__ __forceinline__ int perm32(int rho) { const int n = rho >> 4, i = rho & 15; return 8 * (i >> 2) + 4 * n + (i & 3); }

struct Unit { int pm, pn; };
struct Gemm { const bf16_t* A; const bf16_t* Bt; int M, N, K; };

struct StaticOrder {
    int nM, nN, nwg, G, c;
    __host__ __device__ void init(int M, int N, int G_, int c_) { nM = M / BM; nN = N / BM; nwg = nM * nN; G = G_; c = c_; }
    __host__ __device__ bool next(int i, Unit& u) const {
        const long L = (long)i * G + c; if (L >= nwg) return false;
        int wgid = (int)L; { const int q = nwg / NXCD, r = nwg % NXCD, xcd = wgid % NXCD, off = wgid / NXCD; wgid = (xcd < r ? xcd * (q + 1) : r * (q + 1) + (xcd - r) * q) + off; }
        const int nig = WGM * nN, gid = wgid / nig, fm = gid * WGM, gsz = (nM - fm) < WGM ? (nM - fm) : WGM;
        u.pm = fm + ((wgid % nig) % gsz); u.pn = (wgid % nig) / gsz; return true;
    }
    __device__ __forceinline__ void a_ready(const Unit&) const {}
    __device__ __forceinline__ void done(const Unit&) const {}
};

__device__ __forceinline__ unsigned cvt_pk_bf16(float lo, float hi) { unsigned r; asm volatile("v_cvt_pk_bf16_f32 %0, %1, %2" : "=v"(r) : "v"(lo), "v"(hi)); return r; }
typedef float f32x2 __attribute__((ext_vector_type(2)));
__device__ __forceinline__ f32x2 gelu_pk(f32x2 v) {
    const f32x2 av = __builtin_elementwise_abs(v), d = av * 0.2316418882f + 1.0f;
    f32x2 t; t.x = __builtin_amdgcn_rcpf(d.x); t.y = __builtin_amdgcn_rcpf(d.y);
    f32x2 q = t * 0.5307027145f + (-0.7265760135f); q = q * t + 0.7107068705f; q = q * t + (-0.142248368f); q = q * t + 0.127414796f; q = q * t;
    const f32x2 s = (v * v) * (-0.72134752044f);
    f32x2 e; e.x = __builtin_amdgcn_exp2f(s.x); e.y = __builtin_amdgcn_exp2f(s.y);
    const f32x2 m = v * (q * e), r = v - m;
    f32x2 o; o.x = v.x < 0.f ? m.x : r.x; o.y = v.y < 0.f ? m.y : r.y; return o;
}

template <int ACT  > struct EpiBf16 {
    static constexpr bool PERM = true, AFTER_DRAIN = false; static_assert(ACT == 0 || ACT == 1, "EpiBf16: ACT is 0 (none) or 1 (gelu_pk)");
    bf16_t* O; int ldc; const float* bias; int split_cols; size_t split_stride; float scale0;
    __device__ __forceinline__ void operator()(const f32x4 (&acc)[2][2][4][2], const Unit& u, int wr, int wc, int fr, int fq) const {
        const int row0 = u.pm * BM + wr * 64 + fr; int colt = u.pn * BM; bf16_t* base = O;
        float sc = 1.f; if (split_cols) { const int t = colt / split_cols; base += (size_t)t * split_stride; colt -= t * split_cols; if (t == 0) sc = scale0; }
        const int col0 = colt + wc * 32 + 8 * fq, bcol0 = u.pn * BM + wc * 32 + 8 * fq;
        f32x4 bv[2][2];
#pragma unroll
        for (int bj = 0; bj < 2; ++bj)
#pragma unroll
            for (int n = 0; n < 2; ++n) bv[bj][n] = bias ? *(const f32x4*)(bias + bcol0 + bj * HALF + 4 * n) : (f32x4){0.f, 0.f, 0.f, 0.f};
#pragma unroll
        for (int ai = 0; ai < 2; ++ai)
#pragma unroll
            for (int m = 0; m < 4; ++m) { bf16_t* rowp = base + (size_t)(row0 + ai * HALF + m * 16) * ldc + col0;
#pragma unroll
                for (int bj = 0; bj < 2; ++bj) { f32x4 v0 = acc[ai][bj][m][0] + bv[bj][0], v1 = acc[ai][bj][m][1] + bv[bj][1];
                    if (ACT == 1) { f32x2 a = gelu_pk((f32x2){v0[0], v0[1]}), b = gelu_pk((f32x2){v0[2], v0[3]}), c = gelu_pk((f32x2){v1[0], v1[1]}), d = gelu_pk((f32x2){v1[2], v1[3]});
                        v0 = (f32x4){a.x, a.y, b.x, b.y}; v1 = (f32x4){c.x, c.y, d.x, d.y}; }
                    v0 = v0 * sc; v1 = v1 * sc; u32x4 w; w.x = cvt_pk_bf16(v0[0], v0[1]); w.y = cvt_pk_bf16(v0[2], v0[3]); w.z = cvt_pk_bf16(v1[0], v1[1]); w.w = cvt_pk_bf16(v1[2], v1[3]);
                    *(u32x4*)(rowp + bj * HALF) = w; } }
    }
};
template <class Epi, class Sched, bool ALIGN_EPI = false, bool SP2 = false>
__device__ __forceinline__ void gemm_phase(PG8_LAS unsigned char* lds, const Gemm g, const Sched& S, const Epi& E) {
    const int tid = opaque_tid(), wid = __builtin_amdgcn_readfirstlane(tid >> 6), lane = tid & 63, wr = wid >> 2, wc = wid & 3, fr = lane & 15, fq = lane >> 4;
    const int K = g.K, nt = K / BK;
    unsigned voffA[2], voffB[2];
#pragma unroll
    for (int i = 0; i < 2; ++i) { int R, C; stage_rc(tid * 16 + i * 8192, R, C); const int Rb = Epi::PERM ? ((R & ~31) + perm32(R & 31)) : R;
        voffA[i] = (unsigned)(R * K + C) * 2u; voffB[i] = (unsigned)(Rb * K + C) * 2u; }
    const size_t kstep = (size_t)(BK * 2);
    const size_t hstep = (size_t)HALF * K * 2;
    const size_t tstep = 2 * hstep;
    const unsigned ldsw = (unsigned)wid * 1024u;
    const int aoff = lds_byte(wr * 64 + fr, fq * 8), boff = lds_byte(wc * 32 + fr, fq * 8);
#define PG8_SA(b, h) (((b) * 2 + (h)) * HTB)
#define PG8_SB(b, h) ((4 + (b) * 2 + (h)) * HTB)
#define PG8_STAGE(bufoff, gbase, voff) do { _Pragma("unroll") for (int _i = 0; _i < 2; ++_i) \
        __builtin_amdgcn_global_load_lds((const unsigned*)((const char*)(gbase) + (voff)[_i]), (PG8_LAS unsigned*)(lds + (bufoff) + ldsw + _i * 8192), 16, 0, 0); } while (0)
#define PG8_LDA(dst, b, h) do { _Pragma("unroll") for (int m = 0; m < 4; ++m) _Pragma("unroll") for (int k = 0; k < 2; ++k) dst[m][k] = *(const PG8_LAS bf16x8*)(lds + PG8_SA(b, h) + aoff + m * 2048 + k * 1024); } while (0)
#define PG8_LDB(dst, b, h) do { _Pragma("unroll") for (int n = 0; n < 2; ++n) _Pragma("unroll") for (int k = 0; k < 2; ++k) dst[n][k] = *(const PG8_LAS bf16x8*)(lds + PG8_SB(b, h) + boff + n * 2048 + k * 1024); } while (0)
#define PG8_MMA(ai, bj, At, Bt) do { __builtin_amdgcn_s_setprio(1); _Pragma("unroll") for (int m = 0; m < 4; ++m) _Pragma("unroll") for (int n = 0; n < 2; ++n) _Pragma("unroll") for (int k = 0; k < 2; ++k) \
        acc[ai][bj][m][n] = __builtin_amdgcn_mfma_f32_16x16x32_bf16(Bt[n][k], At[m][k], acc[ai][bj][m][n], 0, 0, 0); __builtin_amdgcn_s_setprio(0); } while (0)
#define PG8_WAIT_V(n) asm volatile("s_waitcnt vmcnt(" #n ")" ::: "memory")
#define PG8_WAIT_L(n) asm volatile("s_waitcnt lgkmcnt(" #n ")" ::: "memory")
#define PG8_BAR __builtin_amdgcn_s_barrier()
#define PG8_SCHED __builtin_amdgcn_sched_barrier(0)
    Unit cur, nxt; int ui = 0;
    if (!S.next(0, cur)) return;
    f32x4 acc[2][2][4][2];
#pragma unroll
    for (int a = 0; a < 2; ++a)
#pragma unroll
        for (int b = 0; b < 2; ++b)
#pragma unroll
            for (int m = 0; m < 4; ++m)
#pragma unroll
                for (int n = 0; n < 2; ++n) acc[a][b][m][n] = (f32x4){0.f, 0.f, 0.f, 0.f};
    bf16x8 At[4][2], B0[2][2], B1[2][2];
    const char* cA = (const char*)g.A + (size_t)cur.pm * tstep; const char* cB = (const char*)g.Bt + (size_t)cur.pn * tstep;
    S.a_ready(cur);
    if constexpr (SP2) {
        PG8_STAGE(PG8_SB(0, 0), cB, voffB); PG8_STAGE(PG8_SB(0, 1), cB + hstep, voffB); PG8_STAGE(PG8_SA(0, 0), cA, voffA); PG8_STAGE(PG8_SA(0, 1), cA + hstep, voffA);
        if (wr == 1) PG8_BAR;
        PG8_WAIT_V(2); PG8_BAR;
        PG8_STAGE(PG8_SB(1, 0), cB + kstep, voffB); PG8_STAGE(PG8_SA(1, 0), cA + kstep, voffA); PG8_STAGE(PG8_SB(1, 1), cB + hstep + kstep, voffB);
        PG8_WAIT_V(6); PG8_BAR;
    } else {
        PG8_STAGE(PG8_SB(0, 0), cB, voffB); PG8_STAGE(PG8_SA(0, 0), cA, voffA); PG8_STAGE(PG8_SB(0, 1), cB + hstep, voffB); PG8_STAGE(PG8_SA(0, 1), cA + hstep, voffA);
        if (wr == 1) PG8_BAR;
        PG8_WAIT_V(4); PG8_BAR;
        PG8_STAGE(PG8_SB(1, 0), cB + kstep, voffB); PG8_STAGE(PG8_SA(1, 0), cA + kstep, voffA); PG8_STAGE(PG8_SB(1, 1), cB + hstep + kstep, voffB);
        PG8_WAIT_V(6); PG8_BAR;
    }
    for (;;) {
        const bool has_next = S.next(ui + 1, nxt);
        const char* nA = has_next ? (const char*)g.A + (size_t)nxt.pm * tstep : cA; const char* nB = has_next ? (const char*)g.Bt + (size_t)nxt.pn * tstep : cB;
        for (int t = 0; t < nt; t += 2) {
            const bool last = (t == nt - 2);
            const char* a1 = cA + (size_t)(t + 1) * kstep;
            const char* a2 = last ? nA : cA + (size_t)(t + 2) * kstep; const char* b2 = last ? nB : cB + (size_t)(t + 2) * kstep;
            const char* a3 = a2 + kstep; const char* b3 = b2 + kstep;
            if (last && has_next) S.a_ready(nxt);
            if constexpr (SP2) {
            PG8_LDB(B0, 0, 0); PG8_LDB(B1, 0, 1); PG8_SCHED; PG8_LDA(At, 0, 0); PG8_STAGE(PG8_SA(1, 1), a1 + hstep, voffA);
            PG8_WAIT_V(8); PG8_WAIT_L(0); PG8_BAR; PG8_MMA(0, 0, At, B0); PG8_MMA(0, 1, At, B1); PG8_BAR; PG8_SCHED;
            PG8_LDA(At, 0, 1); PG8_STAGE(PG8_SB(0, 0), b2, voffB); PG8_STAGE(PG8_SB(0, 1), b2 + hstep, voffB); PG8_STAGE(PG8_SA(0, 0), a2, voffA);
            PG8_WAIT_V(8); PG8_WAIT_L(0); PG8_BAR; PG8_MMA(1, 0, At, B0); PG8_MMA(1, 1, At, B1); PG8_BAR; PG8_SCHED;
            PG8_LDB(B0, 1, 0); PG8_LDB(B1, 1, 1); PG8_SCHED; PG8_LDA(At, 1, 0); PG8_STAGE(PG8_SA(0, 1), a2 + hstep, voffA);
            PG8_WAIT_V(8); PG8_WAIT_L(0); PG8_BAR; PG8_MMA(0, 0, At, B0); PG8_MMA(0, 1, At, B1); PG8_BAR; PG8_SCHED;
            PG8_LDA(At, 1, 1); PG8_STAGE(PG8_SB(1, 0), b3, voffB); PG8_STAGE(PG8_SB(1, 1), b3 + hstep, voffB); PG8_STAGE(PG8_SA(1, 0), a3, voffA);
            PG8_WAIT_V(8); PG8_WAIT_L(0); PG8_BAR; PG8_MMA(1, 0, At, B0); PG8_MMA(1, 1, At, B1); PG8_BAR; PG8_SCHED;
            } else {
            PG8_LDB(B0, 0, 0); PG8_SCHED; PG8_LDA(At, 0, 0); PG8_STAGE(PG8_SA(1, 1), a1 + hstep, voffA);
            PG8_WAIT_L(8); PG8_BAR; PG8_WAIT_L(0); PG8_MMA(0, 0, At, B0); PG8_BAR; PG8_SCHED;
            PG8_LDB(B1, 0, 1); PG8_STAGE(PG8_SB(0, 0), b2, voffB);
            PG8_BAR; PG8_WAIT_L(0); PG8_MMA(0, 1, At, B1); PG8_BAR;
            PG8_LDA(At, 0, 1); PG8_STAGE(PG8_SA(0, 0), a2, voffA);
            PG8_BAR; PG8_WAIT_L(0); PG8_MMA(1, 0, At, B0); PG8_BAR; PG8_SCHED;
            PG8_STAGE(PG8_SB(0, 1), b2 + hstep, voffB);
            PG8_WAIT_V(6); PG8_BAR; PG8_MMA(1, 1, At, B1); PG8_BAR;
            PG8_LDB(B0, 1, 0); PG8_SCHED; PG8_LDA(At, 1, 0); PG8_STAGE(PG8_SA(0, 1), a2 + hstep, voffA);
            PG8_WAIT_L(8); PG8_BAR; PG8_WAIT_L(0); PG8_MMA(0, 0, At, B0); PG8_BAR; PG8_SCHED;
            PG8_LDB(B1, 1, 1); PG8_STAGE(PG8_SB(1, 0), b3, voffB);
            PG8_BAR; PG8_WAIT_L(0); PG8_MMA(0, 1, At, B1); PG8_BAR;
            PG8_LDA(At, 1, 1); PG8_STAGE(PG8_SA(1, 0), a3, voffA);
            PG8_BAR; PG8_WAIT_L(0); PG8_MMA(1, 0, At, B0); PG8_BAR; PG8_SCHED;
            PG8_STAGE(PG8_SB(1, 1), b3 + hstep, voffB);
            PG8_WAIT_V(6); PG8_BAR; PG8_MMA(1, 1, At, B1); PG8_BAR;
            }
        }
        if constexpr (ALIGN_EPI) { if (wr == 0) PG8_BAR; }
        if constexpr (!Epi::AFTER_DRAIN) { E(acc, cur, wr, wc, fr, fq); S.done(cur); }
        if (!has_next) break;
#pragma unroll
        for (int a = 0; a < 2; ++a)
#pragma unroll
            for (int b = 0; b < 2; ++b)
#pragma unroll
                for (int m = 0; m < 4; ++m)
#pragma unroll
                    for (int n = 0; n < 2; ++n) acc[a][b][m][n] = (f32x4){0.f, 0.f, 0.f, 0.f};
        cur = nxt; cA = nA; cB = nB; ++ui;
        if constexpr (ALIGN_EPI) { if (wr == 1) PG8_BAR; }
    }
    PG8_WAIT_V(0);
    if constexpr (!ALIGN_EPI) { if (wr == 0) PG8_BAR; }
    PG8_BAR;
    if constexpr (Epi::AFTER_DRAIN) { E.fused(acc, cur, wr, wc, fr, fq, lds, wid, lane); S.done(cur); }
#undef PG8_SA
#undef PG8_SB
#undef PG8_STAGE
#undef PG8_LDA
#undef PG8_LDB
#undef PG8_MMA
#undef PG8_WAIT_V
#undef PG8_WAIT_L
#undef PG8_BAR
#undef PG8_SCHED
}
}
#ifndef PG8_SP2
#define PG8_SP2 true
#endif
#ifndef PG8_ALIGN
#define PG8_ALIGN true
#endif
#ifndef MK_N_LAUNCHES
#define MK_N_LAUNCHES 1
#endif

constexpr int NB = 8, SEQ = 4096, D = 1024, T = NB * SEQ, NPROJ = 4096, DMIX = 2048;
constexpr int PSTR = 1024; constexpr size_t PSEG = (size_t)T * 1024;
constexpr int NPH = 10;
constexpr float EPS = 1e-6f;
constexpr size_t MiB = 1u << 20;
constexpr size_t WS_WIN = 0, WS_WOUT = 16 * MiB, WS_GW = 24 * MiB, WS_PW = 25 * MiB, WS_MOD = 26 * MiB;
constexpr size_t WS_H = 32 * MiB, WS_YCAT = 96 * MiB, WS_PROJ = 224 * MiB, WS_Y = WS_PROJ, WS_U = WS_H, WS_END = 480 * MiB;
constexpr size_t WS_CTL = 28 * MiB, CTL_BYTES = 16384;
constexpr int LDS_BYTES = 147456, LDS_BST_OFF = 147456 - 64;

#define LAS __attribute__((address_space(3)))
typedef unsigned short bf16;
typedef float f32x4 __attribute__((ext_vector_type(4)));
typedef float f32x2 __attribute__((ext_vector_type(2)));
typedef unsigned u32x4 __attribute__((ext_vector_type(4)));
typedef unsigned u32x2 __attribute__((ext_vector_type(2)));
typedef short bf16x8 __attribute__((ext_vector_type(8)));

struct Args { const float* in[18]; float* out; unsigned char* ws; int ph_lo, ph_hi; };

__device__ __forceinline__ unsigned pk2(float lo, float hi) { return pg8::cvt_pk_bf16(lo, hi); }
__device__ __forceinline__ float bflo(unsigned w) { return u2f(w << 16); }
__device__ __forceinline__ float bfhi(unsigned w) { return u2f(w & 0xffff0000u); }
template <int CTRL> __device__ __forceinline__ float dpp_mov_(float v) { return i2f(__builtin_amdgcn_update_dpp(0, f2i(v), CTRL, 0xf, 0xf, true)); }
__device__ __forceinline__ float wave_sum(float v) {
    v += dpp_mov_<0xB1>(v);
    v += dpp_mov_<0x4E>(v);
    v += dpp_mov_<0x141>(v);
    v += dpp_mov_<0x140>(v);
    const float r0 = i2f(__builtin_amdgcn_readlane(f2i(v), 0)), r1 = i2f(__builtin_amdgcn_readlane(f2i(v), 16));
    const float r2 = i2f(__builtin_amdgcn_readlane(f2i(v), 32)), r3 = i2f(__builtin_amdgcn_readlane(f2i(v), 48));
    return (r0 + r1) + (r2 + r3);
}
__device__ __forceinline__ float sigmoidf_(float x) { return 1.0f / (1.0f + __expf(-x)); }
__device__ __forceinline__ float siluf_(float x) { return x / (1.0f + __expf(-x)); }

__device__ __forceinline__ void transpose_tile(const float* W, int K, int N, bf16* WT, LAS float* scr, int k0, int n0, int drow, int lane, float wscale = 1.0f) {
    {
        f32x4 v[8];
#pragma unroll
        for (int i = 0; i < 8; ++i) v[i] = *(const f32x4*)(W + (size_t)(k0 + (lane >> 3) + 8 * i) * N + n0 + (lane & 7) * 4);
#pragma unroll
        for (int i = 0; i < 8; ++i) { LAS float* d = scr + ((lane >> 3) + 8 * i) * 33 + (lane & 7) * 4; d[0] = v[i].x * wscale; d[1] = v[i].y * wscale; d[2] = v[i].z * wscale; d[3] = v[i].w * wscale; }
    }
    asm volatile("s_waitcnt lgkmcnt(0)" ::: "memory");
    const int c = lane & 7;
#pragma unroll
    for (int j = 0; j < 4; ++j) { const int n = (lane >> 3) + 8 * j; const LAS float* s = scr + (8 * c) * 33 + n;
        u32x4 o; o.x = pk2(s[0 * 33], s[1 * 33]); o.y = pk2(s[2 * 33], s[3 * 33]); o.z = pk2(s[4 * 33], s[5 * 33]); o.w = pk2(s[6 * 33], s[7 * 33]);
        *(u32x4*)(WT + (size_t)(drow + n) * K + k0 + 8 * c) = o; }
    asm volatile("s_waitcnt lgkmcnt(0)" ::: "memory");
}
__device__ __forceinline__ void transpose_item(const float* W, int K, int N, bf16* WT, LAS float* scr, int item, int lane) {
    const int nblk = N / 32, kb = item / nblk, nb = item % nblk;
    transpose_tile(W, K, N, WT, scr, 64 * kb, 32 * nb, 32 * nb, lane);
}

__device__ __forceinline__ void phase_prep(const Args& a, LAS unsigned char* lds) {
    const int tid = opaque_tid(), lane = tid & 63, wv = tid >> 6;
    const int G = gridDim.x;
    unsigned char* ws = a.ws;
    {
        LAS float* sc = (LAS float*)lds;
        LAS float* red = (LAS float*)(lds + 32768);
        const float* c = a.in[1]; const float* ada_w = a.in[2]; const float* ada_b = a.in[3];
        float* MOD = (float*)(ws + WS_MOD);
        if ((int)blockIdx.x < 192) {
            for (int i = tid; i < 8192; i += 512) sc[i] = siluf_(c[i]);
            sync_threads_();
            for (int unit = blockIdx.x; unit < 192; unit += G) {
                const int l = unit / 96, cb = (unit % 96) * 32, cl = tid & 31, ks = tid >> 5;
                const float* wp = ada_w + (size_t)l * 1024 * 3072 + (size_t)(ks * 64) * 3072 + cb + cl;
                float acc[8];
#pragma unroll
                for (int b = 0; b < 8; ++b) acc[b] = 0.f;
#pragma unroll 16
                for (int k = 0; k < 64; ++k) { const float w = wp[(size_t)k * 3072];
#pragma unroll
                    for (int b = 0; b < 8; ++b) acc[b] += sc[b * 1024 + ks * 64 + k] * w; }
#pragma unroll
                for (int b = 0; b < 8; ++b) red[(ks * 8 + b) * 32 + cl] = acc[b];
                sync_threads_();
                if (tid < 256) { const int b = tid >> 5; float s = 0.f;
#pragma unroll
                    for (int k2 = 0; k2 < 16; ++k2) s += red[(k2 * 8 + b) * 32 + cl];
                    MOD[(l * 8 + b) * 3072 + cb + cl] = s + ada_b[l * 3072 + cb + cl]; }
                sync_threads_();
            }
        }
        sync_threads_();
    }
    {
        LAS float* scr = (LAS float*)(lds + wv * 16384);
        const int gw = blockIdx.x * 8 + wv, NGW = G * 8;
        constexpr int I_IN = (1024 / 64) * (4096 / 32), I_OUT = (2048 / 64) * (1024 / 32);
        for (int it = gw; it < 2 * (I_IN + I_OUT); it += NGW) {
            int r = it;
            if (r < 2 * I_IN) { const int l = r / I_IN; r -= l * I_IN;
                transpose_item(a.in[5] + (size_t)l * 1024 * 4096, 1024, 4096, (bf16*)(ws + WS_WIN) + (size_t)l * 4096 * 1024, scr, r, lane); }
            else { r -= 2 * I_IN; const int l = r / I_OUT; r -= l * I_OUT;
                transpose_item(a.in[16] + (size_t)l * 2048 * 1024, 2048, 1024, (bf16*)(ws + WS_WOUT) + (size_t)l * 1024 * 2048, scr, r, lane); }
        }
    }
    {
        LAS float* scr = (LAS float*)(lds + wv * 16384);
        const int gw = blockIdx.x * 8 + wv, NGW = G * 8;
        bf16* GWp = (bf16*)(ws + WS_GW); bf16* PWp = (bf16*)(ws + WS_PW);
        for (int it = NGW - 1 - gw; it < 512; it += NGW) {
            if (it < 256) { const int lh = it >> 4, r = it & 15, gate = r >> 3, kb = (r >> 2) & 1, q = r & 3;
                transpose_tile((gate ? a.in[10] : a.in[8]) + (size_t)lh * 128 * 128, 128, 128, GWp + (size_t)lh * 4 * 64 * 128, scr, 64 * kb, 32 * q, q * 64 + gate * 32, lane, -1.4426950408889634f); }
            else { const int r = it - 256, lg = r >> 5, kb = (r >> 3) & 3, nb = r & 7;
                transpose_tile(a.in[13] + (size_t)lg * 256 * 256, 256, 256, PWp + (size_t)lg * 256 * 256, scr, 64 * kb, 32 * nb, 32 * nb, lane); }
        }
    }
}

constexpr int RPW = 4;
__device__ __forceinline__ void phase_h0(const Args& a) {
    const int tid = opaque_tid(), lane = tid & 63, wv = tid >> 6;
    const int gw = blockIdx.x * 8 + wv, NGW = gridDim.x * 8;
    const float* x = a.in[0]; const float* g = a.in[4]; const float* MOD = (const float*)(a.ws + WS_MOD);
    bf16* H = (bf16*)(a.ws + WS_H);
    const int WPB = NGW / NB, b = gw / WPB, wq = gw % WPB;
    const float* sh = MOD + (size_t)b * 3072; const float* scl = sh + 1024;
    f32x4 A1[4], SH[4];
#pragma unroll
    for (int j = 0; j < 4; ++j) { const int col = 4 * lane + 256 * j; A1[j] = *(const f32x4*)(g + col) * (*(const f32x4*)(scl + col) + 1.0f); SH[j] = *(const f32x4*)(sh + col); }
    for (int mr = wq * RPW; mr < SEQ; mr += WPB * RPW) {
        const int m0 = b * SEQ + mr;
        f32x4 v[RPW][4];
#pragma unroll
        for (int r = 0; r < RPW; ++r) { const f32x4* xr = (const f32x4*)(x + (size_t)(m0 + r) * D) + lane;
#pragma unroll
            for (int j = 0; j < 4; ++j) v[r][j] = __builtin_nontemporal_load(xr + 64 * j); }
#pragma unroll
        for (int r = 0; r < RPW; ++r) {
            float ss = 0.f;
#pragma unroll
            for (int j = 0; j < 4; ++j) ss += (v[r][j].x * v[r][j].x + v[r][j].y * v[r][j].y) + (v[r][j].z * v[r][j].z + v[r][j].w * v[r][j].w);
            const float rstd = 1.0f / __builtin_sqrtf(wave_sum(ss) * (1.0f / D) + EPS);
            u32x2* o = (u32x2*)(H + (size_t)(m0 + r) * D) + lane;
#pragma unroll
            for (int j = 0; j < 4; ++j) {
                const f32x4 rr = (v[r][j] * rstd) * A1[j] + SH[j];
                u32x2 w; w.x = pk2(rr.x, rr.y); w.y = pk2(rr.z, rr.w); o[64 * j] = w; }
        }
    }
}

template <int l> __device__ __forceinline__ void phase_post(const Args& a) {
    const int tid = opaque_tid(), lane = tid & 63, wv = tid >> 6;
    const int gw = blockIdx.x * 8 + wv, NGW = gridDim.x * 8;
    const float* xin = (l == 0) ? a.in[0] : a.out; float* out = a.out;
    const bf16* Y = (const bf16*)(a.ws + WS_Y); bf16* H = (bf16*)(a.ws + WS_H);
    const float* MOD = (const float*)(a.ws + WS_MOD);
    const float* gpost = a.in[17] + l * D; const float* gpre = a.in[4] + (l + 1) * D;
    const int WPB = NGW / NB, b = gw / WPB, wq = gw % WPB;
    const float* gate = MOD + (size_t)(l * 8 + b) * 3072 + 2048;
    const float* sh = MOD + (size_t)(8 + b) * 3072; const float* scl = sh + 1024;
    f32x4 GP[4], A1[4], SH[4];
#pragma unroll
    for (int j = 0; j < 4; ++j) { const int col = 4 * lane + 256 * j; GP[j] = *(const f32x4*)(gate + col) * *(const f32x4*)(gpost + col);
        if (l == 0) { A1[j] = *(const f32x4*)(gpre + col) * (*(const f32x4*)(scl + col) + 1.0f); SH[j] = *(const f32x4*)(sh + col); } }
    for (int mr = wq * RPW; mr < SEQ; mr += WPB * RPW) {
        const int m0 = b * SEQ + mr;
        f32x4 xv[RPW][4]; u32x2 yw[RPW][4];
#pragma unroll
        for (int r = 0; r < RPW; ++r) { const f32x4* xr = (const f32x4*)(xin + (size_t)(m0 + r) * D) + lane; const u32x2* yr = (const u32x2*)(Y + (size_t)(m0 + r) * D) + lane;
#pragma unroll
            for (int j = 0; j < 4; ++j) { xv[r][j] = xr[64 * j]; yw[r][j] = yr[64 * j]; } }
#pragma unroll
        for (int r = 0; r < RPW; ++r) {
            f32x4 yv[4]; float ss = 0.f;
#pragma unroll
            for (int j = 0; j < 4; ++j) { const u32x2 w = yw[r][j]; yv[j] = (f32x4){bflo(w.x), bfhi(w.x), bflo(w.y), bfhi(w.y)};
                ss += (yv[j].x * yv[j].x + yv[j].y * yv[j].y) + (yv[j].z * yv[j].z + yv[j].w * yv[j].w); }
            const float rstd = 1.0f / __builtin_sqrtf(wave_sum(ss) * (1.0f / D) + EPS);
            float ss2 = 0.f;
#pragma unroll
            for (int j = 0; j < 4; ++j) { const int col = 4 * lane + 256 * j;
                const f32x4 xn = xv[r][j] + (yv[j] * rstd) * GP[j];
                xv[r][j] = xn;
                if (l == 0) *((f32x4*)(out + (size_t)(m0 + r) * D + col)) = xn;
                else __builtin_nontemporal_store(xn, (f32x4*)(out + (size_t)(m0 + r) * D + col));
                ss2 += (xn.x * xn.x + xn.y * xn.y) + (xn.z * xn.z + xn.w * xn.w); }
            if (l == 0) {
                const float rstd2 = 1.0f / __builtin_sqrtf(wave_sum(ss2) * (1.0f / D) + EPS);
                u32x2* o = (u32x2*)(H + (size_t)(m0 + r) * D) + lane;
#pragma unroll
                for (int j = 0; j < 4; ++j) {
                    const f32x4 rr = (xv[r][j] * rstd2) * A1[j] + SH[j];
                    u32x2 w; w.x = pk2(rr.x, rr.y); w.y = pk2(rr.z, rr.w); o[64 * j] = w; }
            }
        }
    }
}
#define XB_TMO      128
#define XB_XCNT(j)  (256  + 64 * (j))
#define XB_XSUB(j)  (1280 + 64 * (j))
#define XB_XGEN(j)  (2304 + 64 * (j))
#define XB_TOP      3328
#define XB_TOPGEN   3392
#define XCD_BAR_WORDS 3456
#define XB_SPIN_CAP (1u << 18)

__device__ __forceinline__ unsigned xb_ld(unsigned* p)              { return __hip_atomic_load(p, __ATOMIC_RELAXED, __HIP_MEMORY_SCOPE_AGENT); }
__device__ __forceinline__ unsigned xb_add(unsigned* p, unsigned v) { return __hip_atomic_fetch_add(p, v, __ATOMIC_RELAXED, __HIP_MEMORY_SCOPE_AGENT); }
__device__ __forceinline__ unsigned xb_xcc_id() { return (unsigned)__builtin_amdgcn_s_getreg((3 << 11) | 20) & 0xFu; }
#define XB_SPIN(cond, bar) do { unsigned _sp = 0; while (cond) { __builtin_amdgcn_s_sleep(1); \
    if ((++_sp & 255u) == 0u) { if (xb_ld(&(bar)[XB_TMO])) break; if (_sp > XB_SPIN_CAP) { xb_add(&(bar)[XB_TMO], 1u); break; } } } } while (0)

struct XcdBarrier {
    unsigned* bar; unsigned x;
    volatile LAS unsigned* st;
};

__device__ __forceinline__ XcdBarrier xcd_barrier_post(unsigned* bar, volatile LAS unsigned* st) {
    XcdBarrier b; b.bar = bar; b.x = xb_xcc_id(); b.st = st;
    if (threadIdx.x == 0) (void)xb_add(&bar[XB_XCNT(b.x)], 1u);
    return b;
}
__device__ __forceinline__ void xcd_barrier_complete(unsigned* bar, unsigned x, unsigned& nloc, unsigned& nx) {
    const unsigned G = gridDim.x * gridDim.y * gridDim.z;
    unsigned sum, cnt, mine, sp = 0u;
    for (;;) {
        sum = 0u; cnt = 0u; mine = 0u;
#pragma unroll
        for (unsigned j = 0; j < 16; ++j) { const unsigned c = xb_ld(&bar[XB_XCNT(j)]); sum += c; cnt += (c > 0u) ? 1u : 0u; mine = (j == x) ? c : mine; }
        if (sum == G) break;
        __builtin_amdgcn_s_sleep(1);
        if ((++sp & 255u) == 0u) { if (xb_ld(&bar[XB_TMO])) break; if (sp > XB_SPIN_CAP) { xb_add(&bar[XB_TMO], 1u); break; } }
    }
    nloc = mine > 0u ? mine : 1u; nx = cnt > 0u ? cnt : 1u;
}

__device__ __forceinline__ void xcd_barrier(const XcdBarrier& b) {
    asm volatile("s_waitcnt vmcnt(0)" ::: "memory");
    sync_threads_();
    if (threadIdx.x == 0) {
        unsigned* bar = b.bar;
        __builtin_amdgcn_s_waitcnt(0);
        unsigned nloc = b.st[0], nx = b.st[1];
        if (nloc == 0u) { xcd_barrier_complete(bar, b.x, nloc, nx); b.st[0] = nloc; b.st[1] = nx; }
        const unsigned old = xb_add(&bar[XB_XSUB(b.x)], 1u);
        const unsigned gen = old / nloc;
        if (old + 1u == (gen + 1u) * nloc) {
            __builtin_amdgcn_fence(__ATOMIC_RELEASE, "agent");
            asm volatile("s_waitcnt vmcnt(0)" ::: "memory");
            const unsigned og = xb_add(&bar[XB_TOP], 1u);
            const unsigned tg = og / nx;
            if (og + 1u == (tg + 1u) * nx) xb_add(&bar[XB_TOPGEN], 1u);
            else XB_SPIN(xb_ld(&bar[XB_TOPGEN]) == tg, bar);
            __builtin_amdgcn_fence(__ATOMIC_ACQUIRE, "agent");
            xb_add(&bar[XB_XGEN(b.x)], 1u);
            asm volatile("s_waitcnt vmcnt(0)" ::: "memory");
        } else {
            XB_SPIN(xb_ld(&bar[XB_XGEN(b.x)]) == gen, bar);
            __builtin_amdgcn_fence(__ATOMIC_ACQUIRE, "agent");
            asm volatile("s_waitcnt vmcnt(0)" ::: "memory");
        }
    }
    sync_threads_();
}

#define LDS_BARRIER() do { asm volatile("s_waitcnt lgkmcnt(0)" ::: "memory"); __builtin_amdgcn_s_barrier(); asm volatile("" ::: "memory"); } while (0)
constexpr int XROW = 272;
constexpr int CROW = 132;
constexpr int R_XT = 0, R_UT = 35840, R_AT = 70656, R_VT = 87552, R_EP = 104448, R_CWT = 105472, R_GT = 108032, R_YT = 116736, R_AW = 125440;
constexpr int R_DUMMY_ = 0;
template <int D> __device__ __forceinline__ float dpp_row_shr(float old, float src) {
    return i2f(__builtin_amdgcn_update_dpp(f2i(old), f2i(src), 0x110 | D, 0xf, 0xf, false)); }
__device__ __forceinline__ float softplus_small_(float e) { return (e < 0.03f) ? e * (1.0f + e * (-0.5f + e * (0.33333334f + e * (-0.25f + e * 0.2f)))) : __builtin_logf(1.0f + e); }
typedef __bf16 bf16x2_t_ __attribute__((ext_vector_type(2)));
__device__ __forceinline__ unsigned cvtpk_s(float lo, float hi) { const f32x2 v = {lo, hi}; const bf16x2_t_ b = __builtin_convertvector(v, bf16x2_t_); return __builtin_bit_cast(unsigned, b); }
__device__ __forceinline__ float fast_sigmoid(float x) { return __builtin_amdgcn_rcpf(1.0f + __builtin_amdgcn_exp2f(-1.4426950408889634f * x)); }
__device__ __forceinline__ void rnn_unit(const Args& a, int l, int u, LAS unsigned char* lds) {
    const int tid = opaque_tid(), lane = tid & 63, wv = tid >> 6, fr = lane & 15, fq = lane >> 4;
    const int xcd = u & 7, jj = u >> 3, q = jj & 3, bh = (jj >> 2) * 8 + xcd, b = bh >> 3, h = bh & 7;
    const bf16* PROJ = (const bf16*)(a.ws + WS_PROJ); bf16* YCAT = (bf16*)(a.ws + WS_YCAT);
    const bf16* xr_base = PROJ + 0 * PSEG + (size_t)(b * SEQ) * PSTR + h * 128;
    const bf16* gr_base = PROJ + 1 * PSEG + (size_t)(b * SEQ) * PSTR + h * 128 + q * 32;
    bf16* y_base = YCAT + (size_t)(b * SEQ) * DMIX + h * 128 + q * 32;
    LAS unsigned char* XT = lds + R_XT; LAS unsigned char* UT = lds + R_UT;
    LAS float* AT = (LAS float*)(lds + R_AT); LAS float* VT = (LAS float*)(lds + R_VT);
    LAS unsigned char* GT = lds + R_GT; LAS unsigned char* YT = lds + R_YT;
    const int io_tk = tid >> 2, io_cq = tid & 3;
    LAS float* CB = (LAS float*)(lds + R_CWT);
    if (tid < 128) CB[tid] = a.in[7][(size_t)l * 1024 + h * 128 + tid];
    {
        LAS unsigned char* AW = lds + R_AW;
#pragma unroll
        for (int rep = 0; rep < 2; ++rep) { const int id = tid + 512 * rep, ln = id & 63, hh = (id >> 6) & 1, cb = id >> 7, i = ln & 15, tap = ln >> 4;
            u32x4 v = (u32x4){0u, 0u, 0u, 0u};
            if ((i >> 3) == hh) { const unsigned wb = pk2(a.in[6][(size_t)l * 4 * 1024 + tap * 1024 + h * 128 + cb * 16 + i], 0.f) & 0xffffu;
                const unsigned wsh = (i & 1) ? (wb << 16) : wb; const int d = (i & 7) >> 1;
                v.x = (d == 0) ? wsh : 0u; v.y = (d == 1) ? wsh : 0u; v.z = (d == 2) ? wsh : 0u; v.w = (d == 3) ? wsh : 0u; }
            *(LAS u32x4*)(AW + id * 16) = v; }
    }
    LDS_BARRIER();
    bf16x8 AWf[8][2];
#pragma unroll
    for (int cb = 0; cb < 8; ++cb)
#pragma unroll
        for (int hh = 0; hh < 2; ++hh) AWf[cb][hh] = *(const LAS bf16x8*)(lds + R_AW + ((cb * 2 + hh) * 64 + lane) * 16);
    bf16x8 Wf[4][4];
    {
        const bf16* gwp = (const bf16*)(a.ws + WS_GW) + (size_t)((l * 8 + h) * 4 + q) * 64 * 128;
#pragma unroll
        for (int nb = 0; nb < 4; ++nb)
#pragma unroll
            for (int kb = 0; kb < 4; ++kb) Wf[nb][kb] = *(const bf16x8*)(gwp + (nb * 16 + fr) * 128 + kb * 32 + fq * 8);
    }
    LAS float* EP = (LAS float*)(lds + R_EP);
    if (tid < 96) {
        const int r = tid >> 5, c = tid & 31, ch = h * 128 + q * 32 + c; float v;
        if (r == 0) v = -1.4426950408889634f * a.in[9][l * 1024 + ch];
        else if (r == 1) v = -1.4426950408889634f * a.in[11][l * 1024 + ch];
        else v = 8.0f * 1.4426950408889634f * softplus_small_(__builtin_expf(-a.in[12][l * 1024 + ch]));
        EP[r * 32 + c] = v;
    }
    u32x4 pf[4], pfh = (u32x4){0u, 0u, 0u, 0u};
#pragma unroll
    for (int i = 0; i < 4; ++i) { const int id = tid + 512 * i, row = id >> 4, cc = id & 15; pf[i] = *(const u32x4*)(xr_base + (size_t)row * PSTR + cc * 8); }
    u32x4 gpf = *(const u32x4*)(gr_base + (size_t)io_tk * PSTR + io_cq * 8);
    const int sc_ci = lane >> 4, sc_sg = lane & 15, sc_c = wv * 4 + sc_ci;
    float hcar = 0.f;
#pragma unroll
    for (int i = 0; i < 4; ++i) { const int id = tid + 512 * i, row = id >> 4, cc = id & 15; *(LAS u32x4*)(XT + (3 + row) * XROW + cc * 16) = pf[i]; }
    if (tid < 48) *(LAS u32x4*)(XT + (tid >> 4) * XROW + (tid & 15) * 16) = pfh;
    for (int tile = 0; tile < SEQ / 128; ++tile) {
        const int t0 = tile * 128;
        LDS_BARRIER();
        {
            const int t0n = (tile + 1 < SEQ / 128) ? t0 + 128 : t0;
#pragma unroll
            for (int i = 0; i < 4; ++i) { const int id = tid + 512 * i, row = id >> 4, cc = id & 15; pf[i] = *(const u32x4*)(xr_base + (size_t)(t0n + row) * PSTR + cc * 8); }
            if (tid < 48) pfh = *(const u32x4*)(xr_base + (size_t)(t0n - 3 + (tid >> 4)) * PSTR + (tid & 15) * 8);
        }
        {
            {
                unsigned short yv_[8];
#pragma unroll
                for (int e = 0; e < 8; ++e) yv_[e] = *(const LAS unsigned short*)(YT + (io_cq * 8 + e) * XROW + io_tk * 2);
                u32x4 w; w.x = yv_[0] | ((unsigned)yv_[1] << 16); w.y = yv_[2] | ((unsigned)yv_[3] << 16); w.z = yv_[4] | ((unsigned)yv_[5] << 16); w.w = yv_[6] | ((unsigned)yv_[7] << 16);
                *(u32x4*)(y_base + (size_t)((tile > 0 ? t0 - 128 : 0) + io_tk) * DMIX + io_cq * 8) = w;
            }
            const unsigned gwv[4] = {gpf.x, gpf.y, gpf.z, gpf.w};
#pragma unroll
            for (int e2 = 0; e2 < 4; ++e2) { *(LAS unsigned short*)(GT + (io_cq * 8 + 2 * e2) * XROW + io_tk * 2) = (unsigned short)(gwv[e2] & 0xffffu);
                *(LAS unsigned short*)(GT + (io_cq * 8 + 2 * e2 + 1) * XROW + io_tk * 2) = (unsigned short)(gwv[e2] >> 16); }
            const int t1 = (tile + 1 < SEQ / 128) ? t0 + 128 : t0;
            gpf = *(const u32x4*)(gr_base + (size_t)(t1 + io_tk) * PSTR + io_cq * 8);
        }
        {
            const LAS unsigned char* AW = lds + R_AW;
#pragma unroll
            for (int g4 = 0; g4 < 2; ++g4) {
                f32x4 acc[4]; bf16x8 xb[4][2], aw[4][2];
#pragma unroll
                for (int c = 0; c < 4; ++c) { const int cb = g4 * 4 + c;
                    acc[c] = *(const LAS f32x4*)(CB + cb * 16 + 4 * fq);
#pragma unroll
                    for (int hh = 0; hh < 2; ++hh) {
                        xb[c][hh] = *(const LAS bf16x8*)(XT + (wv * 16 + fr + fq) * XROW + (cb * 2 + hh) * 16);
                        aw[c][hh] = AWf[cb][hh]; } }
#pragma unroll
                for (int hh = 0; hh < 2; ++hh)
#pragma unroll
                    for (int c = 0; c < 4; ++c) acc[c] = __builtin_amdgcn_mfma_f32_16x16x32_bf16(aw[c][hh], xb[c][hh], acc[c], 0, 0, 0);
#pragma unroll
                for (int c = 0; c < 4; ++c) { const int cb = g4 * 4 + c;
                    u32x2 o; o.x = cvtpk_s(acc[c][0], acc[c][1]); o.y = cvtpk_s(acc[c][2], acc[c][3]);
                    *(LAS u32x2*)(UT + (wv * 16 + fr) * XROW + (cb * 16 + 4 * fq) * 2) = o; }
            }
        }
        asm volatile("s_waitcnt lgkmcnt(0)" ::: "memory");
        {
            f32x4 acc[4];
#pragma unroll
            for (int nb = 0; nb < 4; ++nb) acc[nb] = (f32x4){0.f, 0.f, 0.f, 0.f};
#pragma unroll
            for (int kb = 0; kb < 4; ++kb) { const bf16x8 uf = *(const LAS bf16x8*)(UT + (wv * 16 + fr) * XROW + kb * 64 + fq * 16);
#pragma unroll
                for (int nb = 0; nb < 4; ++nb) acc[nb] = __builtin_amdgcn_mfma_f32_16x16x32_bf16(Wf[nb][kb], uf, acc[nb], 0, 0, 0); }
            const int tk = wv * 16 + fr;
#pragma unroll
            for (int nb2 = 0; nb2 < 2; ++nb2) {
                const int c0 = nb2 * 16 + 4 * fq;
                const u32x2 uw = *(const LAS u32x2*)(UT + tk * XROW + (q * 32 + c0) * 2);
                const f32x4 uu = (f32x4){bflo(uw.x), bfhi(uw.x), bflo(uw.y), bfhi(uw.y)};
                const f32x4 ra = acc[nb2] + *(const LAS f32x4*)(EP + c0), rx = acc[nb2 + 2] + *(const LAS f32x4*)(EP + 32 + c0), sp8 = *(const LAS f32x4*)(EP + 64 + c0);
#pragma unroll
                for (int e = 0; e < 4; ++e) { const float r = __builtin_amdgcn_rcpf(1.0f + __builtin_amdgcn_exp2f(ra[e])), ig = __builtin_amdgcn_rcpf(1.0f + __builtin_amdgcn_exp2f(rx[e]));
                    const float av = __builtin_amdgcn_exp2f(-r * sp8[e]);
                    const float m2 = __builtin_fmaxf(__builtin_fmaf(-av, av, 1.0f), 0.f);
                    *(LAS f32x2*)(AT + ((c0 + e) * CROW + tk) * 2) = (f32x2){av, __builtin_amdgcn_sqrtf(m2) * (ig * uu[e])}; }
            }
        }
        LDS_BARRIER();
        {
            const LAS f32x4* avp = (const LAS f32x4*)(AT + (sc_c * CROW + sc_sg * 8) * 2);
            const f32x4 q0 = avp[0], q1 = avp[1], q2 = avp[2], q3 = avp[3];
            const float av[8] = {q0.x, q0.z, q1.x, q1.z, q2.x, q2.z, q3.x, q3.z}, vv[8] = {q0.y, q0.w, q1.y, q1.w, q2.y, q2.w, q3.y, q3.w};
            float hl[8], pp[8]; float hcur = 0.f, pcur = 1.f;
#pragma unroll
            for (int j = 0; j < 8; ++j) { hcur = __builtin_fmaf(av[j], hcur, vv[j]); pcur *= av[j]; hl[j] = hcur; pp[j] = pcur; }
            float P = pcur, H = hcur;
            { float Pp = dpp_row_shr<1>(1.f, P), Hp = dpp_row_shr<1>(0.f, H); H = __builtin_fmaf(P, Hp, H); P *= Pp;
              Pp = dpp_row_shr<2>(1.f, P); Hp = dpp_row_shr<2>(0.f, H); H = __builtin_fmaf(P, Hp, H); P *= Pp;
              Pp = dpp_row_shr<4>(1.f, P); Hp = dpp_row_shr<4>(0.f, H); H = __builtin_fmaf(P, Hp, H); P *= Pp;
              Pp = dpp_row_shr<8>(1.f, P); Hp = dpp_row_shr<8>(0.f, H); H = __builtin_fmaf(P, Hp, H); P *= Pp; }
            const float Pe = dpp_row_shr<1>(1.f, P), He = dpp_row_shr<1>(0.f, H);
            const float carry = __builtin_fmaf(Pe, hcar, He);
            const float hend = __builtin_fmaf(P, hcar, H);
            hcar = row_last_(hend);
            const u32x4 gq = *(const LAS u32x4*)(GT + sc_c * XROW + sc_sg * 16);
            const float gvv[8] = {bflo(gq.x), bfhi(gq.x), bflo(gq.y), bfhi(gq.y), bflo(gq.z), bfhi(gq.z), bflo(gq.w), bfhi(gq.w)};
            float yy[8];
#pragma unroll
            for (int j = 0; j < 8; ++j) { const float hv = __builtin_fmaf(pp[j], carry, hl[j]); yy[j] = hv * gvv[j] * fast_sigmoid(gvv[j]); }
            u32x4 yw_; yw_.x = pk2(yy[0], yy[1]); yw_.y = pk2(yy[2], yy[3]); yw_.z = pk2(yy[4], yy[5]); yw_.w = pk2(yy[6], yy[7]);
            *(LAS u32x4*)(YT + sc_c * XROW + sc_sg * 16) = yw_;
        }
#pragma unroll
        for (int i = 0; i < 4; ++i) { const int id = tid + 512 * i, row = id >> 4, cc = id & 15; *(LAS u32x4*)(XT + (3 + row) * XROW + cc * 16) = pf[i]; }
        if (tid < 48) *(LAS u32x4*)(XT + (tid >> 4) * XROW + (tid & 15) * 16) = pfh;
    }
    LDS_BARRIER();
    {
        unsigned short yv_[8];
#pragma unroll
        for (int e = 0; e < 8; ++e) yv_[e] = *(const LAS unsigned short*)(YT + (io_cq * 8 + e) * XROW + io_tk * 2);
        u32x4 w; w.x = yv_[0] | ((unsigned)yv_[1] << 16); w.y = yv_[2] | ((unsigned)yv_[3] << 16); w.z = yv_[4] | ((unsigned)yv_[5] << 16); w.w = yv_[6] | ((unsigned)yv_[7] << 16);
        *(u32x4*)(y_base + (size_t)(SEQ - 128 + io_tk) * DMIX + io_cq * 8) = w;
    }
    LDS_BARRIER();
}

constexpr int PROW = 528;
constexpr int R_XP = 0, R_PT = 42240;
template <int g> __device__ __forceinline__ void pool_units(const Args& a, int l, int u, LAS unsigned char* lds) {
    const int tid = opaque_tid(), lane = tid & 63, wv = tid >> 6, fr = lane & 15, fq = lane >> 4;
    const int bi = u >> 2; constexpr int win = 2 << g;
    const bf16* PROJ = (const bf16*)(a.ws + WS_PROJ); bf16* YCAT = (bf16*)(a.ws + WS_YCAT);
    LAS unsigned char* XP = lds + R_XP; LAS unsigned char* PT = lds + R_PT;
    const bf16* pw = (const bf16*)(a.ws + WS_PW) + (size_t)(l * 4 + g) * 256 * 256;
    bf16x8 Wf[2][8];
#pragma unroll
    for (int nb = 0; nb < 2; ++nb)
#pragma unroll
        for (int kb = 0; kb < 8; ++kb) Wf[nb][kb] = *(const bf16x8*)(pw + (size_t)(wv * 32 + 8 * (fr >> 2) + 4 * nb + (fr & 3)) * 256 + kb * 32 + fq * 8);
    f32x4 pb[2], ps[2];
#pragma unroll
    for (int nb = 0; nb < 2; ++nb) { const int n = wv * 32 + 8 * fq + 4 * nb;
        pb[nb] = *(const f32x4*)(a.in[14] + (size_t)l * 1024 + g * 256 + n); ps[nb] = *(const f32x4*)(a.in[15] + (size_t)l * 1024 + g * 256 + n); }
    const int ck = tid & 31, tg = tid >> 5;
    u32x4 pf[4], hal;
    const int hr = tid >> 5, hc = tid & 31;
    {
        const int tile = bi * 8, b = tile >> 6, t0 = (tile & 63) * 64;
        const bf16* xp_base = PROJ + 2 * PSEG + (size_t)(b * SEQ) * PSTR + g * 256;
#pragma unroll
        for (int i = 0; i < 4; ++i) { const int id = tid + 512 * i, row = id >> 5, cc = id & 31; pf[i] = *(const u32x4*)(xp_base + (size_t)(t0 + row) * PSTR + cc * 8); }
        const int th = t0 - 16 + hr;
        const u32x4 hv = *(const u32x4*)(xp_base + (size_t)(th < 0 ? 0 : th) * PSTR + hc * 8); hal = (th < 0) ? (u32x4){0u, 0u, 0u, 0u} : hv;
    }
#pragma unroll
    for (int i = 0; i < 4; ++i) { const int id = tid + 512 * i, row = id >> 5, cc = id & 31; *(LAS u32x4*)(XP + (16 + row) * PROW + cc * 16) = pf[i]; }
    *(LAS u32x4*)(XP + hr * PROW + hc * 16) = hal;
    u32x4 gp[4];
    {
        const int tile = bi * 8, b = tile >> 6, t0 = (tile & 63) * 64;
        const bf16* gp_base0 = PROJ + 3 * PSEG + (size_t)(b * SEQ) * PSTR + g * 256;
#pragma unroll
        for (int tb = 0; tb < 4; ++tb)
        { gp[tb] = *(const u32x4*)(gp_base0 + (size_t)(t0 + tb * 16 + fr) * PSTR + wv * 32 + 8 * fq);
                asm volatile("" : "+v"(gp[tb])); }
    }
    for (int it = 0; it < 8; ++it) {
        const int tile = bi * 8 + it, b = tile >> 6, t0 = (tile & 63) * 64;
        bf16* y_base = YCAT + (size_t)(b * SEQ) * DMIX + 1024 + g * 256;
        LDS_BARRIER();
        {
            const int tile2 = bi * 8 + ((it + 1 < 8) ? it + 1 : it), b2 = tile2 >> 6, t02 = (tile2 & 63) * 64;
            const bf16* xp_base = PROJ + 2 * PSEG + (size_t)(b2 * SEQ) * PSTR + g * 256;
#pragma unroll
            for (int i = 0; i < 4; ++i) { const int id = tid + 512 * i, row = id >> 5, cc = id & 31; pf[i] = *(const u32x4*)(xp_base + (size_t)(t02 + row) * PSTR + cc * 8); }
        }
        hal = *(const LAS u32x4*)(XP + (64 + hr) * PROW + hc * 16);
        u32x4 gpn[4];
        {
            const int tile2 = bi * 8 + ((it + 1 < 8) ? it + 1 : it), b2 = tile2 >> 6, t02 = (tile2 & 63) * 64;
            const bf16* gp_base2 = PROJ + 3 * PSEG + (size_t)(b2 * SEQ) * PSTR + g * 256;
#pragma unroll
            for (int tb = 0; tb < 4; ++tb)
                gpn[tb] = *(const u32x4*)(gp_base2 + (size_t)(t02 + tb * 16 + fr) * PSTR + wv * 32 + 8 * fq);
        }
        {
            float s[8];
#pragma unroll
            for (int e = 0; e < 8; ++e) s[e] = 0.f;
            const int r0 = tg * 4 + 16;
#pragma unroll
            for (int r = r0 - win + 1; r < r0; ++r) { const u32x4 w = *(const LAS u32x4*)(XP + r * PROW + ck * 16);
                s[0] += bflo(w.x); s[1] += bfhi(w.x); s[2] += bflo(w.y); s[3] += bfhi(w.y); s[4] += bflo(w.z); s[5] += bfhi(w.z); s[6] += bflo(w.w); s[7] += bfhi(w.w); }
#pragma unroll
            for (int i = 0; i < 4; ++i) {
                const u32x4 w = *(const LAS u32x4*)(XP + (r0 + i) * PROW + ck * 16);
                const float xv[8] = {bflo(w.x), bfhi(w.x), bflo(w.y), bfhi(w.y), bflo(w.z), bfhi(w.z), bflo(w.w), bfhi(w.w)};
                const int t = t0 + tg * 4 + i; const float inv = __builtin_amdgcn_rcpf((float)((t + 1 < win) ? (t + 1) : win));
                float p[8];
#pragma unroll
                for (int e = 0; e < 8; ++e) { s[e] += xv[e]; p[e] = __builtin_fmaf(s[e], inv, -xv[e]); }
                u32x4 o; o.x = pk2(p[0], p[1]); o.y = pk2(p[2], p[3]); o.z = pk2(p[4], p[5]); o.w = pk2(p[6], p[7]);
                *(LAS u32x4*)(PT + (tg * 4 + i) * PROW + ck * 16) = o;
                const u32x4 wo = *(const LAS u32x4*)(XP + (r0 + i - win + 1) * PROW + ck * 16);
                s[0] -= bflo(wo.x); s[1] -= bfhi(wo.x); s[2] -= bflo(wo.y); s[3] -= bfhi(wo.y); s[4] -= bflo(wo.z); s[5] -= bfhi(wo.z); s[6] -= bflo(wo.w); s[7] -= bfhi(wo.w);
            }
        }
        LDS_BARRIER();
#pragma unroll
        for (int tb = 0; tb < 4; ++tb) {
            f32x4 acc[2] = {(f32x4){0.f, 0.f, 0.f, 0.f}, (f32x4){0.f, 0.f, 0.f, 0.f}};
#pragma unroll
            for (int kb = 0; kb < 8; ++kb) { const bf16x8 pfm = *(const LAS bf16x8*)(PT + (tb * 16 + fr) * PROW + kb * 64 + fq * 16);
#pragma unroll
                for (int nb = 0; nb < 2; ++nb) acc[nb] = __builtin_amdgcn_mfma_f32_16x16x32_bf16(Wf[nb][kb], pfm, acc[nb], 0, 0, 0); }
            const int t = t0 + tb * 16 + fr;
            u32x4 o;
#pragma unroll
            for (int nb = 0; nb < 2; ++nb) {
                const unsigned g0 = nb ? gp[tb].z : gp[tb].x, g1 = nb ? gp[tb].w : gp[tb].y;
                const f32x4 gv = (f32x4){bflo(g0), bfhi(g0), bflo(g1), bfhi(g1)};
                f32x4 r = (acc[nb] + pb[nb]) * ps[nb];
#pragma unroll
                for (int e = 0; e < 4; ++e) r[e] *= gv[e] * fast_sigmoid(gv[e]);
                if (nb == 0) { o.x = pk2(r.x, r.y); o.y = pk2(r.z, r.w); } else { o.z = pk2(r.x, r.y); o.w = pk2(r.z, r.w); } }
            *(u32x4*)(y_base + (size_t)t * DMIX + wv * 32 + 8 * fq) = o;
        }
#pragma unroll
        for (int i = 0; i < 4; ++i) { const int id = tid + 512 * i, row = id >> 5, cc = id & 31; *(LAS u32x4*)(XP + (16 + row) * PROW + cc * 16) = pf[i]; }
        *(LAS u32x4*)(XP + hr * PROW + hc * 16) = hal;
#pragma unroll
        for (int tb = 0; tb < 4; ++tb)
            gp[tb] = gpn[tb];
    }
    LDS_BARRIER();
}

__device__ __forceinline__ void phase_mixer(const Args& a, int l, LAS unsigned char* lds) {
#ifndef MK_MIX
#define MK_MIX 3
#endif
#ifndef MK_DBL_RNN
#define MK_DBL_RNN 0
#endif
#ifndef MK_DBL_POOL
#define MK_DBL_POOL 0
#endif
    for (int rep = 0; rep < 1 + ((l == 0) ? MK_DBL_RNN : 0); ++rep) for (int u = blockIdx.x; u < 256; u += gridDim.x) rnn_unit(a, l, u, lds);
    for (int rep = 0; rep < 1 + ((l == 0) ? MK_DBL_POOL : 0); ++rep) for (int u = blockIdx.x; u < 256; u += gridDim.x) { const int g_ = u & 3; if (g_ == 0) pool_units<0>(a, l, u, lds); else if (g_ == 1) pool_units<1>(a, l, u, lds); else if (g_ == 2) pool_units<2>(a, l, u, lds); else pool_units<3>(a, l, u, lds); }
}
#ifndef MK_DBL_PH
#define MK_DBL_PH -1
#endif
#ifndef MK_MASK
#define MK_MASK 63
#endif
__global__ void __launch_bounds__(512, 2) mk_fwd(Args a) {
    extern __shared__ __attribute__((aligned(16))) unsigned char lds_raw[];
    LAS unsigned char* lds = (LAS unsigned char*)lds_raw;
    cg::grid_group grid = cg::this_grid();
    volatile LAS unsigned* bst = (volatile LAS unsigned*)(lds + LDS_BST_OFF);
    if (threadIdx.x < 4) bst[threadIdx.x] = 0u;
    sync_threads_();
    XcdBarrier xbar = xcd_barrier_post((unsigned*)(a.ws + WS_CTL), bst);
#define GRID_BAR() do { if (a.ph_hi - a.ph_lo > 64) grid.sync(); else xcd_barrier(xbar); } while (0)
    for (int ph = a.ph_lo; ph < a.ph_hi; ++ph) {
#if MK_DBL_PH >= 0
      for (int rep = 0; rep < ((ph == MK_DBL_PH) ? 2 : 1); ++rep) {
        if (rep) GRID_BAR();
#endif
        if (ph == 0) { if (MK_MASK & 1) phase_prep(a, lds); }
        else if (ph == 1) { if (MK_MASK & 2) phase_h0(a); }
        else {
            const int l = (ph - 2) >> 2, sub = (ph - 2) & 3;
            if (sub == 0) { if (MK_MASK & 4) {
                pg8::Gemm g{(const pg8::bf16_t*)(a.ws + WS_H), (const pg8::bf16_t*)(a.ws + WS_WIN) + (size_t)l * NPROJ * D, T, NPROJ, D};
                pg8::StaticOrder S; S.init(T, NPROJ, gridDim.x, (int)blockIdx.x);
                pg8::EpiBf16<0> E{(pg8::bf16_t*)(a.ws + WS_PROJ), PSTR, nullptr, 1024, PSEG, 1.f};
                pg8::gemm_phase<pg8::EpiBf16<0>, pg8::StaticOrder, PG8_ALIGN, PG8_SP2>(lds, g, S, E); }
            } else if (sub == 1) {
                if (MK_MASK & 8) phase_mixer(a, l, lds);
            } else if (sub == 2) { if (MK_MASK & 16) {
                pg8::Gemm g{(const pg8::bf16_t*)(a.ws + WS_YCAT), (const pg8::bf16_t*)(a.ws + WS_WOUT) + (size_t)l * D * DMIX, T, D, DMIX};
                pg8::StaticOrder S; S.init(T, D, gridDim.x, (int)blockIdx.x);
                pg8::EpiBf16<0> E{(pg8::bf16_t*)(a.ws + WS_Y), D, nullptr, 0, 0, 1.f};
                pg8::gemm_phase<pg8::EpiBf16<0>, pg8::StaticOrder, PG8_ALIGN, PG8_SP2>(lds, g, S, E); }
            } else {
                if (MK_MASK & 32) { if (l == 0) phase_post<0>(a); else phase_post<1>(a); }
            }
        }
#if MK_DBL_PH >= 0
      }
#endif
        if (ph + 1 < a.ph_hi) GRID_BAR();
    }
}

#if defined(__HIP_DEVICE_COMPILE__)
#pragma clang attribute pop
#endif

extern "C" void kernel_launch(void* const* d_in, const int* in_sizes, int n_in, void* d_out, int out_size, void* d_ws, size_t ws_size, hipStream_t stream) {
    static int grid = 0;
    if (grid == 0) {
        if (n_in != 18 || in_sizes[0] != T * D || out_size != T * D || ws_size < WS_END) {
            fprintf(stderr, "kernel_launch: unexpected shapes (n_in %d, in0 %d, out %d, ws %zu); nothing launched\n", n_in, n_in > 0 ? in_sizes[0] : -1, out_size, ws_size); grid = -1; return; }
        int dev = 0, cus = 0, per_cu = 0;
        if (hipGetDevice(&dev) != hipSuccess || hipDeviceGetAttribute(&cus, hipDeviceAttributeMultiprocessorCount, dev) != hipSuccess) { grid = -1; return; }
        if (hipFuncSetAttribute((const void*)mk_fwd, hipFuncAttributeMaxDynamicSharedMemorySize, LDS_BYTES) != hipSuccess) { fprintf(stderr, "kernel_launch: hipFuncSetAttribute failed\n"); grid = -1; return; }
        if (hipOccupancyMaxActiveBlocksPerMultiprocessor(&per_cu, (const void*)mk_fwd, 512, LDS_BYTES) != hipSuccess || per_cu < 1) { fprintf(stderr, "kernel_launch: occupancy query says %d blocks per CU\n", per_cu); per_cu = 1; }
        (void)hipGetLastError();
        grid = cus;
    }
    if (grid < 0) return;
    Args a{};
    for (int i = 0; i < 18; ++i) a.in[i] = (const float*)d_in[i];
    a.out = (float*)d_out; a.ws = (unsigned char*)d_ws;
    if (hipMemsetAsync((char*)d_ws + WS_CTL, 0, CTL_BYTES, stream) != hipSuccess) { fprintf(stderr, "kernel_launch: memset of the barrier words failed\n"); return; }
#if MK_N_LAUNCHES == 1
    a.ph_lo = 0; a.ph_hi = NPH;
    void* args[] = {&a};
    const hipError_t e = hipLaunchCooperativeKernel((const void*)mk_fwd, dim3(grid), dim3(512), args, LDS_BYTES, stream);
    if (e != hipSuccess) fprintf(stderr, "kernel_launch: cooperative launch failed: %s (grid %d)\n", hipGetErrorString(e), grid);
#else
    for (int ph = 0; ph < NPH; ++ph) {
        a.ph_lo = ph; a.ph_hi = ph + 1;
        hipLaunchKernelGGL(mk_fwd, dim3(grid), dim3(512), LDS_BYTES, stream, a);
    }
#endif
}
```
